# Optimizing an MI355X kernel written in HIP

```python
import jax
import jax.numpy as jnp
from jax import lax
import numpy as np

D_MODEL = 1024
BATCH = 4
SEQ = 8192
DEPTH = 2

HEAD_DIM = 64
BLOCK = 128
SWA_Q_HEADS = 8
SWA_KV_HEADS = 2
SWA_GROUP = SWA_Q_HEADS // SWA_KV_HEADS
WINDOW = 128
SWA_WIDTH = SWA_Q_HEADS * HEAD_DIM
KV_WIDTH = SWA_KV_HEADS * HEAD_DIM
LRU_WIDTH = D_MODEL // 4
LRU_BLOCKS = 8
LRU_BLOCK_W = LRU_WIDTH // LRU_BLOCKS
CONV_WIDTH = 4
LRU_C = 8.0
FOX_HEADS = 4
FOX_WIDTH = FOX_HEADS * HEAD_DIM
D_MIX = SWA_WIDTH + LRU_WIDTH + FOX_WIDTH
OFF_KA = SWA_WIDTH
OFF_VA = OFF_KA + KV_WIDTH
OFF_XB = OFF_VA + KV_WIDTH
OFF_GB = OFF_XB + LRU_WIDTH
OFF_QC = OFF_GB + LRU_WIDTH
OFF_KC = OFF_QC + FOX_WIDTH
OFF_VC = OFF_KC + FOX_WIDTH
OFF_FC = OFF_VC + FOX_WIDTH
IN_COLS = OFF_FC + FOX_HEADS
IN_SPLITS = (OFF_KA, OFF_VA, OFF_XB, OFF_GB, OFF_QC, OFF_KC, OFF_VC, OFF_FC)
N_GROUPS = 4
EXPERTS_PER_GROUP = 4
N_EXPERTS = N_GROUPS * EXPERTS_PER_GROUP
TOP_K = 2
D_EXPERT = 256
EPS = 1e-6
F32 = jnp.float32

kernel_name = 'hymba_style_hybrid_swa_rglru_fox_hmoe_adaln'


def rms_normalize(x):
    xf = x.astype(F32)
    return xf * lax.rsqrt(jnp.mean(xf * xf, axis=-1, keepdims=True) + EPS)


def rms_norm(x, gain):
    return (rms_normalize(x) * gain.astype(F32)).astype(x.dtype)


def modulate(h, shift, scale):
    return h * (1.0 + scale[:, None, :]) + shift[:, None, :]


def alibi_slopes(n_heads):
    return jnp.exp2(-8.0 * jnp.arange(1, n_heads + 1, dtype=F32) / n_heads)


def sliding_window_sink_attention(q, k, v, sinks):
    b, s, _, dh = q.shape
    nb = s // BLOCK
    qb = q.reshape(b, nb, BLOCK, SWA_KV_HEADS, SWA_GROUP, dh)

    def band(t):
        tb = t.reshape(b, nb, BLOCK, SWA_KV_HEADS, dh)
        prev = jnp.pad(tb[:, :-1], ((0, 0), (1, 0), (0, 0), (0, 0), (0, 0)))
        return jnp.concatenate([prev, tb], axis=2)

    kb, vb = band(k), band(v)
    scores = jnp.einsum('bnqhgd,bnkhd->bnhgqk', qb, kb).astype(F32) * (dh ** -0.5)
    q_pos = BLOCK + jnp.arange(BLOCK)
    k_pos = jnp.arange(2 * BLOCK)
    dist = q_pos[:, None] - k_pos[None, :]
    in_window = (dist >= 0) & (dist < WINDOW)
    block_exists = (jnp.arange(nb)[:, None, None] > 0) | (k_pos[None, None, :] >= BLOCK)
    valid = in_window[None] & block_exists
    slopes = alibi_slopes(SWA_Q_HEADS).reshape(SWA_KV_HEADS, SWA_GROUP)
    scores = scores - slopes[:, :, None, None] * dist.astype(F32)
    scores = jnp.where(valid[None, :, None, None], scores, -jnp.inf)
    sink = jnp.broadcast_to(sinks.astype(F32).reshape(SWA_KV_HEADS, SWA_GROUP, 1, 1),
                            scores.shape[:-1] + (1,))
    probs = jax.nn.softmax(jnp.concatenate([scores, sink], axis=-1), axis=-1)[..., :-1]
    out = jnp.einsum('bnhgqk,bnkhd->bnqhgd', probs.astype(v.dtype), vb)
    return out.reshape(b, s, SWA_Q_HEADS * dh)


def causal_depthwise_conv(x, w, bias):
    s = x.shape[1]
    xp = jnp.pad(x, ((0, 0), (CONV_WIDTH - 1, 0), (0, 0)))
    y = bias
    for k in range(CONV_WIDTH):
        y = y + xp[:, k:k + s] * w[k]
    return y


def rg_lru(x, w_a, b_a, w_x, b_x, lam):
    b, s, w = x.shape
    xb = x.reshape(b, s, LRU_BLOCKS, LRU_BLOCK_W)
    gate_a = jnp.einsum('bsnc,ncd->bsnd', xb, w_a).reshape(b, s, w) + b_a
    gate_x = jnp.einsum('bsnc,ncd->bsnd', xb, w_x).reshape(b, s, w) + b_x
    r = jax.nn.sigmoid(gate_a.astype(F32))
    i = jax.nn.sigmoid(gate_x.astype(F32))
    log_a = -LRU_C * r * jax.nn.softplus(-lam.astype(F32))
    a = jnp.exp(log_a)
    u = jnp.sqrt(-jnp.expm1(2.0 * log_a)) * (i * x.astype(F32))

    def combine(left, right):
        a_l, u_l = left
        a_r, u_r = right
        return a_l * a_r, a_r * u_l + u_r

    _, hs = lax.associative_scan(combine, (a, u), axis=1)
    return hs.astype(x.dtype)


def forgetting_attention(q, k, v, log_f):
    b, s, h, dh = q.shape
    nb = s // BLOCK
    cum = jnp.cumsum(log_f, axis=1).transpose(0, 2, 1)
    q_blocks = q.reshape(b, nb, BLOCK, h, dh).transpose(1, 0, 2, 3, 4)
    cum_q = cum.reshape(b, h, nb, BLOCK).transpose(2, 0, 1, 3)
    k_pos = jnp.arange(s)

    def attend_block(args):
        n, q_n, cq_n = args
        logits = jnp.einsum('bqhd,bkhd->bhqk', q_n, k).astype(F32) * (dh ** -0.5)
        logits = logits + (cq_n[..., :, None] - cum[:, :, None, :])
        q_pos = n * BLOCK + jnp.arange(BLOCK)
        causal = k_pos[None, :] <= q_pos[:, None]
        logits = jnp.where(causal, logits, -jnp.inf)
        probs = jax.nn.softmax(logits, axis=-1)
        return jnp.einsum('bhqk,bkhd->bqhd', probs.astype(v.dtype), v)

    out = lax.map(attend_block, (jnp.arange(nb), q_blocks, cum_q))
    return out.transpose(1, 0, 2, 3, 4).reshape(b, s, h * dh)


def hybrid_mixer(h, w_in, w_out, out_gain, sinks, conv_w, conv_b,
                 lru_wa, lru_ba, lru_wx, lru_bx, lru_lam, fox_bf):
    b, s, _ = h.shape
    proj = jnp.einsum('bsd,de->bse', h, w_in)
    q_a, k_a, v_a, x_b, g_b, q_c, k_c, v_c, f_c = jnp.split(proj, IN_SPLITS, axis=-1)
    y_a = sliding_window_sink_attention(
        q_a.reshape(b, s, SWA_Q_HEADS, HEAD_DIM),
        k_a.reshape(b, s, SWA_KV_HEADS, HEAD_DIM),
        v_a.reshape(b, s, SWA_KV_HEADS, HEAD_DIM), sinks)
    x_conv = causal_depthwise_conv(x_b, conv_w, conv_b)
    y_b = rg_lru(x_conv, lru_wa, lru_ba, lru_wx, lru_bx, lru_lam) * jax.nn.gelu(g_b)
    log_f = jax.nn.log_sigmoid(f_c.astype(F32) + fox_bf.astype(F32))
    y_c = forgetting_attention(
        q_c.reshape(b, s, FOX_HEADS, HEAD_DIM),
        k_c.reshape(b, s, FOX_HEADS, HEAD_DIM),
        v_c.reshape(b, s, FOX_HEADS, HEAD_DIM), log_f)
    y = jnp.concatenate([rms_normalize(y_a), rms_normalize(y_b), rms_normalize(y_c)], axis=-1)
    y = (y * out_gain.astype(F32)).astype(h.dtype)
    return jnp.einsum('bse,ed->bsd', y, w_out)


def hierarchical_moe(h, w_rg, b_rg, w_re, b_re, w_gate, w_up, w_down):
    b, s, _ = h.shape
    group_logits = (jnp.einsum('bsd,dg->bsg', h, w_rg) + b_rg).astype(F32)
    group_prob = jax.nn.softmax(group_logits, axis=-1)
    group_p, group_idx = lax.top_k(group_prob, 1)
    expert_logits = (jnp.einsum('bsd,de->bse', h, w_re) + b_re).astype(F32)
    expert_logits = expert_logits.reshape(b, s, N_GROUPS, EXPERTS_PER_GROUP)
    in_group = jnp.take_along_axis(expert_logits, group_idx[..., None], axis=2)[:, :, 0]
    expert_prob = jax.nn.softmax(in_group, axis=-1)
    top_p, top_local = lax.top_k(expert_prob, TOP_K)
    weights = group_p * top_p / jnp.sum(top_p, axis=-1, keepdims=True)
    expert_idx = group_idx * EXPERTS_PER_GROUP + top_local
    combine = jnp.sum(jax.nn.one_hot(expert_idx, N_EXPERTS, dtype=F32) * weights[..., None], axis=-2)
    combine = combine.astype(h.dtype)
    y = jnp.zeros_like(h)
    for e in range(N_EXPERTS):
        hidden = jax.nn.silu(h @ w_gate[e]) * (h @ w_up[e])
        y = y + combine[..., e:e + 1] * (hidden @ w_down[e])
    return y


def setup_inputs(seed: int = 0) -> dict:
    key = jax.random.key(seed)
    ks = jax.random.split(key, 26)
    L, D = DEPTH, D_MODEL

    def nrm(k, shape, scale):
        return scale * jax.random.normal(k, shape, F32)

    gate_offset = jnp.concatenate([jnp.zeros((2 * D,), F32), jnp.ones((D,), F32),
                                   jnp.zeros((2 * D,), F32), jnp.ones((D,), F32)])
    u = jax.random.uniform(ks[16], (L, LRU_WIDTH), F32, 0.9, 0.999)
    root = u ** (1.0 / LRU_C)
    lru_lam = jnp.log(root) - jnp.log1p(-root)
    return {
        'x': nrm(ks[0], (BATCH, SEQ, D), 1.0),
        'c': nrm(ks[1], (BATCH, D), 1.0),
        'w_mod': nrm(ks[2], (L, D, 6 * D), 0.25 * D ** -0.5),
        'b_mod': nrm(ks[3], (L, 6 * D), 0.1) + gate_offset,
        'norm_mix': 1.0 + nrm(ks[4], (L, D), 0.1),
        'norm_ffn': 1.0 + nrm(ks[5], (L, D), 0.1),
        'w_in': nrm(ks[6], (L, D, IN_COLS), D ** -0.5),
        'w_out': nrm(ks[7], (L, D_MIX, D), D_MIX ** -0.5),
        'out_gain': 1.0 + nrm(ks[8], (L, D_MIX), 0.1),
        'sinks': nrm(ks[9], (L, SWA_Q_HEADS), 0.5),
        'conv_w': nrm(ks[10], (L, CONV_WIDTH, LRU_WIDTH), CONV_WIDTH ** -0.5),
        'conv_b': nrm(ks[11], (L, LRU_WIDTH), 0.02),
        'lru_wa': nrm(ks[12], (L, LRU_BLOCKS, LRU_BLOCK_W, LRU_BLOCK_W), LRU_BLOCK_W ** -0.5),
        'lru_ba': nrm(ks[13], (L, LRU_WIDTH), 0.02),
        'lru_wx': nrm(ks[14], (L, LRU_BLOCKS, LRU_BLOCK_W, LRU_BLOCK_W), LRU_BLOCK_W ** -0.5),
        'lru_bx': nrm(ks[15], (L, LRU_WIDTH), 0.02),
        'lru_lam': lru_lam,
        'fox_bf': jax.random.uniform(ks[17], (L, FOX_HEADS), F32, 1.0, 5.0),
        'w_router_group': nrm(ks[18], (L, D, N_GROUPS), D ** -0.5),
        'b_router_group': nrm(ks[19], (L, N_GROUPS), 0.01),
        'w_router_expert': nrm(ks[20], (L, D, N_EXPERTS), D ** -0.5),
        'b_router_expert': nrm(ks[21], (L, N_EXPERTS), 0.01),
        'w_gate': nrm(ks[22], (L, N_EXPERTS, D, D_EXPERT), D ** -0.5),
        'w_up': nrm(ks[23], (L, N_EXPERTS, D, D_EXPERT), D ** -0.5),
        'w_down': nrm(ks[24], (L, N_EXPERTS, D_EXPERT, D), D_EXPERT ** -0.5),
        'norm_final': 1.0 + nrm(ks[25], (D,), 0.1),
    }


def reference(x, c, w_mod, b_mod, norm_mix, norm_ffn, w_in, w_out, out_gain, sinks,
              conv_w, conv_b, lru_wa, lru_ba, lru_wx, lru_bx, lru_lam, fox_bf,
              w_router_group, b_router_group, w_router_expert, b_router_expert,
              w_gate, w_up, w_down, norm_final):
    c_act = jax.nn.silu(c)
    for l in range(DEPTH):
        mod = c_act @ w_mod[l] + b_mod[l]
        shift_m, scale_m, gate_m, shift_f, scale_f, gate_f = jnp.split(mod, 6, axis=-1)
        h = modulate(rms_norm(x, norm_mix[l]), shift_m, scale_m)
        x = x + gate_m[:, None, :] * hybrid_mixer(
            h, w_in[l], w_out[l], out_gain[l], sinks[l], conv_w[l], conv_b[l],
            lru_wa[l], lru_ba[l], lru_wx[l], lru_bx[l], lru_lam[l], fox_bf[l])
        h = modulate(rms_norm(x, norm_ffn[l]), shift_f, scale_f)
        x = x + gate_f[:, None, :] * hierarchical_moe(
            h, w_router_group[l], b_router_group[l], w_router_expert[l], b_router_expert[l],
            w_gate[l], w_up[l], w_down[l])
    return rms_norm(x, norm_final)
```

```cpp
#include <hip/hip_runtime.h>
#include <hip/hip_bf16.h>
#include <cstdio>
#include <cstdint>

#define GAS __attribute__((address_space(1)))
#define LAS __attribute__((address_space(3)))
typedef unsigned short bf16_t;
typedef short bf16x8 __attribute__((ext_vector_type(8)));
typedef short s16x4 __attribute__((ext_vector_type(4)));
typedef float f32x2 __attribute__((ext_vector_type(2)));
typedef float f32x4 __attribute__((ext_vector_type(4)));
typedef float f32x16 __attribute__((ext_vector_type(16)));
typedef unsigned u32x2 __attribute__((ext_vector_type(2)));
typedef unsigned u32x4 __attribute__((ext_vector_type(4)));
typedef __bf16 bf16x2_t __attribute__((ext_vector_type(2)));

#ifndef PH_MASK
#define PH_MASK 0xFFFFFFFFu
#endif
#define PH(n) ((PH_MASK >> (n)) & 1u)
constexpr int D = 1024, NB = 4, SEQ = 8192, T = NB * SEQ, DEPTH = 2;
constexpr int IN_COLS = 2052, NPROJ = 2048;
constexpr int C_QA = 0, C_KA = 512, C_VA = 640, C_XB = 768, C_GB = 1024, C_QC = 1280, C_KC = 1536, C_VC = 1792;
constexpr int NCLS = 24, LCAP = 32768;
constexpr float EPS = 1e-6f;
constexpr float LOG2E = 1.4426950408889634f;
constexpr float C2 = 0.125f * 1.4426950408889634f;

constexpr size_t MiB = 1u << 20;
constexpr size_t WS_CTL = 0, CTL_ZERO_BYTES = 1 * MiB;
constexpr size_t WS_MOD = 1 * MiB;
constexpr size_t WS_CUM = WS_MOD + 256 * 1024;
constexpr size_t WS_CTOT = WS_CUM + 512 * 1024;
constexpr size_t WS_LRUA = 2 * MiB;
constexpr size_t WS_LRUH = WS_LRUA + 512 * 1024;
constexpr size_t WS_LIST = 4 * MiB;
constexpr size_t WS_WIN = 16 * MiB;
constexpr size_t WS_WOUT = 24 * MiB;
constexpr size_t WS_WGU = 28 * MiB;
constexpr size_t WS_WDP = 60 * MiB;
constexpr size_t WS_XA = 108 * MiB;
constexpr size_t WS_H = 236 * MiB;
constexpr size_t WS_PROJ = 300 * MiB;
constexpr size_t WS_Y = 428 * MiB;
constexpr size_t WS_END = 492 * MiB;
constexpr int CW_BAR = 4096;
constexpr int CW_CNT = 16384;

struct LEntry { int tok; float w0, w1; int pad; };

constexpr int RING_BYTES = 131072;
constexpr int LDSCTL_OFF = RING_BYTES;
constexpr int MISC_OFF = LDSCTL_OFF + 320;
constexpr int TT_OFF = LDSCTL_OFF + 1024;
constexpr int LDS_BYTES = 147456;

__device__ __forceinline__ unsigned cvtpk(float lo, float hi) { f32x2 v = {lo, hi}; bf16x2_t b = __builtin_convertvector(v, bf16x2_t); return __builtin_bit_cast(unsigned, b); }
__device__ __forceinline__ float bf2f(bf16_t v) { return __builtin_bit_cast(float, (unsigned)v << 16); }
template <int M> __device__ __forceinline__ float shx(float v) {
    return __int_as_float(__builtin_amdgcn_ds_swizzle(__float_as_int(v), (M << 10) | 0x1f));
}
__device__ __forceinline__ float wave_sum(float v) {
    v += shx<1>(v); v += shx<2>(v); v += shx<4>(v); v += shx<8>(v); v += shx<16>(v);
    auto rr = __builtin_amdgcn_permlane32_swap(__float_as_uint(v), __float_as_uint(v), false, false);
    return __uint_as_float(rr[0]) + __uint_as_float(rr[1]);
}
__device__ __forceinline__ float fast_exp(float x) { return __builtin_amdgcn_exp2f(x * LOG2E); }
__device__ __forceinline__ float sigmoidf_(float x) { return __builtin_amdgcn_rcpf(1.f + fast_exp(-x)); }
__device__ __forceinline__ float gelu_tanh(float x) {
    const float u = 0.7978845608028654f * (x + 0.044715f * x * x * x);
    const float e = fast_exp(2.f * u);
    const float th = 1.f - 2.f * __builtin_amdgcn_rcpf(e + 1.f);
    return 0.5f * x * (1.f + th);
}
#define LDS_WAIT() asm volatile("s_waitcnt lgkmcnt(0)" ::: "memory")
#define VM_WAIT() asm volatile("s_waitcnt vmcnt(0)" ::: "memory")

namespace pg8 {
constexpr int BM = 256, BK = 64, HALF = 128, HTB = HALF * BK * 2, STAGE_BYTES = 8 * HTB, NXCD = 8, WGM = 8;
__host__ __device__ __forceinline__ int lds_byte(int r, int c) { const int st = (r >> 4) * 2 + (c >> 5), rr = r & 15, cc = c & 31, ob = rr * 64 + cc * 2; return st * 1024 + (ob ^ (((ob >> 9) & 1) << 5)); }
__host__ __device__ __forceinline__ void stage_rc(int b, int& R, int& C) { const int st = b / 1024, sb = b % 1024, swz = sb ^ (((sb >> 9) & 1) << 5); R = (st >> 1) * 16 + swz / 64; C = (st & 1) * 32 + (swz % 64) / 2; }
__host__ __device__ __forceinline__ int perm32(int rho) { const int n = rho >> 4, i = rho & 15; return 8 * (i >> 2) + 4 * n + (i & 3); }

struct GUnit { int a0; const char* bb; int e0, e1, e2, e3; };

__device__ __forceinline__ int xcd_remap(int L, int nwg) {
    const int q = nwg / NXCD, r = nwg % NXCD, xcd = L % NXCD, off = L / NXCD;
    return (xcd < r ? xcd * (q + 1) : r * (q + 1) + (xcd - r) * q) + off;
}

struct DenseOrder {
    int nM, nN, nwg, G, c; const char* Bt; unsigned pitchB;
    __device__ __forceinline__ void init(int M, int N, int G_, int c_, const void* Bt_, unsigned pitchB_) { nM = M / BM; nN = N / BM; nwg = nM * nN; G = G_; c = c_; Bt = (const char*)Bt_; pitchB = pitchB_; }
    __device__ __forceinline__ bool next(int i, GUnit& u) const {
        const long L = (long)i * G + c; if (L >= nwg) return false;
        const int wgid = xcd_remap((int)L, nwg);
        const int nig = WGM * nN, gid = wgid / nig, fm = gid * WGM, gsz = (nM - fm) < WGM ? (nM - fm) : WGM;
        const int pm = fm + ((wgid % nig) % gsz), pn = (wgid % nig) / gsz;
        u.a0 = pm * BM; u.bb = Bt + (size_t)pn * BM * pitchB; u.e0 = pm; u.e1 = pn; u.e2 = 0; u.e3 = 0; return true;
    }
    __device__ __forceinline__ unsigned arow(const GUnit& u, int r) const { return (unsigned)(u.a0 + r); }
};

#define PG8_SA(b, h) (((b) * 2 + (h)) * HTB)
#define PG8_SB(b, h) ((4 + (b) * 2 + (h)) * HTB)
#define PG8_STG(bufoff, gptr, v0, v1) do { \
        __builtin_amdgcn_global_load_lds((const unsigned*)((const char*)(gptr) + (v0)), (LAS unsigned*)(lds + (bufoff) + ldsw), 16, 0, 0); \
        __builtin_amdgcn_global_load_lds((const unsigned*)((const char*)(gptr) + (v1)), (LAS unsigned*)(lds + (bufoff) + ldsw + 8192), 16, 0, 0); } while (0)
#define PG8_STGA(bufoff, kb, vo) PG8_STG(bufoff, Abase + (kb), (vo)[0], (vo)[1])
#define PG8_STGB(bufoff, bp) PG8_STG(bufoff, bp, voffB[0], voffB[1])
#define PG8_LDA(dst, b, h) do { _Pragma("unroll") for (int m = 0; m < 4; ++m) _Pragma("unroll") for (int k = 0; k < 2; ++k) dst[m][k] = *(const LAS bf16x8*)(lds + PG8_SA(b, h) + aoff + m * 2048 + k * 1024); } while (0)
#define PG8_LDB(dst, b, h) do { _Pragma("unroll") for (int n = 0; n < 2; ++n) _Pragma("unroll") for (int k = 0; k < 2; ++k) dst[n][k] = *(const LAS bf16x8*)(lds + PG8_SB(b, h) + boff + n * 2048 + k * 1024); } while (0)
#define PG8_MMA(ai, bj, At, Bt) do { __builtin_amdgcn_s_setprio(1); _Pragma("unroll") for (int m = 0; m < 4; ++m) _Pragma("unroll") for (int n = 0; n < 2; ++n) _Pragma("unroll") for (int k = 0; k < 2; ++k) \
        acc[ai][bj][m][n] = __builtin_amdgcn_mfma_f32_16x16x32_bf16(Bt[n][k], At[m][k], acc[ai][bj][m][n], 0, 0, 0); __builtin_amdgcn_s_setprio(0); } while (0)
#define PG8_WAIT_V(n) asm volatile("s_waitcnt vmcnt(" #n ")" ::: "memory")
#define PG8_WAIT_L(n) asm volatile("s_waitcnt lgkmcnt(" #n ")" ::: "memory")
#define PG8_BAR __builtin_amdgcn_s_barrier()
#define PG8_SCHED __builtin_amdgcn_sched_barrier(0)

template <class Epi, class Sched, bool ALIGN_EPI>
__device__ __forceinline__ void gemm_phase(const int tid, LAS unsigned char* lds, const char* Abase, unsigned pitchA, unsigned pitchB, int K, const Sched& S, const Epi& E) {
    const int wid = __builtin_amdgcn_readfirstlane(tid >> 6), lane = tid & 63, wr = wid >> 2, wc = wid & 3, fr = lane & 15, fq = lane >> 4;
    const int nt = K / BK;
    int RA[2]; unsigned cA2[2], voffB[2];
#pragma unroll
    for (int i = 0; i < 2; ++i) { int R, C; stage_rc(tid * 16 + i * 8192, R, C); const int Rb = Epi::PERM ? ((R & ~31) + perm32(R & 31)) : R;
        RA[i] = R; cA2[i] = (unsigned)C * 2u; voffB[i] = (unsigned)Rb * pitchB + (unsigned)C * 2u; }
    const unsigned hstepB = (unsigned)HALF * pitchB;
    const unsigned ldsw = (unsigned)wid * 1024u;
    const int aoff = lds_byte(wr * 64 + fr, fq * 8), boff = lds_byte(wc * 32 + fr, fq * 8);
    GUnit cur, nxt; int ui = 0;
    if (!S.next(0, cur)) return;
    f32x4 acc[2][2][4][2];
#pragma unroll
    for (int a = 0; a < 2; ++a)
#pragma unroll
        for (int b = 0; b < 2; ++b)
#pragma unroll
            for (int m = 0; m < 4; ++m)
#pragma unroll
                for (int n = 0; n < 2; ++n) acc[a][b][m][n] = (f32x4){0.f, 0.f, 0.f, 0.f};
    bf16x8 At[4][2], B0[2][2], B1[2][2];
    unsigned voA[2][2];
#pragma unroll
    for (int h = 0; h < 2; ++h)
#pragma unroll
        for (int i = 0; i < 2; ++i) voA[h][i] = S.arow(cur, h * HALF + RA[i]) * pitchA + cA2[i];
    const char* cB = cur.bb;
    const unsigned kstep = BK * 2;
    PG8_STGB(PG8_SB(0, 0), cB); PG8_STGB(PG8_SB(0, 1), cB + hstepB); PG8_STGA(PG8_SA(0, 0), 0, voA[0]); PG8_STGA(PG8_SA(0, 1), 0, voA[1]);
    if (wr == 1) PG8_BAR;
    PG8_WAIT_V(2); PG8_BAR;
    PG8_STGB(PG8_SB(1, 0), cB + kstep); PG8_STGA(PG8_SA(1, 0), kstep, voA[0]); PG8_STGB(PG8_SB(1, 1), cB + hstepB + kstep);
    PG8_WAIT_V(6); PG8_BAR;
    for (;;) {
        const bool has_next = S.next(ui + 1, nxt);
        const char* nB = has_next ? nxt.bb : cB;
        for (int t = 0; t < nt; t += 2) {
            const bool last = (t == nt - 2);
            const unsigned kb1 = (unsigned)(t + 1) * kstep;
            const unsigned kb2 = last ? 0u : (unsigned)(t + 2) * kstep, kb3 = kb2 + kstep;
            const char* b2 = last ? nB : cB + (size_t)(t + 2) * kstep; const char* b3 = b2 + kstep;
            PG8_LDB(B0, 0, 0); PG8_LDB(B1, 0, 1); PG8_SCHED; PG8_LDA(At, 0, 0); PG8_STGA(PG8_SA(1, 1), kb1, voA[1]);
            if (last && has_next) {
#pragma unroll
                for (int h = 0; h < 2; ++h)
#pragma unroll
                    for (int i = 0; i < 2; ++i) voA[h][i] = S.arow(nxt, h * HALF + RA[i]) * pitchA + cA2[i]; }
            PG8_WAIT_V(8); PG8_WAIT_L(0); PG8_BAR; PG8_MMA(0, 0, At, B0); PG8_MMA(0, 1, At, B1); PG8_BAR; PG8_SCHED;
            PG8_LDA(At, 0, 1); PG8_STGB(PG8_SB(0, 0), b2); PG8_STGB(PG8_SB(0, 1), b2 + hstepB); PG8_STGA(PG8_SA(0, 0), kb2, voA[0]);
            PG8_WAIT_V(8); PG8_WAIT_L(0); PG8_BAR; PG8_MMA(1, 0, At, B0); PG8_MMA(1, 1, At, B1); PG8_BAR; PG8_SCHED;
            PG8_LDB(B0, 1, 0); PG8_LDB(B1, 1, 1); PG8_SCHED; PG8_LDA(At, 1, 0); PG8_STGA(PG8_SA(0, 1), kb2, voA[1]);
            PG8_WAIT_V(8); PG8_WAIT_L(0); PG8_BAR; PG8_MMA(0, 0, At, B0); PG8_MMA(0, 1, At, B1); PG8_BAR; PG8_SCHED;
            PG8_LDA(At, 1, 1); PG8_STGB(PG8_SB(1, 0), b3); PG8_STGB(PG8_SB(1, 1), b3 + hstepB); PG8_STGA(PG8_SA(1, 0), kb3, voA[0]);
            PG8_WAIT_V(8); PG8_WAIT_L(0); PG8_BAR; PG8_MMA(1, 0, At, B0); PG8_MMA(1, 1, At, B1); PG8_BAR; PG8_SCHED;
        }
        if constexpr (ALIGN_EPI) { if (wr == 0) PG8_BAR; }
        E(acc, cur, wr, wc, fr, fq);
        if (!has_next) break;
#pragma unroll
        for (int a = 0; a < 2; ++a)
#pragma unroll
            for (int b = 0; b < 2; ++b)
#pragma unroll
                for (int m = 0; m < 4; ++m)
#pragma unroll
                    for (int n = 0; n < 2; ++n) acc[a][b][m][n] = (f32x4){0.f, 0.f, 0.f, 0.f};
        cur = nxt; cB = nB; ++ui;
        if constexpr (ALIGN_EPI) { if (wr == 1) PG8_BAR; }
    }
    PG8_WAIT_V(0);
    if constexpr (!ALIGN_EPI) { if (wr == 0) PG8_BAR; }
    PG8_BAR;
}
}

#define XB_TMO      128
#define XB_XCNT(j)  (256  + 64 * (j))
#define XB_XSUB(j)  (1280 + 64 * (j))
#define XB_XGEN(j)  (2304 + 64 * (j))
#define XB_TOP      3328
#define XB_TOPGEN   3392
#define XCD_BAR_WORDS 3456
#define XB_SPIN_CAP (1u << 18)
__device__ __forceinline__ unsigned xb_ld(unsigned* p)              { return __hip_atomic_load(p, __ATOMIC_RELAXED, __HIP_MEMORY_SCOPE_AGENT); }
__device__ __forceinline__ unsigned xb_add(unsigned* p, unsigned v) { return __hip_atomic_fetch_add(p, v, __ATOMIC_RELAXED, __HIP_MEMORY_SCOPE_AGENT); }
__device__ __forceinline__ unsigned xb_xcc_id() { return (unsigned)__builtin_amdgcn_s_getreg((3 << 11) | 20) & 0xFu; }
#define XB_SPIN(cond, bar) do { unsigned _sp = 0; while (cond) { __builtin_amdgcn_s_sleep(1); \
    if ((++_sp & 255u) == 0u) { if (xb_ld(&(bar)[XB_TMO])) break; if (_sp > XB_SPIN_CAP) { atomicAdd(&(bar)[XB_TMO], 1u); break; } } } } while (0)
struct XcdBarrier { unsigned* bar; unsigned x; volatile LAS unsigned* st; };
__device__ __forceinline__ XcdBarrier xcd_barrier_post(unsigned* bar, volatile LAS unsigned* st) {
    XcdBarrier b; b.bar = bar; b.x = xb_xcc_id(); b.st = st;
    if (threadIdx.x == 0) (void)xb_add(&bar[XB_XCNT(b.x)], 1u);
    return b;
}
__device__ __forceinline__ void xcd_barrier_complete(unsigned* bar, unsigned x, unsigned& nloc, unsigned& nx) {
    const unsigned G = gridDim.x * gridDim.y * gridDim.z;
    unsigned sum, cnt, mine, sp = 0u;
    for (;;) {
        sum = 0u; cnt = 0u; mine = 0u;
#pragma unroll
        for (unsigned j = 0; j < 16; ++j) { const unsigned c = xb_ld(&bar[XB_XCNT(j)]); sum += c; cnt += (c > 0u) ? 1u : 0u; mine = (j == x) ? c : mine; }
        if (sum == G) break;
        __builtin_amdgcn_s_sleep(1);
        if ((++sp & 255u) == 0u) { if (xb_ld(&bar[XB_TMO])) break; if (sp > XB_SPIN_CAP) { atomicAdd(&bar[XB_TMO], 1u); break; } }
    }
    nloc = mine > 0u ? mine : 1u; nx = cnt > 0u ? cnt : 1u;
}
__device__ __forceinline__ void xcd_barrier(const XcdBarrier& b, const int tid) {
    asm volatile("s_waitcnt vmcnt(0)" ::: "memory");
    __syncthreads();
    if (tid == 0) {
        unsigned* bar = b.bar; const unsigned bx_ = xb_xcc_id();
        __builtin_amdgcn_s_waitcnt(0);
        unsigned nloc = b.st[0], nx = b.st[1];
        if (nloc == 0u) { xcd_barrier_complete(bar, bx_, nloc, nx); b.st[0] = nloc; b.st[1] = nx; }
        const unsigned old = xb_add(&bar[XB_XSUB(bx_)], 1u);
        const unsigned gen = old / nloc;
        if (old + 1u == (gen + 1u) * nloc) {
            __builtin_amdgcn_fence(__ATOMIC_RELEASE, "agent");
            asm volatile("s_waitcnt vmcnt(0)" ::: "memory");
            const unsigned og = xb_add(&bar[XB_TOP], 1u);
            const unsigned tg = og / nx;
            if (og + 1u == (tg + 1u) * nx) xb_add(&bar[XB_TOPGEN], 1u);
            else XB_SPIN(xb_ld(&bar[XB_TOPGEN]) == tg, bar);
            __builtin_amdgcn_fence(__ATOMIC_ACQUIRE, "agent");
            xb_add(&bar[XB_XGEN(bx_)], 1u);
            asm volatile("s_waitcnt vmcnt(0)" ::: "memory");
        } else {
            XB_SPIN(xb_ld(&bar[XB_XGEN(bx_)]) == gen, bar);
            __builtin_amdgcn_fence(__ATOMIC_ACQUIRE, "agent");
            asm volatile("s_waitcnt vmcnt(0)" ::: "memory");
        }
    }
    __syncthreads();
}

__device__ __forceinline__ const void* launder_ptr(const void* p) {
    unsigned lo = (unsigned)(uintptr_t)p, hi = (unsigned)((uintptr_t)p >> 32);
    asm volatile("" : "+v"(lo), "+v"(hi));
    lo = __builtin_amdgcn_readfirstlane(lo); hi = __builtin_amdgcn_readfirstlane(hi);
    return (const void*)(((uintptr_t)hi << 32) | (uintptr_t)lo);
}
struct Args { const float* in[26]; float* out; unsigned char* ws; };

constexpr int PTAB_OFF = LDSCTL_OFF + 512;
__device__ __forceinline__ const void* lds_uptr(const LAS unsigned long long* p) {
    const unsigned long long v = *p; const unsigned lo = __builtin_amdgcn_readfirstlane((unsigned)v), hi = __builtin_amdgcn_readfirstlane((unsigned)(v >> 32));
    return (const void*)(GAS const void*)(((uintptr_t)hi << 32) | (uintptr_t)lo);
}
struct Frame {
    LAS unsigned char* lds; char* shm;
    int tid, lane, wave, vcu, G;
    float* out; unsigned char* ws;
    __device__ __forceinline__ const float* inp(int i) const { return (const float*)lds_uptr((const LAS unsigned long long*)(lds + PTAB_OFF) + i); }
};
#define F_X 0
#define F_C 1
#define F_WMOD 2
#define F_BMOD 3
#define F_NMIX 4
#define F_NFFN 5
#define F_WIN 6
#define F_WOUT 7
#define F_OGAIN 8
#define F_SINKS 9
#define F_CONVW 10
#define F_CONVB 11
#define F_LWA 12
#define F_LBA 13
#define F_LWX 14
#define F_LBX 15
#define F_LAM 16
#define F_FOXB 17
#define F_WRG 18
#define F_BRG 19
#define F_WRE 20
#define F_BRE 21
#define F_WGATE 22
#define F_WUP 23
#define F_WDOWN 24
#define F_NFIN 25

struct EpiProj {
    static constexpr bool PERM = true;
    bf16_t* O;
    __device__ __forceinline__ void operator()(const f32x4 (&acc)[2][2][4][2], const pg8::GUnit& u, int wr, int wc, int fr, int fq) const {
        const int row0 = u.e0 * 256 + wr * 64 + fr, pn = u.e1;
        const float sc = (pn == 0 || pn == 1 || pn == 5) ? C2 : 1.f;
        const int col0 = pn * 256 + wc * 32 + 8 * fq;
#pragma unroll
        for (int ai = 0; ai < 2; ++ai)
#pragma unroll
            for (int m = 0; m < 4; ++m) { bf16_t* rowp = O + (size_t)(row0 + ai * 128 + m * 16) * NPROJ + col0;
#pragma unroll
                for (int bj = 0; bj < 2; ++bj) { const f32x4 v0 = acc[ai][bj][m][0] * sc, v1 = acc[ai][bj][m][1] * sc;
                    u32x4 w; w.x = cvtpk(v0[0], v0[1]); w.y = cvtpk(v0[2], v0[3]); w.z = cvtpk(v1[0], v1[1]); w.w = cvtpk(v1[2], v1[3]);
                    *(u32x4*)(rowp + bj * 128) = w; } }
    }
};
struct EpiRes {
    static constexpr bool PERM = false;
    const float* xin; float* xout; const float* gate;
    __device__ __forceinline__ void operator()(const f32x4 (&acc)[2][2][4][2], const pg8::GUnit& u, int wr, int wc, int fr, int fq) const {
        const int row0 = u.e0 * 256 + wr * 64 + fr, b = u.e0 >> 5, col0 = u.e1 * 256 + wc * 32 + 4 * fq;
        f32x4 gv[2][2];
#pragma unroll
        for (int bj = 0; bj < 2; ++bj)
#pragma unroll
            for (int n = 0; n < 2; ++n) gv[bj][n] = *(const f32x4*)(gate + b * 6144 + col0 + bj * 128 + n * 16);
#pragma unroll
        for (int ai = 0; ai < 2; ++ai)
#pragma unroll
            for (int m = 0; m < 4; ++m) { const size_t off = (size_t)(row0 + ai * 128 + m * 16) * D + col0;
#pragma unroll
                for (int bj = 0; bj < 2; ++bj)
#pragma unroll
                    for (int n = 0; n < 2; ++n) { const f32x4 xv = *(const f32x4*)(xin + off + bj * 128 + n * 16);
                        *(f32x4*)(xout + off + bj * 128 + n * 16) = xv + gv[bj][n] * acc[ai][bj][m][n]; } }
    }
};
struct EpiUp {
    static constexpr bool PERM = true;
    bf16_t* HID; const LEntry* list; const unsigned* cnt;
    __device__ __forceinline__ void operator()(const f32x4 (&acc)[2][2][4][2], const pg8::GUnit& u, int wr, int wc, int fr, int fq) const {
        const int pn = u.e1, slot = pn >> 1, pnl = pn & 1, cls = u.e2;
        const unsigned n = __hip_atomic_load(cnt + 64 * cls, __ATOMIC_RELAXED, __HIP_MEMORY_SCOPE_AGENT);
        const int colh = 256 * slot + 128 * pnl + wc * 32 + 8 * fq;
#pragma unroll
        for (int ai = 0; ai < 2; ++ai)
#pragma unroll
            for (int m = 0; m < 4; ++m) { const int r = ai * 128 + wr * 64 + m * 16 + fr; const unsigned pos = (unsigned)(u.e3 + r);
                float w = 0.f;
                if (pos < n) { const LEntry* e = list + (size_t)cls * LCAP + pos; w = slot ? e->w1 : e->w0; }
                float h[8];
#pragma unroll
                for (int nn = 0; nn < 2; ++nn)
#pragma unroll
                    for (int i = 0; i < 4; ++i) { const float g = acc[ai][0][m][nn][i], up = acc[ai][1][m][nn][i]; h[nn * 4 + i] = g * sigmoidf_(g) * up * w; }
                u32x4 o; o.x = cvtpk(h[0], h[1]); o.y = cvtpk(h[2], h[3]); o.z = cvtpk(h[4], h[5]); o.w = cvtpk(h[6], h[7]);
                *(u32x4*)(HID + (size_t)(u.e0 * 256 + r) * 512 + colh) = o; }
    }
};
struct EpiDown {
    static constexpr bool PERM = false;
    float* X; const float* gate; const LEntry* list; const unsigned* cnt;
    __device__ __forceinline__ void operator()(const f32x4 (&acc)[2][2][4][2], const pg8::GUnit& u, int wr, int wc, int fr, int fq) const {
        const int cls = u.e2, col0 = u.e1 * 256 + wc * 32 + 4 * fq;
        const unsigned n = __hip_atomic_load(cnt + 64 * cls, __ATOMIC_RELAXED, __HIP_MEMORY_SCOPE_AGENT);
#pragma unroll
        for (int ai = 0; ai < 2; ++ai)
#pragma unroll
            for (int m = 0; m < 4; ++m) { const int r = ai * 128 + wr * 64 + m * 16 + fr; const unsigned pos = (unsigned)(u.e3 + r);
                if (pos < n) { const int tok = list[(size_t)cls * LCAP + pos].tok; const int b = tok >> 13;
                    float* xr = X + (size_t)tok * D + col0; const float* gr = gate + b * 6144 + col0;
#pragma unroll
                    for (int bj = 0; bj < 2; ++bj)
#pragma unroll
                        for (int nn = 0; nn < 2; ++nn) { const f32x4 gv = *(const f32x4*)(gr + bj * 128 + nn * 16); const f32x4 xv = *(const f32x4*)(xr + bj * 128 + nn * 16);
                            *(f32x4*)(xr + bj * 128 + nn * 16) = xv + gv * acc[ai][bj][m][nn]; } } }
    }
};

__device__ __forceinline__ void pair_of(int p, int& lo, int& hi) { lo = p < 3 ? 0 : (p < 5 ? 1 : 2); hi = p < 3 ? p + 1 : (p < 5 ? p - 1 : 3); }
struct MoeUpOrder {
    int nunits, G, c; const LAS int* tt; const char* WGU; const LEntry* list; const unsigned* cnt;
    __device__ __forceinline__ bool next(int i, pg8::GUnit& u) const {
        const long L = (long)i * G + c; if (L >= nunits) return false;
        const int wgid = pg8::xcd_remap((int)L, nunits); const int tile = wgid >> 2, pn = wgid & 3; const int e = tt[tile];
        const int cls = e & 255; u.e0 = tile; u.e1 = pn; u.e2 = cls; u.e3 = e >> 8; u.a0 = 0;
        int lo, hi; pair_of(cls % 6, lo, hi); const int ex = (cls / 6) * 4 + ((pn >> 1) ? hi : lo);
        u.bb = WGU + ((size_t)ex * 512 + (size_t)(pn & 1) * 256) * 2048; return true;
    }
    __device__ __forceinline__ unsigned arow(const pg8::GUnit& u, int r) const {
        const unsigned n = __hip_atomic_load(cnt + 64 * u.e2, __ATOMIC_RELAXED, __HIP_MEMORY_SCOPE_AGENT); const unsigned pos = (unsigned)(u.e3 + r);
        return (unsigned)list[(size_t)u.e2 * LCAP + (pos < n ? pos : 0u)].tok;
    }
};
struct MoeDownOrder {
    int nunits, G, c; const LAS int* tt; const char* WDP;
    __device__ __forceinline__ bool next(int i, pg8::GUnit& u) const {
        const long L = (long)i * G + c; if (L >= nunits) return false;
        const int wgid = pg8::xcd_remap((int)L, nunits); const int tile = wgid >> 2, pn = wgid & 3; const int e = tt[tile];
        const int cls = e & 255; u.e0 = tile; u.e1 = pn; u.e2 = cls; u.e3 = e >> 8; u.a0 = tile * 256;
        u.bb = WDP + ((size_t)cls * 1024 + (size_t)pn * 256) * 1024; return true;
    }
    __device__ __forceinline__ unsigned arow(const pg8::GUnit& u, int r) const { return (unsigned)(u.a0 + r); }
};

namespace att {
constexpr int DM = NPROJ;
constexpr int SLOTB = 8192;
constexpr int LDS_K = 0, LDS_V = 3 * SLOTB, LDS_WS = 6 * SLOTB, LDS_OST = LDS_WS + 2048, LDS_BIAS = LDS_OST + 8 * 4096, LDS_BLK = LDS_BIAS + 32768, LDS_END = LDS_BLK + 256;
static_assert(LDS_END <= RING_BYTES, "attention LDS");
typedef LAS const char* lds_cptr;
__device__ __forceinline__ int crow(int r, int hi) { return (r & 3) + 8 * (r >> 2) + 4 * hi; }
__device__ __forceinline__ void glds16(const void* gsrc, unsigned lds_dst) { unsigned keep;
    asm volatile("s_mov_b32 %0, m0\n\ts_mov_b32 m0, %2\n\ts_nop 0\n\tglobal_load_lds_dwordx4 %1, off\n\ts_mov_b32 m0, %0" : "=&s"(keep) : "v"(gsrc), "s"(lds_dst) : "memory"); }
__device__ __forceinline__ float max3f(float a, float b, float c) { return __builtin_fmaxf(__builtin_fmaxf(a, b), c); }
#define ATT_WAIT_BAR(N) asm volatile("s_waitcnt vmcnt(" #N ") lgkmcnt(0)\n\ts_barrier" ::: "memory")
__device__ __forceinline__ float rowmax(const f32x16& p0, const f32x16& p1) {
    float a = max3f(p0[0], p0[1], p1[0]), b = max3f(p0[2], p0[3], p1[1]); a = max3f(a, p1[2], p1[3]);
#pragma unroll
    for (int r = 4; r < 16; r += 4) { a = max3f(a, p0[r], p0[r + 1]); b = max3f(b, p0[r + 2], p0[r + 3]); a = max3f(a, p1[r], p1[r + 1]); b = max3f(b, p1[r + 2], p1[r + 3]); }
    const float m = __builtin_fmaxf(a, b);
    auto rr = __builtin_amdgcn_permlane32_swap(__float_as_uint(m), __float_as_uint(m), false, false);
    return __builtin_fmaxf(__uint_as_float(rr[0]), __uint_as_float(rr[1]));
}
__device__ __forceinline__ void pv(f32x16* o, int vb, bf16x8 pa0, bf16x8 pa1, bf16x8 pa2, bf16x8 pa3) {
#pragma unroll
    for (int d0 = 0; d0 < 2; ++d0) { s16x4 lo[4], hi[4];
#pragma unroll
        for (int ks = 0; ks < 4; ++ks) {
            asm volatile("ds_read_b64_tr_b16 %0,%1 offset:%c2" : "=&v"(lo[ks]) : "v"(vb), "i"(d0 * 4096 + ks * 1024) : "memory");
            asm volatile("ds_read_b64_tr_b16 %0,%1 offset:%c2" : "=&v"(hi[ks]) : "v"(vb), "i"(d0 * 4096 + ks * 1024 + 512) : "memory"); }
        asm volatile("s_waitcnt lgkmcnt(0)" ::: "memory"); __builtin_amdgcn_sched_barrier(0);
#define ATT_PK(k) (bf16x8){lo[k][0], lo[k][1], lo[k][2], lo[k][3], hi[k][0], hi[k][1], hi[k][2], hi[k][3]}
        o[d0] = __builtin_amdgcn_mfma_f32_32x32x16_bf16(pa0, ATT_PK(0), o[d0], 0, 0, 0);
        o[d0] = __builtin_amdgcn_mfma_f32_32x32x16_bf16(pa1, ATT_PK(1), o[d0], 0, 0, 0);
        o[d0] = __builtin_amdgcn_mfma_f32_32x32x16_bf16(pa2, ATT_PK(2), o[d0], 0, 0, 0);
        o[d0] = __builtin_amdgcn_mfma_f32_32x32x16_bf16(pa3, ATT_PK(3), o[d0], 0, 0, 0);
#undef ATT_PK
    }
}
template <int MODE>
__device__ __forceinline__ void attn_core(char* shm, const bf16_t* Qw, const bf16_t* Kh, const bf16_t* Vh, bf16_t* Ow, int q0, int t_lo, int t_hi, float sinkl2, float slope2, const int tid) {
    const int lane = tid & 63, r32 = lane & 31, hi = lane >> 5; const int wid = __builtin_amdgcn_readfirstlane(tid >> 6);
    const unsigned lds0 = (unsigned)(uintptr_t)shm;
    float* wsf = (float*)(shm + LDS_WS) + wid * 64;
    const lds_cptr shm3 = (lds_cptr)shm;
    const bf16_t* ksrc = Kh + (long)lane * DM + wid * 8;
    const bf16_t* vsrc = Vh + (long)(16 * (wid & 3) + (lane >> 2)) * DM + (wid >> 2) * 32 + (lane & 3) * 8;
    const unsigned kdst = lds0 + LDS_K + wid * 1024, vdst = lds0 + LDS_V + wid * 1024;
#define ATT_DMA_K(t, slot) glds16(ksrc + (long)(t) * 64 * DM, (unsigned)__builtin_amdgcn_readfirstlane(kdst + (slot)))
#define ATT_DMA_V(t, slot) glds16(vsrc + (long)(t) * 64 * DM, (unsigned)__builtin_amdgcn_readfirstlane(vdst + (slot)))
    const int vb0 = (int)(lds0 + LDS_V) + ((lane >> 4) & 1) * 32 + (lane & 3) * 8 + (4 * hi + ((lane & 15) >> 2)) * 64;
    const int n = t_hi - t_lo + 1;
    const int qw0 = q0 + 32 * wid, w_hi = (qw0 + 31) >> 6;
    const int w_lo = (MODE == 1) ? ((qw0 - 127 > 0 ? qw0 - 127 : 0) >> 6) : t_lo;
    bf16x8 qr[4];
#pragma unroll
    for (int d0 = 0; d0 < 4; ++d0) qr[d0] = *reinterpret_cast<const bf16x8*>(&Qw[(long)r32 * DM + d0 * 16 + hi * 8]);
    ATT_DMA_K(t_hi, 0); ATT_DMA_V(t_hi, 0);
    if (n > 1) { ATT_DMA_K(t_hi - 1, SLOTB); ATT_DMA_V(t_hi - 1, SLOTB); }
    float mhat = -1e30f, l_reg = 0.f; f32x16 o[2]; o[0] = f32x16{}; o[1] = f32x16{};
    const int q = qw0 + r32;
    int sl_cur = 0, sl_n2 = 2 * SLOTB;
    for (int i = 0; i < n; ++i) {
        const int t = t_hi - i;
        if (i + 1 < n) { ATT_WAIT_BAR(2); } else { ATT_WAIT_BAR(0); }
        if (i + 2 < n) { ATT_DMA_K(t - 2, sl_n2); ATT_DMA_V(t - 2, sl_n2); }
        if (t >= w_lo && t <= w_hi) {
            f32x16 p0, p1;
            { const LAS float* bp = (const LAS float*)(shm3 + LDS_BIAS) + (t - t_lo) * 64 + 4 * hi;
#pragma unroll
              for (int j = 0; j < 4; ++j) { const f32x4 a = *(const LAS f32x4*)(bp + 8 * j), b = *(const LAS f32x4*)(bp + 32 + 8 * j);
                  p0[4 * j] = a[0]; p0[4 * j + 1] = a[1]; p0[4 * j + 2] = a[2]; p0[4 * j + 3] = a[3]; p1[4 * j] = b[0]; p1[4 * j + 1] = b[1]; p1[4 * j + 2] = b[2]; p1[4 * j + 3] = b[3]; } }
            { const lds_cptr kb = shm3 + LDS_K + sl_cur + hi * 1024 + r32 * 16;
#pragma unroll
              for (int d0 = 0; d0 < 4; ++d0) { const bf16x8 b0 = *(const LAS bf16x8*)(kb + d0 * 2048), b1 = *(const LAS bf16x8*)(kb + d0 * 2048 + 512);
                  p0 = __builtin_amdgcn_mfma_f32_32x32x16_bf16(b0, qr[d0], p0, 0, 0, 0); p1 = __builtin_amdgcn_mfma_f32_32x32x16_bf16(b1, qr[d0], p1, 0, 0, 0); } }
            const float NEG = -__builtin_inff();
            if (MODE == 0) { if (t == w_hi) { const int kb_ = 64 * t + 4 * hi;
#pragma unroll
                for (int r = 0; r < 16; ++r) { const int kv = kb_ + (r & 3) + 8 * (r >> 2); if (kv > q) p0[r] = NEG; if (kv + 32 > q) p1[r] = NEG; } } }
            else { const int kb_ = 64 * t + 4 * hi;
#pragma unroll
                for (int r = 0; r < 16; ++r) { const int kv = kb_ + (r & 3) + 8 * (r >> 2); if ((unsigned)(q - kv) >= 128u) p0[r] = NEG; if ((unsigned)(q - kv - 32) >= 128u) p1[r] = NEG; } }
            const float rm = rowmax(p0, p1);
            if (__any(rm > mhat + 8.f)) {
                const float mnew = __builtin_fmaxf(mhat, rm); const float f = __builtin_amdgcn_exp2f(mhat - mnew);
                l_reg *= f; mhat = mnew; if (hi == 0) wsf[r32] = f;
                asm volatile("s_waitcnt lgkmcnt(0)" ::: "memory");
#pragma unroll
                for (int j = 0; j < 4; ++j) { const f32x4 fv = *(const f32x4*)(wsf + 8 * j + 4 * hi);
#pragma unroll
                    for (int i2 = 0; i2 < 4; ++i2) { o[0][4 * j + i2] *= fv[i2]; o[1][4 * j + i2] *= fv[i2]; } }
            }
            float sacc = 0.f;
#pragma unroll
            for (int r = 0; r < 16; ++r) { p0[r] = __builtin_amdgcn_exp2f(p0[r] - mhat); p1[r] = __builtin_amdgcn_exp2f(p1[r] - mhat); sacc += p0[r] + p1[r]; }
            l_reg += sacc;
            u32x4 pw0, pw1, pw2, pw3;
            pw0 = (u32x4){cvtpk(p0[0], p0[1]), cvtpk(p0[2], p0[3]), cvtpk(p0[4], p0[5]), cvtpk(p0[6], p0[7])};
            pw1 = (u32x4){cvtpk(p0[8], p0[9]), cvtpk(p0[10], p0[11]), cvtpk(p0[12], p0[13]), cvtpk(p0[14], p0[15])};
            pw2 = (u32x4){cvtpk(p1[0], p1[1]), cvtpk(p1[2], p1[3]), cvtpk(p1[4], p1[5]), cvtpk(p1[6], p1[7])};
            pw3 = (u32x4){cvtpk(p1[8], p1[9]), cvtpk(p1[10], p1[11]), cvtpk(p1[12], p1[13]), cvtpk(p1[14], p1[15])};
            pv(o, vb0 + sl_cur, __builtin_bit_cast(bf16x8, pw0), __builtin_bit_cast(bf16x8, pw1), __builtin_bit_cast(bf16x8, pw2), __builtin_bit_cast(bf16x8, pw3));
        }
        sl_cur = (sl_cur == 2 * SLOTB) ? 0 : sl_cur + SLOTB; sl_n2 = (sl_n2 == 2 * SLOTB) ? 0 : sl_n2 + SLOTB;
    }
    { auto rr = __builtin_amdgcn_permlane32_swap(__float_as_uint(l_reg), __float_as_uint(l_reg), false, false); l_reg = __uint_as_float(rr[0]) + __uint_as_float(rr[1]); }
    if (MODE == 1) l_reg += __builtin_amdgcn_exp2f(sinkl2 + slope2 * (float)(32 * wid + r32) - mhat);
    if (hi == 0) wsf[32 + r32] = l_reg;
    asm volatile("s_waitcnt lgkmcnt(0)" ::: "memory");
    float rli[16];
#pragma unroll
    for (int r = 0; r < 16; ++r) rli[r] = __builtin_amdgcn_rcpf(wsf[32 + crow(r, hi)]);
    { bf16_t* stg = (bf16_t*)(shm + LDS_OST) + wid * 2048;
#pragma unroll
      for (int r = 0; r < 16; ++r) { const int orow = crow(r, hi);
#pragma unroll
          for (int d0 = 0; d0 < 2; ++d0) stg[orow * 64 + d0 * 32 + r32] = (bf16_t)(cvtpk(o[d0][r] * rli[r], 0.f) & 0xffffu); }
      asm volatile("s_waitcnt lgkmcnt(0)" ::: "memory");
#pragma unroll
      for (int i = 0; i < 4; ++i) { const int row = i * 8 + (lane >> 3), ch = lane & 7; const u32x4 v = *(const u32x4*)(stg + row * 64 + ch * 8); *(u32x4*)(Ow + (long)row * D + ch * 8) = v; } }
    asm volatile("s_waitcnt lgkmcnt(0)\n\ts_barrier" ::: "memory");
#undef ATT_DMA_K
#undef ATT_DMA_V
}
}

__device__ __forceinline__ void p0_tr_item(const float* W, int ld_src, int k0, int n0, bf16_t* d0, bf16_t* d1, bf16_t* d2, int ld_dst, LAS float* scr, int lane) {
#pragma unroll 8
    for (int i = 0; i < 32; ++i) { const int kk = 2 * i + (lane >> 5); scr[kk * 33 + (lane & 31)] = W[(size_t)(k0 + kk) * ld_src + n0 + (lane & 31)]; }
    LDS_WAIT(); asm volatile("" ::: "memory");
    const int c = lane & 7;
#pragma unroll
    for (int j = 0; j < 4; ++j) { const int n = (lane >> 3) + 8 * j; const LAS float* s = scr + (8 * c) * 33 + n;
        u32x4 o; o.x = cvtpk(s[0 * 33], s[1 * 33]); o.y = cvtpk(s[2 * 33], s[3 * 33]); o.z = cvtpk(s[4 * 33], s[5 * 33]); o.w = cvtpk(s[6 * 33], s[7 * 33]);
        *(u32x4*)(d0 + (size_t)n * ld_dst + 8 * c) = o;
        if (d1) *(u32x4*)(d1 + (size_t)n * ld_dst + 8 * c) = o;
        if (d2) *(u32x4*)(d2 + (size_t)n * ld_dst + 8 * c) = o; }
    LDS_WAIT(); asm volatile("" ::: "memory");
}
__device__ __forceinline__ int pair_idx(int lo, int hi) { return lo == 0 ? hi - 1 : (lo == 1 ? hi + 1 : 5); }

__device__ __forceinline__ void phase_p0(Frame& F) {
    {
        LAS float* sc = (LAS float*)F.lds;
        LAS float* red = (LAS float*)(F.lds + 16384);
        float* MOD = (float*)(F.ws + WS_MOD);
        bool have = false;
        for (int task = F.vcu; task < 48; task += F.G) {
            if (!have) { for (int i = F.tid; i < 4096; i += 512) { const float v = F.inp(F_C)[i]; sc[i] = v * sigmoidf_(v); } __syncthreads(); have = true; }
            const int l = task / 24, j0 = (task % 24) * 256;
            const float* wp = F.inp(F_WMOD) + (size_t)l * 1024 * 6144 + j0 + 4 * F.lane;
            f32x4 a0 = {0, 0, 0, 0}, a1 = a0, a2 = a0, a3 = a0;
            const int kbeg = F.wave * 128;
#pragma unroll 8
            for (int k = kbeg; k < kbeg + 128; ++k) { const f32x4 wv = *(const f32x4*)(wp + (size_t)k * 6144);
                a0 += wv * sc[k]; a1 += wv * sc[1024 + k]; a2 += wv * sc[2048 + k]; a3 += wv * sc[3072 + k]; }
            *(LAS f32x4*)(red + (F.wave * 4 + 0) * 256 + 4 * F.lane) = a0; *(LAS f32x4*)(red + (F.wave * 4 + 1) * 256 + 4 * F.lane) = a1;
            *(LAS f32x4*)(red + (F.wave * 4 + 2) * 256 + 4 * F.lane) = a2; *(LAS f32x4*)(red + (F.wave * 4 + 3) * 256 + 4 * F.lane) = a3;
            __syncthreads();
            for (int o = F.tid; o < 1024; o += 512) { const int b = o >> 8, cidx = o & 255; float s = F.inp(F_BMOD)[l * 6144 + j0 + cidx];
#pragma unroll
                for (int w = 0; w < 8; ++w) s += red[(w * 4 + b) * 256 + cidx];
                MOD[(size_t)(l * 4 + b) * 6144 + j0 + cidx] = s; }
            __syncthreads();
        }
        __syncthreads();
    }
    LAS float* scr = (LAS float*)(F.lds + F.wave * 16384);
    const int gw = F.vcu * 8 + F.wave, NGW = F.G * 8;
    bf16_t* WIN = (bf16_t*)(F.ws + WS_WIN); bf16_t* WOUT = (bf16_t*)(F.ws + WS_WOUT); bf16_t* WGU = (bf16_t*)(F.ws + WS_WGU); bf16_t* WDP = (bf16_t*)(F.ws + WS_WDP);
    constexpr int I_IN = 2 * 16 * 64, I_OUT = 2 * 16 * 32, I_GU = 2 * 16 * 2 * 16 * 8, I_DN = 2 * 16 * 4 * 32;
    for (int it = gw; it < I_IN + I_OUT + I_GU + I_DN; it += NGW) {
        int r = it;
        if (r < I_IN) { const int l = r / 1024, kb = (r % 1024) / 64, nb = r % 64;
            p0_tr_item(F.inp(F_WIN) + (size_t)l * 1024 * IN_COLS, IN_COLS, 64 * kb, 32 * nb, WIN + ((size_t)l * 2048 + 32 * nb) * 1024 + 64 * kb, nullptr, nullptr, 1024, scr, F.lane); continue; }
        r -= I_IN;
        if (r < I_OUT) { const int l = r / 512, kb = (r % 512) / 32, nb = r % 32;
            p0_tr_item(F.inp(F_WOUT) + (size_t)l * 1024 * 1024, 1024, 64 * kb, 32 * nb, WOUT + ((size_t)l * 1024 + 32 * nb) * 1024 + 64 * kb, nullptr, nullptr, 1024, scr, F.lane); continue; }
        r -= I_OUT;
        if (r < I_GU) { const int le = r / 256, which = (r % 256) / 128, kb = (r % 128) / 8, nb = r % 8;
            const int j0 = 32 * nb, row = 256 * (j0 >> 7) + (j0 & 127) + which * 128;
            p0_tr_item((which ? F.inp(F_WUP) : F.inp(F_WGATE)) + (size_t)le * 1024 * 256, 256, 64 * kb, j0, WGU + ((size_t)le * 512 + row) * 1024 + 64 * kb, nullptr, nullptr, 1024, scr, F.lane); continue; }
        r -= I_GU;
        { const int le = r / 128, kb = (r % 128) / 32, nb = r % 32; const int l = le >> 4, e = le & 15, g = e >> 2, i = e & 3;
          bf16_t* dst[3]; int nd = 0;
#pragma unroll
          for (int j = 0; j < 4; ++j) { if (j == i) continue; const int lo = i < j ? i : j, hi = i < j ? j : i; const int cls = g * 6 + pair_idx(lo, hi); const int kofs = (i == lo) ? 0 : 256;
              dst[nd++] = WDP + ((size_t)(l * 24 + cls) * 1024 + 32 * nb) * 512 + kofs + 64 * kb; }
          p0_tr_item(F.inp(F_WDOWN) + (size_t)le * 256 * 1024, 1024, 64 * kb, 32 * nb, dst[0], dst[1], dst[2], 512, scr, F.lane); }
    }
}

__device__ __forceinline__ void phase_norm1(Frame& F, int l, const float* xin) {
    const float* MOD = (const float*)(F.ws + WS_MOD) + (size_t)l * 4 * 6144;
    bf16_t* H = (bf16_t*)(F.ws + WS_H); float* CUM = (float*)(F.ws + WS_CUM); float* CTOT = (float*)(F.ws + WS_CTOT);
    LAS float* wtot = (LAS float*)F.lds;
    for (int tile = F.vcu; tile < T / 128; tile += F.G) {
        const int b = tile >> 6, row0 = tile * 128;
        f32x4 g1[4], s1[4], wfc[16];
#pragma unroll
        for (int j = 0; j < 4; ++j) { const int col = 4 * F.lane + 256 * j;
            const f32x4 nm = *(const f32x4*)(F.inp(F_NMIX) + l * 1024 + col), scv = *(const f32x4*)(MOD + b * 6144 + 1024 + col);
            g1[j] = nm * (scv + 1.0f); s1[j] = *(const f32x4*)(MOD + b * 6144 + col);
#pragma unroll
            for (int i = 0; i < 4; ++i) wfc[j * 4 + i] = *(const f32x4*)(F.inp(F_WIN) + ((size_t)l * 1024 + col + i) * IN_COLS + 2048); }
        const f32x4 fb = *(const f32x4*)(F.inp(F_FOXB) + l * 4);
        f32x4 run = {0.f, 0.f, 0.f, 0.f}, keep = {0.f, 0.f, 0.f, 0.f};
#pragma unroll 1
        for (int i = 0; i < 16; ++i) {
            const int row = row0 + F.wave * 16 + i;
            const f32x4* xr = (const f32x4*)(xin + (size_t)row * D) + F.lane;
            f32x4 v[4]; float ss = 0.f;
#pragma unroll
            for (int j = 0; j < 4; ++j) { v[j] = xr[64 * j]; ss += (v[j].x * v[j].x + v[j].y * v[j].y) + (v[j].z * v[j].z + v[j].w * v[j].w); }
            const float rstd = 1.0f / sqrtf(wave_sum(ss) * (1.f / D) + EPS);
            f32x4 fa = {0.f, 0.f, 0.f, 0.f};
            u32x2* o8 = (u32x2*)(H + (size_t)row * D) + F.lane;
#pragma unroll
            for (int j = 0; j < 4; ++j) { const f32x4 h = v[j] * rstd * g1[j] + s1[j];
                fa += wfc[j * 4 + 0] * h.x + wfc[j * 4 + 1] * h.y + wfc[j * 4 + 2] * h.z + wfc[j * 4 + 3] * h.w;
                u32x2 w; w.x = cvtpk(h.x, h.y); w.y = cvtpk(h.z, h.w); o8[64 * j] = w; }
#pragma unroll
            for (int e = 0; e < 4; ++e) { const float z = wave_sum(fa[e]) + fb[e];
                const float lf = fminf(z, 0.f) - __builtin_amdgcn_logf(1.f + fast_exp(-fabsf(z))) * 0.6931471805599453f;
                run[e] += lf; }
            if (F.lane == i) keep = run;
        }
        if (F.lane == 0) *(LAS f32x4*)(wtot + F.wave * 4) = run;
        __syncthreads();
        f32x4 pre = {0.f, 0.f, 0.f, 0.f}, tot = {0.f, 0.f, 0.f, 0.f};
#pragma unroll
        for (int w = 0; w < 8; ++w) { const f32x4 tv = *(const LAS f32x4*)(wtot + w * 4); if (w < F.wave) pre += tv; tot += tv; }
        if (F.lane < 16) { const int s = (row0 & (SEQ - 1)) + F.wave * 16 + F.lane; const f32x4 cv = keep + pre;
#pragma unroll
            for (int e = 0; e < 4; ++e) CUM[(size_t)(b * 4 + e) * SEQ + s] = cv[e]; }
        if (F.tid == 0) *(f32x4*)(CTOT + (size_t)(b * 64 + (tile & 63)) * 4) = tot;
        __syncthreads();
    }
}

__device__ __forceinline__ void lru_unit(Frame& F, int l, int b, int tt) {
    const bf16_t* PROJ = (const bf16_t*)(F.ws + WS_PROJ);
    float* HLOC = (float*)(F.ws + WS_H); float* PP = HLOC + (size_t)T * 256;
    float* LRUA = (float*)(F.ws + WS_LRUA); float* LRUH = (float*)(F.ws + WS_LRUH);
    LAS float* xcb = (LAS float*)F.lds;
    const int c = F.tid & 255, sl = F.tid >> 8, blk = c >> 5, dd = c & 31;
    float wa[32], wx[32];
#pragma unroll
    for (int j = 0; j < 32; ++j) { wa[j] = F.inp(F_LWA)[((size_t)(l * 8 + blk) * 32 + j) * 32 + dd]; wx[j] = F.inp(F_LWX)[((size_t)(l * 8 + blk) * 32 + j) * 32 + dd]; }
    const float cw0 = F.inp(F_CONVW)[(l * 4 + 0) * 256 + c], cw1 = F.inp(F_CONVW)[(l * 4 + 1) * 256 + c], cw2 = F.inp(F_CONVW)[(l * 4 + 2) * 256 + c], cw3 = F.inp(F_CONVW)[(l * 4 + 3) * 256 + c];
    const float cb = F.inp(F_CONVB)[l * 256 + c], ba = F.inp(F_LBA)[l * 256 + c], bx = F.inp(F_LBX)[l * 256 + c];
    const float lam = F.inp(F_LAM)[l * 256 + c];
    const float sp = -8.0f * (fmaxf(-lam, 0.f) + log1pf(expf(-fabsf(lam))));
    const int s0 = tt * 128 + sl * 64;
    const bf16_t* xp = PROJ + ((size_t)b * SEQ + s0) * NPROJ + C_XB + c;
    float xm3 = s0 >= 3 ? bf2f(xp[-3 * (long)NPROJ]) : 0.f, xm2 = s0 >= 2 ? bf2f(xp[-2 * (long)NPROJ]) : 0.f, xm1 = s0 >= 1 ? bf2f(xp[-1 * (long)NPROJ]) : 0.f;
    float h = 0.f, P = 1.f;
    for (int sub = 0; sub < 4; ++sub) {
        LAS float* xw = xcb + ((sub & 1) * 2 + sl) * 16 * 256;
        float xv[16];
#pragma unroll
        for (int i = 0; i < 16; ++i) { const float xc = bf2f(xp[(long)(sub * 16 + i) * NPROJ]); xv[i] = cb + cw0 * xm3 + cw1 * xm2 + cw2 * xm1 + cw3 * xc; xm3 = xm2; xm2 = xm1; xm1 = xc; xw[i * 256 + c] = xv[i]; }
        __syncthreads();
#pragma unroll
        for (int i = 0; i < 16; ++i) {
            float ga = ba, gx = bx; const LAS f32x4* xr = (const LAS f32x4*)(xw + i * 256 + blk * 32);
#pragma unroll
            for (int j4 = 0; j4 < 8; ++j4) { const f32x4 q = xr[j4];
                ga += q.x * wa[4 * j4] + q.y * wa[4 * j4 + 1] + q.z * wa[4 * j4 + 2] + q.w * wa[4 * j4 + 3];
                gx += q.x * wx[4 * j4] + q.y * wx[4 * j4 + 1] + q.z * wx[4 * j4 + 2] + q.w * wx[4 * j4 + 3]; }
            const float r = sigmoidf_(ga), ig = sigmoidf_(gx);
            const float la = sp * r; const float a = fast_exp(la);
            const float mult = sqrtf(-expm1f(2.f * la));
            const float u = mult * ig * xv[i];
            h = a * h + u; P *= a;
            const size_t off = ((size_t)b * SEQ + s0 + sub * 16 + i) * 256 + c;
            HLOC[off] = h; PP[off] = P;
        }
    }
    const size_t so = ((size_t)(b * 128 + tt * 2 + sl)) * 256 + c;
    LRUA[so] = P; LRUH[so] = h;
    __syncthreads();
}

__device__ __forceinline__ void fox_unit(Frame& F, int l, int b, int h, int qb) {
    const bf16_t* PROJ = (const bf16_t*)(F.ws + WS_PROJ); bf16_t* Y = (bf16_t*)(F.ws + WS_Y);
    const float* CUM = (const float*)(F.ws + WS_CUM) + (size_t)(b * 4 + h) * SEQ; const float* CTOT = (const float*)(F.ws + WS_CTOT);
    LAS float* bias = (LAS float*)(F.lds + att::LDS_BIAS); LAS float* blk = (LAS float*)(F.lds + att::LDS_BLK);
    const int q0 = qb * 256;
    if (F.wave == 0) { const float v = CTOT[(size_t)(b * 64 + F.lane) * 4 + h]; float s = v;
#pragma unroll
        for (int o = 1; o < 64; o <<= 1) { const float t = __int_as_float(__builtin_amdgcn_ds_bpermute(((F.lane - o) & 63) << 2, __float_as_int(s))); if (F.lane >= o) s += t; }
        blk[F.lane] = s - v; }
    __syncthreads();
    const float cref = CUM[q0 + 255] + blk[(q0 + 255) >> 7];
    for (int s = F.tid; s < q0 + 256; s += 512) bias[s] = (cref - (CUM[s] + blk[s >> 7])) * LOG2E;
    __syncthreads();
    const size_t rowbase = (size_t)b * SEQ;
    att::attn_core<0>(F.shm, PROJ + (rowbase + q0 + F.wave * 32) * NPROJ + C_QC + h * 64, PROJ + rowbase * NPROJ + C_KC + h * 64, PROJ + rowbase * NPROJ + C_VC + h * 64,
                      Y + (rowbase + q0 + F.wave * 32) * D + 768 + h * 64, q0, 0, (q0 + 255) >> 6, 0.f, 0.f, F.tid);
}
__device__ __forceinline__ void swa_unit(Frame& F, int l, int b, int h, int qb) {
    const bf16_t* PROJ = (const bf16_t*)(F.ws + WS_PROJ); bf16_t* Y = (bf16_t*)(F.ws + WS_Y);
    LAS float* bias = (LAS float*)(F.lds + att::LDS_BIAS);
    const int q0 = qb * 256, kvh = h >> 2;
    const int t_lo = (q0 >= 128 ? q0 - 128 : 0) >> 6, t_hi = (q0 + 255) >> 6, n = t_hi - t_lo + 1;
    const float slope2 = exp2f(-(float)(h + 1)) * LOG2E;
    for (int i = F.tid; i < n * 64; i += 512) bias[i] = slope2 * (float)(64 * t_lo + i - q0);
    __syncthreads();
    const size_t rowbase = (size_t)b * SEQ;
    att::attn_core<1>(F.shm, PROJ + (rowbase + q0 + F.wave * 32) * NPROJ + C_QA + h * 64, PROJ + rowbase * NPROJ + C_KA + kvh * 64, PROJ + rowbase * NPROJ + C_VA + kvh * 64,
                      Y + (rowbase + q0 + F.wave * 32) * D + h * 64, q0, t_lo, t_hi, F.inp(F_SINKS)[l * 8 + h] * LOG2E, slope2, F.tid);
}
__device__ __forceinline__ void phase_mixer(Frame& F, int l) {
    if (PH(10)) for (int id = F.vcu; id < 256; id += F.G) lru_unit(F, l, id >> 6, id & 63);
    if (PH(11)) for (int id = F.vcu; id < 256; id += F.G) { const int bh = id >> 4, s = id & 15; fox_unit(F, l, bh >> 2, bh & 3, 31 - s); fox_unit(F, l, bh >> 2, bh & 3, s); }
    if (PH(12)) for (int id = F.vcu; id < 256; id += F.G)
        for (int k = 0; k < 4; ++k) { const int u = id * 4 + k; swa_unit(F, l, u >> 8, (u & 255) >> 5, u & 31); }
}

__device__ __forceinline__ void phase_ynorm(Frame& F, int l) {
    bf16_t* Y = (bf16_t*)(F.ws + WS_Y); const bf16_t* PROJ = (const bf16_t*)(F.ws + WS_PROJ);
    const float* HLOC = (const float*)(F.ws + WS_H); const float* PP = HLOC + (size_t)T * 256;
    const float* LRUA = (const float*)(F.ws + WS_LRUA); const float* LRUH = (const float*)(F.ws + WS_LRUH);
    LAS float* cs = (LAS float*)F.lds;
    LAS float* carry = (LAS float*)(F.lds + 4096);
    const float* og = F.inp(F_OGAIN) + l * 1024;
    for (int tile = F.vcu; tile < T / 128; tile += F.G) {
        const int b = tile >> 6, tt = tile & 63, j0 = 2 * tt;
        { const int c = F.tid & 255, seg = F.tid >> 8; const int jb = seg ? j0 / 2 : 0, je = seg ? j0 : j0 / 2;
          float A = 1.f, Hh = 0.f;
          for (int j = jb; j < je; ++j) { const size_t so = (size_t)(b * 128 + j) * 256 + c; const float aj = LRUA[so], hj = LRUH[so]; Hh = aj * Hh + hj; A *= aj; }
          cs[(seg * 2 + 0) * 256 + c] = A; cs[(seg * 2 + 1) * 256 + c] = Hh; }
        __syncthreads();
        if (F.tid < 256) { const int c = F.tid; const float c0 = cs[(2 + 0) * 256 + c] * cs[(0 + 1) * 256 + c] + cs[(2 + 1) * 256 + c];
            const size_t so = (size_t)(b * 128 + j0) * 256 + c; carry[c] = c0; carry[256 + c] = LRUA[so] * c0 + LRUH[so]; }
        __syncthreads();
#pragma unroll 1
        for (int i = 0; i < 16; ++i) {
            const int rl = F.wave * 16 + i; const size_t row = (size_t)tile * 128 + rl;
            bf16_t* yr = Y + row * D;
            const u32x4 ya = *(const u32x4*)(yr + 8 * F.lane);
            float fa[8]; fa[0] = __uint_as_float(ya.x << 16); fa[1] = __uint_as_float(ya.x & 0xffff0000u); fa[2] = __uint_as_float(ya.y << 16); fa[3] = __uint_as_float(ya.y & 0xffff0000u);
            fa[4] = __uint_as_float(ya.z << 16); fa[5] = __uint_as_float(ya.z & 0xffff0000u); fa[6] = __uint_as_float(ya.w << 16); fa[7] = __uint_as_float(ya.w & 0xffff0000u);
            float sa = 0.f;
#pragma unroll
            for (int k = 0; k < 8; ++k) sa += fa[k] * fa[k];
            const u32x2 yc = *(const u32x2*)(yr + 768 + 4 * F.lane);
            float fc[4]; fc[0] = __uint_as_float(yc.x << 16); fc[1] = __uint_as_float(yc.x & 0xffff0000u); fc[2] = __uint_as_float(yc.y << 16); fc[3] = __uint_as_float(yc.y & 0xffff0000u);
            float sc_ = fc[0] * fc[0] + fc[1] * fc[1] + fc[2] * fc[2] + fc[3] * fc[3];
            const f32x4 hl = *(const f32x4*)(HLOC + row * 256 + 4 * F.lane), pp = *(const f32x4*)(PP + row * 256 + 4 * F.lane);
            const f32x4 cr = *(const LAS f32x4*)(carry + (rl >> 6) * 256 + 4 * F.lane);
            const u32x2 gb = *(const u32x2*)(PROJ + row * NPROJ + C_GB + 4 * F.lane);
            float fb[4]; { const f32x4 hh = hl + pp * cr;
                fb[0] = hh.x * gelu_tanh(__uint_as_float(gb.x << 16)); fb[1] = hh.y * gelu_tanh(__uint_as_float(gb.x & 0xffff0000u));
                fb[2] = hh.z * gelu_tanh(__uint_as_float(gb.y << 16)); fb[3] = hh.w * gelu_tanh(__uint_as_float(gb.y & 0xffff0000u)); }
            float sb = fb[0] * fb[0] + fb[1] * fb[1] + fb[2] * fb[2] + fb[3] * fb[3];
            const float ra = 1.0f / sqrtf(wave_sum(sa) * (1.f / 512.f) + EPS), rb = 1.0f / sqrtf(wave_sum(sb) * (1.f / 256.f) + EPS), rc = 1.0f / sqrtf(wave_sum(sc_) * (1.f / 256.f) + EPS);
            { const f32x4 g0 = *(const f32x4*)(og + 8 * F.lane), g1 = *(const f32x4*)(og + 8 * F.lane + 4);
              u32x4 w; w.x = cvtpk(fa[0] * ra * g0.x, fa[1] * ra * g0.y); w.y = cvtpk(fa[2] * ra * g0.z, fa[3] * ra * g0.w); w.z = cvtpk(fa[4] * ra * g1.x, fa[5] * ra * g1.y); w.w = cvtpk(fa[6] * ra * g1.z, fa[7] * ra * g1.w);
              *(u32x4*)(yr + 8 * F.lane) = w; }
            { const f32x4 g = *(const f32x4*)(og + 512 + 4 * F.lane); u32x2 w; w.x = cvtpk(fb[0] * rb * g.x, fb[1] * rb * g.y); w.y = cvtpk(fb[2] * rb * g.z, fb[3] * rb * g.w); *(u32x2*)(yr + 512 + 4 * F.lane) = w; }
            { const f32x4 g = *(const f32x4*)(og + 768 + 4 * F.lane); u32x2 w; w.x = cvtpk(fc[0] * rc * g.x, fc[1] * rc * g.y); w.y = cvtpk(fc[2] * rc * g.z, fc[3] * rc * g.w); *(u32x2*)(yr + 768 + 4 * F.lane) = w; }
        }
        __syncthreads();
    }
}

template <int N, int MASK> __device__ __forceinline__ void tr_step(float (&v)[40], bool upper) {
#pragma unroll
    for (int i = 0; i < N / 2; ++i) { const float a = v[i], b = v[i + N / 2]; const float send = upper ? a : b, kp = upper ? b : a; float rcv;
        if constexpr (MASK == 32) { auto rr = __builtin_amdgcn_permlane32_swap(__float_as_uint(send), __float_as_uint(send), false, false); rcv = upper ? __uint_as_float(rr[0]) : __uint_as_float(rr[1]); }
        else rcv = shx<MASK>(send);
        v[i] = kp + rcv; }
}
__device__ __forceinline__ void phase_norm2_router(Frame& F, int l, const float* xa) {
    const float* MOD = (const float*)(F.ws + WS_MOD) + (size_t)l * 4 * 6144;
    bf16_t* H = (bf16_t*)(F.ws + WS_H);
    LEntry* list = (LEntry*)(F.ws + WS_LIST); unsigned* cnt = (unsigned*)(F.ws + WS_CTL) + CW_CNT + l * NCLS * 64;
    LAS float* wr = (LAS float*)F.lds;
    LAS float* gs = (LAS float*)(F.lds + 81920);
    LAS float* lg = (LAS float*)(F.lds + 90112);
    LAS int* tcls = (LAS int*)(F.lds + 92672);
    LAS float* tw = (LAS float*)(F.lds + 93184);
    LAS int* trank = (LAS int*)(F.lds + 94208);
    LAS unsigned* lcnt = (LAS unsigned*)(F.lds + 94720);
    LAS unsigned* lbase = (LAS unsigned*)(F.lds + 94848);
    for (int i = F.tid; i < 1024 * 4; i += 512) { const int k = i >> 2, e = i & 3; wr[e * 1024 + k] = F.inp(F_WRG)[(size_t)l * 4096 + i]; }
    for (int i = F.tid; i < 1024 * 16; i += 512) { const int k = i >> 4, e = i & 15; wr[(4 + e) * 1024 + k] = F.inp(F_WRE)[(size_t)l * 16384 + i]; }
    int cur_b = -1;
    for (int tile = F.vcu; tile < T / 128; tile += F.G) {
        const int b = tile >> 6;
        __syncthreads();
        if (b != cur_b) { for (int i = F.tid; i < 1024; i += 512) { gs[i] = F.inp(F_NFFN)[l * 1024 + i] * (1.f + MOD[b * 6144 + 4096 + i]); gs[1024 + i] = MOD[b * 6144 + 3072 + i]; } cur_b = b; }
        if (F.tid < NCLS) lcnt[F.tid] = 0u;
        __syncthreads();
#pragma unroll 1
        for (int grp = 0; grp < 8; ++grp) {
            const size_t row0 = (size_t)tile * 128 + F.wave * 16 + grp * 2;
            f32x4 hv[2][4];
#pragma unroll
            for (int r = 0; r < 2; ++r) { const f32x4* xr = (const f32x4*)(xa + (row0 + r) * D) + F.lane; float ss = 0.f;
#pragma unroll
                for (int j = 0; j < 4; ++j) { hv[r][j] = xr[64 * j]; ss += (hv[r][j].x * hv[r][j].x + hv[r][j].y * hv[r][j].y) + (hv[r][j].z * hv[r][j].z + hv[r][j].w * hv[r][j].w); }
                const float rstd = 1.0f / sqrtf(wave_sum(ss) * (1.f / D) + EPS);
                u32x2* o8 = (u32x2*)(H + (row0 + r) * D) + F.lane;
#pragma unroll
                for (int j = 0; j < 4; ++j) { const f32x4 g = *(const LAS f32x4*)(gs + 4 * F.lane + 256 * j), s = *(const LAS f32x4*)(gs + 1024 + 4 * F.lane + 256 * j);
                    hv[r][j] = hv[r][j] * rstd * g + s; u32x2 w; w.x = cvtpk(hv[r][j].x, hv[r][j].y); w.y = cvtpk(hv[r][j].z, hv[r][j].w); o8[64 * j] = w; } }
            float acc[40];
#pragma unroll
            for (int e = 0; e < 20; ++e) { float a0 = 0.f, a1 = 0.f;
#pragma unroll
                for (int j = 0; j < 4; ++j) { const f32x4 w = *(const LAS f32x4*)(wr + e * 1024 + 4 * F.lane + 256 * j);
                    a0 += hv[0][j].x * w.x + hv[0][j].y * w.y + hv[0][j].z * w.z + hv[0][j].w * w.w;
                    a1 += hv[1][j].x * w.x + hv[1][j].y * w.y + hv[1][j].z * w.z + hv[1][j].w * w.w; }
                acc[e] = a0; acc[20 + e] = a1; }
            tr_step<40, 32>(acc, (F.lane & 32) != 0); tr_step<20, 16>(acc, (F.lane & 16) != 0); tr_step<10, 8>(acc, (F.lane & 8) != 0);
#pragma unroll
            for (int i = 0; i < 5; ++i) { acc[i] += shx<4>(acc[i]); acc[i] += shx<2>(acc[i]); acc[i] += shx<1>(acc[i]); }
            if ((F.lane & 7) == 0) { const int v0 = 5 * (F.lane >> 3);
#pragma unroll
                for (int i = 0; i < 5; ++i) lg[F.wave * 40 + v0 + i] = acc[i]; }
            LDS_WAIT();
            if (F.lane < 2) {
                const LAS float* q = lg + F.wave * 40 + F.lane * 20;
                float gl[4];
#pragma unroll
                for (int j = 0; j < 4; ++j) gl[j] = q[j] + F.inp(F_BRG)[l * 4 + j];
                int gsel = 0; float gm = gl[0];
#pragma unroll
                for (int j = 1; j < 4; ++j) if (gl[j] > gm) { gm = gl[j]; gsel = j; }
                float den = 0.f;
#pragma unroll
                for (int j = 0; j < 4; ++j) den += expf(gl[j] - gm);
                const float gp = 1.0f / den;
                float el[4];
#pragma unroll
                for (int j = 0; j < 4; ++j) el[j] = q[4 + 4 * gsel + j] + F.inp(F_BRE)[l * 16 + gsel * 4 + j];
                int i1 = 0; float m1 = el[0];
#pragma unroll
                for (int j = 1; j < 4; ++j) if (el[j] > m1) { m1 = el[j]; i1 = j; }
                int i2 = -1; float m2 = -__builtin_inff();
#pragma unroll
                for (int j = 0; j < 4; ++j) if (j != i1 && el[j] > m2) { m2 = el[j]; i2 = j; }
                const float e2 = expf(m2 - m1); const float w1 = gp / (1.f + e2), w2 = gp * e2 / (1.f + e2);
                const int lo = i1 < i2 ? i1 : i2, hi = i1 < i2 ? i2 : i1;
                const int rl = F.wave * 16 + grp * 2 + F.lane;
                tcls[rl] = gsel * 6 + pair_idx(lo, hi); tw[rl * 2] = (i1 < i2) ? w1 : w2; tw[rl * 2 + 1] = (i1 < i2) ? w2 : w1;
            }
        }
        __syncthreads();
        if (F.tid < 128) trank[F.tid] = (int)atomicAdd((unsigned*)&lcnt[tcls[F.tid]], 1u);
        __syncthreads();
        if (F.tid < NCLS) lbase[F.tid] = lcnt[F.tid] ? __hip_atomic_fetch_add(cnt + 64 * F.tid, lcnt[F.tid], __ATOMIC_RELAXED, __HIP_MEMORY_SCOPE_AGENT) : 0u;
        __syncthreads();
        if (F.tid < 128) { const int cls = tcls[F.tid]; const unsigned pos = lbase[cls] + (unsigned)trank[F.tid];
            LEntry e; e.tok = tile * 128 + F.tid; e.w0 = tw[F.tid * 2]; e.w1 = tw[F.tid * 2 + 1]; e.pad = 0; list[(size_t)cls * LCAP + pos] = e; }
    }
    __syncthreads();
}

__device__ __forceinline__ int build_tile_table(Frame& F, int l) {
    unsigned* cnt = (unsigned*)(F.ws + WS_CTL) + CW_CNT + l * NCLS * 64;
    LAS int* tt = (LAS int*)(F.lds + TT_OFF); LAS int* ntl = (LAS int*)(F.lds + TT_OFF + 1024);
    __syncthreads();
    if (F.tid == 0) { int nt = 0;
        for (int c = 0; c < NCLS; ++c) { const unsigned n = __hip_atomic_load(cnt + 64 * c, __ATOMIC_RELAXED, __HIP_MEMORY_SCOPE_AGENT); const int k = (int)((n + 255u) >> 8);
            for (int j = 0; j < k; ++j) tt[nt++] = c | ((j * 256) << 8); }
        ntl[0] = nt; }
    __syncthreads();
    return ntl[0];
}

__device__ __forceinline__ void phase_final(Frame& F, const float* xa) {
    const int gw = F.vcu * 8 + F.wave, NGW = F.G * 8;
    f32x4 g[4];
#pragma unroll
    for (int j = 0; j < 4; ++j) g[j] = *(const f32x4*)(F.inp(F_NFIN) + 4 * F.lane + 256 * j);
    for (int row = gw; row < T; row += NGW) {
        const f32x4* xr = (const f32x4*)(xa + (size_t)row * D) + F.lane; f32x4 v[4]; float ss = 0.f;
#pragma unroll
        for (int j = 0; j < 4; ++j) { v[j] = xr[64 * j]; ss += (v[j].x * v[j].x + v[j].y * v[j].y) + (v[j].z * v[j].z + v[j].w * v[j].w); }
        const float rstd = 1.0f / sqrtf(wave_sum(ss) * (1.f / D) + EPS);
        f32x4* o = (f32x4*)(F.out + (size_t)row * D) + F.lane;
#pragma unroll
        for (int j = 0; j < 4; ++j) o[64 * j] = v[j] * rstd * g[j];
    }
}

__global__ void __launch_bounds__(512, 2) mk_fwd(const Args args) {
    extern __shared__ __attribute__((aligned(16))) unsigned char lds[];
    Frame F;
    F.lds = (LAS unsigned char*)lds; F.shm = (char*)lds;
    F.tid = threadIdx.x; F.lane = F.tid & 63; F.wave = __builtin_amdgcn_readfirstlane(F.tid >> 6);
    F.G = gridDim.x; { const int bx = blockIdx.x; F.vcu = (F.G % 8 == 0) ? (bx % 8) * (F.G / 8) + bx / 8 : bx; }
    for (int u = F.tid; u < (LDS_BYTES - LDSCTL_OFF) / 4; u += 512) ((LAS unsigned*)(F.lds + LDSCTL_OFF))[u] = 0u;
    __syncthreads();
    if (F.tid < 26) ((LAS unsigned long long*)(F.lds + PTAB_OFF))[F.tid] = (unsigned long long)(uintptr_t)args.in[F.tid];
    if (F.tid == 26) ((LAS unsigned long long*)(F.lds + PTAB_OFF))[26] = (unsigned long long)(uintptr_t)args.out;
    if (F.tid == 27) ((LAS unsigned long long*)(F.lds + PTAB_OFF))[27] = (unsigned long long)(uintptr_t)args.ws;
    __syncthreads();
#define REFRESH() do { asm volatile("" ::: "memory"); int t_ = threadIdx.x; asm volatile("" : "+v"(t_)); F.tid = t_; F.lane = t_ & 63; F.wave = __builtin_amdgcn_readfirstlane(t_ >> 6); \
        F.out = (float*)lds_uptr((const LAS unsigned long long*)(F.lds + PTAB_OFF) + 26); F.ws = (unsigned char*)lds_uptr((const LAS unsigned long long*)(F.lds + PTAB_OFF) + 27); } while (0)
    REFRESH();
    unsigned* ctl = (unsigned*)(F.ws + WS_CTL);
    XcdBarrier bar = xcd_barrier_post(ctl + CW_BAR, (volatile LAS unsigned*)(F.lds + MISC_OFF) + 8);

    if (PH(0)) phase_p0(F);
    xcd_barrier(bar, F.tid);
    float* XA = (float*)(F.ws + WS_XA);
    for (int l = 0; l < DEPTH; ++l) {
        const float* xin = (l == 0) ? F.inp(F_X) : XA;
        const float* MODl = (const float*)(F.ws + WS_MOD) + (size_t)l * 4 * 6144;
        REFRESH();
        if (PH(1)) phase_norm1(F, l, xin);
        xcd_barrier(bar, F.tid);
        REFRESH();
        if (PH(2)) { pg8::DenseOrder S; S.init(T, NPROJ, F.G, (int)blockIdx.x, F.ws + WS_WIN + (size_t)l * 2048 * 1024 * 2, 2048u);
          EpiProj E{(bf16_t*)(F.ws + WS_PROJ)};
          pg8::gemm_phase<EpiProj, pg8::DenseOrder, true>(F.tid, F.lds, (const char*)(F.ws + WS_H), 2048u, 2048u, 1024, S, E); }
        xcd_barrier(bar, F.tid);
        REFRESH();
        if (PH(3)) phase_mixer(F, l);
        xcd_barrier(bar, F.tid);
        REFRESH();
        if (PH(4)) phase_ynorm(F, l);
        xcd_barrier(bar, F.tid);
        REFRESH();
        if (PH(5)) { pg8::DenseOrder S; S.init(T, D, F.G, (int)blockIdx.x, F.ws + WS_WOUT + (size_t)l * 1024 * 1024 * 2, 2048u);
          EpiRes E{xin, XA, MODl + 2048};
          pg8::gemm_phase<EpiRes, pg8::DenseOrder, true>(F.tid, F.lds, (const char*)(F.ws + WS_Y), 2048u, 2048u, 1024, S, E); }
        xcd_barrier(bar, F.tid);
        REFRESH();
        if (PH(6)) phase_norm2_router(F, l, XA);
        xcd_barrier(bar, F.tid);
        REFRESH();
        const int ntiles = build_tile_table(F, l);
        const LEntry* list = (const LEntry*)(F.ws + WS_LIST); const unsigned* cnt = (const unsigned*)(F.ws + WS_CTL) + CW_CNT + l * NCLS * 64;
        if (PH(7)) { MoeUpOrder S{ntiles * 4, F.G, (int)blockIdx.x, (const LAS int*)(F.lds + TT_OFF), (const char*)(F.ws + WS_WGU + (size_t)l * 16 * 512 * 1024 * 2), list, cnt};
          EpiUp E{(bf16_t*)(F.ws + WS_PROJ), list, cnt};
          pg8::gemm_phase<EpiUp, MoeUpOrder, true>(F.tid, F.lds, (const char*)(F.ws + WS_H), 2048u, 2048u, 1024, S, E); }
        xcd_barrier(bar, F.tid);
        REFRESH();
        if (PH(8)) { MoeDownOrder S{ntiles * 4, F.G, (int)blockIdx.x, (const LAS int*)(F.lds + TT_OFF), (const char*)(F.ws + WS_WDP + (size_t)l * 24 * 1024 * 512 * 2)};
          EpiDown E{XA, MODl + 5120, list, cnt};
          pg8::gemm_phase<EpiDown, MoeDownOrder, true>(F.tid, F.lds, (const char*)(F.ws + WS_PROJ), 1024u, 1024u, 512, S, E); }
        xcd_barrier(bar, F.tid);
    }
        REFRESH();
    if (PH(9)) phase_final(F, XA);
}

extern "C" void kernel_launch(void* const* d_in, const int* in_sizes, int n_in, void* d_out, int out_size, void* d_ws, size_t ws_size, hipStream_t stream) {
    static int grid = 0;
    if (grid == 0) {
        if (n_in != 26 || in_sizes[0] != T * D || out_size != T * D || ws_size < WS_END) { fprintf(stderr, "kernel_launch: unexpected shapes (n_in %d, in0 %d, out %d, ws %zu)\n", n_in, n_in > 0 ? in_sizes[0] : -1, out_size, ws_size); grid = -1; return; }
        int dev = 0, cus = 0, per_cu = 0;
        if (hipGetDevice(&dev) != hipSuccess || hipDeviceGetAttribute(&cus, hipDeviceAttributeMultiprocessorCount, dev) != hipSuccess) { grid = -1; return; }
        if (hipFuncSetAttribute((const void*)mk_fwd, hipFuncAttributeMaxDynamicSharedMemorySize, LDS_BYTES) != hipSuccess) { fprintf(stderr, "kernel_launch: hipFuncSetAttribute failed\n"); grid = -1; return; }
        if (hipOccupancyMaxActiveBlocksPerMultiprocessor(&per_cu, (const void*)mk_fwd, 512, LDS_BYTES) != hipSuccess || per_cu < 1) fprintf(stderr, "kernel_launch: occupancy query reports %d\n", per_cu);
        (void)hipGetLastError();
        grid = cus;
    }
    if (grid < 0) return;
    (void)hipMemsetAsync((char*)d_ws + WS_CTL, 0, CTL_ZERO_BYTES, stream);
    Args a{};
    for (int i = 0; i < 26; ++i) a.in[i] = (const float*)d_in[i];
    a.out = (float*)d_out; a.ws = (unsigned char*)d_ws;
    hipLaunchKernelGGL(mk_fwd, dim3(grid), dim3(512), LDS_BYTES, stream, a);
}
```

```cpp
#include <hip/hip_runtime.h>
#include <hip/hip_bf16.h>
#include <cstdio>
#include <cstdint>

#define GAS __attribute__((address_space(1)))
#define LAS __attribute__((address_space(3)))
typedef unsigned short bf16_t;
typedef short bf16x8 __attribute__((ext_vector_type(8)));
typedef short s16x4 __attribute__((ext_vector_type(4)));
typedef float f32x2 __attribute__((ext_vector_type(2)));
typedef float f32x4 __attribute__((ext_vector_type(4)));
typedef float f32x16 __attribute__((ext_vector_type(16)));
typedef unsigned u32x2 __attribute__((ext_vector_type(2)));
typedef unsigned u32x4 __attribute__((ext_vector_type(4)));
typedef __bf16 bf16x2_t __attribute__((ext_vector_type(2)));

#ifndef DUP_MASK
#define DUP_MASK 0x0u
#endif
#define DUP(n) (1 + (int)((DUP_MASK >> (n)) & 1u))
#ifndef G1REP
#define G1REP 1
#endif
#ifndef UPREP
#define UPREP 1
#endif
#ifndef PH_MASK
#define PH_MASK 0xFFFFFFFFu
#endif
#define PH(n) ((PH_MASK >> (n)) & 1u)
constexpr int D = 1024, NB = 4, SEQ = 8192, T = NB * SEQ, DEPTH = 2;
constexpr int IN_COLS = 2052, NPROJ = 2048;
constexpr int C_QA = 0, C_KA = 512, C_VA = 640, C_XB = 768, C_GB = 1024, C_QC = 1280, C_KC = 1536, C_VC = 1792;
constexpr int NCLS = 24, LCAP = 32768;
constexpr float EPS = 1e-6f;
constexpr float LOG2E = 1.4426950408889634f;
constexpr float C2 = 0.125f * 1.4426950408889634f;

constexpr size_t MiB = 1u << 20;
constexpr size_t WS_CTL = 0, CTL_ZERO_BYTES = 1 * MiB;
constexpr size_t WS_MOD = 1 * MiB;
constexpr size_t WS_CUM = WS_MOD + 256 * 1024;
constexpr size_t WS_CTOT = WS_CUM + 512 * 1024;
constexpr size_t WS_LRUA = 2 * MiB;
constexpr size_t WS_LRUH = WS_LRUA + 512 * 1024;
constexpr size_t WS_LIST = 4 * MiB;
constexpr size_t WS_WIN = 16 * MiB;
constexpr size_t WS_WOUT = 24 * MiB;
constexpr size_t WS_WGU = 28 * MiB;
constexpr size_t WS_WDP = 60 * MiB;
constexpr size_t WS_XA = 108 * MiB;
constexpr size_t WS_H = 236 * MiB;
constexpr size_t WS_PROJ = 300 * MiB;
constexpr size_t WS_Y = 428 * MiB;
constexpr size_t WS_END = 492 * MiB;
constexpr int CW_BAR = 4096;
constexpr int CW_KM = 20480;
constexpr int CW_Q = 21504;
constexpr int CW_CNT = 16384;

struct LEntry { int tok; float w0, w1; int pad; };

constexpr int RING_BYTES = 131072;
constexpr int LDSCTL_OFF = RING_BYTES;
constexpr int MISC_OFF = LDSCTL_OFF + 320;
constexpr int TT_OFF = LDSCTL_OFF + 1024;
constexpr int LDS_BYTES = 147456;

__device__ __forceinline__ unsigned cvtpk(float lo, float hi) { f32x2 v = {lo, hi}; bf16x2_t b = __builtin_convertvector(v, bf16x2_t); return __builtin_bit_cast(unsigned, b); }
__device__ __forceinline__ float bf2f(bf16_t v) { return __builtin_bit_cast(float, (unsigned)v << 16); }
template <int M> __device__ __forceinline__ float shx(float v) {
    return __int_as_float(__builtin_amdgcn_ds_swizzle(__float_as_int(v), (M << 10) | 0x1f));
}
__device__ __forceinline__ float wave_sum(float v) {
    v += shx<1>(v); v += shx<2>(v); v += shx<4>(v); v += shx<8>(v); v += shx<16>(v);
    auto rr = __builtin_amdgcn_permlane32_swap(__float_as_uint(v), __float_as_uint(v), false, false);
    return __uint_as_float(rr[0]) + __uint_as_float(rr[1]);
}
__device__ __forceinline__ float fast_exp(float x) { return __builtin_amdgcn_exp2f(x * LOG2E); }
__device__ __forceinline__ float sigmoidf_(float x) { return __builtin_amdgcn_rcpf(1.f + fast_exp(-x)); }
__device__ __forceinline__ float gelu_tanh(float x) {
    const float u = 0.7978845608028654f * (x + 0.044715f * x * x * x);
    const float e = fast_exp(2.f * u);
    const float th = 1.f - 2.f * __builtin_amdgcn_rcpf(e + 1.f);
    return 0.5f * x * (1.f + th);
}
#define LDS_WAIT() asm volatile("s_waitcnt lgkmcnt(0)" ::: "memory")
#define VM_WAIT() asm volatile("s_waitcnt vmcnt(0)" ::: "memory")

namespace pg8 {
constexpr int BM = 256, BK = 64, HALF = 128, HTB = HALF * BK * 2, STAGE_BYTES = 8 * HTB, NXCD = 8, WGM = 8;
__host__ __device__ __forceinline__ int lds_byte(int r, int c) { const int st = (r >> 4) * 2 + (c >> 5), rr = r & 15, cc = c & 31, ob = rr * 64 + cc * 2; return st * 1024 + (ob ^ (((ob >> 9) & 1) << 5)); }
__host__ __device__ __forceinline__ void stage_rc(int b, int& R, int& C) { const int st = b / 1024, sb = b % 1024, swz = sb ^ (((sb >> 9) & 1) << 5); R = (st >> 1) * 16 + swz / 64; C = (st & 1) * 32 + (swz % 64) / 2; }
__host__ __device__ __forceinline__ int perm32(int rho) { const int n = rho >> 4, i = rho & 15; return 8 * (i >> 2) + 4 * n + (i & 3); }

struct GUnit { int a0; const char* bb; int e0, e1, e2, e3; };

__device__ __forceinline__ int xcd_remap(int L, int nwg) {
    const int q = nwg / NXCD, r = nwg % NXCD, xcd = L % NXCD, off = L / NXCD;
    return (xcd < r ? xcd * (q + 1) : r * (q + 1) + (xcd - r) * q) + off;
}

struct DenseOrder {
    int nM, nN, nwg, G, c, rep; const char* Bt; unsigned pitchB;
    __device__ __forceinline__ void init(int M, int N, int G_, int c_, const void* Bt_, unsigned pitchB_, int rep_ = 1) { nM = M / BM; nN = N / BM; nwg = nM * nN; G = G_; c = c_; Bt = (const char*)Bt_; pitchB = pitchB_; rep = rep_; }
    __device__ __forceinline__ bool next(int i, GUnit& u) const {
        const long L = (long)i * G + c; if (L >= (long)nwg * rep) return false;
        const int wgid = xcd_remap((int)(L % nwg), nwg);
        const int nig = WGM * nN, gid = wgid / nig, fm = gid * WGM, gsz = (nM - fm) < WGM ? (nM - fm) : WGM;
        const int pm = fm + ((wgid % nig) % gsz), pn = (wgid % nig) / gsz;
        u.a0 = pm * BM; u.bb = Bt + (size_t)pn * BM * pitchB; u.e0 = pm; u.e1 = pn; u.e2 = 0; u.e3 = 0; return true;
    }
    __device__ __forceinline__ unsigned arow(const GUnit& u, int r) const { return (unsigned)(u.a0 + r); }
};

#define PG8_SA(b, h) (((b) * 2 + (h)) * HTB)
#define PG8_SB(b, h) ((4 + (b) * 2 + (h)) * HTB)
#define PG8_STG(bufoff, gptr, v0, v1) do { \
        __builtin_amdgcn_global_load_lds((const unsigned*)((const char*)(gptr) + (v0)), (LAS unsigned*)(lds + (bufoff) + ldsw), 16, 0, 0); \
        __builtin_amdgcn_global_load_lds((const unsigned*)((const char*)(gptr) + (v1)), (LAS unsigned*)(lds + (bufoff) + ldsw + 8192), 16, 0, 0); } while (0)
#define PG8_STGA(bufoff, kb, vo) PG8_STG(bufoff, Abase + (kb), (vo)[0], (vo)[1])
#define PG8_STGB(bufoff, bp) PG8_STG(bufoff, bp, voffB[0], voffB[1])
#define PG8_LDA(dst, b, h) do { _Pragma("unroll") for (int m = 0; m < 4; ++m) _Pragma("unroll") for (int k = 0; k < 2; ++k) dst[m][k] = *(const LAS bf16x8*)(lds + PG8_SA(b, h) + aoff + m * 2048 + k * 1024); } while (0)
#define PG8_LDB(dst, b, h) do { _Pragma("unroll") for (int n = 0; n < 2; ++n) _Pragma("unroll") for (int k = 0; k < 2; ++k) dst[n][k] = *(const LAS bf16x8*)(lds + PG8_SB(b, h) + boff + n * 2048 + k * 1024); } while (0)
#define PG8_MMA(ai, bj, At, Bt) do { __builtin_amdgcn_s_setprio(1); _Pragma("unroll") for (int m = 0; m < 4; ++m) _Pragma("unroll") for (int n = 0; n < 2; ++n) _Pragma("unroll") for (int k = 0; k < 2; ++k) \
        acc[ai][bj][m][n] = __builtin_amdgcn_mfma_f32_16x16x32_bf16(Bt[n][k], At[m][k], acc[ai][bj][m][n], 0, 0, 0); __builtin_amdgcn_s_setprio(0); } while (0)
#define PG8_WAIT_V(n) asm volatile("s_waitcnt vmcnt(" #n ")" ::: "memory")
#define PG8_WAIT_L(n) asm volatile("s_waitcnt lgkmcnt(" #n ")" ::: "memory")
#define PG8_BAR __builtin_amdgcn_s_barrier()
#define PG8_SCHED __builtin_amdgcn_sched_barrier(0)

template <class Epi, class Sched, bool ALIGN_EPI>
__device__ __forceinline__ void gemm_phase(const int tid, LAS unsigned char* lds, const char* Abase, unsigned pitchA, unsigned pitchB, int K, const Sched& S, const Epi& E) {
    const int wid = __builtin_amdgcn_readfirstlane(tid >> 6), lane = tid & 63, wr = wid >> 2, wc = wid & 3, fr = lane & 15, fq = lane >> 4;
    const int nt = K / BK;
    int RA[2]; unsigned cA2[2], voffB[2];
#pragma unroll
    for (int i = 0; i < 2; ++i) { int R, C; stage_rc(tid * 16 + i * 8192, R, C); const int Rb = Epi::PERM ? ((R & ~31) + perm32(R & 31)) : R;
        RA[i] = R; cA2[i] = (unsigned)C * 2u; voffB[i] = (unsigned)Rb * pitchB + (unsigned)C * 2u; }
    const unsigned hstepB = (unsigned)HALF * pitchB;
    const unsigned ldsw = (unsigned)wid * 1024u;
    const int aoff = lds_byte(wr * 64 + fr, fq * 8), boff = lds_byte(wc * 32 + fr, fq * 8);
    GUnit cur, nxt; int ui = 0;
    if (!S.next(0, cur)) return;
    f32x4 acc[2][2][4][2];
#pragma unroll
    for (int a = 0; a < 2; ++a)
#pragma unroll
        for (int b = 0; b < 2; ++b)
#pragma unroll
            for (int m = 0; m < 4; ++m)
#pragma unroll
                for (int n = 0; n < 2; ++n) acc[a][b][m][n] = (f32x4){0.f, 0.f, 0.f, 0.f};
    bf16x8 At[4][2], B0[2][2], B1[2][2];
    unsigned voA[2][2];
#pragma unroll
    for (int h = 0; h < 2; ++h)
#pragma unroll
        for (int i = 0; i < 2; ++i) voA[h][i] = S.arow(cur, h * HALF + RA[i]) * pitchA + cA2[i];
    const char* cB = cur.bb;
    const unsigned kstep = BK * 2;
    PG8_STGB(PG8_SB(0, 0), cB); PG8_STGB(PG8_SB(0, 1), cB + hstepB); PG8_STGA(PG8_SA(0, 0), 0, voA[0]); PG8_STGA(PG8_SA(0, 1), 0, voA[1]);
    if (wr == 1) PG8_BAR;
    PG8_WAIT_V(2); PG8_BAR;
    PG8_STGB(PG8_SB(1, 0), cB + kstep); PG8_STGA(PG8_SA(1, 0), kstep, voA[0]); PG8_STGB(PG8_SB(1, 1), cB + hstepB + kstep);
    PG8_WAIT_V(6); PG8_BAR;
    for (;;) {
        const bool has_next = S.next(ui + 1, nxt);
        const char* nB = has_next ? nxt.bb : cB;
        for (int t = 0; t < nt; t += 2) {
            const bool last = (t == nt - 2);
            const unsigned kb1 = (unsigned)(t + 1) * kstep;
            const unsigned kb2 = last ? 0u : (unsigned)(t + 2) * kstep, kb3 = kb2 + kstep;
            const char* b2 = last ? nB : cB + (size_t)(t + 2) * kstep; const char* b3 = b2 + kstep;
            PG8_LDB(B0, 0, 0); PG8_LDB(B1, 0, 1); PG8_SCHED; PG8_LDA(At, 0, 0); PG8_STGA(PG8_SA(1, 1), kb1, voA[1]);
            if (last && has_next) {
#pragma unroll
                for (int h = 0; h < 2; ++h)
#pragma unroll
                    for (int i = 0; i < 2; ++i) voA[h][i] = S.arow(nxt, h * HALF + RA[i]) * pitchA + cA2[i]; }
            PG8_WAIT_V(8); PG8_WAIT_L(0); PG8_BAR; PG8_MMA(0, 0, At, B0); PG8_MMA(0, 1, At, B1); PG8_BAR; PG8_SCHED;
            PG8_LDA(At, 0, 1); PG8_STGB(PG8_SB(0, 0), b2); PG8_STGB(PG8_SB(0, 1), b2 + hstepB); PG8_STGA(PG8_SA(0, 0), kb2, voA[0]);
            PG8_WAIT_V(8); PG8_WAIT_L(0); PG8_BAR; PG8_MMA(1, 0, At, B0); PG8_MMA(1, 1, At, B1); PG8_BAR; PG8_SCHED;
            PG8_LDB(B0, 1, 0); PG8_LDB(B1, 1, 1); PG8_SCHED; PG8_LDA(At, 1, 0); PG8_STGA(PG8_SA(0, 1), kb2, voA[1]);
            PG8_WAIT_V(8); PG8_WAIT_L(0); PG8_BAR; PG8_MMA(0, 0, At, B0); PG8_MMA(0, 1, At, B1); PG8_BAR; PG8_SCHED;
            PG8_LDA(At, 1, 1); PG8_STGB(PG8_SB(1, 0), b3); PG8_STGB(PG8_SB(1, 1), b3 + hstepB); PG8_STGA(PG8_SA(1, 0), kb3, voA[0]);
            PG8_WAIT_V(8); PG8_WAIT_L(0); PG8_BAR; PG8_MMA(1, 0, At, B0); PG8_MMA(1, 1, At, B1); PG8_BAR; PG8_SCHED;
        }
        if constexpr (ALIGN_EPI) { if (wr == 0) PG8_BAR; }
        E(acc, cur, wr, wc, fr, fq);
        if (!has_next) break;
#pragma unroll
        for (int a = 0; a < 2; ++a)
#pragma unroll
            for (int b = 0; b < 2; ++b)
#pragma unroll
                for (int m = 0; m < 4; ++m)
#pragma unroll
                    for (int n = 0; n < 2; ++n) acc[a][b][m][n] = (f32x4){0.f, 0.f, 0.f, 0.f};
        cur = nxt; cB = nB; ++ui;
        if constexpr (ALIGN_EPI) { if (wr == 1) PG8_BAR; }
    }
    PG8_WAIT_V(0);
    if constexpr (!ALIGN_EPI) { if (wr == 0) PG8_BAR; }
    PG8_BAR;
}
}

#define XB_TMO      128
#define XB_XCNT(j)  (256  + 64 * (j))
#define XB_XSUB(j)  (1280 + 64 * (j))
#define XB_XGEN(j)  (2304 + 64 * (j))
#define XB_TOP      3328
#define XB_TOPGEN   3392
#define XCD_BAR_WORDS 3456
#define XB_SPIN_CAP (1u << 18)
__device__ __forceinline__ unsigned xb_ld(unsigned* p)              { return __hip_atomic_load(p, __ATOMIC_RELAXED, __HIP_MEMORY_SCOPE_AGENT); }
__device__ __forceinline__ unsigned xb_add(unsigned* p, unsigned v) { return __hip_atomic_fetch_add(p, v, __ATOMIC_RELAXED, __HIP_MEMORY_SCOPE_AGENT); }
__device__ __forceinline__ unsigned xb_xcc_id() { return (unsigned)__builtin_amdgcn_s_getreg((3 << 11) | 20) & 0xFu; }
#define XB_SPIN(cond, bar) do { unsigned _sp = 0; while (cond) { __builtin_amdgcn_s_sleep(1); \
    if ((++_sp & 255u) == 0u) { if (xb_ld(&(bar)[XB_TMO])) break; if (_sp > XB_SPIN_CAP) { atomicAdd(&(bar)[XB_TMO], 1u); break; } } } } while (0)
struct XcdBarrier { unsigned* bar; unsigned x; volatile LAS unsigned* st; };
__device__ __forceinline__ XcdBarrier xcd_barrier_post(unsigned* bar, volatile LAS unsigned* st) {
    XcdBarrier b; b.bar = bar; b.x = xb_xcc_id(); b.st = st;
    if (threadIdx.x == 0) (void)xb_add(&bar[XB_XCNT(b.x)], 1u);
    return b;
}
__device__ __forceinline__ void xcd_barrier_complete(unsigned* bar, unsigned x, unsigned& nloc, unsigned& nx) {
    const unsigned G = gridDim.x * gridDim.y * gridDim.z;
    unsigned sum, cnt, mine, sp = 0u;
    for (;;) {
        sum = 0u; cnt = 0u; mine = 0u;
#pragma unroll
        for (unsigned j = 0; j < 16; ++j) { const unsigned c = xb_ld(&bar[XB_XCNT(j)]); sum += c; cnt += (c > 0u) ? 1u : 0u; mine = (j == x) ? c : mine; }
        if (sum == G) break;
        __builtin_amdgcn_s_sleep(1);
        if ((++sp & 255u) == 0u) { if (xb_ld(&bar[XB_TMO])) break; if (sp > XB_SPIN_CAP) { atomicAdd(&bar[XB_TMO], 1u); break; } }
    }
    nloc = mine > 0u ? mine : 1u; nx = cnt > 0u ? cnt : 1u;
}
__device__ __forceinline__ void xcd_barrier(const XcdBarrier& b, const int tid) {
    asm volatile("s_waitcnt vmcnt(0)" ::: "memory");
    __syncthreads();
    if (tid == 0) {
        unsigned* bar = b.bar; const unsigned bx_ = xb_xcc_id();
        __builtin_amdgcn_s_waitcnt(0);
        unsigned nloc = b.st[0], nx = b.st[1];
        if (nloc == 0u) { xcd_barrier_complete(bar, bx_, nloc, nx); b.st[0] = nloc; b.st[1] = nx; }
        const unsigned old = xb_add(&bar[XB_XSUB(bx_)], 1u);
        const unsigned gen = old / nloc;
        if (old + 1u == (gen + 1u) * nloc) {
            __builtin_amdgcn_fence(__ATOMIC_RELEASE, "agent");
            asm volatile("s_waitcnt vmcnt(0)" ::: "memory");
            const unsigned og = xb_add(&bar[XB_TOP], 1u);
            const unsigned tg = og / nx;
            if (og + 1u == (tg + 1u) * nx) xb_add(&bar[XB_TOPGEN], 1u);
            else XB_SPIN(xb_ld(&bar[XB_TOPGEN]) == tg, bar);
            __builtin_amdgcn_fence(__ATOMIC_ACQUIRE, "agent");
            xb_add(&bar[XB_XGEN(bx_)], 1u);
            asm volatile("s_waitcnt vmcnt(0)" ::: "memory");
        } else {
            XB_SPIN(xb_ld(&bar[XB_XGEN(bx_)]) == gen, bar);
            __builtin_amdgcn_fence(__ATOMIC_ACQUIRE, "agent");
            asm volatile("s_waitcnt vmcnt(0)" ::: "memory");
        }
    }
    __syncthreads();
}

__device__ __forceinline__ const void* launder_ptr(const void* p) {
    unsigned lo = (unsigned)(uintptr_t)p, hi = (unsigned)((uintptr_t)p >> 32);
    asm volatile("" : "+v"(lo), "+v"(hi));
    lo = __builtin_amdgcn_readfirstlane(lo); hi = __builtin_amdgcn_readfirstlane(hi);
    return (const void*)(((uintptr_t)hi << 32) | (uintptr_t)lo);
}
struct Args { const float* in[26]; float* out; unsigned char* ws; };

__device__ __forceinline__ const void* karg_ptr(int idx) {
    const unsigned long long ka = (unsigned long long)__builtin_amdgcn_kernarg_segment_ptr();
    unsigned long long v; asm volatile("s_load_dwordx2 %0, %1, %2\n\ts_waitcnt lgkmcnt(0)" : "=s"(v) : "s"(ka), "s"(idx * 8) : "memory");
    return (const void*)(GAS const void*)(uintptr_t)v;
}
struct Frame {
    LAS unsigned char* lds; char* shm;
    int tid, lane, wave, vcu, G;
    float* out; unsigned char* ws; int wave_s;
    __device__ __forceinline__ const float* inp(int i) const { return (const float*)karg_ptr(i); }
};
__device__ __forceinline__ void frame_refresh(Frame& F) {
    asm volatile("" ::: "memory");
    int t_; asm volatile("v_mbcnt_lo_u32_b32 %0, -1, 0\n\tv_mbcnt_hi_u32_b32 %0, -1, %0" : "=v"(t_)); t_ |= (F.wave_s << 6);
    F.tid = t_; F.lane = t_ & 63; F.wave = __builtin_amdgcn_readfirstlane(t_ >> 6);
    F.out = (float*)karg_ptr(26); F.ws = (unsigned char*)karg_ptr(27);
}
#define F_X 0
#define F_C 1
#define F_WMOD 2
#define F_BMOD 3
#define F_NMIX 4
#define F_NFFN 5
#define F_WIN 6
#define F_WOUT 7
#define F_OGAIN 8
#define F_SINKS 9
#define F_CONVW 10
#define F_CONVB 11
#define F_LWA 12
#define F_LBA 13
#define F_LWX 14
#define F_LBX 15
#define F_LAM 16
#define F_FOXB 17
#define F_WRG 18
#define F_BRG 19
#define F_WRE 20
#define F_BRE 21
#define F_WGATE 22
#define F_WUP 23
#define F_WDOWN 24
#define F_NFIN 25

struct EpiProj {
    static constexpr bool PERM = true;
    bf16_t* O; unsigned* km;
    __device__ __forceinline__ void operator()(const f32x4 (&acc)[2][2][4][2], const pg8::GUnit& u, int wr, int wc, int fr, int fq) const {
        const int row0 = u.e0 * 256 + wr * 64 + fr, pn = u.e1;
        const float sc = (pn == 0 || pn == 1 || pn == 5) ? C2 : 1.f;
        const int col0 = pn * 256 + wc * 32 + 8 * fq;
#pragma unroll
        for (int ai = 0; ai < 2; ++ai)
#pragma unroll
            for (int m = 0; m < 4; ++m) { bf16_t* rowp = O + (size_t)(row0 + ai * 128 + m * 16) * NPROJ + col0;
#pragma unroll
                for (int bj = 0; bj < 2; ++bj) { const f32x4 v0 = acc[ai][bj][m][0] * sc, v1 = acc[ai][bj][m][1] * sc;
                    u32x4 w; w.x = cvtpk(v0[0], v0[1]); w.y = cvtpk(v0[2], v0[3]); w.z = cvtpk(v1[0], v1[1]); w.w = cvtpk(v1[2], v1[3]);
                    *(u32x4*)(rowp + bj * 128) = w; } }
        if (pn == 6) {
            const int b = u.e0 >> 5;
#pragma unroll
            for (int bj = 0; bj < 2; ++bj) { float mx = 0.f;
#pragma unroll
                for (int ai = 0; ai < 2; ++ai)
#pragma unroll
                    for (int m = 0; m < 4; ++m) { const f32x4 v0 = acc[ai][bj][m][0], v1 = acc[ai][bj][m][1];
                        mx = __builtin_fmaxf(mx, (v0[0] * v0[0] + v0[1] * v0[1]) + (v0[2] * v0[2] + v0[3] * v0[3]) + (v1[0] * v1[0] + v1[1] * v1[1]) + (v1[2] * v1[2] + v1[3] * v1[3])); }
                mx = __builtin_fmaxf(mx, shx<1>(mx)); mx = __builtin_fmaxf(mx, shx<2>(mx)); mx = __builtin_fmaxf(mx, shx<4>(mx)); mx = __builtin_fmaxf(mx, shx<8>(mx));
                if (fr == 0) atomicMax(km + ((b * 4 + 2 * bj + (wc >> 1)) * 8 + 4 * (wc & 1) + fq), __float_as_uint(mx)); }
        }
    }
};
struct EpiRes {
    static constexpr bool PERM = false;
    const float* xin; float* xout; const float* gate;
    __device__ __forceinline__ void operator()(const f32x4 (&acc)[2][2][4][2], const pg8::GUnit& u, int wr, int wc, int fr, int fq) const {
        const int row0 = u.e0 * 256 + wr * 64 + fr, b = u.e0 >> 5, col0 = u.e1 * 256 + wc * 32 + 4 * fq;
        f32x4 gv[2][2];
#pragma unroll
        for (int bj = 0; bj < 2; ++bj)
#pragma unroll
            for (int n = 0; n < 2; ++n) gv[bj][n] = *(const f32x4*)(gate + b * 6144 + col0 + bj * 128 + n * 16);
#pragma unroll
        for (int ai = 0; ai < 2; ++ai)
#pragma unroll
            for (int m = 0; m < 4; ++m) { const size_t off = (size_t)(row0 + ai * 128 + m * 16) * D + col0;
#pragma unroll
                for (int bj = 0; bj < 2; ++bj)
#pragma unroll
                    for (int n = 0; n < 2; ++n) { const f32x4 xv = *(const f32x4*)(xin + off + bj * 128 + n * 16);
                        *(f32x4*)(xout + off + bj * 128 + n * 16) = xv + gv[bj][n] * acc[ai][bj][m][n]; } }
    }
};
struct EpiUp {
    static constexpr bool PERM = true;
    bf16_t* HID; const LEntry* list; const unsigned* cnt;
    __device__ __forceinline__ void operator()(const f32x4 (&acc)[2][2][4][2], const pg8::GUnit& u, int wr, int wc, int fr, int fq) const {
        const int pn = u.e1, slot = pn >> 1, pnl = pn & 1, cls = u.e2;
        const unsigned n = __hip_atomic_load(cnt + 64 * cls, __ATOMIC_RELAXED, __HIP_MEMORY_SCOPE_AGENT);
        const int colh = 256 * slot + 128 * pnl + wc * 32 + 8 * fq;
#pragma unroll
        for (int ai = 0; ai < 2; ++ai)
#pragma unroll
            for (int m = 0; m < 4; ++m) { const int r = ai * 128 + wr * 64 + m * 16 + fr; const unsigned pos = (unsigned)(u.e3 + r);
                float w = 0.f;
                if (pos < n) { const LEntry* e = list + (size_t)cls * LCAP + pos; w = slot ? e->w1 : e->w0; }
                float h[8];
#pragma unroll
                for (int nn = 0; nn < 2; ++nn)
#pragma unroll
                    for (int i = 0; i < 4; ++i) { const float g = acc[ai][0][m][nn][i], up = acc[ai][1][m][nn][i]; h[nn * 4 + i] = g * sigmoidf_(g) * up * w; }
                u32x4 o; o.x = cvtpk(h[0], h[1]); o.y = cvtpk(h[2], h[3]); o.z = cvtpk(h[4], h[5]); o.w = cvtpk(h[6], h[7]);
                *(u32x4*)(HID + (size_t)(u.e0 * 256 + r) * 512 + colh) = o; }
    }
};
struct EpiDown {
    static constexpr bool PERM = false;
    float* X; const float* gate; const LEntry* list; const unsigned* cnt;
    __device__ __forceinline__ void operator()(const f32x4 (&acc)[2][2][4][2], const pg8::GUnit& u, int wr, int wc, int fr, int fq) const {
        const int cls = u.e2, col0 = u.e1 * 256 + wc * 32 + 4 * fq;
        const unsigned n = __hip_atomic_load(cnt + 64 * cls, __ATOMIC_RELAXED, __HIP_MEMORY_SCOPE_AGENT);
#pragma unroll
        for (int ai = 0; ai < 2; ++ai)
#pragma unroll
            for (int m = 0; m < 4; ++m) { const int r = ai * 128 + wr * 64 + m * 16 + fr; const unsigned pos = (unsigned)(u.e3 + r);
                if (pos < n) { const int tok = list[(size_t)cls * LCAP + pos].tok; const int b = tok >> 13;
                    float* xr = X + (size_t)tok * D + col0; const float* gr = gate + b * 6144 + col0;
#pragma unroll
                    for (int bj = 0; bj < 2; ++bj)
#pragma unroll
                        for (int nn = 0; nn < 2; ++nn) { const f32x4 gv = *(const f32x4*)(gr + bj * 128 + nn * 16); const f32x4 xv = *(const f32x4*)(xr + bj * 128 + nn * 16);
                            *(f32x4*)(xr + bj * 128 + nn * 16) = xv + gv * acc[ai][bj][m][nn]; } } }
    }
};

__device__ __forceinline__ void pair_of(int p, int& lo, int& hi) { lo = p < 3 ? 0 : (p < 5 ? 1 : 2); hi = p < 3 ? p + 1 : (p < 5 ? p - 1 : 3); }
struct MoeUpOrder {
    int nunits, G, c; const LAS int* tt; const char* WGU; const LEntry* list; const unsigned* cnt;
    __device__ __forceinline__ bool next(int i, pg8::GUnit& u) const {
        const long L = (long)i * G + c; if (L >= (long)nunits * UPREP) return false;
        const int wgid = pg8::xcd_remap((int)(L % nunits), nunits); const int tile = wgid >> 2, pn = wgid & 3; const int e = tt[tile];
        const int cls = e & 255; u.e0 = tile; u.e1 = pn; u.e2 = cls; u.e3 = e >> 8; u.a0 = 0;
        int lo, hi; pair_of(cls % 6, lo, hi); const int ex = (cls / 6) * 4 + ((pn >> 1) ? hi : lo);
        u.bb = WGU + ((size_t)ex * 512 + (size_t)(pn & 1) * 256) * 2048; return true;
    }
    __device__ __forceinline__ unsigned arow(const pg8::GUnit& u, int r) const {
        const unsigned n = __hip_atomic_load(cnt + 64 * u.e2, __ATOMIC_RELAXED, __HIP_MEMORY_SCOPE_AGENT); const unsigned pos = (unsigned)(u.e3 + r);
        return (unsigned)list[(size_t)u.e2 * LCAP + (pos < n ? pos : 0u)].tok;
    }
};
struct MoeDownOrder {
    int nunits, G, c; const LAS int* tt; const char* WDP;
    __device__ __forceinline__ bool next(int i, pg8::GUnit& u) const {
        const long L = (long)i * G + c; if (L >= nunits) return false;
        const int wgid = pg8::xcd_remap((int)L, nunits); const int tile = wgid >> 2, pn = wgid & 3; const int e = tt[tile];
        const int cls = e & 255; u.e0 = tile; u.e1 = pn; u.e2 = cls; u.e3 = e >> 8; u.a0 = tile * 256;
        u.bb = WDP + ((size_t)cls * 1024 + (size_t)pn * 256) * 1024; return true;
    }
    __device__ __forceinline__ unsigned arow(const pg8::GUnit& u, int r) const { return (unsigned)(u.a0 + r); }
};

namespace att {
constexpr int DM = NPROJ;
constexpr int SLOTB = 8192;
constexpr int LDS_K = 0, LDS_V = 3 * SLOTB, LDS_WS = 6 * SLOTB, LDS_OST = LDS_WS + 2048, LDS_BIAS = LDS_OST + 8 * 4096, LDS_BLK = LDS_BIAS + 32768, LDS_MM = LDS_BLK + 256  , LDS_QM = LDS_MM + 96  , LDS_END = LDS_QM + 32;
static_assert(LDS_END <= RING_BYTES, "attention LDS");
typedef LAS const char* lds_cptr;
__device__ __forceinline__ int crow(int r, int hi) { return (r & 3) + 8 * (r >> 2) + 4 * hi; }
__device__ __forceinline__ void glds16(const void* gsrc, unsigned lds_dst) { unsigned keep;
    asm volatile("s_mov_b32 %0, m0\n\ts_mov_b32 m0, %2\n\ts_nop 0\n\tglobal_load_lds_dwordx4 %1, off\n\ts_mov_b32 m0, %0" : "=&s"(keep) : "v"(gsrc), "s"(lds_dst) : "memory"); }
__device__ __forceinline__ float max3f(float a, float b, float c) { return __builtin_fmaxf(__builtin_fmaxf(a, b), c); }
#define ATT_WAIT_BAR(N) asm volatile("s_waitcnt vmcnt(" #N ") lgkmcnt(0)\n\ts_barrier" ::: "memory")
typedef short v4i16_t __attribute__((ext_vector_type(4)));
__device__ __forceinline__ s16x4 vtr(lds_cptr p) { return __builtin_bit_cast(s16x4, __builtin_amdgcn_ds_read_tr16_b64_v4i16((LAS v4i16_t*)p)); }
__device__ __forceinline__ float rowmax(const f32x16& p0, const f32x16& p1) {
    float a = max3f(p0[0], p0[1], p1[0]), b = max3f(p0[2], p0[3], p1[1]); a = max3f(a, p1[2], p1[3]);
#pragma unroll
    for (int r = 4; r < 16; r += 4) { a = max3f(a, p0[r], p0[r + 1]); b = max3f(b, p0[r + 2], p0[r + 3]); a = max3f(a, p1[r], p1[r + 1]); b = max3f(b, p1[r + 2], p1[r + 3]); }
    const float m = __builtin_fmaxf(a, b);
    auto rr = __builtin_amdgcn_permlane32_swap(__float_as_uint(m), __float_as_uint(m), false, false);
    return __builtin_fmaxf(__uint_as_float(rr[0]), __uint_as_float(rr[1]));
}
__device__ __forceinline__ void pv(f32x16* o, int vb, bf16x8 pa0, bf16x8 pa1, bf16x8 pa2, bf16x8 pa3) {
#pragma unroll
    for (int d0 = 0; d0 < 2; ++d0) { s16x4 lo[4], hi[4];
#pragma unroll
        for (int ks = 0; ks < 4; ++ks) {
            asm volatile("ds_read_b64_tr_b16 %0,%1 offset:%c2" : "=&v"(lo[ks]) : "v"(vb), "i"(d0 * 4096 + ks * 1024) : "memory");
            asm volatile("ds_read_b64_tr_b16 %0,%1 offset:%c2" : "=&v"(hi[ks]) : "v"(vb), "i"(d0 * 4096 + ks * 1024 + 512) : "memory"); }
        asm volatile("s_waitcnt lgkmcnt(0)" ::: "memory"); __builtin_amdgcn_sched_barrier(0);
#define ATT_PK(k) (bf16x8){lo[k][0], lo[k][1], lo[k][2], lo[k][3], hi[k][0], hi[k][1], hi[k][2], hi[k][3]}
        o[d0] = __builtin_amdgcn_mfma_f32_32x32x16_bf16(pa0, ATT_PK(0), o[d0], 0, 0, 0);
        o[d0] = __builtin_amdgcn_mfma_f32_32x32x16_bf16(pa1, ATT_PK(1), o[d0], 0, 0, 0);
        o[d0] = __builtin_amdgcn_mfma_f32_32x32x16_bf16(pa2, ATT_PK(2), o[d0], 0, 0, 0);
        o[d0] = __builtin_amdgcn_mfma_f32_32x32x16_bf16(pa3, ATT_PK(3), o[d0], 0, 0, 0);
#undef ATT_PK
    }
}
template <int MODE>
__device__ __forceinline__ void attn_core(char* shm, const bf16_t* Qw, const bf16_t* Kh, const bf16_t* Vh, bf16_t* Ow, int q0, int t_lo, int t_hi, float sinkl2, float slope2, const int tid, const float kn2 = 0.f) {
    const int lane = tid & 63, r32 = lane & 31, hi = lane >> 5; const int wid = __builtin_amdgcn_readfirstlane(tid >> 6);
    const unsigned lds0 = (unsigned)(uintptr_t)shm;
    float* wsf = (float*)(shm + LDS_WS) + wid * 64;
    const lds_cptr shm3 = (lds_cptr)shm;
    const bf16_t* ksrc = Kh + (long)lane * DM + wid * 8;
    const bf16_t* vsrc = Vh + (long)(16 * (wid & 3) + (lane >> 2)) * DM + (wid >> 2) * 32 + (lane & 3) * 8;
    const unsigned kdst = lds0 + LDS_K + wid * 1024, vdst = lds0 + LDS_V + wid * 1024;
#define ATT_DMA_K(t, slot) glds16(ksrc + (long)(t) * 64 * DM, (unsigned)__builtin_amdgcn_readfirstlane(kdst + (slot)))
#define ATT_DMA_V(t, slot) glds16(vsrc + (long)(t) * 64 * DM, (unsigned)__builtin_amdgcn_readfirstlane(vdst + (slot)))
    const int vb0 = (int)(lds0 + LDS_V) + ((lane >> 4) & 1) * 32 + (lane & 3) * 8 + (4 * hi + ((lane & 15) >> 2)) * 64;
    const int n = t_hi - t_lo + 1;
    const int qw0 = q0 + 32 * wid, w_hi = (qw0 + 31) >> 6;
    const int w_lo = (MODE == 1) ? ((qw0 - 127 > 0 ? qw0 - 127 : 0) >> 6) : t_lo;
    bf16x8 qr[4];
#pragma unroll
    for (int d0 = 0; d0 < 4; ++d0) qr[d0] = *reinterpret_cast<const bf16x8*>(&Qw[(long)r32 * DM + d0 * 16 + hi * 8]);
    ATT_DMA_K(t_hi, 0); ATT_DMA_V(t_hi, 0);
    if (n > 1) { ATT_DMA_K(t_hi - 1, SLOTB); ATT_DMA_V(t_hi - 1, SLOTB); }
    LAS float* mmp = (LAS float*)(shm3 + LDS_MM); LAS float* qmp = (LAS float*)(shm3 + LDS_QM);
    if (MODE == 0) {
        float qs = 0.f;
#pragma unroll
        for (int d0 = 0; d0 < 4; ++d0)
#pragma unroll
            for (int e = 0; e < 8; ++e) { const float v = bf2f((bf16_t)qr[d0][e]); qs += v * v; }
        { auto rr = __builtin_amdgcn_permlane32_swap(__float_as_uint(qs), __float_as_uint(qs), false, false); qs = __uint_as_float(rr[0]) + __uint_as_float(rr[1]); }
        qs = __builtin_fmaxf(qs, shx<1>(qs)); qs = __builtin_fmaxf(qs, shx<2>(qs)); qs = __builtin_fmaxf(qs, shx<4>(qs)); qs = __builtin_fmaxf(qs, shx<8>(qs)); qs = __builtin_fmaxf(qs, shx<16>(qs));
        if (lane == 0) { qmp[wid] = qs; mmp[wid] = -1e30f; mmp[8 + wid] = -1e30f; mmp[16 + wid] = -1e30f; }
    }
    float bqk = 0.f;
    float mhat = 0.f, l_reg = 0.f; f32x16 o[2]; o[0] = f32x16{}; o[1] = f32x16{}; bool first = true;
    const int q = qw0 + r32;
    const int grp = wid >> 2;
#define ATT_LBAR() asm volatile("s_waitcnt lgkmcnt(0)\n\ts_barrier" ::: "memory")
#define ATT_ISSUE(i2) do { if ((i2) < n) { const int sl_ = ((i2) % 3) * SLOTB; ATT_DMA_K(t_hi - (i2), sl_); ATT_DMA_V(t_hi - (i2), sl_); } } while (0)
    if (grp == 1) { if (n > 1) { ATT_WAIT_BAR(2); } else { ATT_WAIT_BAR(0); } }
#pragma unroll 1
    for (int ti = 0; ti < n; ++ti) {
        const int t = t_hi - ti, sl_cur = (ti % 3) * SLOTB;
        const bool need = (t >= w_lo && t <= w_hi);
        if (MODE == 0 && ti >= 2) {
            if (ti == 2) { const f32x4 qa = *(const LAS f32x4*)qmp, qb_ = *(const LAS f32x4*)(qmp + 4);
                const float qn2 = __builtin_fmaxf(__builtin_fmaxf(__builtin_fmaxf(qa[0], qa[1]), __builtin_fmaxf(qa[2], qa[3])), __builtin_fmaxf(__builtin_fmaxf(qb_[0], qb_[1]), __builtin_fmaxf(qb_[2], qb_[3])));
                bqk = __int_as_float(__builtin_amdgcn_readfirstlane(__float_as_int(sqrtf(qn2 * kn2) * 1.02f + 1.0f))); }
            const LAS float* mp = mmp + ((ti - 2) % 3) * 8; const f32x4 ma = *(const LAS f32x4*)mp, mb = *(const LAS f32x4*)(mp + 4);
            const float mm = __builtin_fminf(__builtin_fminf(__builtin_fminf(ma[0], ma[1]), __builtin_fminf(ma[2], ma[3])), __builtin_fminf(__builtin_fminf(mb[0], mb[1]), __builtin_fminf(mb[2], mb[3])));
            const float bmax = *((const LAS float*)(shm3 + LDS_BIAS) + (t - t_lo) * 64 + 63);
            if (__builtin_amdgcn_readfirstlane((int)(bqk + bmax < mm - 160.f))) break;
        }
        if (grp == 0) { if (ti + 1 < n) { ATT_WAIT_BAR(2); } else { ATT_WAIT_BAR(0); } }
        else { ATT_LBAR(); ATT_ISSUE(ti + 2); }
        f32x16 p0, p1;
        if (need) {
            { const LAS float* bp = (const LAS float*)(shm3 + LDS_BIAS) + (t - t_lo) * 64 + 4 * hi;
#pragma unroll
              for (int jj = 0; jj < 4; ++jj) { const f32x4 a = *(const LAS f32x4*)(bp + 8 * jj), b = *(const LAS f32x4*)(bp + 32 + 8 * jj);
                  p0[4 * jj] = a[0] - mhat; p0[4 * jj + 1] = a[1] - mhat; p0[4 * jj + 2] = a[2] - mhat; p0[4 * jj + 3] = a[3] - mhat;
                  p1[4 * jj] = b[0] - mhat; p1[4 * jj + 1] = b[1] - mhat; p1[4 * jj + 2] = b[2] - mhat; p1[4 * jj + 3] = b[3] - mhat; } }
            { const lds_cptr kb = shm3 + LDS_K + sl_cur + hi * 1024 + r32 * 16;
#pragma unroll
              for (int d0 = 0; d0 < 4; ++d0) { const bf16x8 b0 = *(const LAS bf16x8*)(kb + d0 * 2048), b1 = *(const LAS bf16x8*)(kb + d0 * 2048 + 512);
                  p0 = __builtin_amdgcn_mfma_f32_32x32x16_bf16(b0, qr[d0], p0, 0, 0, 0); p1 = __builtin_amdgcn_mfma_f32_32x32x16_bf16(b1, qr[d0], p1, 0, 0, 0); } }
            const float NEG = -__builtin_inff();
            if (MODE == 0) { if (t == w_hi) { const int kb_ = 64 * t + 4 * hi;
#pragma unroll
                for (int r = 0; r < 16; ++r) { const int kv = kb_ + (r & 3) + 8 * (r >> 2); if (kv > q) p0[r] = NEG; if (kv + 32 > q) p1[r] = NEG; } } }
            else { const int kb_ = 64 * t + 4 * hi;
#pragma unroll
                for (int r = 0; r < 16; ++r) { const int kv = kb_ + (r & 3) + 8 * (r >> 2); if ((unsigned)(q - kv) >= 128u) p0[r] = NEG; if ((unsigned)(q - kv - 32) >= 128u) p1[r] = NEG; } }
            const float rm = rowmax(p0, p1);
            if (first || __any(rm > 8.f)) {
                const float dl = first ? __builtin_fmaxf(rm, -1e30f) : __builtin_fmaxf(rm, 0.f); const float f = first ? 1.f : __builtin_amdgcn_exp2f(-dl);
                first = false; mhat += dl; l_reg *= f; if (hi == 0) wsf[r32] = f;
#pragma unroll
                for (int r = 0; r < 16; ++r) { p0[r] -= dl; p1[r] -= dl; }
                asm volatile("s_waitcnt lgkmcnt(0)" ::: "memory");
#pragma unroll
                for (int jj = 0; jj < 4; ++jj) { const f32x4 fv = *(const f32x4*)(wsf + 8 * jj + 4 * hi);
#pragma unroll
                    for (int i2 = 0; i2 < 4; ++i2) { o[0][4 * jj + i2] *= fv[i2]; o[1][4 * jj + i2] *= fv[i2]; } }
            }
            if (MODE == 0) {
                float mn = mhat; mn = __builtin_fminf(mn, shx<1>(mn)); mn = __builtin_fminf(mn, shx<2>(mn)); mn = __builtin_fminf(mn, shx<4>(mn)); mn = __builtin_fminf(mn, shx<8>(mn)); mn = __builtin_fminf(mn, shx<16>(mn));
                if (lane == 0) mmp[(ti % 3) * 8 + wid] = mn; }
        }
        if (grp == 0) { ATT_LBAR(); ATT_ISSUE(ti + 2); }
        else { if (ti + 1 < n) { if (ti + 2 < n) { ATT_WAIT_BAR(2); } else { ATT_WAIT_BAR(0); } } else { ATT_LBAR(); } }
        if (need) {
            const lds_cptr vp = shm3 + LDS_V + sl_cur + ((lane >> 4) & 1) * 32 + (lane & 3) * 8 + (4 * hi + ((lane & 15) >> 2)) * 64;
#define ATT_SB() __builtin_amdgcn_sched_barrier(0)
#define ATT_PIN(x) asm volatile("" : "+v"(x))
#define ATT_VRD(i) do { vlo[i] = vtr(vp + (((i) >> 2) * 4096 + ((i) & 3) * 1024)); vhi[i] = vtr(vp + (((i) >> 2) * 4096 + ((i) & 3) * 1024 + 512)); } while (0)
#define ATT_VF(i) (bf16x8){vlo[i][0], vlo[i][1], vlo[i][2], vlo[i][3], vhi[i][0], vhi[i][1], vhi[i][2], vhi[i][3]}
#define ATT_PIN4(B) asm volatile("" : "+v"(ex[B]), "+v"(ex[B + 1]), "+v"(ex[B + 2]), "+v"(ex[B + 3]))
#define ATT_EX4(P, PB, B) do { ex[B] = __builtin_amdgcn_exp2f(P[PB]); ex[B + 1] = __builtin_amdgcn_exp2f(P[PB + 1]); ex[B + 2] = __builtin_amdgcn_exp2f(P[PB + 2]); ex[B + 3] = __builtin_amdgcn_exp2f(P[PB + 3]); ATT_PIN4(B); } while (0)
#define ATT_PK4(B) (u32x4){cvtpk(ex[B], ex[B + 1]), cvtpk(ex[B + 2], ex[B + 3]), cvtpk(ex[B + 4], ex[B + 5]), cvtpk(ex[B + 6], ex[B + 7])}
#define ATT_SUM4(B) do { sacc += ex[B]; sacc += ex[B + 1]; sacc += ex[B + 2]; sacc += ex[B + 3]; ATT_PIN(sacc); } while (0)
            s16x4 vlo[8], vhi[8]; u32x4 pw0, pw1, pw2, pw3; float sacc = 0.f; float ex[32];
            ATT_VRD(0); ATT_VRD(4);
            ATT_EX4(p0, 0, 0); ATT_EX4(p0, 4, 4); pw0 = ATT_PK4(0); ATT_PIN(pw0); ATT_SB();
            o[0] = __builtin_amdgcn_mfma_f32_32x32x16_bf16(__builtin_bit_cast(bf16x8, pw0), ATT_VF(0), o[0], 0, 0, 0); ATT_VRD(1); ATT_EX4(p0, 8, 8); ATT_SUM4(0); ATT_SB();
            o[1] = __builtin_amdgcn_mfma_f32_32x32x16_bf16(__builtin_bit_cast(bf16x8, pw0), ATT_VF(4), o[1], 0, 0, 0); ATT_VRD(5); ATT_EX4(p0, 12, 12); pw1 = ATT_PK4(8); ATT_PIN(pw1); ATT_SB();
            o[0] = __builtin_amdgcn_mfma_f32_32x32x16_bf16(__builtin_bit_cast(bf16x8, pw1), ATT_VF(1), o[0], 0, 0, 0); ATT_VRD(2); ATT_EX4(p1, 0, 16); ATT_SUM4(4); ATT_SB();
            o[1] = __builtin_amdgcn_mfma_f32_32x32x16_bf16(__builtin_bit_cast(bf16x8, pw1), ATT_VF(5), o[1], 0, 0, 0); ATT_VRD(6); ATT_EX4(p1, 4, 20); pw2 = ATT_PK4(16); ATT_PIN(pw2); ATT_SB();
            o[0] = __builtin_amdgcn_mfma_f32_32x32x16_bf16(__builtin_bit_cast(bf16x8, pw2), ATT_VF(2), o[0], 0, 0, 0); ATT_VRD(3); ATT_EX4(p1, 8, 24); ATT_SUM4(8); ATT_SB();
            o[1] = __builtin_amdgcn_mfma_f32_32x32x16_bf16(__builtin_bit_cast(bf16x8, pw2), ATT_VF(6), o[1], 0, 0, 0); ATT_VRD(7); ATT_EX4(p1, 12, 28); pw3 = ATT_PK4(24); ATT_PIN(pw3); ATT_SB();
            o[0] = __builtin_amdgcn_mfma_f32_32x32x16_bf16(__builtin_bit_cast(bf16x8, pw3), ATT_VF(3), o[0], 0, 0, 0); ATT_SUM4(12); ATT_SUM4(16); ATT_SUM4(20); ATT_SB();
            o[1] = __builtin_amdgcn_mfma_f32_32x32x16_bf16(__builtin_bit_cast(bf16x8, pw3), ATT_VF(7), o[1], 0, 0, 0); ATT_SUM4(24); ATT_SUM4(28); ATT_SB();
            l_reg += sacc;
#undef ATT_SB
#undef ATT_PIN
#undef ATT_VRD
#undef ATT_VF
#undef ATT_EX4
#undef ATT_PK4
#undef ATT_SUM4
#undef ATT_PIN4
        }
    }
    if (grp == 0) { ATT_LBAR(); }
#undef ATT_LBAR
#undef ATT_ISSUE
    { auto rr = __builtin_amdgcn_permlane32_swap(__float_as_uint(l_reg), __float_as_uint(l_reg), false, false); l_reg = __uint_as_float(rr[0]) + __uint_as_float(rr[1]); }
    if (MODE == 1) l_reg += __builtin_amdgcn_exp2f(sinkl2 + slope2 * (float)(32 * wid + r32) - mhat);
    if (hi == 0) wsf[32 + r32] = l_reg;
    asm volatile("s_waitcnt lgkmcnt(0)" ::: "memory");
    float rli[16];
#pragma unroll
    for (int r = 0; r < 16; ++r) rli[r] = __builtin_amdgcn_rcpf(wsf[32 + crow(r, hi)]);
    { bf16_t* stg = (bf16_t*)(shm + LDS_OST) + wid * 2048;
#pragma unroll
      for (int r = 0; r < 16; ++r) { const int orow = crow(r, hi);
#pragma unroll
          for (int d0 = 0; d0 < 2; ++d0) stg[orow * 64 + d0 * 32 + r32] = (bf16_t)(cvtpk(o[d0][r] * rli[r], 0.f) & 0xffffu); }
      asm volatile("s_waitcnt lgkmcnt(0)" ::: "memory");
#pragma unroll
      for (int i = 0; i < 4; ++i) { const int row = i * 8 + (lane >> 3), ch = lane & 7; const u32x4 v = *(const u32x4*)(stg + row * 64 + ch * 8); *(u32x4*)(Ow + (long)row * D + ch * 8) = v; } }
    asm volatile("s_waitcnt vmcnt(0) lgkmcnt(0)\n\ts_barrier" ::: "memory");
#undef ATT_DMA_K
#undef ATT_DMA_V
}
}

__device__ __forceinline__ void p0_tr_item(const float* W, int ld_src, int k0, int n0, bf16_t* d0, bf16_t* d1, bf16_t* d2, int ld_dst, LAS float* scr, int lane) {
#pragma unroll 8
    for (int i = 0; i < 32; ++i) { const int kk = 2 * i + (lane >> 5); scr[kk * 33 + (lane & 31)] = W[(size_t)(k0 + kk) * ld_src + n0 + (lane & 31)]; }
    LDS_WAIT(); asm volatile("" ::: "memory");
    const int c = lane & 7;
#pragma unroll
    for (int j = 0; j < 4; ++j) { const int n = (lane >> 3) + 8 * j; const LAS float* s = scr + (8 * c) * 33 + n;
        u32x4 o; o.x = cvtpk(s[0 * 33], s[1 * 33]); o.y = cvtpk(s[2 * 33], s[3 * 33]); o.z = cvtpk(s[4 * 33], s[5 * 33]); o.w = cvtpk(s[6 * 33], s[7 * 33]);
        *(u32x4*)(d0 + (size_t)n * ld_dst + 8 * c) = o;
        if (d1) *(u32x4*)(d1 + (size_t)n * ld_dst + 8 * c) = o;
        if (d2) *(u32x4*)(d2 + (size_t)n * ld_dst + 8 * c) = o; }
    LDS_WAIT(); asm volatile("" ::: "memory");
}
__device__ __forceinline__ int pair_idx(int lo, int hi) { return lo == 0 ? hi - 1 : (lo == 1 ? hi + 1 : 5); }

__device__ __forceinline__ void phase_p0(Frame& F) {
    {
        LAS float* sc = (LAS float*)F.lds;
        LAS float* red = (LAS float*)(F.lds + 16384);
        float* MOD = (float*)(F.ws + WS_MOD);
        bool have = false;
        for (int task = F.vcu; task < 48; task += F.G) {
            if (!have) { for (int i = F.tid; i < 4096; i += 512) { const float v = F.inp(F_C)[i]; sc[i] = v * sigmoidf_(v); } __syncthreads(); have = true; }
            const int l = task / 24, j0 = (task % 24) * 256;
            const float* wp = F.inp(F_WMOD) + (size_t)l * 1024 * 6144 + j0 + 4 * F.lane;
            f32x4 a0 = {0, 0, 0, 0}, a1 = a0, a2 = a0, a3 = a0;
            const int kbeg = F.wave * 128;
#pragma unroll 8
            for (int k = kbeg; k < kbeg + 128; ++k) { const f32x4 wv = *(const f32x4*)(wp + (size_t)k * 6144);
                a0 += wv * sc[k]; a1 += wv * sc[1024 + k]; a2 += wv * sc[2048 + k]; a3 += wv * sc[3072 + k]; }
            *(LAS f32x4*)(red + (F.wave * 4 + 0) * 256 + 4 * F.lane) = a0; *(LAS f32x4*)(red + (F.wave * 4 + 1) * 256 + 4 * F.lane) = a1;
            *(LAS f32x4*)(red + (F.wave * 4 + 2) * 256 + 4 * F.lane) = a2; *(LAS f32x4*)(red + (F.wave * 4 + 3) * 256 + 4 * F.lane) = a3;
            __syncthreads();
            for (int o = F.tid; o < 1024; o += 512) { const int b = o >> 8, cidx = o & 255; float s = F.inp(F_BMOD)[l * 6144 + j0 + cidx];
#pragma unroll
                for (int w = 0; w < 8; ++w) s += red[(w * 4 + b) * 256 + cidx];
                MOD[(size_t)(l * 4 + b) * 6144 + j0 + cidx] = s; }
            __syncthreads();
        }
        __syncthreads();
    }
    LAS float* scr = (LAS float*)(F.lds + F.wave * 16384);
    const int gw = F.vcu * 8 + F.wave, NGW = F.G * 8;
    bf16_t* WIN = (bf16_t*)(F.ws + WS_WIN); bf16_t* WOUT = (bf16_t*)(F.ws + WS_WOUT); bf16_t* WGU = (bf16_t*)(F.ws + WS_WGU); bf16_t* WDP = (bf16_t*)(F.ws + WS_WDP);
    constexpr int I_IN = 2 * 16 * 64, I_OUT = 2 * 16 * 32, I_GU = 2 * 16 * 2 * 16 * 8, I_DN = 2 * 16 * 4 * 32;
    for (int it = gw; it < I_IN + I_OUT + I_GU + I_DN; it += NGW) {
        int r = it;
        if (r < I_IN) { const int l = r / 1024, kb = (r % 1024) / 64, nb = r % 64;
            p0_tr_item(F.inp(F_WIN) + (size_t)l * 1024 * IN_COLS, IN_COLS, 64 * kb, 32 * nb, WIN + ((size_t)l * 2048 + 32 * nb) * 1024 + 64 * kb, nullptr, nullptr, 1024, scr, F.lane); continue; }
        r -= I_IN;
        if (r < I_OUT) { const int l = r / 512, kb = (r % 512) / 32, nb = r % 32;
            p0_tr_item(F.inp(F_WOUT) + (size_t)l * 1024 * 1024, 1024, 64 * kb, 32 * nb, WOUT + ((size_t)l * 1024 + 32 * nb) * 1024 + 64 * kb, nullptr, nullptr, 1024, scr, F.lane); continue; }
        r -= I_OUT;
        if (r < I_GU) { const int le = r / 256, which = (r % 256) / 128, kb = (r % 128) / 8, nb = r % 8;
            const int j0 = 32 * nb, row = 256 * (j0 >> 7) + (j0 & 127) + which * 128;
            p0_tr_item((which ? F.inp(F_WUP) : F.inp(F_WGATE)) + (size_t)le * 1024 * 256, 256, 64 * kb, j0, WGU + ((size_t)le * 512 + row) * 1024 + 64 * kb, nullptr, nullptr, 1024, scr, F.lane); continue; }
        r -= I_GU;
        { const int le = r / 128, kb = (r % 128) / 32, nb = r % 32; const int l = le >> 4, e = le & 15, g = e >> 2, i = e & 3;
          bf16_t* dst[3]; int nd = 0;
#pragma unroll
          for (int j = 0; j < 4; ++j) { if (j == i) continue; const int lo = i < j ? i : j, hi = i < j ? j : i; const int cls = g * 6 + pair_idx(lo, hi); const int kofs = (i == lo) ? 0 : 256;
              dst[nd++] = WDP + ((size_t)(l * 24 + cls) * 1024 + 32 * nb) * 512 + kofs + 64 * kb; }
          p0_tr_item(F.inp(F_WDOWN) + (size_t)le * 256 * 1024, 1024, 64 * kb, 32 * nb, dst[0], dst[1], dst[2], 512, scr, F.lane); }
    }
}

__device__ __forceinline__ void phase_norm1(Frame& F, int l, const float* xin) {
    const float* MOD = (const float*)(F.ws + WS_MOD) + (size_t)l * 4 * 6144;
    bf16_t* H = (bf16_t*)(F.ws + WS_H); float* CUM = (float*)(F.ws + WS_CUM); float* CTOT = (float*)(F.ws + WS_CTOT);
    LAS float* wtot = (LAS float*)F.lds;
    for (int tile = F.vcu; tile < T / 128; tile += F.G) {
        const int b = tile >> 6, row0 = tile * 128;
        f32x4 g1[4], s1[4], wfc[16];
#pragma unroll
        for (int j = 0; j < 4; ++j) { const int col = 4 * F.lane + 256 * j;
            const f32x4 nm = *(const f32x4*)(F.inp(F_NMIX) + l * 1024 + col), scv = *(const f32x4*)(MOD + b * 6144 + 1024 + col);
            g1[j] = nm * (scv + 1.0f); s1[j] = *(const f32x4*)(MOD + b * 6144 + col);
#pragma unroll
            for (int i = 0; i < 4; ++i) wfc[j * 4 + i] = *(const f32x4*)(F.inp(F_WIN) + ((size_t)l * 1024 + col + i) * IN_COLS + 2048); }
        const f32x4 fb = *(const f32x4*)(F.inp(F_FOXB) + l * 4);
        f32x4 run = {0.f, 0.f, 0.f, 0.f}, keep = {0.f, 0.f, 0.f, 0.f};
#pragma unroll 1
        for (int i = 0; i < 16; ++i) {
            const int row = row0 + F.wave * 16 + i;
            const f32x4* xr = (const f32x4*)(xin + (size_t)row * D) + F.lane;
            f32x4 v[4]; float ss = 0.f;
#pragma unroll
            for (int j = 0; j < 4; ++j) { v[j] = xr[64 * j]; ss += (v[j].x * v[j].x + v[j].y * v[j].y) + (v[j].z * v[j].z + v[j].w * v[j].w); }
            const float rstd = 1.0f / sqrtf(wave_sum(ss) * (1.f / D) + EPS);
            f32x4 fa = {0.f, 0.f, 0.f, 0.f};
            u32x2* o8 = (u32x2*)(H + (size_t)row * D) + F.lane;
#pragma unroll
            for (int j = 0; j < 4; ++j) { const f32x4 h = v[j] * rstd * g1[j] + s1[j];
                fa += wfc[j * 4 + 0] * h.x + wfc[j * 4 + 1] * h.y + wfc[j * 4 + 2] * h.z + wfc[j * 4 + 3] * h.w;
                u32x2 w; w.x = cvtpk(h.x, h.y); w.y = cvtpk(h.z, h.w); o8[64 * j] = w; }
#pragma unroll
            for (int e = 0; e < 4; ++e) { const float z = wave_sum(fa[e]) + fb[e];
                const float lf = fminf(z, 0.f) - __builtin_amdgcn_logf(1.f + fast_exp(-fabsf(z))) * 0.6931471805599453f;
                run[e] += lf; }
            if (F.lane == i) keep = run;
        }
        if (F.lane == 0) *(LAS f32x4*)(wtot + F.wave * 4) = run;
        __syncthreads();
        f32x4 pre = {0.f, 0.f, 0.f, 0.f}, tot = {0.f, 0.f, 0.f, 0.f};
#pragma unroll
        for (int w = 0; w < 8; ++w) { const f32x4 tv = *(const LAS f32x4*)(wtot + w * 4); if (w < F.wave) pre += tv; tot += tv; }
        if (F.lane < 16) { const int s = (row0 & (SEQ - 1)) + F.wave * 16 + F.lane; const f32x4 cv = keep + pre;
#pragma unroll
            for (int e = 0; e < 4; ++e) CUM[(size_t)(b * 4 + e) * SEQ + s] = cv[e]; }
        if (F.tid == 0) *(f32x4*)(CTOT + (size_t)(b * 64 + (tile & 63)) * 4) = tot;
        __syncthreads();
    }
}

__device__ __forceinline__ void lru_unit(Frame& F, int l, int b, int tt) {
    const bf16_t* PROJ = (const bf16_t*)(F.ws + WS_PROJ);
    float* HLOC = (float*)(F.ws + WS_H); float* PP = HLOC + (size_t)T * 256;
    float* LRUA = (float*)(F.ws + WS_LRUA); float* LRUH = (float*)(F.ws + WS_LRUH);
    LAS float* xcb = (LAS float*)F.lds;
    const int c = F.tid & 255, sl = F.tid >> 8, blk = c >> 5, dd = c & 31;
    float wa[32], wx[32];
#pragma unroll
    for (int j = 0; j < 32; ++j) { wa[j] = F.inp(F_LWA)[((size_t)(l * 8 + blk) * 32 + j) * 32 + dd]; wx[j] = F.inp(F_LWX)[((size_t)(l * 8 + blk) * 32 + j) * 32 + dd]; }
    const float cw0 = F.inp(F_CONVW)[(l * 4 + 0) * 256 + c], cw1 = F.inp(F_CONVW)[(l * 4 + 1) * 256 + c], cw2 = F.inp(F_CONVW)[(l * 4 + 2) * 256 + c], cw3 = F.inp(F_CONVW)[(l * 4 + 3) * 256 + c];
    const float cb = F.inp(F_CONVB)[l * 256 + c], ba = F.inp(F_LBA)[l * 256 + c], bx = F.inp(F_LBX)[l * 256 + c];
    const float lam = F.inp(F_LAM)[l * 256 + c];
    const float sp = -8.0f * (fmaxf(-lam, 0.f) + log1pf(expf(-fabsf(lam))));
    const int s0 = tt * 128 + sl * 64;
    const bf16_t* xp = PROJ + ((size_t)b * SEQ + s0) * NPROJ + C_XB + c;
    float xm3 = s0 >= 3 ? bf2f(xp[-3 * (long)NPROJ]) : 0.f, xm2 = s0 >= 2 ? bf2f(xp[-2 * (long)NPROJ]) : 0.f, xm1 = s0 >= 1 ? bf2f(xp[-1 * (long)NPROJ]) : 0.f;
    float h = 0.f, P = 1.f;
    for (int sub = 0; sub < 4; ++sub) {
        LAS float* xw = xcb + ((sub & 1) * 2 + sl) * 16 * 256;
        float xv[16];
#pragma unroll
        for (int i = 0; i < 16; ++i) { const float xc = bf2f(xp[(long)(sub * 16 + i) * NPROJ]); xv[i] = cb + cw0 * xm3 + cw1 * xm2 + cw2 * xm1 + cw3 * xc; xm3 = xm2; xm2 = xm1; xm1 = xc; xw[i * 256 + c] = xv[i]; }
        __syncthreads();
#pragma unroll
        for (int i = 0; i < 16; ++i) {
            float ga = ba, gx = bx; const LAS f32x4* xr = (const LAS f32x4*)(xw + i * 256 + blk * 32);
#pragma unroll
            for (int j4 = 0; j4 < 8; ++j4) { const f32x4 q = xr[j4];
                ga += q.x * wa[4 * j4] + q.y * wa[4 * j4 + 1] + q.z * wa[4 * j4 + 2] + q.w * wa[4 * j4 + 3];
                gx += q.x * wx[4 * j4] + q.y * wx[4 * j4 + 1] + q.z * wx[4 * j4 + 2] + q.w * wx[4 * j4 + 3]; }
            const float r = sigmoidf_(ga), ig = sigmoidf_(gx);
            const float la = sp * r; const float a = fast_exp(la);
            const float mult = sqrtf(-expm1f(2.f * la));
            const float u = mult * ig * xv[i];
            h = a * h + u; P *= a;
            const size_t off = ((size_t)b * SEQ + s0 + sub * 16 + i) * 256 + c;
            HLOC[off] = h; PP[off] = P;
        }
    }
    const size_t so = ((size_t)(b * 128 + tt * 2 + sl)) * 256 + c;
    LRUA[so] = P; LRUH[so] = h;
    __syncthreads();
}

__device__ __forceinline__ void fox_unit(Frame& F, int l, int b, int h, int qb) {
    const bf16_t* PROJ = (const bf16_t*)(F.ws + WS_PROJ); bf16_t* Y = (bf16_t*)(F.ws + WS_Y);
    const float* CUM = (const float*)(F.ws + WS_CUM) + (size_t)(b * 4 + h) * SEQ; const float* CTOT = (const float*)(F.ws + WS_CTOT);
    LAS float* bias = (LAS float*)(F.lds + att::LDS_BIAS); LAS float* blk = (LAS float*)(F.lds + att::LDS_BLK);
    const int q0 = qb * 256;
    if (F.wave == 0) { const float v = CTOT[(size_t)(b * 64 + F.lane) * 4 + h]; float s = v;
#pragma unroll
        for (int o = 1; o < 64; o <<= 1) { const float t = __int_as_float(__builtin_amdgcn_ds_bpermute(((F.lane - o) & 63) << 2, __float_as_int(s))); if (F.lane >= o) s += t; }
        blk[F.lane] = s - v; }
    __syncthreads();
    const float cref = CUM[q0 + 255] + blk[(q0 + 255) >> 7];
    for (int s = F.tid; s < q0 + 256; s += 512) bias[s] = (cref - (CUM[s] + blk[s >> 7])) * LOG2E;
    __syncthreads();
    float kn2 = 0.f; { const unsigned* km = (const unsigned*)(F.ws + WS_CTL) + CW_KM + l * 128 + (b * 4 + h) * 8;
#pragma unroll
        for (int c = 0; c < 8; ++c) kn2 += __uint_as_float(__hip_atomic_load(km + c, __ATOMIC_RELAXED, __HIP_MEMORY_SCOPE_AGENT)); }
    const size_t rowbase = (size_t)b * SEQ;
    att::attn_core<0>(F.shm, PROJ + (rowbase + q0 + F.wave * 32) * NPROJ + C_QC + h * 64, PROJ + rowbase * NPROJ + C_KC + h * 64, PROJ + rowbase * NPROJ + C_VC + h * 64,
                      Y + (rowbase + q0 + F.wave * 32) * D + 768 + h * 64, q0, 0, (q0 + 255) >> 6, 0.f, 0.f, F.tid, kn2);
}
__device__ __forceinline__ void swa_unit(Frame& F, int l, int b, int h, int qb) {
    const bf16_t* PROJ = (const bf16_t*)(F.ws + WS_PROJ); bf16_t* Y = (bf16_t*)(F.ws + WS_Y);
    LAS float* bias = (LAS float*)(F.lds + att::LDS_BIAS);
    const int q0 = qb * 256, kvh = h >> 2;
    const int t_lo = (q0 >= 128 ? q0 - 128 : 0) >> 6, t_hi = (q0 + 255) >> 6, n = t_hi - t_lo + 1;
    const float slope2 = exp2f(-(float)(h + 1)) * LOG2E;
    for (int i = F.tid; i < n * 64; i += 512) bias[i] = slope2 * (float)(64 * t_lo + i - q0);
    __syncthreads();
    const size_t rowbase = (size_t)b * SEQ;
    att::attn_core<1>(F.shm, PROJ + (rowbase + q0 + F.wave * 32) * NPROJ + C_QA + h * 64, PROJ + rowbase * NPROJ + C_KA + kvh * 64, PROJ + rowbase * NPROJ + C_VA + kvh * 64,
                      Y + (rowbase + q0 + F.wave * 32) * D + h * 64, q0, t_lo, t_hi, F.inp(F_SINKS)[l * 8 + h] * LOG2E, slope2, F.tid);
}
__device__ __forceinline__ void phase_mixer(Frame& F, int l) {
    unsigned* qhead = (unsigned*)(F.ws + WS_CTL) + CW_Q + l * 64;
    LAS unsigned* qslot = (LAS unsigned*)(F.lds + LDSCTL_OFF + 16);
#pragma unroll 1
    for (;;) {
        frame_refresh(F);
        if (F.tid == 0) qslot[0] = __hip_atomic_fetch_add(qhead, 1u, __ATOMIC_RELAXED, __HIP_MEMORY_SCOPE_AGENT);
        __syncthreads();
        const int u = __builtin_amdgcn_readfirstlane((int)qslot[0]);
        __syncthreads();
        if (u >= 512 + 256 + 1024) break;
        if (u < 512) { if (PH(11)) fox_unit(F, l, (u & 15) >> 2, u & 3, 31 - (u >> 4)); }
        else if (u < 768) { if (PH(10)) lru_unit(F, l, (u - 512) >> 6, (u - 512) & 63); }
        else { if (PH(12)) { const int v = u - 768; swa_unit(F, l, v >> 8, (v & 255) >> 5, v & 31); } }
    }
}

__device__ __forceinline__ void phase_ynorm(Frame& F, int l) {
    bf16_t* Y = (bf16_t*)(F.ws + WS_Y); const bf16_t* PROJ = (const bf16_t*)(F.ws + WS_PROJ);
    const float* HLOC = (const float*)(F.ws + WS_H); const float* PP = HLOC + (size_t)T * 256;
    const float* LRUA = (const float*)(F.ws + WS_LRUA); const float* LRUH = (const float*)(F.ws + WS_LRUH);
    LAS float* cs = (LAS float*)F.lds;
    LAS float* carry = (LAS float*)(F.lds + 4096);
    const float* og = F.inp(F_OGAIN) + l * 1024;
    for (int tile = F.vcu; tile < T / 128; tile += F.G) {
        const int b = tile >> 6, tt = tile & 63, j0 = 2 * tt;
        { const int c = F.tid & 255, seg = F.tid >> 8; const int jb = seg ? j0 / 2 : 0, je = seg ? j0 : j0 / 2;
          float A = 1.f, Hh = 0.f;
          for (int j = jb; j < je; ++j) { const size_t so = (size_t)(b * 128 + j) * 256 + c; const float aj = LRUA[so], hj = LRUH[so]; Hh = aj * Hh + hj; A *= aj; }
          cs[(seg * 2 + 0) * 256 + c] = A; cs[(seg * 2 + 1) * 256 + c] = Hh; }
        __syncthreads();
        if (F.tid < 256) { const int c = F.tid; const float c0 = cs[(2 + 0) * 256 + c] * cs[(0 + 1) * 256 + c] + cs[(2 + 1) * 256 + c];
            const size_t so = (size_t)(b * 128 + j0) * 256 + c; carry[c] = c0; carry[256 + c] = LRUA[so] * c0 + LRUH[so]; }
        __syncthreads();
#pragma unroll 1
        for (int i = 0; i < 16; ++i) {
            const int rl = F.wave * 16 + i; const size_t row = (size_t)tile * 128 + rl;
            bf16_t* yr = Y + row * D;
            const u32x4 ya = *(const u32x4*)(yr + 8 * F.lane);
            float fa[8]; fa[0] = __uint_as_float(ya.x << 16); fa[1] = __uint_as_float(ya.x & 0xffff0000u); fa[2] = __uint_as_float(ya.y << 16); fa[3] = __uint_as_float(ya.y & 0xffff0000u);
            fa[4] = __uint_as_float(ya.z << 16); fa[5] = __uint_as_float(ya.z & 0xffff0000u); fa[6] = __uint_as_float(ya.w << 16); fa[7] = __uint_as_float(ya.w & 0xffff0000u);
            float sa = 0.f;
#pragma unroll
            for (int k = 0; k < 8; ++k) sa += fa[k] * fa[k];
            const u32x2 yc = *(const u32x2*)(yr + 768 + 4 * F.lane);
            float fc[4]; fc[0] = __uint_as_float(yc.x << 16); fc[1] = __uint_as_float(yc.x & 0xffff0000u); fc[2] = __uint_as_float(yc.y << 16); fc[3] = __uint_as_float(yc.y & 0xffff0000u);
            float sc_ = fc[0] * fc[0] + fc[1] * fc[1] + fc[2] * fc[2] + fc[3] * fc[3];
            const f32x4 hl = *(const f32x4*)(HLOC + row * 256 + 4 * F.lane), pp = *(const f32x4*)(PP + row * 256 + 4 * F.lane);
            const f32x4 cr = *(const LAS f32x4*)(carry + (rl >> 6) * 256 + 4 * F.lane);
            const u32x2 gb = *(const u32x2*)(PROJ + row * NPROJ + C_GB + 4 * F.lane);
            float fb[4]; { const f32x4 hh = hl + pp * cr;
                fb[0] = hh.x * gelu_tanh(__uint_as_float(gb.x << 16)); fb[1] = hh.y * gelu_tanh(__uint_as_float(gb.x & 0xffff0000u));
                fb[2] = hh.z * gelu_tanh(__uint_as_float(gb.y << 16)); fb[3] = hh.w * gelu_tanh(__uint_as_float(gb.y & 0xffff0000u)); }
            float sb = fb[0] * fb[0] + fb[1] * fb[1] + fb[2] * fb[2] + fb[3] * fb[3];
            const float ra = 1.0f / sqrtf(wave_sum(sa) * (1.f / 512.f) + EPS), rb = 1.0f / sqrtf(wave_sum(sb) * (1.f / 256.f) + EPS), rc = 1.0f / sqrtf(wave_sum(sc_) * (1.f / 256.f) + EPS);
            { const f32x4 g0 = *(const f32x4*)(og + 8 * F.lane), g1 = *(const f32x4*)(og + 8 * F.lane + 4);
              u32x4 w; w.x = cvtpk(fa[0] * ra * g0.x, fa[1] * ra * g0.y); w.y = cvtpk(fa[2] * ra * g0.z, fa[3] * ra * g0.w); w.z = cvtpk(fa[4] * ra * g1.x, fa[5] * ra * g1.y); w.w = cvtpk(fa[6] * ra * g1.z, fa[7] * ra * g1.w);
              *(u32x4*)(yr + 8 * F.lane) = w; }
            { const f32x4 g = *(const f32x4*)(og + 512 + 4 * F.lane); u32x2 w; w.x = cvtpk(fb[0] * rb * g.x, fb[1] * rb * g.y); w.y = cvtpk(fb[2] * rb * g.z, fb[3] * rb * g.w); *(u32x2*)(yr + 512 + 4 * F.lane) = w; }
            { const f32x4 g = *(const f32x4*)(og + 768 + 4 * F.lane); u32x2 w; w.x = cvtpk(fc[0] * rc * g.x, fc[1] * rc * g.y); w.y = cvtpk(fc[2] * rc * g.z, fc[3] * rc * g.w); *(u32x2*)(yr + 768 + 4 * F.lane) = w; }
        }
        __syncthreads();
    }
}

template <int N, int MASK> __device__ __forceinline__ void tr_step(float (&v)[40], bool upper) {
#pragma unroll
    for (int i = 0; i < N / 2; ++i) { const float a = v[i], b = v[i + N / 2]; const float send = upper ? a : b, kp = upper ? b : a; float rcv;
        if constexpr (MASK == 32) { auto rr = __builtin_amdgcn_permlane32_swap(__float_as_uint(send), __float_as_uint(send), false, false); rcv = upper ? __uint_as_float(rr[0]) : __uint_as_float(rr[1]); }
        else rcv = shx<MASK>(send);
        v[i] = kp + rcv; }
}
__device__ __forceinline__ void phase_norm2_router(Frame& F, int l, const float* xa) {
    const float* MOD = (const float*)(F.ws + WS_MOD) + (size_t)l * 4 * 6144;
    bf16_t* H = (bf16_t*)(F.ws + WS_H);
    LEntry* list = (LEntry*)(F.ws + WS_LIST); unsigned* cnt = (unsigned*)(F.ws + WS_CTL) + CW_CNT + l * NCLS * 64;
    LAS float* wr = (LAS float*)F.lds;
    LAS float* gs = (LAS float*)(F.lds + 81920);
    LAS float* lg = (LAS float*)(F.lds + 90112);
    LAS int* tcls = (LAS int*)(F.lds + 92672);
    LAS float* tw = (LAS float*)(F.lds + 93184);
    LAS int* trank = (LAS int*)(F.lds + 94208);
    LAS unsigned* lcnt = (LAS unsigned*)(F.lds + 94720);
    LAS unsigned* lbase = (LAS unsigned*)(F.lds + 94848);
    for (int i = F.tid; i < 1024 * 4; i += 512) { const int k = i >> 2, e = i & 3; wr[e * 1024 + k] = F.inp(F_WRG)[(size_t)l * 4096 + i]; }
    for (int i = F.tid; i < 1024 * 16; i += 512) { const int k = i >> 4, e = i & 15; wr[(4 + e) * 1024 + k] = F.inp(F_WRE)[(size_t)l * 16384 + i]; }
    int cur_b = -1;
    for (int tile = F.vcu; tile < T / 128; tile += F.G) {
        const int b = tile >> 6;
        __syncthreads();
        if (b != cur_b) { for (int i = F.tid; i < 1024; i += 512) { gs[i] = F.inp(F_NFFN)[l * 1024 + i] * (1.f + MOD[b * 6144 + 4096 + i]); gs[1024 + i] = MOD[b * 6144 + 3072 + i]; } cur_b = b; }
        if (F.tid < NCLS) lcnt[F.tid] = 0u;
        __syncthreads();
#pragma unroll 1
        for (int grp = 0; grp < 8; ++grp) {
            const size_t row0 = (size_t)tile * 128 + F.wave * 16 + grp * 2;
            f32x4 hv[2][4];
#pragma unroll
            for (int r = 0; r < 2; ++r) { const f32x4* xr = (const f32x4*)(xa + (row0 + r) * D) + F.lane; float ss = 0.f;
#pragma unroll
                for (int j = 0; j < 4; ++j) { hv[r][j] = xr[64 * j]; ss += (hv[r][j].x * hv[r][j].x + hv[r][j].y * hv[r][j].y) + (hv[r][j].z * hv[r][j].z + hv[r][j].w * hv[r][j].w); }
                const float rstd = 1.0f / sqrtf(wave_sum(ss) * (1.f / D) + EPS);
                u32x2* o8 = (u32x2*)(H + (row0 + r) * D) + F.lane;
#pragma unroll
                for (int j = 0; j < 4; ++j) { const f32x4 g = *(const LAS f32x4*)(gs + 4 * F.lane + 256 * j), s = *(const LAS f32x4*)(gs + 1024 + 4 * F.lane + 256 * j);
                    hv[r][j] = hv[r][j] * rstd * g + s; u32x2 w; w.x = cvtpk(hv[r][j].x, hv[r][j].y); w.y = cvtpk(hv[r][j].z, hv[r][j].w); o8[64 * j] = w; } }
            float acc[40];
#pragma unroll
            for (int e = 0; e < 20; ++e) { float a0 = 0.f, a1 = 0.f;
#pragma unroll
                for (int j = 0; j < 4; ++j) { const f32x4 w = *(const LAS f32x4*)(wr + e * 1024 + 4 * F.lane + 256 * j);
                    a0 += hv[0][j].x * w.x + hv[0][j].y * w.y + hv[0][j].z * w.z + hv[0][j].w * w.w;
                    a1 += hv[1][j].x * w.x + hv[1][j].y * w.y + hv[1][j].z * w.z + hv[1][j].w * w.w; }
                acc[e] = a0; acc[20 + e] = a1; }
            tr_step<40, 32>(acc, (F.lane & 32) != 0); tr_step<20, 16>(acc, (F.lane & 16) != 0); tr_step<10, 8>(acc, (F.lane & 8) != 0);
#pragma unroll
            for (int i = 0; i < 5; ++i) { acc[i] += shx<4>(acc[i]); acc[i] += shx<2>(acc[i]); acc[i] += shx<1>(acc[i]); }
            if ((F.lane & 7) == 0) { const int v0 = 5 * (F.lane >> 3);
#pragma unroll
                for (int i = 0; i < 5; ++i) lg[F.wave * 40 + v0 + i] = acc[i]; }
            LDS_WAIT();
            if (F.lane < 2) {
                const LAS float* q = lg + F.wave * 40 + F.lane * 20;
                float gl[4];
#pragma unroll
                for (int j = 0; j < 4; ++j) gl[j] = q[j] + F.inp(F_BRG)[l * 4 + j];
                int gsel = 0; float gm = gl[0];
#pragma unroll
                for (int j = 1; j < 4; ++j) if (gl[j] > gm) { gm = gl[j]; gsel = j; }
                float den = 0.f;
#pragma unroll
                for (int j = 0; j < 4; ++j) den += expf(gl[j] - gm);
                const float gp = 1.0f / den;
                float el[4];
#pragma unroll
                for (int j = 0; j < 4; ++j) el[j] = q[4 + 4 * gsel + j] + F.inp(F_BRE)[l * 16 + gsel * 4 + j];
                int i1 = 0; float m1 = el[0];
#pragma unroll
                for (int j = 1; j < 4; ++j) if (el[j] > m1) { m1 = el[j]; i1 = j; }
                int i2 = -1; float m2 = -__builtin_inff();
#pragma unroll
                for (int j = 0; j < 4; ++j) if (j != i1 && el[j] > m2) { m2 = el[j]; i2 = j; }
                const float e2 = expf(m2 - m1); const float w1 = gp / (1.f + e2), w2 = gp * e2 / (1.f + e2);
                const int lo = i1 < i2 ? i1 : i2, hi = i1 < i2 ? i2 : i1;
                const int rl = F.wave * 16 + grp * 2 + F.lane;
                tcls[rl] = gsel * 6 + pair_idx(lo, hi); tw[rl * 2] = (i1 < i2) ? w1 : w2; tw[rl * 2 + 1] = (i1 < i2) ? w2 : w1;
            }
        }
        __syncthreads();
        if (F.tid < 128) trank[F.tid] = (int)atomicAdd((unsigned*)&lcnt[tcls[F.tid]], 1u);
        __syncthreads();
        if (F.tid < NCLS) lbase[F.tid] = lcnt[F.tid] ? __hip_atomic_fetch_add(cnt + 64 * F.tid, lcnt[F.tid], __ATOMIC_RELAXED, __HIP_MEMORY_SCOPE_AGENT) : 0u;
        __syncthreads();
        if (F.tid < 128) { const int cls = tcls[F.tid]; const unsigned pos = lbase[cls] + (unsigned)trank[F.tid];
            LEntry e; e.tok = tile * 128 + F.tid; e.w0 = tw[F.tid * 2]; e.w1 = tw[F.tid * 2 + 1]; e.pad = 0; list[(size_t)cls * LCAP + pos] = e; }
    }
    __syncthreads();
}

__device__ __forceinline__ int build_tile_table(Frame& F, int l) {
    unsigned* cnt = (unsigned*)(F.ws + WS_CTL) + CW_CNT + l * NCLS * 64;
    LAS int* tt = (LAS int*)(F.lds + TT_OFF); LAS int* ntl = (LAS int*)(F.lds + TT_OFF + 1024);
    __syncthreads();
    if (F.tid == 0) { int nt = 0;
        for (int c = 0; c < NCLS; ++c) { const unsigned n = __hip_atomic_load(cnt + 64 * c, __ATOMIC_RELAXED, __HIP_MEMORY_SCOPE_AGENT); const int k = (int)((n + 255u) >> 8);
            for (int j = 0; j < k; ++j) tt[nt++] = c | ((j * 256) << 8); }
        ntl[0] = nt; }
    __syncthreads();
    return ntl[0];
}

__device__ __forceinline__ void phase_final(Frame& F, const float* xa) {
    const int gw = F.vcu * 8 + F.wave, NGW = F.G * 8;
    f32x4 g[4];
#pragma unroll
    for (int j = 0; j < 4; ++j) g[j] = *(const f32x4*)(F.inp(F_NFIN) + 4 * F.lane + 256 * j);
    for (int row = gw; row < T; row += NGW) {
        const f32x4* xr = (const f32x4*)(xa + (size_t)row * D) + F.lane; f32x4 v[4]; float ss = 0.f;
#pragma unroll
        for (int j = 0; j < 4; ++j) { v[j] = xr[64 * j]; ss += (v[j].x * v[j].x + v[j].y * v[j].y) + (v[j].z * v[j].z + v[j].w * v[j].w); }
        const float rstd = 1.0f / sqrtf(wave_sum(ss) * (1.f / D) + EPS);
        f32x4* o = (f32x4*)(F.out + (size_t)row * D) + F.lane;
#pragma unroll
        for (int j = 0; j < 4; ++j) o[64 * j] = v[j] * rstd * g[j];
    }
}

__global__ void __launch_bounds__(512, 2) mk_fwd(const Args args) {
    extern __shared__ __attribute__((aligned(16))) unsigned char lds[];
    Frame F;
    F.lds = (LAS unsigned char*)lds; F.shm = (char*)lds;
    F.tid = threadIdx.x; F.lane = F.tid & 63; F.wave = __builtin_amdgcn_readfirstlane(F.tid >> 6);
    F.G = 256; { const int bx = blockIdx.x; __builtin_assume(bx >= 0 && bx < 256); F.vcu = (bx % 8) * 32 + bx / 8; }
    for (int u = F.tid; u < (LDS_BYTES - LDSCTL_OFF) / 4; u += 512) ((LAS unsigned*)(F.lds + LDSCTL_OFF))[u] = 0u;
    __syncthreads();
    F.wave_s = __builtin_amdgcn_readfirstlane((int)threadIdx.x >> 6);
#define REFRESH() frame_refresh(F)
    REFRESH();
    unsigned* ctl = (unsigned*)(F.ws + WS_CTL);
    XcdBarrier bar = xcd_barrier_post(ctl + CW_BAR, (volatile LAS unsigned*)(F.lds + MISC_OFF) + 8);

    for (int rep = 0; rep < DUP(0); ++rep) if (PH(0)) phase_p0(F);
    xcd_barrier(bar, F.tid);
    float* XA = (float*)(F.ws + WS_XA);
    for (int l = 0; l < DEPTH; ++l) {
        const float* xin = (l == 0) ? F.inp(F_X) : XA;
        const float* MODl = (const float*)(F.ws + WS_MOD) + (size_t)l * 4 * 6144;
        REFRESH();
        for (int rep = 0; rep < DUP(1); ++rep) if (PH(1)) phase_norm1(F, l, xin);
        xcd_barrier(bar, F.tid);
        REFRESH();
        for (int rep = 0; rep < DUP(2); ++rep) if (PH(2)) { pg8::DenseOrder S; S.init(T, NPROJ, F.G, (int)blockIdx.x, F.ws + WS_WIN + (size_t)l * 2048 * 1024 * 2, 2048u, G1REP);
          EpiProj E{(bf16_t*)(F.ws + WS_PROJ), (unsigned*)(F.ws + WS_CTL) + CW_KM + l * 128};
          pg8::gemm_phase<EpiProj, pg8::DenseOrder, true>(F.tid, F.lds, (const char*)(F.ws + WS_H), 2048u, 2048u, 1024, S, E); }
        xcd_barrier(bar, F.tid);
        REFRESH();
        if (PH(3)) phase_mixer(F, l);
        xcd_barrier(bar, F.tid);
        REFRESH();
        if (PH(4)) phase_ynorm(F, l);
        xcd_barrier(bar, F.tid);
        REFRESH();
        if (PH(5)) { pg8::DenseOrder S; S.init(T, D, F.G, (int)blockIdx.x, F.ws + WS_WOUT + (size_t)l * 1024 * 1024 * 2, 2048u);
          EpiRes E{xin, XA, MODl + 2048};
          pg8::gemm_phase<EpiRes, pg8::DenseOrder, true>(F.tid, F.lds, (const char*)(F.ws + WS_Y), 2048u, 2048u, 1024, S, E); }
        xcd_barrier(bar, F.tid);
        REFRESH();
        if (PH(6)) phase_norm2_router(F, l, XA);
        xcd_barrier(bar, F.tid);
        REFRESH();
        const int ntiles = build_tile_table(F, l);
        const LEntry* list = (const LEntry*)(F.ws + WS_LIST); const unsigned* cnt = (const unsigned*)(F.ws + WS_CTL) + CW_CNT + l * NCLS * 64;
        for (int rep = 0; rep < DUP(7); ++rep) if (PH(7)) { MoeUpOrder S{ntiles * 4, F.G, (int)blockIdx.x, (const LAS int*)(F.lds + TT_OFF), (const char*)(F.ws + WS_WGU + (size_t)l * 16 * 512 * 1024 * 2), list, cnt};
          EpiUp E{(bf16_t*)(F.ws + WS_PROJ), list, cnt};
          pg8::gemm_phase<EpiUp, MoeUpOrder, true>(F.tid, F.lds, (const char*)(F.ws + WS_H), 2048u, 2048u, 1024, S, E); }
        xcd_barrier(bar, F.tid);
        REFRESH();
        if (PH(8)) { MoeDownOrder S{ntiles * 4, F.G, (int)blockIdx.x, (const LAS int*)(F.lds + TT_OFF), (const char*)(F.ws + WS_WDP + (size_t)l * 24 * 1024 * 512 * 2)};
          EpiDown E{XA, MODl + 5120, list, cnt};
          pg8::gemm_phase<EpiDown, MoeDownOrder, true>(F.tid, F.lds, (const char*)(F.ws + WS_PROJ), 1024u, 1024u, 512, S, E); }
        xcd_barrier(bar, F.tid);
    }
        REFRESH();
    for (int rep = 0; rep < DUP(9); ++rep) if (PH(9)) phase_final(F, XA);
}

extern "C" void kernel_launch(void* const* d_in, const int* in_sizes, int n_in, void* d_out, int out_size, void* d_ws, size_t ws_size, hipStream_t stream) {
    static int grid = 0;
    if (grid == 0) {
        if (n_in != 26 || in_sizes[0] != T * D || out_size != T * D || ws_size < WS_END) { fprintf(stderr, "kernel_launch: unexpected shapes (n_in %d, in0 %d, out %d, ws %zu)\n", n_in, n_in > 0 ? in_sizes[0] : -1, out_size, ws_size); grid = -1; return; }
        int dev = 0, cus = 0, per_cu = 0;
        if (hipGetDevice(&dev) != hipSuccess || hipDeviceGetAttribute(&cus, hipDeviceAttributeMultiprocessorCount, dev) != hipSuccess) { grid = -1; return; }
        if (hipFuncSetAttribute((const void*)mk_fwd, hipFuncAttributeMaxDynamicSharedMemorySize, LDS_BYTES) != hipSuccess) { fprintf(stderr, "kernel_launch: hipFuncSetAttribute failed\n"); grid = -1; return; }
        if (hipOccupancyMaxActiveBlocksPerMultiprocessor(&per_cu, (const void*)mk_fwd, 512, LDS_BYTES) != hipSuccess || per_cu < 1) fprintf(stderr, "kernel_launch: occupancy query reports %d\n", per_cu);
        (void)hipGetLastError();
        if (cus != 256) fprintf(stderr, "kernel_launch: built for 256 CUs, device reports %d\n", cus);
        grid = 256;
    }
    if (grid < 0) return;
    (void)hipMemsetAsync((char*)d_ws + WS_CTL, 0, CTL_ZERO_BYTES, stream);
    Args a{};
    for (int i = 0; i < 26; ++i) a.in[i] = (const float*)d_in[i];
    a.out = (float*)d_out; a.ws = (unsigned char*)d_ws;
    hipLaunchKernelGGL(mk_fwd, dim3(grid), dim3(512), LDS_BYTES, stream, a);
}
```

```cpp
#include <hip/hip_runtime.h>
#include <hip/hip_bf16.h>
#include <cstdio>
#include <cstdint>

#define GAS __attribute__((address_space(1)))
#define LAS __attribute__((address_space(3)))
typedef unsigned short bf16_t;
typedef short bf16x8 __attribute__((ext_vector_type(8)));
typedef short s16x4 __attribute__((ext_vector_type(4)));
typedef float f32x2 __attribute__((ext_vector_type(2)));
typedef float f32x4 __attribute__((ext_vector_type(4)));
typedef float f32x16 __attribute__((ext_vector_type(16)));
typedef unsigned u32x2 __attribute__((ext_vector_type(2)));
typedef unsigned u32x4 __attribute__((ext_vector_type(4)));
typedef __bf16 bf16x2_t __attribute__((ext_vector_type(2)));

#ifndef DUP_MASK
#define DUP_MASK 0x0u
#endif
#define DUP(n) (1 + (int)((DUP_MASK >> (n)) & 1u))
#ifndef G2REP
#define G2REP 1
#endif
#ifndef G1REP
#define G1REP 1
#endif
#ifndef UPREP
#define UPREP 1
#endif
#ifndef PH_MASK
#define PH_MASK 0xFFFFFFFFu
#endif
#define PH(n) ((PH_MASK >> (n)) & 1u)
constexpr int D = 1024, NB = 4, SEQ = 8192, T = NB * SEQ, DEPTH = 2;
constexpr int IN_COLS = 2052, NPROJ = 2048;
constexpr int C_QA = 0, C_KA = 512, C_VA = 640, C_XB = 768, C_GB = 1024, C_QC = 1280, C_KC = 1536, C_VC = 1792;
constexpr int NCLS = 24, LCAP = 32768;
constexpr float EPS = 1e-6f;
constexpr float LOG2E = 1.4426950408889634f;
constexpr float C2 = 0.125f * 1.4426950408889634f;

constexpr size_t MiB = 1u << 20;
constexpr size_t WS_CTL = 0, CTL_ZERO_BYTES = 1 * MiB;
constexpr size_t WS_MOD = 1 * MiB;
constexpr size_t WS_CUM = WS_MOD + 256 * 1024;
constexpr size_t WS_CTOT = WS_CUM + 512 * 1024;
constexpr size_t WS_LRUA = 2 * MiB;
constexpr size_t WS_LRUH = WS_LRUA + 512 * 1024;
constexpr size_t WS_LIST = 4 * MiB;
constexpr size_t WS_WIN = 16 * MiB;
constexpr size_t WS_WOUT = 24 * MiB;
constexpr size_t WS_WGU = 28 * MiB;
constexpr size_t WS_WDP = 60 * MiB;
constexpr size_t WS_XA = 108 * MiB;
constexpr size_t WS_H = 236 * MiB;
constexpr size_t WS_PROJ = 300 * MiB;
constexpr size_t WS_Y = 428 * MiB;
constexpr size_t WS_P = WS_PROJ + 64 * MiB;
constexpr size_t WS_M = WS_Y;
constexpr size_t WS_END = 492 * MiB;
constexpr int CW_BAR = 4096;
constexpr int CW_KM = 20480;
constexpr int CW_Q = 21504;
constexpr int CW_CNT = 16384;

struct LEntry { int tok; float w0, w1; int pad; };

constexpr int RING_BYTES = 131072;
constexpr int LDSCTL_OFF = RING_BYTES;
constexpr int MISC_OFF = LDSCTL_OFF + 320;
constexpr int TT_OFF = LDSCTL_OFF + 1024;
constexpr int LDS_BYTES = 147456;

__device__ __forceinline__ unsigned cvtpk(float lo, float hi) { f32x2 v = {lo, hi}; bf16x2_t b = __builtin_convertvector(v, bf16x2_t); return __builtin_bit_cast(unsigned, b); }
__device__ __forceinline__ float bf2f(bf16_t v) { return __builtin_bit_cast(float, (unsigned)v << 16); }
__device__ __forceinline__ f32x4 bf4_to_f32(u32x2 v) { return (f32x4){__uint_as_float(v.x << 16), __uint_as_float(v.x & 0xffff0000u), __uint_as_float(v.y << 16), __uint_as_float(v.y & 0xffff0000u)}; }
template <int M> __device__ __forceinline__ float shx(float v) {
    return __int_as_float(__builtin_amdgcn_ds_swizzle(__float_as_int(v), (M << 10) | 0x1f));
}
__device__ __forceinline__ float wave_sum(float v) {
    v += shx<1>(v); v += shx<2>(v); v += shx<4>(v); v += shx<8>(v); v += shx<16>(v);
    auto rr = __builtin_amdgcn_permlane32_swap(__float_as_uint(v), __float_as_uint(v), false, false);
    return __uint_as_float(rr[0]) + __uint_as_float(rr[1]);
}
__device__ __forceinline__ float fast_exp(float x) { return __builtin_amdgcn_exp2f(x * LOG2E); }
__device__ __forceinline__ float sigmoidf_(float x) { return __builtin_amdgcn_rcpf(1.f + fast_exp(-x)); }
__device__ __forceinline__ float gelu_tanh(float x) {
    const float u = 0.7978845608028654f * (x + 0.044715f * x * x * x);
    const float e = fast_exp(2.f * u);
    const float th = 1.f - 2.f * __builtin_amdgcn_rcpf(e + 1.f);
    return 0.5f * x * (1.f + th);
}
#define LDS_WAIT() asm volatile("s_waitcnt lgkmcnt(0)" ::: "memory")
#define VM_WAIT() asm volatile("s_waitcnt vmcnt(0)" ::: "memory")

namespace pg8 {
constexpr int BM = 256, BK = 64, HALF = 128, HTB = HALF * BK * 2, STAGE_BYTES = 8 * HTB, NXCD = 8, WGM = 8;
__host__ __device__ __forceinline__ int lds_byte(int r, int c) { const int st = (r >> 4) * 2 + (c >> 5), rr = r & 15, cc = c & 31, ob = rr * 64 + cc * 2; return st * 1024 + (ob ^ (((ob >> 9) & 1) << 5)); }
__host__ __device__ __forceinline__ void stage_rc(int b, int& R, int& C) { const int st = b / 1024, sb = b % 1024, swz = sb ^ (((sb >> 9) & 1) << 5); R = (st >> 1) * 16 + swz / 64; C = (st & 1) * 32 + (swz % 64) / 2; }
__host__ __device__ __forceinline__ int perm32(int rho) { const int n = rho >> 4, i = rho & 15; return 8 * (i >> 2) + 4 * n + (i & 3); }

struct GUnit { int a0; const char* bb; int e0, e1, e2, e3; };

__device__ __forceinline__ int xcd_remap(int L, int nwg) {
    const int q = nwg / NXCD, r = nwg % NXCD, xcd = L % NXCD, off = L / NXCD;
    return (xcd < r ? xcd * (q + 1) : r * (q + 1) + (xcd - r) * q) + off;
}

struct DenseOrder {
    int nM, nN, nwg, G, c, rep; const char* Bt; unsigned pitchB;
    __device__ __forceinline__ void init(int M, int N, int G_, int c_, const void* Bt_, unsigned pitchB_, int rep_ = 1) { nM = M / BM; nN = N / BM; nwg = nM * nN; G = G_; c = c_; Bt = (const char*)Bt_; pitchB = pitchB_; rep = rep_; }
    __device__ __forceinline__ bool next(int i, GUnit& u) const {
        const long L = (long)i * G + c; if (L >= (long)nwg * rep) return false;
        const int wgid = xcd_remap((int)(L % nwg), nwg);
        const int nig = WGM * nN, gid = wgid / nig, fm = gid * WGM, gsz = (nM - fm) < WGM ? (nM - fm) : WGM;
        const int pm = fm + ((wgid % nig) % gsz), pn = (wgid % nig) / gsz;
        u.a0 = pm * BM; u.bb = Bt + (size_t)pn * BM * pitchB; u.e0 = pm; u.e1 = pn; u.e2 = 0; u.e3 = 0; return true;
    }
    __device__ __forceinline__ unsigned arow(const GUnit& u, int r) const { return (unsigned)(u.a0 + r); }
};

#define PG8_SA(b, h) (((b) * 2 + (h)) * HTB)
#define PG8_SB(b, h) ((4 + (b) * 2 + (h)) * HTB)
#define PG8_STG(bufoff, gptr, v0, v1) do { \
        __builtin_amdgcn_global_load_lds((const unsigned*)((const char*)(gptr) + (v0)), (LAS unsigned*)(lds + (bufoff) + ldsw), 16, 0, 0); \
        __builtin_amdgcn_global_load_lds((const unsigned*)((const char*)(gptr) + (v1)), (LAS unsigned*)(lds + (bufoff) + ldsw + 8192), 16, 0, 0); } while (0)
#define PG8_STGA(bufoff, kb, vo) PG8_STG(bufoff, Abase + (kb), (vo)[0], (vo)[1])
#define PG8_STGB(bufoff, bp) PG8_STG(bufoff, bp, voffB[0], voffB[1])
#define PG8_LDA(dst, b, h) do { _Pragma("unroll") for (int m = 0; m < 4; ++m) _Pragma("unroll") for (int k = 0; k < 2; ++k) dst[m][k] = *(const LAS bf16x8*)(lds + PG8_SA(b, h) + aoff + m * 2048 + k * 1024); } while (0)
#define PG8_LDB(dst, b, h) do { _Pragma("unroll") for (int n = 0; n < 2; ++n) _Pragma("unroll") for (int k = 0; k < 2; ++k) dst[n][k] = *(const LAS bf16x8*)(lds + PG8_SB(b, h) + boff + n * 2048 + k * 1024); } while (0)
#define PG8_MMA(ai, bj, At, Bt) do { __builtin_amdgcn_s_setprio(1); _Pragma("unroll") for (int m = 0; m < 4; ++m) _Pragma("unroll") for (int n = 0; n < 2; ++n) _Pragma("unroll") for (int k = 0; k < 2; ++k) \
        acc[ai][bj][m][n] = __builtin_amdgcn_mfma_f32_16x16x32_bf16(Bt[n][k], At[m][k], acc[ai][bj][m][n], 0, 0, 0); __builtin_amdgcn_s_setprio(0); } while (0)
#define PG8_WAIT_V(n) asm volatile("s_waitcnt vmcnt(" #n ")" ::: "memory")
#define PG8_WAIT_L(n) asm volatile("s_waitcnt lgkmcnt(" #n ")" ::: "memory")
#define PG8_BAR __builtin_amdgcn_s_barrier()
#define PG8_SCHED __builtin_amdgcn_sched_barrier(0)

template <class Epi, class Sched, bool ALIGN_EPI>
__device__ __forceinline__ void gemm_phase(const int tid, LAS unsigned char* lds, const char* Abase, unsigned pitchA, unsigned pitchB, int K, const Sched& S, const Epi& E) {
    const int wid = __builtin_amdgcn_readfirstlane(tid >> 6), lane = tid & 63, wr = wid >> 2, wc = wid & 3, fr = lane & 15, fq = lane >> 4;
    const int nt = K / BK;
    int RA[2]; unsigned cA2[2], voffB[2];
#pragma unroll
    for (int i = 0; i < 2; ++i) { int R, C; stage_rc(tid * 16 + i * 8192, R, C); const int Rb = Epi::PERM ? ((R & ~31) + perm32(R & 31)) : R;
        RA[i] = R; cA2[i] = (unsigned)C * 2u; voffB[i] = (unsigned)Rb * pitchB + (unsigned)C * 2u; }
    const unsigned hstepB = (unsigned)HALF * pitchB;
    const unsigned ldsw = (unsigned)wid * 1024u;
    const int aoff = lds_byte(wr * 64 + fr, fq * 8), boff = lds_byte(wc * 32 + fr, fq * 8);
    GUnit cur, nxt; int ui = 0;
    if (!S.next(0, cur)) return;
    f32x4 acc[2][2][4][2];
#pragma unroll
    for (int a = 0; a < 2; ++a)
#pragma unroll
        for (int b = 0; b < 2; ++b)
#pragma unroll
            for (int m = 0; m < 4; ++m)
#pragma unroll
                for (int n = 0; n < 2; ++n) acc[a][b][m][n] = (f32x4){0.f, 0.f, 0.f, 0.f};
    bf16x8 At[4][2], B0[2][2], B1[2][2];
    unsigned voA[2][2];
#pragma unroll
    for (int h = 0; h < 2; ++h)
#pragma unroll
        for (int i = 0; i < 2; ++i) voA[h][i] = S.arow(cur, h * HALF + RA[i]) * pitchA + cA2[i];
    const char* cB = cur.bb;
    const unsigned kstep = BK * 2;
    PG8_STGB(PG8_SB(0, 0), cB); PG8_STGB(PG8_SB(0, 1), cB + hstepB); PG8_STGA(PG8_SA(0, 0), 0, voA[0]); PG8_STGA(PG8_SA(0, 1), 0, voA[1]);
    if (wr == 1) PG8_BAR;
    PG8_WAIT_V(2); PG8_BAR;
    PG8_STGB(PG8_SB(1, 0), cB + kstep); PG8_STGA(PG8_SA(1, 0), kstep, voA[0]); PG8_STGB(PG8_SB(1, 1), cB + hstepB + kstep);
    PG8_WAIT_V(6); PG8_BAR;
    for (;;) {
        const bool has_next = S.next(ui + 1, nxt);
        const char* nB = has_next ? nxt.bb : cB;
        for (int t = 0; t < nt; t += 2) {
            const bool last = (t == nt - 2);
            const unsigned kb1 = (unsigned)(t + 1) * kstep;
            const unsigned kb2 = last ? 0u : (unsigned)(t + 2) * kstep, kb3 = kb2 + kstep;
            const char* b2 = last ? nB : cB + (size_t)(t + 2) * kstep; const char* b3 = b2 + kstep;
            PG8_LDB(B0, 0, 0); PG8_LDB(B1, 0, 1); PG8_SCHED; PG8_LDA(At, 0, 0); PG8_STGA(PG8_SA(1, 1), kb1, voA[1]);
            if (last && has_next) {
#pragma unroll
                for (int h = 0; h < 2; ++h)
#pragma unroll
                    for (int i = 0; i < 2; ++i) voA[h][i] = S.arow(nxt, h * HALF + RA[i]) * pitchA + cA2[i]; }
            PG8_WAIT_V(8); PG8_WAIT_L(0); PG8_BAR; PG8_MMA(0, 0, At, B0); PG8_MMA(0, 1, At, B1); PG8_BAR; PG8_SCHED;
            PG8_LDA(At, 0, 1); PG8_STGB(PG8_SB(0, 0), b2); PG8_STGB(PG8_SB(0, 1), b2 + hstepB); PG8_STGA(PG8_SA(0, 0), kb2, voA[0]);
            PG8_WAIT_V(8); PG8_WAIT_L(0); PG8_BAR; PG8_MMA(1, 0, At, B0); PG8_MMA(1, 1, At, B1); PG8_BAR; PG8_SCHED;
            PG8_LDB(B0, 1, 0); PG8_LDB(B1, 1, 1); PG8_SCHED; PG8_LDA(At, 1, 0); PG8_STGA(PG8_SA(0, 1), kb2, voA[1]);
            PG8_WAIT_V(8); PG8_WAIT_L(0); PG8_BAR; PG8_MMA(0, 0, At, B0); PG8_MMA(0, 1, At, B1); PG8_BAR; PG8_SCHED;
            PG8_LDA(At, 1, 1); PG8_STGB(PG8_SB(1, 0), b3); PG8_STGB(PG8_SB(1, 1), b3 + hstepB); PG8_STGA(PG8_SA(1, 0), kb3, voA[0]);
            PG8_WAIT_V(8); PG8_WAIT_L(0); PG8_BAR; PG8_MMA(1, 0, At, B0); PG8_MMA(1, 1, At, B1); PG8_BAR; PG8_SCHED;
        }
        if constexpr (ALIGN_EPI) { if (wr == 0) PG8_BAR; }
        E(acc, cur, wr, wc, fr, fq);
        if (!has_next) break;
#pragma unroll
        for (int a = 0; a < 2; ++a)
#pragma unroll
            for (int b = 0; b < 2; ++b)
#pragma unroll
                for (int m = 0; m < 4; ++m)
#pragma unroll
                    for (int n = 0; n < 2; ++n) acc[a][b][m][n] = (f32x4){0.f, 0.f, 0.f, 0.f};
        cur = nxt; cB = nB; ++ui;
        if constexpr (ALIGN_EPI) { if (wr == 1) PG8_BAR; }
    }
    PG8_WAIT_V(0);
    if constexpr (!ALIGN_EPI) { if (wr == 0) PG8_BAR; }
    PG8_BAR;
}
}

#define XB_TMO      128
#define XB_XCNT(j)  (256  + 64 * (j))
#define XB_XSUB(j)  (1280 + 64 * (j))
#define XB_XGEN(j)  (2304 + 64 * (j))
#define XB_TOP      3328
#define XB_TOPGEN   3392
#define XCD_BAR_WORDS 3456
#define XB_SPIN_CAP (1u << 18)
__device__ __forceinline__ unsigned xb_ld(unsigned* p)              { return __hip_atomic_load(p, __ATOMIC_RELAXED, __HIP_MEMORY_SCOPE_AGENT); }
__device__ __forceinline__ unsigned xb_add(unsigned* p, unsigned v) { return __hip_atomic_fetch_add(p, v, __ATOMIC_RELAXED, __HIP_MEMORY_SCOPE_AGENT); }
__device__ __forceinline__ unsigned xb_xcc_id() { return (unsigned)__builtin_amdgcn_s_getreg((3 << 11) | 20) & 0xFu; }
#define XB_SPIN(cond, bar) do { unsigned _sp = 0; while (cond) { __builtin_amdgcn_s_sleep(1); \
    if ((++_sp & 255u) == 0u) { if (xb_ld(&(bar)[XB_TMO])) break; if (_sp > XB_SPIN_CAP) { atomicAdd(&(bar)[XB_TMO], 1u); break; } } } } while (0)
struct XcdBarrier { unsigned* bar; unsigned x; volatile LAS unsigned* st; };
__device__ __forceinline__ XcdBarrier xcd_barrier_post(unsigned* bar, volatile LAS unsigned* st) {
    XcdBarrier b; b.bar = bar; b.x = xb_xcc_id(); b.st = st;
    if (threadIdx.x == 0) (void)xb_add(&bar[XB_XCNT(b.x)], 1u);
    return b;
}
__device__ __forceinline__ void xcd_barrier_complete(unsigned* bar, unsigned x, unsigned& nloc, unsigned& nx) {
    const unsigned G = gridDim.x * gridDim.y * gridDim.z;
    unsigned sum, cnt, mine, sp = 0u;
    for (;;) {
        sum = 0u; cnt = 0u; mine = 0u;
#pragma unroll
        for (unsigned j = 0; j < 16; ++j) { const unsigned c = xb_ld(&bar[XB_XCNT(j)]); sum += c; cnt += (c > 0u) ? 1u : 0u; mine = (j == x) ? c : mine; }
        if (sum == G) break;
        __builtin_amdgcn_s_sleep(1);
        if ((++sp & 255u) == 0u) { if (xb_ld(&bar[XB_TMO])) break; if (sp > XB_SPIN_CAP) { atomicAdd(&bar[XB_TMO], 1u); break; } }
    }
    nloc = mine > 0u ? mine : 1u; nx = cnt > 0u ? cnt : 1u;
}
__device__ __forceinline__ void xcd_barrier(const XcdBarrier& b, const int tid) {
    asm volatile("s_waitcnt vmcnt(0)" ::: "memory");
    __syncthreads();
    if (tid == 0) {
        unsigned* bar = b.bar; const unsigned bx_ = xb_xcc_id();
        __builtin_amdgcn_s_waitcnt(0);
        unsigned nloc = b.st[0], nx = b.st[1];
        if (nloc == 0u) { xcd_barrier_complete(bar, bx_, nloc, nx); b.st[0] = nloc; b.st[1] = nx; }
        const unsigned old = xb_add(&bar[XB_XSUB(bx_)], 1u);
        const unsigned gen = old / nloc;
        if (old + 1u == (gen + 1u) * nloc) {
            __builtin_amdgcn_fence(__ATOMIC_RELEASE, "agent");
            asm volatile("s_waitcnt vmcnt(0)" ::: "memory");
            const unsigned og = xb_add(&bar[XB_TOP], 1u);
            const unsigned tg = og / nx;
            if (og + 1u == (tg + 1u) * nx) xb_add(&bar[XB_TOPGEN], 1u);
            else XB_SPIN(xb_ld(&bar[XB_TOPGEN]) == tg, bar);
            __builtin_amdgcn_fence(__ATOMIC_ACQUIRE, "agent");
            xb_add(&bar[XB_XGEN(bx_)], 1u);
            asm volatile("s_waitcnt vmcnt(0)" ::: "memory");
        } else {
            XB_SPIN(xb_ld(&bar[XB_XGEN(bx_)]) == gen, bar);
            __builtin_amdgcn_fence(__ATOMIC_ACQUIRE, "agent");
            asm volatile("s_waitcnt vmcnt(0)" ::: "memory");
        }
    }
    __syncthreads();
}

__device__ __forceinline__ const void* launder_ptr(const void* p) {
    unsigned lo = (unsigned)(uintptr_t)p, hi = (unsigned)((uintptr_t)p >> 32);
    asm volatile("" : "+v"(lo), "+v"(hi));
    lo = __builtin_amdgcn_readfirstlane(lo); hi = __builtin_amdgcn_readfirstlane(hi);
    return (const void*)(((uintptr_t)hi << 32) | (uintptr_t)lo);
}
struct Args { const float* in[26]; float* out; unsigned char* ws; };

__device__ __forceinline__ const void* karg_ptr(int idx) {
    const unsigned long long ka = (unsigned long long)__builtin_amdgcn_kernarg_segment_ptr();
    unsigned long long v; asm volatile("s_load_dwordx2 %0, %1, %2\n\ts_waitcnt lgkmcnt(0)" : "=s"(v) : "s"(ka), "s"(idx * 8) : "memory");
    return (const void*)(GAS const void*)(uintptr_t)v;
}
struct Frame {
    LAS unsigned char* lds; char* shm;
    int tid, lane, wave, vcu, G;
    float* out; unsigned char* ws; int wave_s;
    __device__ __forceinline__ const float* inp(int i) const { return (const float*)karg_ptr(i); }
};
__device__ __forceinline__ void frame_refresh(Frame& F) {
    asm volatile("" ::: "memory");
    int t_; asm volatile("v_mbcnt_lo_u32_b32 %0, -1, 0\n\tv_mbcnt_hi_u32_b32 %0, -1, %0" : "=v"(t_)); t_ |= (F.wave_s << 6);
    F.tid = t_; F.lane = t_ & 63; F.wave = __builtin_amdgcn_readfirstlane(t_ >> 6);
    F.out = (float*)karg_ptr(26); F.ws = (unsigned char*)karg_ptr(27);
}
#define F_X 0
#define F_C 1
#define F_WMOD 2
#define F_BMOD 3
#define F_NMIX 4
#define F_NFFN 5
#define F_WIN 6
#define F_WOUT 7
#define F_OGAIN 8
#define F_SINKS 9
#define F_CONVW 10
#define F_CONVB 11
#define F_LWA 12
#define F_LBA 13
#define F_LWX 14
#define F_LBX 15
#define F_LAM 16
#define F_FOXB 17
#define F_WRG 18
#define F_BRG 19
#define F_WRE 20
#define F_BRE 21
#define F_WGATE 22
#define F_WUP 23
#define F_WDOWN 24
#define F_NFIN 25

struct EpiProj {
    static constexpr bool PERM = true;
    bf16_t* O; unsigned* km;
    __device__ __forceinline__ void operator()(const f32x4 (&acc)[2][2][4][2], const pg8::GUnit& u, int wr, int wc, int fr, int fq) const {
        const int row0 = u.e0 * 256 + wr * 64 + fr, pn = u.e1;
        const float sc = (pn == 0 || pn == 1 || pn == 5) ? C2 : 1.f;
        const int col0 = pn * 256 + wc * 32 + 8 * fq;
#pragma unroll
        for (int ai = 0; ai < 2; ++ai)
#pragma unroll
            for (int m = 0; m < 4; ++m) { bf16_t* rowp = O + (size_t)(row0 + ai * 128 + m * 16) * NPROJ + col0;
#pragma unroll
                for (int bj = 0; bj < 2; ++bj) { const f32x4 v0 = acc[ai][bj][m][0] * sc, v1 = acc[ai][bj][m][1] * sc;
                    u32x4 w; w.x = cvtpk(v0[0], v0[1]); w.y = cvtpk(v0[2], v0[3]); w.z = cvtpk(v1[0], v1[1]); w.w = cvtpk(v1[2], v1[3]);
                    *(u32x4*)(rowp + bj * 128) = w; } }
        if (pn == 6) {
            const int b = u.e0 >> 5;
#pragma unroll
            for (int bj = 0; bj < 2; ++bj) { float mx = 0.f;
#pragma unroll
                for (int ai = 0; ai < 2; ++ai)
#pragma unroll
                    for (int m = 0; m < 4; ++m) { const f32x4 v0 = acc[ai][bj][m][0], v1 = acc[ai][bj][m][1];
                        mx = __builtin_fmaxf(mx, (v0[0] * v0[0] + v0[1] * v0[1]) + (v0[2] * v0[2] + v0[3] * v0[3]) + (v1[0] * v1[0] + v1[1] * v1[1]) + (v1[2] * v1[2] + v1[3] * v1[3])); }
                mx = __builtin_fmaxf(mx, shx<1>(mx)); mx = __builtin_fmaxf(mx, shx<2>(mx)); mx = __builtin_fmaxf(mx, shx<4>(mx)); mx = __builtin_fmaxf(mx, shx<8>(mx));
                if (fr == 0) atomicMax(km + ((b * 4 + 2 * bj + (wc >> 1)) * 8 + 4 * (wc & 1) + fq), __float_as_uint(mx)); }
        }
    }
};
struct EpiP {
    static constexpr bool PERM = true;
    bf16_t* P;
    __device__ __forceinline__ void operator()(const f32x4 (&acc)[2][2][4][2], const pg8::GUnit& u, int wr, int wc, int fr, int fq) const {
        const int row0 = u.e0 * 256 + wr * 64 + fr, col0 = u.e1 * 256 + wc * 32 + 8 * fq;
#pragma unroll
        for (int ai = 0; ai < 2; ++ai)
#pragma unroll
            for (int m = 0; m < 4; ++m) { bf16_t* rowp = P + (size_t)(row0 + ai * 128 + m * 16) * D + col0;
#pragma unroll
                for (int bj = 0; bj < 2; ++bj) { const f32x4 v0 = acc[ai][bj][m][0], v1 = acc[ai][bj][m][1];
                    u32x4 w; w.x = cvtpk(v0[0], v0[1]); w.y = cvtpk(v0[2], v0[3]); w.z = cvtpk(v1[0], v1[1]); w.w = cvtpk(v1[2], v1[3]);
                    *(u32x4*)(rowp + bj * 128) = w; } }
    }
};
struct EpiUp {
    static constexpr bool PERM = true;
    bf16_t* HID; const LEntry* list; const unsigned* cnt;
    __device__ __forceinline__ void operator()(const f32x4 (&acc)[2][2][4][2], const pg8::GUnit& u, int wr, int wc, int fr, int fq) const {
        const int pn = u.e1, slot = pn >> 1, pnl = pn & 1, cls = u.e2;
        const unsigned n = __hip_atomic_load(cnt + 64 * cls, __ATOMIC_RELAXED, __HIP_MEMORY_SCOPE_AGENT);
        const int colh = 256 * slot + 128 * pnl + wc * 32 + 8 * fq;
        float wrow[8];
#pragma unroll
        for (int k = 0; k < 8; ++k) { const int r = (k >> 2) * 128 + wr * 64 + (k & 3) * 16 + fr; const unsigned pos = (unsigned)(u.e3 + r);
            const LEntry* e = list + (size_t)cls * LCAP + (pos < n ? pos : 0u); const float w = slot ? e->w1 : e->w0; wrow[k] = pos < n ? w : 0.f; }
#pragma unroll
        for (int ai = 0; ai < 2; ++ai)
#pragma unroll
            for (int m = 0; m < 4; ++m) { const int r = ai * 128 + wr * 64 + m * 16 + fr; const float w = wrow[ai * 4 + m];
                float h[8];
#pragma unroll
                for (int nn = 0; nn < 2; ++nn)
#pragma unroll
                    for (int i = 0; i < 4; ++i) { const float g = acc[ai][0][m][nn][i], up = acc[ai][1][m][nn][i]; h[nn * 4 + i] = g * sigmoidf_(g) * up * w; }
                u32x4 o; o.x = cvtpk(h[0], h[1]); o.y = cvtpk(h[2], h[3]); o.z = cvtpk(h[4], h[5]); o.w = cvtpk(h[6], h[7]);
                *(u32x4*)(HID + (size_t)(u.e0 * 256 + r) * 512 + colh) = o; }
    }
};
struct EpiDown {
    static constexpr bool PERM = true;
    bf16_t* M; const LEntry* list; const unsigned* cnt;
    __device__ __forceinline__ void operator()(const f32x4 (&acc)[2][2][4][2], const pg8::GUnit& u, int wr, int wc, int fr, int fq) const {
        const int cls = u.e2, col0 = u.e1 * 256 + wc * 32 + 8 * fq;
        const unsigned n = __hip_atomic_load(cnt + 64 * cls, __ATOMIC_RELAXED, __HIP_MEMORY_SCOPE_AGENT);
        int tok[8];
#pragma unroll
        for (int k = 0; k < 8; ++k) { const int r = (k >> 2) * 128 + wr * 64 + (k & 3) * 16 + fr; const unsigned pos = (unsigned)(u.e3 + r);
            const int t = list[(size_t)cls * LCAP + (pos < n ? pos : 0u)].tok; tok[k] = pos < n ? t : -1; }
#pragma unroll
        for (int k = 0; k < 8; ++k) { const int ai = k >> 2, m = k & 3;
            if (tok[k] >= 0) { bf16_t* rowp = M + (size_t)tok[k] * D + col0;
#pragma unroll
                for (int bj = 0; bj < 2; ++bj) { const f32x4 v0 = acc[ai][bj][m][0], v1 = acc[ai][bj][m][1];
                    u32x4 w; w.x = cvtpk(v0[0], v0[1]); w.y = cvtpk(v0[2], v0[3]); w.z = cvtpk(v1[0], v1[1]); w.w = cvtpk(v1[2], v1[3]);
                    *(u32x4*)(rowp + bj * 128) = w; } } }
    }
};

__device__ __forceinline__ void pair_of(int p, int& lo, int& hi) { lo = p < 3 ? 0 : (p < 5 ? 1 : 2); hi = p < 3 ? p + 1 : (p < 5 ? p - 1 : 3); }
struct MoeUpOrder {
    int nunits, G, c; const LAS int* tt; const char* WGU; const LEntry* list; const unsigned* cnt;
    __device__ __forceinline__ bool next(int i, pg8::GUnit& u) const {
        const long L = (long)i * G + c; if (L >= (long)nunits * UPREP) return false;
        const int wgid = pg8::xcd_remap((int)(L % nunits), nunits); const int tile = wgid >> 2, pn = wgid & 3; const int e = tt[tile];
        const int cls = e & 255; u.e0 = tile; u.e1 = pn; u.e2 = cls; u.e3 = e >> 8; u.a0 = 0;
        int lo, hi; pair_of(cls % 6, lo, hi); const int ex = (cls / 6) * 4 + ((pn >> 1) ? hi : lo);
        u.bb = WGU + ((size_t)ex * 512 + (size_t)(pn & 1) * 256) * 2048; return true;
    }
    __device__ __forceinline__ unsigned arow(const pg8::GUnit& u, int r) const {
        const unsigned n = __hip_atomic_load(cnt + 64 * u.e2, __ATOMIC_RELAXED, __HIP_MEMORY_SCOPE_AGENT); const unsigned pos = (unsigned)(u.e3 + r);
        return (unsigned)list[(size_t)u.e2 * LCAP + (pos < n ? pos : 0u)].tok;
    }
};
struct MoeDownOrder {
    int nunits, G, c; const LAS int* tt; const char* WDP;
    __device__ __forceinline__ bool next(int i, pg8::GUnit& u) const {
        const long L = (long)i * G + c; if (L >= nunits) return false;
        const int wgid = pg8::xcd_remap((int)L, nunits); const int tile = wgid >> 2, pn = wgid & 3; const int e = tt[tile];
        const int cls = e & 255; u.e0 = tile; u.e1 = pn; u.e2 = cls; u.e3 = e >> 8; u.a0 = tile * 256;
        u.bb = WDP + ((size_t)cls * 1024 + (size_t)pn * 256) * 1024; return true;
    }
    __device__ __forceinline__ unsigned arow(const pg8::GUnit& u, int r) const { return (unsigned)(u.a0 + r); }
};

namespace att {
constexpr int DM = NPROJ;
constexpr int SLOTB = 8192;
constexpr int LDS_K = 0, LDS_V = 3 * SLOTB, LDS_WS = 6 * SLOTB, LDS_OST = LDS_WS + 2048, LDS_BIAS = LDS_OST + 8 * 4096, LDS_BLK = LDS_BIAS + 32768, LDS_MM = LDS_BLK + 256  , LDS_QM = LDS_MM + 96  , LDS_END = LDS_QM + 32;
static_assert(LDS_END <= RING_BYTES, "attention LDS");
typedef LAS const char* lds_cptr;
__device__ __forceinline__ int crow(int r, int hi) { return (r & 3) + 8 * (r >> 2) + 4 * hi; }
__device__ __forceinline__ void glds16(const void* gsrc, unsigned lds_dst) { unsigned keep;
    asm volatile("s_mov_b32 %0, m0\n\ts_mov_b32 m0, %2\n\ts_nop 0\n\tglobal_load_lds_dwordx4 %1, off\n\ts_mov_b32 m0, %0" : "=&s"(keep) : "v"(gsrc), "s"(lds_dst) : "memory"); }
__device__ __forceinline__ float max3f(float a, float b, float c) { return __builtin_fmaxf(__builtin_fmaxf(a, b), c); }
#define ATT_WAIT_BAR(N) asm volatile("s_waitcnt vmcnt(" #N ") lgkmcnt(0)\n\ts_barrier" ::: "memory")
typedef short v4i16_t __attribute__((ext_vector_type(4)));
__device__ __forceinline__ s16x4 vtr(lds_cptr p) { return __builtin_bit_cast(s16x4, __builtin_amdgcn_ds_read_tr16_b64_v4i16((LAS v4i16_t*)p)); }
__device__ __forceinline__ float rowmax(const f32x16& p0, const f32x16& p1) {
    float a = max3f(p0[0], p0[1], p1[0]), b = max3f(p0[2], p0[3], p1[1]); a = max3f(a, p1[2], p1[3]);
#pragma unroll
    for (int r = 4; r < 16; r += 4) { a = max3f(a, p0[r], p0[r + 1]); b = max3f(b, p0[r + 2], p0[r + 3]); a = max3f(a, p1[r], p1[r + 1]); b = max3f(b, p1[r + 2], p1[r + 3]); }
    const float m = __builtin_fmaxf(a, b);
    auto rr = __builtin_amdgcn_permlane32_swap(__float_as_uint(m), __float_as_uint(m), false, false);
    return __builtin_fmaxf(__uint_as_float(rr[0]), __uint_as_float(rr[1]));
}
__device__ __forceinline__ void pv(f32x16* o, int vb, bf16x8 pa0, bf16x8 pa1, bf16x8 pa2, bf16x8 pa3) {
#pragma unroll
    for (int d0 = 0; d0 < 2; ++d0) { s16x4 lo[4], hi[4];
#pragma unroll
        for (int ks = 0; ks < 4; ++ks) {
            asm volatile("ds_read_b64_tr_b16 %0,%1 offset:%c2" : "=&v"(lo[ks]) : "v"(vb), "i"(d0 * 4096 + ks * 1024) : "memory");
            asm volatile("ds_read_b64_tr_b16 %0,%1 offset:%c2" : "=&v"(hi[ks]) : "v"(vb), "i"(d0 * 4096 + ks * 1024 + 512) : "memory"); }
        asm volatile("s_waitcnt lgkmcnt(0)" ::: "memory"); __builtin_amdgcn_sched_barrier(0);
#define ATT_PK(k) (bf16x8){lo[k][0], lo[k][1], lo[k][2], lo[k][3], hi[k][0], hi[k][1], hi[k][2], hi[k][3]}
        o[d0] = __builtin_amdgcn_mfma_f32_32x32x16_bf16(pa0, ATT_PK(0), o[d0], 0, 0, 0);
        o[d0] = __builtin_amdgcn_mfma_f32_32x32x16_bf16(pa1, ATT_PK(1), o[d0], 0, 0, 0);
        o[d0] = __builtin_amdgcn_mfma_f32_32x32x16_bf16(pa2, ATT_PK(2), o[d0], 0, 0, 0);
        o[d0] = __builtin_amdgcn_mfma_f32_32x32x16_bf16(pa3, ATT_PK(3), o[d0], 0, 0, 0);
#undef ATT_PK
    }
}
template <int MODE>
__device__ __forceinline__ void attn_core(char* shm, const bf16_t* Qw, const bf16_t* Kh, const bf16_t* Vh, bf16_t* Ow, int q0, int t_lo, int t_hi, float sinkl2, float slope2, const int tid, const float kn2 = 0.f) {
    const int lane = tid & 63, r32 = lane & 31, hi = lane >> 5; const int wid = __builtin_amdgcn_readfirstlane(tid >> 6);
    const unsigned lds0 = (unsigned)(uintptr_t)shm;
    float* wsf = (float*)(shm + LDS_WS) + wid * 64;
    const lds_cptr shm3 = (lds_cptr)shm;
    const bf16_t* ksrc = Kh + (long)lane * DM + wid * 8;
    const bf16_t* vsrc = Vh + (long)(16 * (wid & 3) + (lane >> 2)) * DM + (wid >> 2) * 32 + (lane & 3) * 8;
    const unsigned kdst = lds0 + LDS_K + wid * 1024, vdst = lds0 + LDS_V + wid * 1024;
#define ATT_DMA_K(t, slot) glds16(ksrc + (long)(t) * 64 * DM, (unsigned)__builtin_amdgcn_readfirstlane(kdst + (slot)))
#define ATT_DMA_V(t, slot) glds16(vsrc + (long)(t) * 64 * DM, (unsigned)__builtin_amdgcn_readfirstlane(vdst + (slot)))
    const int vb0 = (int)(lds0 + LDS_V) + ((lane >> 4) & 1) * 32 + (lane & 3) * 8 + (4 * hi + ((lane & 15) >> 2)) * 64;
    const int n = t_hi - t_lo + 1;
    const int qw0 = q0 + 32 * wid, w_hi = (qw0 + 31) >> 6;
    const int w_lo = (MODE == 1) ? ((qw0 - 127 > 0 ? qw0 - 127 : 0) >> 6) : t_lo;
    bf16x8 qr[4];
#pragma unroll
    for (int d0 = 0; d0 < 4; ++d0) qr[d0] = *reinterpret_cast<const bf16x8*>(&Qw[(long)r32 * DM + d0 * 16 + hi * 8]);
    ATT_DMA_K(t_hi, 0); ATT_DMA_V(t_hi, 0);
    if (n > 1) { ATT_DMA_K(t_hi - 1, SLOTB); ATT_DMA_V(t_hi - 1, SLOTB); }
    LAS float* mmp = (LAS float*)(shm3 + LDS_MM); LAS float* qmp = (LAS float*)(shm3 + LDS_QM);
    if (MODE == 0) {
        float qs = 0.f;
#pragma unroll
        for (int d0 = 0; d0 < 4; ++d0)
#pragma unroll
            for (int e = 0; e < 8; ++e) { const float v = bf2f((bf16_t)qr[d0][e]); qs += v * v; }
        { auto rr = __builtin_amdgcn_permlane32_swap(__float_as_uint(qs), __float_as_uint(qs), false, false); qs = __uint_as_float(rr[0]) + __uint_as_float(rr[1]); }
        qs = __builtin_fmaxf(qs, shx<1>(qs)); qs = __builtin_fmaxf(qs, shx<2>(qs)); qs = __builtin_fmaxf(qs, shx<4>(qs)); qs = __builtin_fmaxf(qs, shx<8>(qs)); qs = __builtin_fmaxf(qs, shx<16>(qs));
        if (lane == 0) { qmp[wid] = qs; mmp[wid] = -1e30f; mmp[8 + wid] = -1e30f; mmp[16 + wid] = -1e30f; }
    }
    float bqk = 0.f;
    float mhat = 0.f, l_reg = 0.f; f32x16 o[2]; o[0] = f32x16{}; o[1] = f32x16{}; bool first = true;
    const int q = qw0 + r32;
    const int grp = wid >> 2;
#define ATT_LBAR() asm volatile("s_waitcnt lgkmcnt(0)\n\ts_barrier" ::: "memory")
#define ATT_ISSUE(i2) do { if ((i2) < n) { const int sl_ = ((i2) % 3) * SLOTB; ATT_DMA_K(t_hi - (i2), sl_); ATT_DMA_V(t_hi - (i2), sl_); } } while (0)
    if (grp == 1) { if (n > 1) { ATT_WAIT_BAR(2); } else { ATT_WAIT_BAR(0); } }
#pragma unroll 1
    for (int ti = 0; ti < n; ++ti) {
        const int t = t_hi - ti, sl_cur = (ti % 3) * SLOTB;
        const bool need = (t >= w_lo && t <= w_hi);
        if (MODE == 0 && ti >= 2) {
            if (ti == 2) { const f32x4 qa = *(const LAS f32x4*)qmp, qb_ = *(const LAS f32x4*)(qmp + 4);
                const float qn2 = __builtin_fmaxf(__builtin_fmaxf(__builtin_fmaxf(qa[0], qa[1]), __builtin_fmaxf(qa[2], qa[3])), __builtin_fmaxf(__builtin_fmaxf(qb_[0], qb_[1]), __builtin_fmaxf(qb_[2], qb_[3])));
                bqk = __int_as_float(__builtin_amdgcn_readfirstlane(__float_as_int(sqrtf(qn2 * kn2) * 1.02f + 1.0f))); }
            const LAS float* mp = mmp + ((ti - 2) % 3) * 8; const f32x4 ma = *(const LAS f32x4*)mp, mb = *(const LAS f32x4*)(mp + 4);
            const float mm = __builtin_fminf(__builtin_fminf(__builtin_fminf(ma[0], ma[1]), __builtin_fminf(ma[2], ma[3])), __builtin_fminf(__builtin_fminf(mb[0], mb[1]), __builtin_fminf(mb[2], mb[3])));
            const float bmax = *((const LAS float*)(shm3 + LDS_BIAS) + (t - t_lo) * 64 + 63);
            if (__builtin_amdgcn_readfirstlane((int)(bqk + bmax < mm - 160.f))) break;
        }
        if (grp == 0) { if (ti + 1 < n) { ATT_WAIT_BAR(2); } else { ATT_WAIT_BAR(0); } }
        else { ATT_LBAR(); ATT_ISSUE(ti + 2); }
        f32x16 p0, p1;
        if (need) {
            { const LAS float* bp = (const LAS float*)(shm3 + LDS_BIAS) + (t - t_lo) * 64 + 4 * hi;
#pragma unroll
              for (int jj = 0; jj < 4; ++jj) { const f32x4 a = *(const LAS f32x4*)(bp + 8 * jj), b = *(const LAS f32x4*)(bp + 32 + 8 * jj);
                  p0[4 * jj] = a[0] - mhat; p0[4 * jj + 1] = a[1] - mhat; p0[4 * jj + 2] = a[2] - mhat; p0[4 * jj + 3] = a[3] - mhat;
                  p1[4 * jj] = b[0] - mhat; p1[4 * jj + 1] = b[1] - mhat; p1[4 * jj + 2] = b[2] - mhat; p1[4 * jj + 3] = b[3] - mhat; } }
            { const lds_cptr kb = shm3 + LDS_K + sl_cur + hi * 1024 + r32 * 16;
#pragma unroll
              for (int d0 = 0; d0 < 4; ++d0) { const bf16x8 b0 = *(const LAS bf16x8*)(kb + d0 * 2048), b1 = *(const LAS bf16x8*)(kb + d0 * 2048 + 512);
                  p0 = __builtin_amdgcn_mfma_f32_32x32x16_bf16(b0, qr[d0], p0, 0, 0, 0); p1 = __builtin_amdgcn_mfma_f32_32x32x16_bf16(b1, qr[d0], p1, 0, 0, 0); } }
            const float NEG = -__builtin_inff();
            if (MODE == 0) { if (t == w_hi) { const int kb_ = 64 * t + 4 * hi;
#pragma unroll
                for (int r = 0; r < 16; ++r) { const int kv = kb_ + (r & 3) + 8 * (r >> 2); if (kv > q) p0[r] = NEG; if (kv + 32 > q) p1[r] = NEG; } } }
            else { const int kb_ = 64 * t + 4 * hi;
#pragma unroll
                for (int r = 0; r < 16; ++r) { const int kv = kb_ + (r & 3) + 8 * (r >> 2); if ((unsigned)(q - kv) >= 128u) p0[r] = NEG; if ((unsigned)(q - kv - 32) >= 128u) p1[r] = NEG; } }
            const float rm = rowmax(p0, p1);
            if (first || __any(rm > 8.f)) {
                const float dl = first ? __builtin_fmaxf(rm, -1e30f) : __builtin_fmaxf(rm, 0.f); const float f = first ? 1.f : __builtin_amdgcn_exp2f(-dl);
                first = false; mhat += dl; l_reg *= f; if (hi == 0) wsf[r32] = f;
#pragma unroll
                for (int r = 0; r < 16; ++r) { p0[r] -= dl; p1[r] -= dl; }
                asm volatile("s_waitcnt lgkmcnt(0)" ::: "memory");
#pragma unroll
                for (int jj = 0; jj < 4; ++jj) { const f32x4 fv = *(const f32x4*)(wsf + 8 * jj + 4 * hi);
#pragma unroll
                    for (int i2 = 0; i2 < 4; ++i2) { o[0][4 * jj + i2] *= fv[i2]; o[1][4 * jj + i2] *= fv[i2]; } }
            }
            if (MODE == 0) {
                float mn = mhat; mn = __builtin_fminf(mn, shx<1>(mn)); mn = __builtin_fminf(mn, shx<2>(mn)); mn = __builtin_fminf(mn, shx<4>(mn)); mn = __builtin_fminf(mn, shx<8>(mn)); mn = __builtin_fminf(mn, shx<16>(mn));
                if (lane == 0) mmp[(ti % 3) * 8 + wid] = mn; }
        }
        if (grp == 0) { ATT_LBAR(); ATT_ISSUE(ti + 2); }
        else { if (ti + 1 < n) { if (ti + 2 < n) { ATT_WAIT_BAR(2); } else { ATT_WAIT_BAR(0); } } else { ATT_LBAR(); } }
        if (need) {
            const lds_cptr vp = shm3 + LDS_V + sl_cur + ((lane >> 4) & 1) * 32 + (lane & 3) * 8 + (4 * hi + ((lane & 15) >> 2)) * 64;
#define ATT_SB() __builtin_amdgcn_sched_barrier(0)
#define ATT_PIN(x) asm volatile("" : "+v"(x))
#define ATT_VRD(i) do { vlo[i] = vtr(vp + (((i) >> 2) * 4096 + ((i) & 3) * 1024)); vhi[i] = vtr(vp + (((i) >> 2) * 4096 + ((i) & 3) * 1024 + 512)); } while (0)
#define ATT_VF(i) (bf16x8){vlo[i][0], vlo[i][1], vlo[i][2], vlo[i][3], vhi[i][0], vhi[i][1], vhi[i][2], vhi[i][3]}
#define ATT_PIN4(B) asm volatile("" : "+v"(ex[B]), "+v"(ex[B + 1]), "+v"(ex[B + 2]), "+v"(ex[B + 3]))
#define ATT_EX4(P, PB, B) do { ex[B] = __builtin_amdgcn_exp2f(P[PB]); ex[B + 1] = __builtin_amdgcn_exp2f(P[PB + 1]); ex[B + 2] = __builtin_amdgcn_exp2f(P[PB + 2]); ex[B + 3] = __builtin_amdgcn_exp2f(P[PB + 3]); ATT_PIN4(B); } while (0)
#define ATT_PK4(B) (u32x4){cvtpk(ex[B], ex[B + 1]), cvtpk(ex[B + 2], ex[B + 3]), cvtpk(ex[B + 4], ex[B + 5]), cvtpk(ex[B + 6], ex[B + 7])}
#define ATT_SUM4(B) do { sacc += ex[B]; sacc += ex[B + 1]; sacc += ex[B + 2]; sacc += ex[B + 3]; ATT_PIN(sacc); } while (0)
            s16x4 vlo[8], vhi[8]; u32x4 pw0, pw1, pw2, pw3; float sacc = 0.f; float ex[32];
            ATT_VRD(0); ATT_VRD(4);
            ATT_EX4(p0, 0, 0); ATT_EX4(p0, 4, 4); pw0 = ATT_PK4(0); ATT_PIN(pw0); ATT_SB();
            o[0] = __builtin_amdgcn_mfma_f32_32x32x16_bf16(__builtin_bit_cast(bf16x8, pw0), ATT_VF(0), o[0], 0, 0, 0); ATT_VRD(1); ATT_EX4(p0, 8, 8); ATT_SUM4(0); ATT_SB();
            o[1] = __builtin_amdgcn_mfma_f32_32x32x16_bf16(__builtin_bit_cast(bf16x8, pw0), ATT_VF(4), o[1], 0, 0, 0); ATT_VRD(5); ATT_EX4(p0, 12, 12); pw1 = ATT_PK4(8); ATT_PIN(pw1); ATT_SB();
            o[0] = __builtin_amdgcn_mfma_f32_32x32x16_bf16(__builtin_bit_cast(bf16x8, pw1), ATT_VF(1), o[0], 0, 0, 0); ATT_VRD(2); ATT_EX4(p1, 0, 16); ATT_SUM4(4); ATT_SB();
            o[1] = __builtin_amdgcn_mfma_f32_32x32x16_bf16(__builtin_bit_cast(bf16x8, pw1), ATT_VF(5), o[1], 0, 0, 0); ATT_VRD(6); ATT_EX4(p1, 4, 20); pw2 = ATT_PK4(16); ATT_PIN(pw2); ATT_SB();
            o[0] = __builtin_amdgcn_mfma_f32_32x32x16_bf16(__builtin_bit_cast(bf16x8, pw2), ATT_VF(2), o[0], 0, 0, 0); ATT_VRD(3); ATT_EX4(p1, 8, 24); ATT_SUM4(8); ATT_SB();
            o[1] = __builtin_amdgcn_mfma_f32_32x32x16_bf16(__builtin_bit_cast(bf16x8, pw2), ATT_VF(6), o[1], 0, 0, 0); ATT_VRD(7); ATT_EX4(p1, 12, 28); pw3 = ATT_PK4(24); ATT_PIN(pw3); ATT_SB();
            o[0] = __builtin_amdgcn_mfma_f32_32x32x16_bf16(__builtin_bit_cast(bf16x8, pw3), ATT_VF(3), o[0], 0, 0, 0); ATT_SUM4(12); ATT_SUM4(16); ATT_SUM4(20); ATT_SB();
            o[1] = __builtin_amdgcn_mfma_f32_32x32x16_bf16(__builtin_bit_cast(bf16x8, pw3), ATT_VF(7), o[1], 0, 0, 0); ATT_SUM4(24); ATT_SUM4(28); ATT_SB();
            l_reg += sacc;
#undef ATT_SB
#undef ATT_PIN
#undef ATT_VRD
#undef ATT_VF
#undef ATT_EX4
#undef ATT_PK4
#undef ATT_SUM4
#undef ATT_PIN4
        }
    }
    if (grp == 0) { ATT_LBAR(); }
#undef ATT_LBAR
#undef ATT_ISSUE
    { auto rr = __builtin_amdgcn_permlane32_swap(__float_as_uint(l_reg), __float_as_uint(l_reg), false, false); l_reg = __uint_as_float(rr[0]) + __uint_as_float(rr[1]); }
    if (MODE == 1) l_reg += __builtin_amdgcn_exp2f(sinkl2 + slope2 * (float)(32 * wid + r32) - mhat);
    if (hi == 0) wsf[32 + r32] = l_reg;
    asm volatile("s_waitcnt lgkmcnt(0)" ::: "memory");
    float rli[16];
#pragma unroll
    for (int r = 0; r < 16; ++r) rli[r] = __builtin_amdgcn_rcpf(wsf[32 + crow(r, hi)]);
    { bf16_t* stg = (bf16_t*)(shm + LDS_OST) + wid * 2048;
#pragma unroll
      for (int r = 0; r < 16; ++r) { const int orow = crow(r, hi);
#pragma unroll
          for (int d0 = 0; d0 < 2; ++d0) stg[orow * 64 + d0 * 32 + r32] = (bf16_t)(cvtpk(o[d0][r] * rli[r], 0.f) & 0xffffu); }
      asm volatile("s_waitcnt lgkmcnt(0)" ::: "memory");
#pragma unroll
      for (int i = 0; i < 4; ++i) { const int row = i * 8 + (lane >> 3), ch = lane & 7; const u32x4 v = *(const u32x4*)(stg + row * 64 + ch * 8); *(u32x4*)(Ow + (long)row * D + ch * 8) = v; } }
    asm volatile("s_waitcnt vmcnt(0) lgkmcnt(0)\n\ts_barrier" ::: "memory");
#undef ATT_DMA_K
#undef ATT_DMA_V
}
}

__device__ __forceinline__ void p0_tr_item(const float* W, int ld_src, int k0, int n0, bf16_t* d0, bf16_t* d1, bf16_t* d2, int ld_dst, LAS float* scr, int lane) {
#pragma unroll 8
    for (int i = 0; i < 32; ++i) { const int kk = 2 * i + (lane >> 5); scr[kk * 33 + (lane & 31)] = W[(size_t)(k0 + kk) * ld_src + n0 + (lane & 31)]; }
    LDS_WAIT(); asm volatile("" ::: "memory");
    const int c = lane & 7;
#pragma unroll
    for (int j = 0; j < 4; ++j) { const int n = (lane >> 3) + 8 * j; const LAS float* s = scr + (8 * c) * 33 + n;
        u32x4 o; o.x = cvtpk(s[0 * 33], s[1 * 33]); o.y = cvtpk(s[2 * 33], s[3 * 33]); o.z = cvtpk(s[4 * 33], s[5 * 33]); o.w = cvtpk(s[6 * 33], s[7 * 33]);
        *(u32x4*)(d0 + (size_t)n * ld_dst + 8 * c) = o;
        if (d1) *(u32x4*)(d1 + (size_t)n * ld_dst + 8 * c) = o;
        if (d2) *(u32x4*)(d2 + (size_t)n * ld_dst + 8 * c) = o; }
    LDS_WAIT(); asm volatile("" ::: "memory");
}
__device__ __forceinline__ int pair_idx(int lo, int hi) { return lo == 0 ? hi - 1 : (lo == 1 ? hi + 1 : 5); }

__device__ __forceinline__ void phase_p0(Frame& F) {
    __syncthreads();
    {
        LAS float* sc = (LAS float*)F.lds;
        LAS float* red = (LAS float*)(F.lds + 16384);
        float* MOD = (float*)(F.ws + WS_MOD);
        bool have = false;
        for (int task = F.vcu; task < 48; task += F.G) {
            if (!have) { for (int i = F.tid; i < 4096; i += 512) { const float v = F.inp(F_C)[i]; sc[i] = v * sigmoidf_(v); } __syncthreads(); have = true; }
            const int l = task / 24, j0 = (task % 24) * 256;
            const float* wp = F.inp(F_WMOD) + (size_t)l * 1024 * 6144 + j0 + 4 * F.lane;
            f32x4 a0 = {0, 0, 0, 0}, a1 = a0, a2 = a0, a3 = a0;
            const int kbeg = F.wave * 128;
#pragma unroll 8
            for (int k = kbeg; k < kbeg + 128; ++k) { const f32x4 wv = *(const f32x4*)(wp + (size_t)k * 6144);
                a0 += wv * sc[k]; a1 += wv * sc[1024 + k]; a2 += wv * sc[2048 + k]; a3 += wv * sc[3072 + k]; }
            *(LAS f32x4*)(red + (F.wave * 4 + 0) * 256 + 4 * F.lane) = a0; *(LAS f32x4*)(red + (F.wave * 4 + 1) * 256 + 4 * F.lane) = a1;
            *(LAS f32x4*)(red + (F.wave * 4 + 2) * 256 + 4 * F.lane) = a2; *(LAS f32x4*)(red + (F.wave * 4 + 3) * 256 + 4 * F.lane) = a3;
            __syncthreads();
            for (int o = F.tid; o < 1024; o += 512) { const int b = o >> 8, cidx = o & 255; float s = F.inp(F_BMOD)[l * 6144 + j0 + cidx];
#pragma unroll
                for (int w = 0; w < 8; ++w) s += red[(w * 4 + b) * 256 + cidx];
                MOD[(size_t)(l * 4 + b) * 6144 + j0 + cidx] = s; }
            __syncthreads();
        }
        __syncthreads();
    }
    LAS float* scr = (LAS float*)(F.lds + F.wave * 16384);
    const int gw = F.vcu * 8 + F.wave, NGW = F.G * 8;
    bf16_t* WIN = (bf16_t*)(F.ws + WS_WIN); bf16_t* WOUT = (bf16_t*)(F.ws + WS_WOUT); bf16_t* WGU = (bf16_t*)(F.ws + WS_WGU); bf16_t* WDP = (bf16_t*)(F.ws + WS_WDP);
    constexpr int I_IN = 2 * 16 * 64, I_OUT = 2 * 16 * 32, I_GU = 2 * 16 * 2 * 16 * 8, I_DN = 2 * 16 * 4 * 32;
    for (int it = gw; it < I_IN + I_OUT + I_GU + I_DN; it += NGW) {
        int r = it;
        if (r < I_IN) { const int l = r / 1024, kb = (r % 1024) / 64, nb = r % 64;
            p0_tr_item(F.inp(F_WIN) + (size_t)l * 1024 * IN_COLS, IN_COLS, 64 * kb, 32 * nb, WIN + ((size_t)l * 2048 + 32 * nb) * 1024 + 64 * kb, nullptr, nullptr, 1024, scr, F.lane); continue; }
        r -= I_IN;
        if (r < I_OUT) { const int l = r / 512, kb = (r % 512) / 32, nb = r % 32;
            p0_tr_item(F.inp(F_WOUT) + (size_t)l * 1024 * 1024, 1024, 64 * kb, 32 * nb, WOUT + ((size_t)l * 1024 + 32 * nb) * 1024 + 64 * kb, nullptr, nullptr, 1024, scr, F.lane); continue; }
        r -= I_OUT;
        if (r < I_GU) { const int le = r / 256, which = (r % 256) / 128, kb = (r % 128) / 8, nb = r % 8;
            const int j0 = 32 * nb, row = 256 * (j0 >> 7) + (j0 & 127) + which * 128;
            p0_tr_item((which ? F.inp(F_WUP) : F.inp(F_WGATE)) + (size_t)le * 1024 * 256, 256, 64 * kb, j0, WGU + ((size_t)le * 512 + row) * 1024 + 64 * kb, nullptr, nullptr, 1024, scr, F.lane); continue; }
        r -= I_GU;
        { const int le = r / 128, kb = (r % 128) / 32, nb = r % 32; const int l = le >> 4, e = le & 15, g = e >> 2, i = e & 3;
          bf16_t* dst[3]; int nd = 0;
#pragma unroll
          for (int j = 0; j < 4; ++j) { if (j == i) continue; const int lo = i < j ? i : j, hi = i < j ? j : i; const int cls = g * 6 + pair_idx(lo, hi); const int kofs = (i == lo) ? 0 : 256;
              dst[nd++] = WDP + ((size_t)(l * 24 + cls) * 1024 + 32 * nb) * 512 + kofs + 64 * kb; }
          p0_tr_item(F.inp(F_WDOWN) + (size_t)le * 256 * 1024, 1024, 64 * kb, 32 * nb, dst[0], dst[1], dst[2], 512, scr, F.lane); }
    }
}

template <bool PM>
__device__ __forceinline__ void phase_norm1(Frame& F, int l, const float* xin) {
    const bf16_t* Pb = (const bf16_t*)(F.ws + WS_P); const bf16_t* Mb = (const bf16_t*)(F.ws + WS_M); float* XA = (float*)(F.ws + WS_XA);
    LAS float* gpm = (LAS float*)(F.lds + 256);
    const float* MOD = (const float*)(F.ws + WS_MOD) + (size_t)l * 4 * 6144;
    bf16_t* H = (bf16_t*)(F.ws + WS_H); float* CUM = (float*)(F.ws + WS_CUM); float* CTOT = (float*)(F.ws + WS_CTOT);
    LAS float* wtot = (LAS float*)F.lds;
    for (int tile = F.vcu; tile < T / 128; tile += F.G) {
        const int b = tile >> 6, row0 = tile * 128;
        f32x4 g1[4], s1[4], wfc[16];
#pragma unroll
        for (int j = 0; j < 4; ++j) { const int col = 4 * F.lane + 256 * j;
            const f32x4 nm = *(const f32x4*)(F.inp(F_NMIX) + l * 1024 + col), scv = *(const f32x4*)(MOD + b * 6144 + 1024 + col);
            g1[j] = nm * (scv + 1.0f); s1[j] = *(const f32x4*)(MOD + b * 6144 + col);
#pragma unroll
            for (int i = 0; i < 4; ++i) wfc[j * 4 + i] = *(const f32x4*)(F.inp(F_WIN) + ((size_t)l * 1024 + col + i) * IN_COLS + 2048); }
        const f32x4 fb = *(const f32x4*)(F.inp(F_FOXB) + l * 4);
        if (PM) { const float* MODp = (const float*)(F.ws + WS_MOD) + (size_t)(l - 1) * 4 * 6144 + b * 6144;
            for (int i = F.tid; i < 1024; i += 512) { gpm[i] = MODp[2048 + i]; gpm[1024 + i] = MODp[5120 + i]; }
            __syncthreads(); }
        f32x4 run = {0.f, 0.f, 0.f, 0.f}, keep = {0.f, 0.f, 0.f, 0.f};
#pragma unroll 1
        for (int i = 0; i < 16; i += 2) {
            const int row = row0 + F.wave * 16 + i;
            const f32x4* xr0 = (const f32x4*)(xin + (size_t)row * D) + F.lane; const f32x4* xr1 = xr0 + D / 4;
            f32x4 v0[4], v1[4]; float ss0 = 0.f, ss1 = 0.f;
#pragma unroll
            for (int j = 0; j < 4; ++j) { v0[j] = xr0[64 * j]; v1[j] = xr1[64 * j]; }
            if (PM) {
                u32x2 p0[4], p1[4], m0[4], m1[4];
                const u32x2* pr0 = (const u32x2*)(Pb + (size_t)row * D) + F.lane; const u32x2* mr0 = (const u32x2*)(Mb + (size_t)row * D) + F.lane;
#pragma unroll
                for (int j = 0; j < 4; ++j) { p0[j] = pr0[64 * j]; p1[j] = pr0[64 * j + D / 4]; m0[j] = mr0[64 * j]; m1[j] = mr0[64 * j + D / 4]; }
                f32x4* xo0 = (f32x4*)(XA + (size_t)row * D) + F.lane; f32x4* xo1 = xo0 + D / 4;
#pragma unroll
                for (int j = 0; j < 4; ++j) { const f32x4 gm = *(const LAS f32x4*)(gpm + 4 * F.lane + 256 * j), gf = *(const LAS f32x4*)(gpm + 1024 + 4 * F.lane + 256 * j);
                    v0[j] = v0[j] + gm * bf4_to_f32(p0[j]) + gf * bf4_to_f32(m0[j]); v1[j] = v1[j] + gm * bf4_to_f32(p1[j]) + gf * bf4_to_f32(m1[j]);
                    xo0[64 * j] = v0[j]; xo1[64 * j] = v1[j]; }
            }
#pragma unroll
            for (int j = 0; j < 4; ++j) { ss0 += (v0[j].x * v0[j].x + v0[j].y * v0[j].y) + (v0[j].z * v0[j].z + v0[j].w * v0[j].w); ss1 += (v1[j].x * v1[j].x + v1[j].y * v1[j].y) + (v1[j].z * v1[j].z + v1[j].w * v1[j].w); }
            const float rstd0 = 1.0f / sqrtf(wave_sum(ss0) * (1.f / D) + EPS), rstd1 = 1.0f / sqrtf(wave_sum(ss1) * (1.f / D) + EPS);
            f32x4 fa0 = {0.f, 0.f, 0.f, 0.f}, fa1 = {0.f, 0.f, 0.f, 0.f};
            u32x2* o0 = (u32x2*)(H + (size_t)row * D) + F.lane; u32x2* o1 = o0 + D / 4;
#pragma unroll
            for (int j = 0; j < 4; ++j) { const f32x4 h0 = v0[j] * rstd0 * g1[j] + s1[j], h1 = v1[j] * rstd1 * g1[j] + s1[j];
                fa0 += wfc[j * 4 + 0] * h0.x + wfc[j * 4 + 1] * h0.y + wfc[j * 4 + 2] * h0.z + wfc[j * 4 + 3] * h0.w;
                fa1 += wfc[j * 4 + 0] * h1.x + wfc[j * 4 + 1] * h1.y + wfc[j * 4 + 2] * h1.z + wfc[j * 4 + 3] * h1.w;
                u32x2 w; w.x = cvtpk(h0.x, h0.y); w.y = cvtpk(h0.z, h0.w); o0[64 * j] = w; w.x = cvtpk(h1.x, h1.y); w.y = cvtpk(h1.z, h1.w); o1[64 * j] = w; }
            f32x4 lf0, lf1;
#pragma unroll
            for (int e = 0; e < 4; ++e) { const float z0 = wave_sum(fa0[e]) + fb[e], z1 = wave_sum(fa1[e]) + fb[e];
                lf0[e] = fminf(z0, 0.f) - __builtin_amdgcn_logf(1.f + fast_exp(-fabsf(z0))) * 0.6931471805599453f;
                lf1[e] = fminf(z1, 0.f) - __builtin_amdgcn_logf(1.f + fast_exp(-fabsf(z1))) * 0.6931471805599453f; }
            run += lf0; if (F.lane == i) keep = run;
            run += lf1; if (F.lane == i + 1) keep = run;
        }
        if (F.lane == 0) *(LAS f32x4*)(wtot + F.wave * 4) = run;
        __syncthreads();
        f32x4 pre = {0.f, 0.f, 0.f, 0.f}, tot = {0.f, 0.f, 0.f, 0.f};
#pragma unroll
        for (int w = 0; w < 8; ++w) { const f32x4 tv = *(const LAS f32x4*)(wtot + w * 4); if (w < F.wave) pre += tv; tot += tv; }
        if (F.lane < 16) { const int s = (row0 & (SEQ - 1)) + F.wave * 16 + F.lane; const f32x4 cv = keep + pre;
#pragma unroll
            for (int e = 0; e < 4; ++e) CUM[(size_t)(b * 4 + e) * SEQ + s] = cv[e]; }
        if (F.tid == 0) *(f32x4*)(CTOT + (size_t)(b * 64 + (tile & 63)) * 4) = tot;
        __syncthreads();
    }
}

__device__ __forceinline__ void lru_unit(Frame& F, int l, int b, int tt) {
    const bf16_t* PROJ = (const bf16_t*)(F.ws + WS_PROJ);
    float* HLOC = (float*)(F.ws + WS_H); float* PP = HLOC + (size_t)T * 256;
    float* LRUA = (float*)(F.ws + WS_LRUA); float* LRUH = (float*)(F.ws + WS_LRUH);
    LAS float* xcb = (LAS float*)F.lds;
    const int c = F.tid & 255, sl = F.tid >> 8, blk = c >> 5, dd = c & 31;
    float wa[32], wx[32];
#pragma unroll
    for (int j = 0; j < 32; ++j) { wa[j] = F.inp(F_LWA)[((size_t)(l * 8 + blk) * 32 + j) * 32 + dd]; wx[j] = F.inp(F_LWX)[((size_t)(l * 8 + blk) * 32 + j) * 32 + dd]; }
    const float cw0 = F.inp(F_CONVW)[(l * 4 + 0) * 256 + c], cw1 = F.inp(F_CONVW)[(l * 4 + 1) * 256 + c], cw2 = F.inp(F_CONVW)[(l * 4 + 2) * 256 + c], cw3 = F.inp(F_CONVW)[(l * 4 + 3) * 256 + c];
    const float cb = F.inp(F_CONVB)[l * 256 + c], ba = F.inp(F_LBA)[l * 256 + c], bx = F.inp(F_LBX)[l * 256 + c];
    const float lam = F.inp(F_LAM)[l * 256 + c];
    const float sp = -8.0f * (fmaxf(-lam, 0.f) + log1pf(expf(-fabsf(lam))));
    const int s0 = tt * 128 + sl * 64;
    const bf16_t* xp = PROJ + ((size_t)b * SEQ + s0) * NPROJ + C_XB + c;
    float xm3 = s0 >= 3 ? bf2f(xp[-3 * (long)NPROJ]) : 0.f, xm2 = s0 >= 2 ? bf2f(xp[-2 * (long)NPROJ]) : 0.f, xm1 = s0 >= 1 ? bf2f(xp[-1 * (long)NPROJ]) : 0.f;
    float h = 0.f, P = 1.f;
    for (int sub = 0; sub < 4; ++sub) {
        LAS float* xw = xcb + ((sub & 1) * 2 + sl) * 16 * 256;
        float xv[16];
#pragma unroll
        for (int i = 0; i < 16; ++i) { const float xc = bf2f(xp[(long)(sub * 16 + i) * NPROJ]); xv[i] = cb + cw0 * xm3 + cw1 * xm2 + cw2 * xm1 + cw3 * xc; xm3 = xm2; xm2 = xm1; xm1 = xc; xw[i * 256 + c] = xv[i]; }
        __syncthreads();
#pragma unroll
        for (int i = 0; i < 16; ++i) {
            float ga = ba, gx = bx; const LAS f32x4* xr = (const LAS f32x4*)(xw + i * 256 + blk * 32);
#pragma unroll
            for (int j4 = 0; j4 < 8; ++j4) { const f32x4 q = xr[j4];
                ga += q.x * wa[4 * j4] + q.y * wa[4 * j4 + 1] + q.z * wa[4 * j4 + 2] + q.w * wa[4 * j4 + 3];
                gx += q.x * wx[4 * j4] + q.y * wx[4 * j4 + 1] + q.z * wx[4 * j4 + 2] + q.w * wx[4 * j4 + 3]; }
            const float r = sigmoidf_(ga), ig = sigmoidf_(gx);
            const float la = sp * r; const float a = fast_exp(la);
            const float mult = sqrtf(-expm1f(2.f * la));
            const float u = mult * ig * xv[i];
            h = a * h + u; P *= a;
            const size_t off = ((size_t)b * SEQ + s0 + sub * 16 + i) * 256 + c;
            HLOC[off] = h; PP[off] = P;
        }
    }
    const size_t so = ((size_t)(b * 128 + tt * 2 + sl)) * 256 + c;
    LRUA[so] = P; LRUH[so] = h;
    __syncthreads();
}

__device__ __forceinline__ void fox_unit(Frame& F, int l, int b, int h, int qb) {
    const bf16_t* PROJ = (const bf16_t*)(F.ws + WS_PROJ); bf16_t* Y = (bf16_t*)(F.ws + WS_Y);
    const float* CUM = (const float*)(F.ws + WS_CUM) + (size_t)(b * 4 + h) * SEQ; const float* CTOT = (const float*)(F.ws + WS_CTOT);
    LAS float* bias = (LAS float*)(F.lds + att::LDS_BIAS); LAS float* blk = (LAS float*)(F.lds + att::LDS_BLK);
    const int q0 = qb * 256;
    if (F.wave == 0) { const float v = CTOT[(size_t)(b * 64 + F.lane) * 4 + h]; float s = v;
#pragma unroll
        for (int o = 1; o < 64; o <<= 1) { const float t = __int_as_float(__builtin_amdgcn_ds_bpermute(((F.lane - o) & 63) << 2, __float_as_int(s))); if (F.lane >= o) s += t; }
        blk[F.lane] = s - v; }
    __syncthreads();
    const float cref = CUM[q0 + 255] + blk[(q0 + 255) >> 7];
    for (int s = F.tid; s < q0 + 256; s += 512) bias[s] = (cref - (CUM[s] + blk[s >> 7])) * LOG2E;
    __syncthreads();
    float kn2 = 0.f; { const unsigned* km = (const unsigned*)(F.ws + WS_CTL) + CW_KM + l * 128 + (b * 4 + h) * 8;
#pragma unroll
        for (int c = 0; c < 8; ++c) kn2 += __uint_as_float(__hip_atomic_load(km + c, __ATOMIC_RELAXED, __HIP_MEMORY_SCOPE_AGENT)); }
    const size_t rowbase = (size_t)b * SEQ;
    att::attn_core<0>(F.shm, PROJ + (rowbase + q0 + F.wave * 32) * NPROJ + C_QC + h * 64, PROJ + rowbase * NPROJ + C_KC + h * 64, PROJ + rowbase * NPROJ + C_VC + h * 64,
                      Y + (rowbase + q0 + F.wave * 32) * D + 768 + h * 64, q0, 0, (q0 + 255) >> 6, 0.f, 0.f, F.tid, kn2);
}
__device__ __forceinline__ void swa_unit(Frame& F, int l, int b, int h, int qb) {
    const bf16_t* PROJ = (const bf16_t*)(F.ws + WS_PROJ); bf16_t* Y = (bf16_t*)(F.ws + WS_Y);
    LAS float* bias = (LAS float*)(F.lds + att::LDS_BIAS);
    const int q0 = qb * 256, kvh = h >> 2;
    const int t_lo = (q0 >= 128 ? q0 - 128 : 0) >> 6, t_hi = (q0 + 255) >> 6, n = t_hi - t_lo + 1;
    const float slope2 = exp2f(-(float)(h + 1)) * LOG2E;
    for (int i = F.tid; i < n * 64; i += 512) bias[i] = slope2 * (float)(64 * t_lo + i - q0);
    __syncthreads();
    const size_t rowbase = (size_t)b * SEQ;
    att::attn_core<1>(F.shm, PROJ + (rowbase + q0 + F.wave * 32) * NPROJ + C_QA + h * 64, PROJ + rowbase * NPROJ + C_KA + kvh * 64, PROJ + rowbase * NPROJ + C_VA + kvh * 64,
                      Y + (rowbase + q0 + F.wave * 32) * D + h * 64, q0, t_lo, t_hi, F.inp(F_SINKS)[l * 8 + h] * LOG2E, slope2, F.tid);
}
__device__ __forceinline__ void phase_mixer(Frame& F, int l) {
    unsigned* qhead = (unsigned*)(F.ws + WS_CTL) + CW_Q + l * 64;
    LAS unsigned* qslot = (LAS unsigned*)(F.lds + LDSCTL_OFF + 16);
#pragma unroll 1
    for (;;) {
        frame_refresh(F);
        if (F.tid == 0) qslot[0] = __hip_atomic_fetch_add(qhead, 1u, __ATOMIC_RELAXED, __HIP_MEMORY_SCOPE_AGENT);
        __syncthreads();
        const int u = __builtin_amdgcn_readfirstlane((int)qslot[0]);
        __syncthreads();
        if (u >= 512 + 256 + 1024) break;
        if (u < 512) { if (PH(11)) fox_unit(F, l, (u & 15) >> 2, u & 3, 31 - (u >> 4)); }
        else if (u < 768) { if (PH(10)) lru_unit(F, l, (u - 512) >> 6, (u - 512) & 63); }
        else { if (PH(12)) { const int v = u - 768; swa_unit(F, l, v >> 8, (v & 255) >> 5, v & 31); } }
    }
}

__device__ __forceinline__ void phase_ynorm(Frame& F, int l, bf16_t* YO) {
    const bf16_t* Y = (const bf16_t*)(F.ws + WS_Y); const bf16_t* PROJ = (const bf16_t*)(F.ws + WS_PROJ);
    const float* HLOC = (const float*)(F.ws + WS_H); const float* PP = HLOC + (size_t)T * 256;
    const float* LRUA = (const float*)(F.ws + WS_LRUA); const float* LRUH = (const float*)(F.ws + WS_LRUH);
    LAS float* cs = (LAS float*)F.lds;
    LAS float* carry = (LAS float*)(F.lds + 4096);
    const float* og = F.inp(F_OGAIN) + l * 1024;
    for (int tile = F.vcu; tile < T / 128; tile += F.G) {
        const int b = tile >> 6, tt = tile & 63, j0 = 2 * tt;
        { const int c = F.tid & 255, seg = F.tid >> 8; const int jb = seg ? j0 / 2 : 0, je = seg ? j0 : j0 / 2;
          float A = 1.f, Hh = 0.f;
          for (int j = jb; j < je; ++j) { const size_t so = (size_t)(b * 128 + j) * 256 + c; const float aj = LRUA[so], hj = LRUH[so]; Hh = aj * Hh + hj; A *= aj; }
          cs[(seg * 2 + 0) * 256 + c] = A; cs[(seg * 2 + 1) * 256 + c] = Hh; }
        __syncthreads();
        if (F.tid < 256) { const int c = F.tid; const float c0 = cs[(2 + 0) * 256 + c] * cs[(0 + 1) * 256 + c] + cs[(2 + 1) * 256 + c];
            const size_t so = (size_t)(b * 128 + j0) * 256 + c; carry[c] = c0; carry[256 + c] = LRUA[so] * c0 + LRUH[so]; }
        __syncthreads();
#pragma unroll 1
        for (int i = 0; i < 16; i += 2) {
            u32x4 ya[2]; u32x2 yc[2], gb[2]; f32x4 hl[2], pp[2], cr[2];
#pragma unroll
            for (int k = 0; k < 2; ++k) { const int rl = F.wave * 16 + i + k; const size_t row = (size_t)tile * 128 + rl; const bf16_t* yr = Y + row * D;
                ya[k] = *(const u32x4*)(yr + 8 * F.lane); yc[k] = *(const u32x2*)(yr + 768 + 4 * F.lane);
                hl[k] = *(const f32x4*)(HLOC + row * 256 + 4 * F.lane); pp[k] = *(const f32x4*)(PP + row * 256 + 4 * F.lane);
                gb[k] = *(const u32x2*)(PROJ + row * NPROJ + C_GB + 4 * F.lane); cr[k] = *(const LAS f32x4*)(carry + (rl >> 6) * 256 + 4 * F.lane); }
#pragma unroll
            for (int k = 0; k < 2; ++k) { const int rl = F.wave * 16 + i + k; const size_t row = (size_t)tile * 128 + rl; bf16_t* yr = YO + row * D;
                float fa[8]; fa[0] = __uint_as_float(ya[k].x << 16); fa[1] = __uint_as_float(ya[k].x & 0xffff0000u); fa[2] = __uint_as_float(ya[k].y << 16); fa[3] = __uint_as_float(ya[k].y & 0xffff0000u);
                fa[4] = __uint_as_float(ya[k].z << 16); fa[5] = __uint_as_float(ya[k].z & 0xffff0000u); fa[6] = __uint_as_float(ya[k].w << 16); fa[7] = __uint_as_float(ya[k].w & 0xffff0000u);
                float sa = 0.f;
#pragma unroll
                for (int e = 0; e < 8; ++e) sa += fa[e] * fa[e];
                float fc[4]; fc[0] = __uint_as_float(yc[k].x << 16); fc[1] = __uint_as_float(yc[k].x & 0xffff0000u); fc[2] = __uint_as_float(yc[k].y << 16); fc[3] = __uint_as_float(yc[k].y & 0xffff0000u);
                const float sc_ = fc[0] * fc[0] + fc[1] * fc[1] + fc[2] * fc[2] + fc[3] * fc[3];
                float fb[4]; { const f32x4 hh = hl[k] + pp[k] * cr[k];
                    fb[0] = hh.x * gelu_tanh(__uint_as_float(gb[k].x << 16)); fb[1] = hh.y * gelu_tanh(__uint_as_float(gb[k].x & 0xffff0000u));
                    fb[2] = hh.z * gelu_tanh(__uint_as_float(gb[k].y << 16)); fb[3] = hh.w * gelu_tanh(__uint_as_float(gb[k].y & 0xffff0000u)); }
                const float sb = fb[0] * fb[0] + fb[1] * fb[1] + fb[2] * fb[2] + fb[3] * fb[3];
                const float ra = 1.0f / sqrtf(wave_sum(sa) * (1.f / 512.f) + EPS), rb = 1.0f / sqrtf(wave_sum(sb) * (1.f / 256.f) + EPS), rc = 1.0f / sqrtf(wave_sum(sc_) * (1.f / 256.f) + EPS);
                { const f32x4 g0 = *(const f32x4*)(og + 8 * F.lane), g1 = *(const f32x4*)(og + 8 * F.lane + 4);
                  u32x4 w; w.x = cvtpk(fa[0] * ra * g0.x, fa[1] * ra * g0.y); w.y = cvtpk(fa[2] * ra * g0.z, fa[3] * ra * g0.w); w.z = cvtpk(fa[4] * ra * g1.x, fa[5] * ra * g1.y); w.w = cvtpk(fa[6] * ra * g1.z, fa[7] * ra * g1.w);
                  *(u32x4*)(yr + 8 * F.lane) = w; }
                { const f32x4 g = *(const f32x4*)(og + 512 + 4 * F.lane); u32x2 w; w.x = cvtpk(fb[0] * rb * g.x, fb[1] * rb * g.y); w.y = cvtpk(fb[2] * rb * g.z, fb[3] * rb * g.w); *(u32x2*)(yr + 512 + 4 * F.lane) = w; }
                { const f32x4 g = *(const f32x4*)(og + 768 + 4 * F.lane); u32x2 w; w.x = cvtpk(fc[0] * rc * g.x, fc[1] * rc * g.y); w.y = cvtpk(fc[2] * rc * g.z, fc[3] * rc * g.w); *(u32x2*)(yr + 768 + 4 * F.lane) = w; }
            }
        }
        __syncthreads();
    }
}

template <int N, int MASK> __device__ __forceinline__ void tr_step(float (&v)[40], bool upper) {
#pragma unroll
    for (int i = 0; i < N / 2; ++i) { const float a = v[i], b = v[i + N / 2]; const float send = upper ? a : b, kp = upper ? b : a; float rcv;
        if constexpr (MASK == 32) { auto rr = __builtin_amdgcn_permlane32_swap(__float_as_uint(send), __float_as_uint(send), false, false); rcv = upper ? __uint_as_float(rr[0]) : __uint_as_float(rr[1]); }
        else rcv = shx<MASK>(send);
        v[i] = kp + rcv; }
}
__device__ __forceinline__ void phase_norm2_router(Frame& F, int l, const float* xa, unsigned* cnt) {
    const float* MOD = (const float*)(F.ws + WS_MOD) + (size_t)l * 4 * 6144;
    bf16_t* H = (bf16_t*)(F.ws + WS_H);
    LEntry* list = (LEntry*)(F.ws + WS_LIST);
    LAS float* wr = (LAS float*)F.lds;
    LAS float* gs = (LAS float*)(F.lds + 81920);
    LAS float* lg = (LAS float*)(F.lds + 90112);
    LAS int* tcls = (LAS int*)(F.lds + 92672);
    LAS float* tw = (LAS float*)(F.lds + 93184);
    LAS int* trank = (LAS int*)(F.lds + 94208);
    LAS unsigned* lcnt = (LAS unsigned*)(F.lds + 94720);
    LAS unsigned* lbase = (LAS unsigned*)(F.lds + 94848);
    const bf16_t* Pb = (const bf16_t*)(F.ws + WS_P); LAS float* gmv = (LAS float*)(F.lds + 98304);
    for (int i = F.tid; i < 1024 * 4; i += 512) { const int k = i >> 2, e = i & 3; wr[e * 1024 + k] = F.inp(F_WRG)[(size_t)l * 4096 + i]; }
    for (int i = F.tid; i < 1024 * 16; i += 512) { const int k = i >> 4, e = i & 15; wr[(4 + e) * 1024 + k] = F.inp(F_WRE)[(size_t)l * 16384 + i]; }
    int cur_b = -1;
    for (int tile = F.vcu; tile < T / 128; tile += F.G) {
        const int b = tile >> 6;
        __syncthreads();
        if (b != cur_b) { for (int i = F.tid; i < 1024; i += 512) { gs[i] = F.inp(F_NFFN)[l * 1024 + i] * (1.f + MOD[b * 6144 + 4096 + i]); gs[1024 + i] = MOD[b * 6144 + 3072 + i]; gmv[i] = MOD[b * 6144 + 2048 + i]; } cur_b = b; }
        if (F.tid < NCLS) lcnt[F.tid] = 0u;
        __syncthreads();
#pragma unroll 1
        for (int grp = 0; grp < 8; ++grp) {
            const size_t row0 = (size_t)tile * 128 + F.wave * 16 + grp * 2;
            f32x4 hv[2][4];
#pragma unroll
            for (int r = 0; r < 2; ++r) { const f32x4* xr = (const f32x4*)(xa + (row0 + r) * D) + F.lane;
#pragma unroll
                for (int j = 0; j < 4; ++j) hv[r][j] = xr[64 * j]; }
            { u32x2 pv_[2][4];
#pragma unroll
              for (int r = 0; r < 2; ++r) { const u32x2* pr = (const u32x2*)(Pb + (row0 + r) * D) + F.lane;
#pragma unroll
                  for (int j = 0; j < 4; ++j) pv_[r][j] = pr[64 * j]; }
#pragma unroll
              for (int j = 0; j < 4; ++j) { const f32x4 gm = *(const LAS f32x4*)(gmv + 4 * F.lane + 256 * j);
                  hv[0][j] = hv[0][j] + gm * bf4_to_f32(pv_[0][j]); hv[1][j] = hv[1][j] + gm * bf4_to_f32(pv_[1][j]); } }
#pragma unroll
            for (int r = 0; r < 2; ++r) { float ss = 0.f;
#pragma unroll
                for (int j = 0; j < 4; ++j) ss += (hv[r][j].x * hv[r][j].x + hv[r][j].y * hv[r][j].y) + (hv[r][j].z * hv[r][j].z + hv[r][j].w * hv[r][j].w);
                const float rstd = 1.0f / sqrtf(wave_sum(ss) * (1.f / D) + EPS);
                u32x2* o8 = (u32x2*)(H + (row0 + r) * D) + F.lane;
#pragma unroll
                for (int j = 0; j < 4; ++j) { const f32x4 g = *(const LAS f32x4*)(gs + 4 * F.lane + 256 * j), s = *(const LAS f32x4*)(gs + 1024 + 4 * F.lane + 256 * j);
                    hv[r][j] = hv[r][j] * rstd * g + s; u32x2 w; w.x = cvtpk(hv[r][j].x, hv[r][j].y); w.y = cvtpk(hv[r][j].z, hv[r][j].w); o8[64 * j] = w; } }
            float acc[40];
#pragma unroll
            for (int e = 0; e < 20; ++e) { float a0 = 0.f, a1 = 0.f;
#pragma unroll
                for (int j = 0; j < 4; ++j) { const f32x4 w = *(const LAS f32x4*)(wr + e * 1024 + 4 * F.lane + 256 * j);
                    a0 += hv[0][j].x * w.x + hv[0][j].y * w.y + hv[0][j].z * w.z + hv[0][j].w * w.w;
                    a1 += hv[1][j].x * w.x + hv[1][j].y * w.y + hv[1][j].z * w.z + hv[1][j].w * w.w; }
                acc[e] = a0; acc[20 + e] = a1; }
            tr_step<40, 32>(acc, (F.lane & 32) != 0); tr_step<20, 16>(acc, (F.lane & 16) != 0); tr_step<10, 8>(acc, (F.lane & 8) != 0);
#pragma unroll
            for (int i = 0; i < 5; ++i) { acc[i] += shx<4>(acc[i]); acc[i] += shx<2>(acc[i]); acc[i] += shx<1>(acc[i]); }
            if ((F.lane & 7) == 0) { const int v0 = 5 * (F.lane >> 3);
#pragma unroll
                for (int i = 0; i < 5; ++i) lg[F.wave * 40 + v0 + i] = acc[i]; }
            LDS_WAIT();
            if (F.lane < 2) {
                const LAS float* q = lg + F.wave * 40 + F.lane * 20;
                float gl[4];
#pragma unroll
                for (int j = 0; j < 4; ++j) gl[j] = q[j] + F.inp(F_BRG)[l * 4 + j];
                int gsel = 0; float gm = gl[0];
#pragma unroll
                for (int j = 1; j < 4; ++j) if (gl[j] > gm) { gm = gl[j]; gsel = j; }
                float den = 0.f;
#pragma unroll
                for (int j = 0; j < 4; ++j) den += expf(gl[j] - gm);
                const float gp = 1.0f / den;
                float el[4];
#pragma unroll
                for (int j = 0; j < 4; ++j) el[j] = q[4 + 4 * gsel + j] + F.inp(F_BRE)[l * 16 + gsel * 4 + j];
                int i1 = 0; float m1 = el[0];
#pragma unroll
                for (int j = 1; j < 4; ++j) if (el[j] > m1) { m1 = el[j]; i1 = j; }
                int i2 = -1; float m2 = -__builtin_inff();
#pragma unroll
                for (int j = 0; j < 4; ++j) if (j != i1 && el[j] > m2) { m2 = el[j]; i2 = j; }
                const float e2 = expf(m2 - m1); const float w1 = gp / (1.f + e2), w2 = gp * e2 / (1.f + e2);
                const int lo = i1 < i2 ? i1 : i2, hi = i1 < i2 ? i2 : i1;
                const int rl = F.wave * 16 + grp * 2 + F.lane;
                tcls[rl] = gsel * 6 + pair_idx(lo, hi); tw[rl * 2] = (i1 < i2) ? w1 : w2; tw[rl * 2 + 1] = (i1 < i2) ? w2 : w1;
            }
        }
        __syncthreads();
        if (F.tid < 128) trank[F.tid] = (int)atomicAdd((unsigned*)&lcnt[tcls[F.tid]], 1u);
        __syncthreads();
        if (F.tid < NCLS) lbase[F.tid] = lcnt[F.tid] ? __hip_atomic_fetch_add(cnt + 64 * F.tid, lcnt[F.tid], __ATOMIC_RELAXED, __HIP_MEMORY_SCOPE_AGENT) : 0u;
        __syncthreads();
        if (F.tid < 128) { const int cls = tcls[F.tid]; const unsigned pos = lbase[cls] + (unsigned)trank[F.tid];
            LEntry e; e.tok = tile * 128 + F.tid; e.w0 = tw[F.tid * 2]; e.w1 = tw[F.tid * 2 + 1]; e.pad = 0; list[(size_t)cls * LCAP + pos] = e; }
    }
    __syncthreads();
}

__device__ __forceinline__ int build_tile_table(Frame& F, int l) {
    unsigned* cnt = (unsigned*)(F.ws + WS_CTL) + CW_CNT + l * NCLS * 64;
    LAS int* tt = (LAS int*)(F.lds + TT_OFF); LAS int* ntl = (LAS int*)(F.lds + TT_OFF + 1024);
    __syncthreads();
    if (F.tid == 0) { int nt = 0;
        for (int c = 0; c < NCLS; ++c) { const unsigned n = __hip_atomic_load(cnt + 64 * c, __ATOMIC_RELAXED, __HIP_MEMORY_SCOPE_AGENT); const int k = (int)((n + 255u) >> 8);
            for (int j = 0; j < k; ++j) tt[nt++] = c | ((j * 256) << 8); }
        ntl[0] = nt; }
    __syncthreads();
    return ntl[0];
}

__device__ __forceinline__ void phase_final(Frame& F, const float* xa, int lp) {
    const bf16_t* Pb = (const bf16_t*)(F.ws + WS_P); const bf16_t* Mb = (const bf16_t*)(F.ws + WS_M); const float* MODp = (const float*)(F.ws + WS_MOD) + (size_t)lp * 4 * 6144;
    const int gw = F.vcu * 8 + F.wave, NGW = F.G * 8;
    f32x4 g[4];
#pragma unroll
    for (int j = 0; j < 4; ++j) g[j] = *(const f32x4*)(F.inp(F_NFIN) + 4 * F.lane + 256 * j);
#pragma unroll 1
    for (int row = gw; row < T; row += 2 * NGW) {
        const f32x4* xr0 = (const f32x4*)(xa + (size_t)row * D) + F.lane; const f32x4* xr1 = (const f32x4*)(xa + (size_t)(row + NGW) * D) + F.lane;
        f32x4 v0[4], v1[4]; float ss0 = 0.f, ss1 = 0.f;
#pragma unroll
        for (int j = 0; j < 4; ++j) { v0[j] = xr0[64 * j]; v1[j] = xr1[64 * j]; }
        { const int r1 = row + NGW; const float* g0p = MODp + (row >> 13) * 6144; const float* g1p = MODp + (r1 >> 13) * 6144;
          const u32x2* pa = (const u32x2*)(Pb + (size_t)row * D) + F.lane; const u32x2* pb = (const u32x2*)(Pb + (size_t)r1 * D) + F.lane;
          const u32x2* ma = (const u32x2*)(Mb + (size_t)row * D) + F.lane; const u32x2* mb = (const u32x2*)(Mb + (size_t)r1 * D) + F.lane;
#pragma unroll
          for (int j = 0; j < 4; ++j) { const int col = 4 * F.lane + 256 * j;
              v0[j] = v0[j] + *(const f32x4*)(g0p + 2048 + col) * bf4_to_f32(pa[64 * j]) + *(const f32x4*)(g0p + 5120 + col) * bf4_to_f32(ma[64 * j]);
              v1[j] = v1[j] + *(const f32x4*)(g1p + 2048 + col) * bf4_to_f32(pb[64 * j]) + *(const f32x4*)(g1p + 5120 + col) * bf4_to_f32(mb[64 * j]); } }
#pragma unroll
        for (int j = 0; j < 4; ++j) { ss0 += (v0[j].x * v0[j].x + v0[j].y * v0[j].y) + (v0[j].z * v0[j].z + v0[j].w * v0[j].w); ss1 += (v1[j].x * v1[j].x + v1[j].y * v1[j].y) + (v1[j].z * v1[j].z + v1[j].w * v1[j].w); }
        const float rstd0 = 1.0f / sqrtf(wave_sum(ss0) * (1.f / D) + EPS), rstd1 = 1.0f / sqrtf(wave_sum(ss1) * (1.f / D) + EPS);
        f32x4* o0 = (f32x4*)(F.out + (size_t)row * D) + F.lane; f32x4* o1 = (f32x4*)(F.out + (size_t)(row + NGW) * D) + F.lane;
#pragma unroll
        for (int j = 0; j < 4; ++j) { o0[64 * j] = v0[j] * rstd0 * g[j]; o1[64 * j] = v1[j] * rstd1 * g[j]; }
    }
}

__global__ void __launch_bounds__(512, 2) mk_fwd(const Args args) {
    extern __shared__ __attribute__((aligned(16))) unsigned char lds[];
    Frame F;
    F.lds = (LAS unsigned char*)lds; F.shm = (char*)lds;
    F.tid = threadIdx.x; F.lane = F.tid & 63; F.wave = __builtin_amdgcn_readfirstlane(F.tid >> 6);
    F.G = 256; { const int bx = blockIdx.x; __builtin_assume(bx >= 0 && bx < 256); F.vcu = (bx % 8) * 32 + bx / 8; }
    for (int u = F.tid; u < (LDS_BYTES - LDSCTL_OFF) / 4; u += 512) ((LAS unsigned*)(F.lds + LDSCTL_OFF))[u] = 0u;
    __syncthreads();
    F.wave_s = __builtin_amdgcn_readfirstlane((int)threadIdx.x >> 6);
#define REFRESH() frame_refresh(F)
    REFRESH();
    unsigned* ctl = (unsigned*)(F.ws + WS_CTL);
    XcdBarrier bar = xcd_barrier_post(ctl + CW_BAR, (volatile LAS unsigned*)(F.lds + MISC_OFF) + 8);

    for (int rep = 0; rep < DUP(0); ++rep) if (PH(0)) phase_p0(F);
    xcd_barrier(bar, F.tid);
    float* XA = (float*)(F.ws + WS_XA);
    for (int l = 0; l < DEPTH; ++l) {
        const float* xin = (l <= 1) ? F.inp(F_X) : XA;
        const float* xbase = (l == 0) ? F.inp(F_X) : XA;
        const float* MODl = (const float*)(F.ws + WS_MOD) + (size_t)l * 4 * 6144;
        REFRESH();
        for (int rep = 0; rep < DUP(1); ++rep) if (PH(1)) { if (l == 0) phase_norm1<false>(F, l, xin); else phase_norm1<true>(F, l, xin); }
        xcd_barrier(bar, F.tid);
        REFRESH();
        for (int rep = 0; rep < DUP(2); ++rep) if (PH(2)) { pg8::DenseOrder S; S.init(T, NPROJ, F.G, (int)blockIdx.x, F.ws + WS_WIN + (size_t)l * 2048 * 1024 * 2, 2048u, G1REP);
          EpiProj E{(bf16_t*)(F.ws + WS_PROJ), (unsigned*)(F.ws + WS_CTL) + CW_KM + l * 128};
          pg8::gemm_phase<EpiProj, pg8::DenseOrder, true>(F.tid, F.lds, (const char*)(F.ws + WS_H), 2048u, 2048u, 1024, S, E); }
        xcd_barrier(bar, F.tid);
        REFRESH();
        if (PH(3)) phase_mixer(F, l);
        xcd_barrier(bar, F.tid);
        REFRESH();
        for (int rep = 0; rep < DUP(4); ++rep) if (PH(4)) phase_ynorm(F, l, (rep + 1 < DUP(4)) ? (bf16_t*)F.out : (bf16_t*)(F.ws + WS_Y));
        xcd_barrier(bar, F.tid);
        REFRESH();
        for (int rep = 0; rep < DUP(5); ++rep) if (PH(5)) { pg8::DenseOrder S; S.init(T, D, F.G, (int)blockIdx.x, F.ws + WS_WOUT + (size_t)l * 1024 * 1024 * 2, 2048u, (l == 0) ? G2REP : 1);
          EpiP E{(bf16_t*)(F.ws + WS_P)};
          pg8::gemm_phase<EpiP, pg8::DenseOrder, true>(F.tid, F.lds, (const char*)(F.ws + WS_Y), 2048u, 2048u, 1024, S, E); }
        xcd_barrier(bar, F.tid);
        REFRESH();
        for (int rep = 0; rep < DUP(6); ++rep) if (PH(6)) phase_norm2_router(F, l, xbase, (unsigned*)(F.ws + WS_CTL) + ((rep + 1 < DUP(6)) ? 32768 + l * NCLS * 64 : CW_CNT + l * NCLS * 64));
        xcd_barrier(bar, F.tid);
        REFRESH();
        const int ntiles = build_tile_table(F, l);
        const LEntry* list = (const LEntry*)(F.ws + WS_LIST); const unsigned* cnt = (const unsigned*)(F.ws + WS_CTL) + CW_CNT + l * NCLS * 64;
        for (int rep = 0; rep < DUP(7); ++rep) if (PH(7)) { MoeUpOrder S{ntiles * 4, F.G, (int)blockIdx.x, (const LAS int*)(F.lds + TT_OFF), (const char*)(F.ws + WS_WGU + (size_t)l * 16 * 512 * 1024 * 2), list, cnt};
          EpiUp E{(bf16_t*)(F.ws + WS_PROJ), list, cnt};
          pg8::gemm_phase<EpiUp, MoeUpOrder, true>(F.tid, F.lds, (const char*)(F.ws + WS_H), 2048u, 2048u, 1024, S, E); }
        xcd_barrier(bar, F.tid);
        REFRESH();
        for (int rep = 0; rep < DUP(8); ++rep) if (PH(8)) { MoeDownOrder S{ntiles * 4, F.G, (int)blockIdx.x, (const LAS int*)(F.lds + TT_OFF), (const char*)(F.ws + WS_WDP + (size_t)l * 24 * 1024 * 512 * 2)};
          EpiDown E{(bf16_t*)(F.ws + WS_M), list, cnt};
          pg8::gemm_phase<EpiDown, MoeDownOrder, true>(F.tid, F.lds, (const char*)(F.ws + WS_PROJ), 1024u, 1024u, 512, S, E); }
        xcd_barrier(bar, F.tid);
    }
        REFRESH();
    for (int rep = 0; rep < DUP(9); ++rep) if (PH(9)) phase_final(F, (DEPTH == 1) ? F.inp(F_X) : XA, DEPTH - 1);
}

extern "C" void kernel_launch(void* const* d_in, const int* in_sizes, int n_in, void* d_out, int out_size, void* d_ws, size_t ws_size, hipStream_t stream) {
    static int grid = 0;
    if (grid == 0) {
        if (n_in != 26 || in_sizes[0] != T * D || out_size != T * D || ws_size < WS_END) { fprintf(stderr, "kernel_launch: unexpected shapes (n_in %d, in0 %d, out %d, ws %zu)\n", n_in, n_in > 0 ? in_sizes[0] : -1, out_size, ws_size); grid = -1; return; }
        int dev = 0, cus = 0, per_cu = 0;
        if (hipGetDevice(&dev) != hipSuccess || hipDeviceGetAttribute(&cus, hipDeviceAttributeMultiprocessorCount, dev) != hipSuccess) { grid = -1; return; }
        if (hipFuncSetAttribute((const void*)mk_fwd, hipFuncAttributeMaxDynamicSharedMemorySize, LDS_BYTES) != hipSuccess) { fprintf(stderr, "kernel_launch: hipFuncSetAttribute failed\n"); grid = -1; return; }
        if (hipOccupancyMaxActiveBlocksPerMultiprocessor(&per_cu, (const void*)mk_fwd, 512, LDS_BYTES) != hipSuccess || per_cu < 1) fprintf(stderr, "kernel_launch: occupancy query reports %d\n", per_cu);
        (void)hipGetLastError();
        if (cus != 256) fprintf(stderr, "kernel_launch: built for 256 CUs, device reports %d\n", cus);
        grid = 256;
    }
    if (grid < 0) return;
    (void)hipMemsetAsync((char*)d_ws + WS_CTL, 0, CTL_ZERO_BYTES, stream);
    Args a{};
    for (int i = 0; i < 26; ++i) a.in[i] = (const float*)d_in[i];
    a.out = (float*)d_out; a.ws = (unsigned char*)d_ws;
    hipLaunchKernelGGL(mk_fwd, dim3(grid), dim3(512), LDS_BYTES, stream, a);
}
```

```cpp
#include <hip/hip_runtime.h>
#include <hip/hip_bf16.h>
#include <cstdio>
#include <cstdint>

#define GAS __attribute__((address_space(1)))
#define LAS __attribute__((address_space(3)))
typedef unsigned short bf16_t;
typedef short bf16x8 __attribute__((ext_vector_type(8)));
typedef short s16x4 __attribute__((ext_vector_type(4)));
typedef float f32x2 __attribute__((ext_vector_type(2)));
typedef float f32x4 __attribute__((ext_vector_type(4)));
typedef float f32x16 __attribute__((ext_vector_type(16)));
typedef unsigned u32x2 __attribute__((ext_vector_type(2)));
typedef unsigned u32x4 __attribute__((ext_vector_type(4)));
typedef __bf16 bf16x2_t __attribute__((ext_vector_type(2)));

#ifndef DUP_MASK
#define DUP_MASK 0x0u
#endif
#define DUP(n) (1 + (int)((DUP_MASK >> (n)) & 1u))
#ifndef G2REP
#define G2REP 1
#endif
#ifndef G1REP
#define G1REP 1
#endif
#ifndef UPREP
#define UPREP 1
#endif
#ifndef PH_MASK
#define PH_MASK 0xFFFFFFFFu
#endif
#define PH(n) ((PH_MASK >> (n)) & 1u)
constexpr int D = 1024, NB = 4, SEQ = 8192, T = NB * SEQ, DEPTH = 2;
constexpr int IN_COLS = 2052, NPROJ = 2048;
constexpr int C_QA = 0, C_KA = 512, C_VA = 640, C_XB = 768, C_GB = 1024, C_QC = 1280, C_KC = 1536, C_VC = 1792;
constexpr int NCLS = 24, LCAP = 32768;
constexpr float EPS = 1e-6f;
constexpr float LOG2E = 1.4426950408889634f;
constexpr float C2 = 0.125f * 1.4426950408889634f;

constexpr size_t MiB = 1u << 20;
constexpr size_t WS_CTL = 0, CTL_ZERO_BYTES = 1 * MiB;
constexpr size_t WS_MOD = 1 * MiB;
constexpr size_t WS_CUM = WS_MOD + 256 * 1024;
constexpr size_t WS_CTOT = WS_CUM + 512 * 1024;
constexpr size_t WS_LRUA = 2 * MiB;
constexpr size_t WS_LRUH = WS_LRUA + 512 * 1024;
constexpr size_t WS_LIST = 4 * MiB;
constexpr size_t WS_WIN = 16 * MiB;
constexpr size_t WS_WOUT = 24 * MiB;
constexpr size_t WS_WGU = 28 * MiB;
constexpr size_t WS_WDP = 60 * MiB;
constexpr size_t WS_XA = 108 * MiB;
constexpr size_t WS_H = 236 * MiB;
constexpr size_t WS_PROJ = 300 * MiB;
constexpr size_t WS_Y = 428 * MiB;
constexpr size_t WS_P = WS_PROJ + 64 * MiB;
constexpr size_t WS_M = WS_Y;
constexpr size_t WS_END = 492 * MiB;
constexpr int CW_BAR = 4096;
constexpr int CW_KM = 20480;
constexpr int CW_Q = 21504;
constexpr int CW_CNT = 16384;

struct LEntry { int tok; float w0, w1; int pad; };

constexpr int RING_BYTES = 131072;
constexpr int LDSCTL_OFF = RING_BYTES;
constexpr int MISC_OFF = LDSCTL_OFF + 320;
constexpr int TT_OFF = LDSCTL_OFF + 1024;
constexpr int LDS_BYTES = 147456;

__device__ __forceinline__ unsigned cvtpk(float lo, float hi) { f32x2 v = {lo, hi}; bf16x2_t b = __builtin_convertvector(v, bf16x2_t); return __builtin_bit_cast(unsigned, b); }
__device__ __forceinline__ float bf2f(bf16_t v) { return __builtin_bit_cast(float, (unsigned)v << 16); }
__device__ __forceinline__ f32x4 bf4_to_f32(u32x2 v) { return (f32x4){__uint_as_float(v.x << 16), __uint_as_float(v.x & 0xffff0000u), __uint_as_float(v.y << 16), __uint_as_float(v.y & 0xffff0000u)}; }
template <int M> __device__ __forceinline__ float shx(float v) {
    return __int_as_float(__builtin_amdgcn_ds_swizzle(__float_as_int(v), (M << 10) | 0x1f));
}
__device__ __forceinline__ float wave_sum(float v) {
    v += shx<1>(v); v += shx<2>(v); v += shx<4>(v); v += shx<8>(v); v += shx<16>(v);
    auto rr = __builtin_amdgcn_permlane32_swap(__float_as_uint(v), __float_as_uint(v), false, false);
    return __uint_as_float(rr[0]) + __uint_as_float(rr[1]);
}
__device__ __forceinline__ float fast_exp(float x) { return __builtin_amdgcn_exp2f(x * LOG2E); }
__device__ __forceinline__ float sigmoidf_(float x) { return __builtin_amdgcn_rcpf(1.f + fast_exp(-x)); }
__device__ __forceinline__ float gelu_tanh(float x) {
    const float u = 0.7978845608028654f * (x + 0.044715f * x * x * x);
    const float e = fast_exp(2.f * u);
    const float th = 1.f - 2.f * __builtin_amdgcn_rcpf(e + 1.f);
    return 0.5f * x * (1.f + th);
}
#define LDS_WAIT() asm volatile("s_waitcnt lgkmcnt(0)" ::: "memory")
#define VM_WAIT() asm volatile("s_waitcnt vmcnt(0)" ::: "memory")

namespace pg8 {
constexpr int BM = 256, BK = 64, HALF = 128, HTB = HALF * BK * 2, STAGE_BYTES = 8 * HTB, NXCD = 8, WGM = 8;
__host__ __device__ __forceinline__ int lds_byte(int r, int c) { const int st = (r >> 4) * 2 + (c >> 5), rr = r & 15, cc = c & 31, ob = rr * 64 + cc * 2; return st * 1024 + (ob ^ (((ob >> 9) & 1) << 5)); }
__host__ __device__ __forceinline__ void stage_rc(int b, int& R, int& C) { const int st = b / 1024, sb = b % 1024, swz = sb ^ (((sb >> 9) & 1) << 5); R = (st >> 1) * 16 + swz / 64; C = (st & 1) * 32 + (swz % 64) / 2; }
__host__ __device__ __forceinline__ int perm32(int rho) { const int n = rho >> 4, i = rho & 15; return 8 * (i >> 2) + 4 * n + (i & 3); }

struct GUnit { int a0; const char* bb; int e0, e1, e2, e3; };

__device__ __forceinline__ int xcd_remap(int L, int nwg) {
    const int q = nwg / NXCD, r = nwg % NXCD, xcd = L % NXCD, off = L / NXCD;
    return (xcd < r ? xcd * (q + 1) : r * (q + 1) + (xcd - r) * q) + off;
}

struct DenseOrder {
    int nM, nN, nwg, G, c, rep; const char* Bt; unsigned pitchB;
    __device__ __forceinline__ void init(int M, int N, int G_, int c_, const void* Bt_, unsigned pitchB_, int rep_ = 1) { nM = M / BM; nN = N / BM; nwg = nM * nN; G = G_; c = c_; Bt = (const char*)Bt_; pitchB = pitchB_; rep = rep_; }
    __device__ __forceinline__ bool next(int i, GUnit& u) const {
        const long L = (long)i * G + c; if (L >= (long)nwg * rep) return false;
        const int wgid = xcd_remap((int)(L % nwg), nwg);
        const int nig = WGM * nN, gid = wgid / nig, fm = gid * WGM, gsz = (nM - fm) < WGM ? (nM - fm) : WGM;
        const int pm = fm + ((wgid % nig) % gsz), pn = (wgid % nig) / gsz;
        u.a0 = pm * BM; u.bb = Bt + (size_t)pn * BM * pitchB; u.e0 = pm; u.e1 = pn; u.e2 = 0; u.e3 = 0; return true;
    }
    __device__ __forceinline__ unsigned arow(const GUnit& u, int r) const { return (unsigned)(u.a0 + r); }
};

#define PG8_SA(b, h) (((b) * 2 + (h)) * HTB)
#define PG8_SB(b, h) ((4 + (b) * 2 + (h)) * HTB)
#define PG8_STG(bufoff, gptr, v0, v1) do { \
        __builtin_amdgcn_global_load_lds((const unsigned*)((const char*)(gptr) + (v0)), (LAS unsigned*)(lds + (bufoff) + ldsw), 16, 0, 0); \
        __builtin_amdgcn_global_load_lds((const unsigned*)((const char*)(gptr) + (v1)), (LAS unsigned*)(lds + (bufoff) + ldsw + 8192), 16, 0, 0); } while (0)
#define PG8_STGA(bufoff, kb, vo) PG8_STG(bufoff, Abase + (kb), (vo)[0], (vo)[1])
#define PG8_STGB(bufoff, bp) PG8_STG(bufoff, bp, voffB[0], voffB[1])
#define PG8_LDA(dst, b, h) do { _Pragma("unroll") for (int m = 0; m < 4; ++m) _Pragma("unroll") for (int k = 0; k < 2; ++k) dst[m][k] = *(const LAS bf16x8*)(lds + PG8_SA(b, h) + aoff + m * 2048 + k * 1024); } while (0)
#define PG8_LDB(dst, b, h) do { _Pragma("unroll") for (int n = 0; n < 2; ++n) _Pragma("unroll") for (int k = 0; k < 2; ++k) dst[n][k] = *(const LAS bf16x8*)(lds + PG8_SB(b, h) + boff + n * 2048 + k * 1024); } while (0)
#define PG8_MMA(ai, bj, At, Bt) do { __builtin_amdgcn_s_setprio(1); _Pragma("unroll") for (int m = 0; m < 4; ++m) _Pragma("unroll") for (int n = 0; n < 2; ++n) _Pragma("unroll") for (int k = 0; k < 2; ++k) \
        acc[ai][bj][m][n] = __builtin_amdgcn_mfma_f32_16x16x32_bf16(Bt[n][k], At[m][k], acc[ai][bj][m][n], 0, 0, 0); __builtin_amdgcn_s_setprio(0); } while (0)
#define PG8_WAIT_V(n) asm volatile("s_waitcnt vmcnt(" #n ")" ::: "memory")
#define PG8_WAIT_L(n) asm volatile("s_waitcnt lgkmcnt(" #n ")" ::: "memory")
#define PG8_BAR __builtin_amdgcn_s_barrier()
#define PG8_SCHED __builtin_amdgcn_sched_barrier(0)

template <class Epi, class Sched, bool ALIGN_EPI>
__device__ __forceinline__ void gemm_phase(const int tid, LAS unsigned char* lds, const char* Abase, unsigned pitchA, unsigned pitchB, int K, const Sched& S, const Epi& E) {
    const int wid = __builtin_amdgcn_readfirstlane(tid >> 6), lane = tid & 63, wr = wid >> 2, wc = wid & 3, fr = lane & 15, fq = lane >> 4;
    const int nt = K / BK;
    int RA[2]; unsigned cA2[2], voffB[2];
#pragma unroll
    for (int i = 0; i < 2; ++i) { int R, C; stage_rc(tid * 16 + i * 8192, R, C); const int Rb = Epi::PERM ? ((R & ~31) + perm32(R & 31)) : R;
        RA[i] = R; cA2[i] = (unsigned)C * 2u; voffB[i] = (unsigned)Rb * pitchB + (unsigned)C * 2u; }
    const unsigned hstepB = (unsigned)HALF * pitchB;
    const unsigned ldsw = (unsigned)wid * 1024u;
    const int aoff = lds_byte(wr * 64 + fr, fq * 8), boff = lds_byte(wc * 32 + fr, fq * 8);
    GUnit cur, nxt; int ui = 0;
    if (!S.next(0, cur)) return;
    f32x4 acc[2][2][4][2];
#pragma unroll
    for (int a = 0; a < 2; ++a)
#pragma unroll
        for (int b = 0; b < 2; ++b)
#pragma unroll
            for (int m = 0; m < 4; ++m)
#pragma unroll
                for (int n = 0; n < 2; ++n) acc[a][b][m][n] = (f32x4){0.f, 0.f, 0.f, 0.f};
    bf16x8 At[4][2], B0[2][2], B1[2][2];
    unsigned voA[2][2];
#pragma unroll
    for (int h = 0; h < 2; ++h)
#pragma unroll
        for (int i = 0; i < 2; ++i) voA[h][i] = S.arow(cur, h * HALF + RA[i]) * pitchA + cA2[i];
    const char* cB = cur.bb;
    const unsigned kstep = BK * 2;
    PG8_STGB(PG8_SB(0, 0), cB); PG8_STGB(PG8_SB(0, 1), cB + hstepB); PG8_STGA(PG8_SA(0, 0), 0, voA[0]); PG8_STGA(PG8_SA(0, 1), 0, voA[1]);
    if (wr == 1) PG8_BAR;
    PG8_WAIT_V(2); PG8_BAR;
    PG8_STGB(PG8_SB(1, 0), cB + kstep); PG8_STGA(PG8_SA(1, 0), kstep, voA[0]); PG8_STGB(PG8_SB(1, 1), cB + hstepB + kstep);
    PG8_WAIT_V(6); PG8_BAR;
    for (;;) {
        const bool has_next = S.next(ui + 1, nxt);
        const char* nB = has_next ? nxt.bb : cB;
        for (int t = 0; t < nt; t += 2) {
            const bool last = (t == nt - 2);
            const unsigned kb1 = (unsigned)(t + 1) * kstep;
            const unsigned kb2 = last ? 0u : (unsigned)(t + 2) * kstep, kb3 = kb2 + kstep;
            const char* b2 = last ? nB : cB + (size_t)(t + 2) * kstep; const char* b3 = b2 + kstep;
            PG8_LDB(B0, 0, 0); PG8_LDB(B1, 0, 1); PG8_SCHED; PG8_LDA(At, 0, 0); PG8_STGA(PG8_SA(1, 1), kb1, voA[1]);
            if (last && has_next) {
#pragma unroll
                for (int h = 0; h < 2; ++h)
#pragma unroll
                    for (int i = 0; i < 2; ++i) voA[h][i] = S.arow(nxt, h * HALF + RA[i]) * pitchA + cA2[i]; }
            PG8_WAIT_V(8); PG8_WAIT_L(0); PG8_BAR; PG8_MMA(0, 0, At, B0); PG8_MMA(0, 1, At, B1); PG8_BAR; PG8_SCHED;
            PG8_LDA(At, 0, 1); PG8_STGB(PG8_SB(0, 0), b2); PG8_STGB(PG8_SB(0, 1), b2 + hstepB); PG8_STGA(PG8_SA(0, 0), kb2, voA[0]);
            PG8_WAIT_V(8); PG8_WAIT_L(0); PG8_BAR; PG8_MMA(1, 0, At, B0); PG8_MMA(1, 1, At, B1); PG8_BAR; PG8_SCHED;
            PG8_LDB(B0, 1, 0); PG8_LDB(B1, 1, 1); PG8_SCHED; PG8_LDA(At, 1, 0); PG8_STGA(PG8_SA(0, 1), kb2, voA[1]);
            PG8_WAIT_V(8); PG8_WAIT_L(0); PG8_BAR; PG8_MMA(0, 0, At, B0); PG8_MMA(0, 1, At, B1); PG8_BAR; PG8_SCHED;
            PG8_LDA(At, 1, 1); PG8_STGB(PG8_SB(1, 0), b3); PG8_STGB(PG8_SB(1, 1), b3 + hstepB); PG8_STGA(PG8_SA(1, 0), kb3, voA[0]);
            PG8_WAIT_V(8); PG8_WAIT_L(0); PG8_BAR; PG8_MMA(1, 0, At, B0); PG8_MMA(1, 1, At, B1); PG8_BAR; PG8_SCHED;
        }
        if constexpr (ALIGN_EPI) { if (wr == 0) PG8_BAR; }
        E(acc, cur, wr, wc, fr, fq);
        if (!has_next) break;
#pragma unroll
        for (int a = 0; a < 2; ++a)
#pragma unroll
            for (int b = 0; b < 2; ++b)
#pragma unroll
                for (int m = 0; m < 4; ++m)
#pragma unroll
                    for (int n = 0; n < 2; ++n) acc[a][b][m][n] = (f32x4){0.f, 0.f, 0.f, 0.f};
        cur = nxt; cB = nB; ++ui;
        if constexpr (ALIGN_EPI) { if (wr == 1) PG8_BAR; }
    }
    PG8_WAIT_V(0);
    if constexpr (!ALIGN_EPI) { if (wr == 0) PG8_BAR; }
    PG8_BAR;
}
}

#define XB_TMO      128
#define XB_XCNT(j)  (256  + 64 * (j))
#define XB_XSUB(j)  (1280 + 64 * (j))
#define XB_XGEN(j)  (2304 + 64 * (j))
#define XB_TOP      3328
#define XB_TOPGEN   3392
#define XCD_BAR_WORDS 3456
#define XB_SPIN_CAP (1u << 18)
__device__ __forceinline__ unsigned xb_ld(unsigned* p)              { return __hip_atomic_load(p, __ATOMIC_RELAXED, __HIP_MEMORY_SCOPE_AGENT); }
__device__ __forceinline__ unsigned xb_add(unsigned* p, unsigned v) { return __hip_atomic_fetch_add(p, v, __ATOMIC_RELAXED, __HIP_MEMORY_SCOPE_AGENT); }
__device__ __forceinline__ unsigned xb_xcc_id() { return (unsigned)__builtin_amdgcn_s_getreg((3 << 11) | 20) & 0xFu; }
#define XB_SPIN(cond, bar) do { unsigned _sp = 0; while (cond) { __builtin_amdgcn_s_sleep(1); \
    if ((++_sp & 255u) == 0u) { if (xb_ld(&(bar)[XB_TMO])) break; if (_sp > XB_SPIN_CAP) { atomicAdd(&(bar)[XB_TMO], 1u); break; } } } } while (0)
struct XcdBarrier { unsigned* bar; unsigned x; volatile LAS unsigned* st; };
__device__ __forceinline__ XcdBarrier xcd_barrier_post(unsigned* bar, volatile LAS unsigned* st) {
    XcdBarrier b; b.bar = bar; b.x = xb_xcc_id(); b.st = st;
    if (threadIdx.x == 0) (void)xb_add(&bar[XB_XCNT(b.x)], 1u);
    return b;
}
__device__ __forceinline__ void xcd_barrier_complete(unsigned* bar, unsigned x, unsigned& nloc, unsigned& nx) {
    const unsigned G = gridDim.x * gridDim.y * gridDim.z;
    unsigned sum, cnt, mine, sp = 0u;
    for (;;) {
        sum = 0u; cnt = 0u; mine = 0u;
#pragma unroll
        for (unsigned j = 0; j < 16; ++j) { const unsigned c = xb_ld(&bar[XB_XCNT(j)]); sum += c; cnt += (c > 0u) ? 1u : 0u; mine = (j == x) ? c : mine; }
        if (sum == G) break;
        __builtin_amdgcn_s_sleep(1);
        if ((++sp & 255u) == 0u) { if (xb_ld(&bar[XB_TMO])) break; if (sp > XB_SPIN_CAP) { atomicAdd(&bar[XB_TMO], 1u); break; } }
    }
    nloc = mine > 0u ? mine : 1u; nx = cnt > 0u ? cnt : 1u;
}
__device__ __forceinline__ void xcd_barrier(const XcdBarrier& b, const int tid) {
    asm volatile("s_waitcnt vmcnt(0)" ::: "memory");
    __syncthreads();
    if (tid == 0) {
        unsigned* bar = b.bar; const unsigned bx_ = xb_xcc_id();
        __builtin_amdgcn_s_waitcnt(0);
        unsigned nloc = b.st[0], nx = b.st[1];
        if (nloc == 0u) { xcd_barrier_complete(bar, bx_, nloc, nx); b.st[0] = nloc; b.st[1] = nx; }
        const unsigned old = xb_add(&bar[XB_XSUB(bx_)], 1u);
        const unsigned gen = old / nloc;
        if (old + 1u == (gen + 1u) * nloc) {
            __builtin_amdgcn_fence(__ATOMIC_RELEASE, "agent");
            asm volatile("s_waitcnt vmcnt(0)" ::: "memory");
            const unsigned og = xb_add(&bar[XB_TOP], 1u);
            const unsigned tg = og / nx;
            if (og + 1u == (tg + 1u) * nx) xb_add(&bar[XB_TOPGEN], 1u);
            else XB_SPIN(xb_ld(&bar[XB_TOPGEN]) == tg, bar);
            __builtin_amdgcn_fence(__ATOMIC_ACQUIRE, "agent");
            xb_add(&bar[XB_XGEN(bx_)], 1u);
            asm volatile("s_waitcnt vmcnt(0)" ::: "memory");
        } else {
            XB_SPIN(xb_ld(&bar[XB_XGEN(bx_)]) == gen, bar);
            __builtin_amdgcn_fence(__ATOMIC_ACQUIRE, "agent");
            asm volatile("s_waitcnt vmcnt(0)" ::: "memory");
        }
    }
    __syncthreads();
}

__device__ __forceinline__ const void* launder_ptr(const void* p) {
    unsigned lo = (unsigned)(uintptr_t)p, hi = (unsigned)((uintptr_t)p >> 32);
    asm volatile("" : "+v"(lo), "+v"(hi));
    lo = __builtin_amdgcn_readfirstlane(lo); hi = __builtin_amdgcn_readfirstlane(hi);
    return (const void*)(((uintptr_t)hi << 32) | (uintptr_t)lo);
}
struct Args { const float* in[26]; float* out; unsigned char* ws; };

__device__ __forceinline__ const void* karg_ptr(int idx) {
    const unsigned long long ka = (unsigned long long)__builtin_amdgcn_kernarg_segment_ptr();
    unsigned long long v; asm volatile("s_load_dwordx2 %0, %1, %2\n\ts_waitcnt lgkmcnt(0)" : "=s"(v) : "s"(ka), "s"(idx * 8) : "memory");
    return (const void*)(GAS const void*)(uintptr_t)v;
}
struct Frame {
    LAS unsigned char* lds; char* shm;
    int tid, lane, wave, vcu, G;
    float* out; unsigned char* ws; int wave_s;
    __device__ __forceinline__ const float* inp(int i) const { return (const float*)karg_ptr(i); }
};
__device__ __forceinline__ void frame_refresh(Frame& F) {
    asm volatile("" ::: "memory");
    int t_; asm volatile("v_mbcnt_lo_u32_b32 %0, -1, 0\n\tv_mbcnt_hi_u32_b32 %0, -1, %0" : "=v"(t_)); t_ |= (F.wave_s << 6);
    F.tid = t_; F.lane = t_ & 63; F.wave = __builtin_amdgcn_readfirstlane(t_ >> 6);
    F.out = (float*)karg_ptr(26); F.ws = (unsigned char*)karg_ptr(27);
}
#define F_X 0
#define F_C 1
#define F_WMOD 2
#define F_BMOD 3
#define F_NMIX 4
#define F_NFFN 5
#define F_WIN 6
#define F_WOUT 7
#define F_OGAIN 8
#define F_SINKS 9
#define F_CONVW 10
#define F_CONVB 11
#define F_LWA 12
#define F_LBA 13
#define F_LWX 14
#define F_LBX 15
#define F_LAM 16
#define F_FOXB 17
#define F_WRG 18
#define F_BRG 19
#define F_WRE 20
#define F_BRE 21
#define F_WGATE 22
#define F_WUP 23
#define F_WDOWN 24
#define F_NFIN 25

struct EpiProj {
    static constexpr bool PERM = true;
    bf16_t* O; unsigned* km;
    __device__ __forceinline__ void operator()(const f32x4 (&acc)[2][2][4][2], const pg8::GUnit& u, int wr, int wc, int fr, int fq) const {
        const int row0 = u.e0 * 256 + wr * 64 + fr, pn = u.e1;
        const float sc = (pn == 0 || pn == 1 || pn == 5) ? C2 : 1.f;
        const int col0 = pn * 256 + wc * 32 + 8 * fq;
#pragma unroll
        for (int ai = 0; ai < 2; ++ai)
#pragma unroll
            for (int m = 0; m < 4; ++m) { bf16_t* rowp = O + (size_t)(row0 + ai * 128 + m * 16) * NPROJ + col0;
#pragma unroll
                for (int bj = 0; bj < 2; ++bj) { const f32x4 v0 = acc[ai][bj][m][0] * sc, v1 = acc[ai][bj][m][1] * sc;
                    u32x4 w; w.x = cvtpk(v0[0], v0[1]); w.y = cvtpk(v0[2], v0[3]); w.z = cvtpk(v1[0], v1[1]); w.w = cvtpk(v1[2], v1[3]);
                    *(u32x4*)(rowp + bj * 128) = w; } }
        if (pn == 6) {
            const int b = u.e0 >> 5;
#pragma unroll
            for (int bj = 0; bj < 2; ++bj) { float mx = 0.f;
#pragma unroll
                for (int ai = 0; ai < 2; ++ai)
#pragma unroll
                    for (int m = 0; m < 4; ++m) { const f32x4 v0 = acc[ai][bj][m][0], v1 = acc[ai][bj][m][1];
                        mx = __builtin_fmaxf(mx, (v0[0] * v0[0] + v0[1] * v0[1]) + (v0[2] * v0[2] + v0[3] * v0[3]) + (v1[0] * v1[0] + v1[1] * v1[1]) + (v1[2] * v1[2] + v1[3] * v1[3])); }
                mx = __builtin_fmaxf(mx, shx<1>(mx)); mx = __builtin_fmaxf(mx, shx<2>(mx)); mx = __builtin_fmaxf(mx, shx<4>(mx)); mx = __builtin_fmaxf(mx, shx<8>(mx));
                if (fr == 0) atomicMax(km + ((b * 4 + 2 * bj + (wc >> 1)) * 8 + 4 * (wc & 1) + fq), __float_as_uint(mx)); }
        }
    }
};
struct EpiP {
    static constexpr bool PERM = true;
    bf16_t* P;
    __device__ __forceinline__ void operator()(const f32x4 (&acc)[2][2][4][2], const pg8::GUnit& u, int wr, int wc, int fr, int fq) const {
        const int row0 = u.e0 * 256 + wr * 64 + fr, col0 = u.e1 * 256 + wc * 32 + 8 * fq;
#pragma unroll
        for (int ai = 0; ai < 2; ++ai)
#pragma unroll
            for (int m = 0; m < 4; ++m) { bf16_t* rowp = P + (size_t)(row0 + ai * 128 + m * 16) * D + col0;
#pragma unroll
                for (int bj = 0; bj < 2; ++bj) { const f32x4 v0 = acc[ai][bj][m][0], v1 = acc[ai][bj][m][1];
                    u32x4 w; w.x = cvtpk(v0[0], v0[1]); w.y = cvtpk(v0[2], v0[3]); w.z = cvtpk(v1[0], v1[1]); w.w = cvtpk(v1[2], v1[3]);
                    *(u32x4*)(rowp + bj * 128) = w; } }
    }
};
struct EpiUp {
    static constexpr bool PERM = true;
    bf16_t* HID; const LEntry* list; const unsigned* cnt;
    __device__ __forceinline__ void operator()(const f32x4 (&acc)[2][2][4][2], const pg8::GUnit& u, int wr, int wc, int fr, int fq) const {
        const int pn = u.e1, slot = pn >> 1, pnl = pn & 1, cls = u.e2;
        const unsigned n = __hip_atomic_load(cnt + 64 * cls, __ATOMIC_RELAXED, __HIP_MEMORY_SCOPE_AGENT);
        const int colh = 256 * slot + 128 * pnl + wc * 32 + 8 * fq;
        float wrow[8];
#pragma unroll
        for (int k = 0; k < 8; ++k) { const int r = (k >> 2) * 128 + wr * 64 + (k & 3) * 16 + fr; const unsigned pos = (unsigned)(u.e3 + r);
            const LEntry* e = list + (size_t)cls * LCAP + (pos < n ? pos : 0u); const float w = slot ? e->w1 : e->w0; wrow[k] = pos < n ? w : 0.f; }
#pragma unroll
        for (int ai = 0; ai < 2; ++ai)
#pragma unroll
            for (int m = 0; m < 4; ++m) { const int r = ai * 128 + wr * 64 + m * 16 + fr; const float w = wrow[ai * 4 + m];
                float h[8];
#pragma unroll
                for (int nn = 0; nn < 2; ++nn)
#pragma unroll
                    for (int i = 0; i < 4; ++i) { const float g = acc[ai][0][m][nn][i], up = acc[ai][1][m][nn][i]; h[nn * 4 + i] = g * sigmoidf_(g) * up * w; }
                u32x4 o; o.x = cvtpk(h[0], h[1]); o.y = cvtpk(h[2], h[3]); o.z = cvtpk(h[4], h[5]); o.w = cvtpk(h[6], h[7]);
                *(u32x4*)(HID + (size_t)(u.e0 * 256 + r) * 512 + colh) = o; }
    }
};
struct EpiDown {
    static constexpr bool PERM = true;
    bf16_t* M; const LEntry* list; const unsigned* cnt;
    __device__ __forceinline__ void operator()(const f32x4 (&acc)[2][2][4][2], const pg8::GUnit& u, int wr, int wc, int fr, int fq) const {
        const int cls = u.e2, col0 = u.e1 * 256 + wc * 32 + 8 * fq;
        const unsigned n = __hip_atomic_load(cnt + 64 * cls, __ATOMIC_RELAXED, __HIP_MEMORY_SCOPE_AGENT);
        int tok[8];
#pragma unroll
        for (int k = 0; k < 8; ++k) { const int r = (k >> 2) * 128 + wr * 64 + (k & 3) * 16 + fr; const unsigned pos = (unsigned)(u.e3 + r);
            const int t = list[(size_t)cls * LCAP + (pos < n ? pos : 0u)].tok; tok[k] = pos < n ? t : -1; }
#pragma unroll
        for (int k = 0; k < 8; ++k) { const int ai = k >> 2, m = k & 3;
            if (tok[k] >= 0) { bf16_t* rowp = M + (size_t)tok[k] * D + col0;
#pragma unroll
                for (int bj = 0; bj < 2; ++bj) { const f32x4 v0 = acc[ai][bj][m][0], v1 = acc[ai][bj][m][1];
                    u32x4 w; w.x = cvtpk(v0[0], v0[1]); w.y = cvtpk(v0[2], v0[3]); w.z = cvtpk(v1[0], v1[1]); w.w = cvtpk(v1[2], v1[3]);
                    *(u32x4*)(rowp + bj * 128) = w; } } }
    }
};

__device__ __forceinline__ void pair_of(int p, int& lo, int& hi) { lo = p < 3 ? 0 : (p < 5 ? 1 : 2); hi = p < 3 ? p + 1 : (p < 5 ? p - 1 : 3); }
struct MoeUpOrder {
    int nunits, G, c; const LAS int* tt; const char* WGU; const LEntry* list; const unsigned* cnt;
    __device__ __forceinline__ bool next(int i, pg8::GUnit& u) const {
        const long L = (long)i * G + c; if (L >= (long)nunits * UPREP) return false;
        const int wgid = pg8::xcd_remap((int)(L % nunits), nunits); const int tile = wgid >> 2, pn = wgid & 3; const int e = tt[tile];
        const int cls = e & 255; u.e0 = tile; u.e1 = pn; u.e2 = cls; u.e3 = e >> 8; u.a0 = 0;
        int lo, hi; pair_of(cls % 6, lo, hi); const int ex = (cls / 6) * 4 + ((pn >> 1) ? hi : lo);
        u.bb = WGU + ((size_t)ex * 512 + (size_t)(pn & 1) * 256) * 2048; return true;
    }
    __device__ __forceinline__ unsigned arow(const pg8::GUnit& u, int r) const {
        const unsigned n = __hip_atomic_load(cnt + 64 * u.e2, __ATOMIC_RELAXED, __HIP_MEMORY_SCOPE_AGENT); const unsigned pos = (unsigned)(u.e3 + r);
        return (unsigned)list[(size_t)u.e2 * LCAP + (pos < n ? pos : 0u)].tok;
    }
};
struct MoeDownOrder {
    int nunits, G, c; const LAS int* tt; const char* WDP;
    __device__ __forceinline__ bool next(int i, pg8::GUnit& u) const {
        const long L = (long)i * G + c; if (L >= nunits) return false;
        const int wgid = pg8::xcd_remap((int)L, nunits); const int tile = wgid >> 2, pn = wgid & 3; const int e = tt[tile];
        const int cls = e & 255; u.e0 = tile; u.e1 = pn; u.e2 = cls; u.e3 = e >> 8; u.a0 = tile * 256;
        u.bb = WDP + ((size_t)cls * 1024 + (size_t)pn * 256) * 1024; return true;
    }
    __device__ __forceinline__ unsigned arow(const pg8::GUnit& u, int r) const { return (unsigned)(u.a0 + r); }
};

namespace att {
constexpr int DM = NPROJ;
constexpr int SLOTB = 8192;
constexpr int LDS_K = 0, LDS_V = 3 * SLOTB, LDS_WS = 6 * SLOTB, LDS_OST = LDS_WS + 2048, LDS_BIAS = LDS_OST + 8 * 4096, LDS_BLK = LDS_BIAS + 32768, LDS_MM = LDS_BLK + 256  , LDS_QM = LDS_MM + 96  , LDS_END = LDS_QM + 32;
static_assert(LDS_END <= RING_BYTES, "attention LDS");
typedef LAS const char* lds_cptr;
__device__ __forceinline__ int crow(int r, int hi) { return (r & 3) + 8 * (r >> 2) + 4 * hi; }
__device__ __forceinline__ void glds16(const void* gsrc, unsigned lds_dst) { unsigned keep;
    asm volatile("s_mov_b32 %0, m0\n\ts_mov_b32 m0, %2\n\ts_nop 0\n\tglobal_load_lds_dwordx4 %1, off\n\ts_mov_b32 m0, %0" : "=&s"(keep) : "v"(gsrc), "s"(lds_dst) : "memory"); }
__device__ __forceinline__ float max3f(float a, float b, float c) { return __builtin_fmaxf(__builtin_fmaxf(a, b), c); }
#define ATT_WAIT_BAR(N) asm volatile("s_waitcnt vmcnt(" #N ") lgkmcnt(0)\n\ts_barrier" ::: "memory")
typedef short v4i16_t __attribute__((ext_vector_type(4)));
__device__ __forceinline__ s16x4 vtr(lds_cptr p) { return __builtin_bit_cast(s16x4, __builtin_amdgcn_ds_read_tr16_b64_v4i16((LAS v4i16_t*)p)); }
__device__ __forceinline__ float rowmax(const f32x16& p0, const f32x16& p1) {
    float a = max3f(p0[0], p0[1], p1[0]), b = max3f(p0[2], p0[3], p1[1]); a = max3f(a, p1[2], p1[3]);
#pragma unroll
    for (int r = 4; r < 16; r += 4) { a = max3f(a, p0[r], p0[r + 1]); b = max3f(b, p0[r + 2], p0[r + 3]); a = max3f(a, p1[r], p1[r + 1]); b = max3f(b, p1[r + 2], p1[r + 3]); }
    const float m = __builtin_fmaxf(a, b);
    auto rr = __builtin_amdgcn_permlane32_swap(__float_as_uint(m), __float_as_uint(m), false, false);
    return __builtin_fmaxf(__uint_as_float(rr[0]), __uint_as_float(rr[1]));
}
__device__ __forceinline__ void pv(f32x16* o, int vb, bf16x8 pa0, bf16x8 pa1, bf16x8 pa2, bf16x8 pa3) {
#pragma unroll
    for (int d0 = 0; d0 < 2; ++d0) { s16x4 lo[4], hi[4];
#pragma unroll
        for (int ks = 0; ks < 4; ++ks) {
            asm volatile("ds_read_b64_tr_b16 %0,%1 offset:%c2" : "=&v"(lo[ks]) : "v"(vb), "i"(d0 * 4096 + ks * 1024) : "memory");
            asm volatile("ds_read_b64_tr_b16 %0,%1 offset:%c2" : "=&v"(hi[ks]) : "v"(vb), "i"(d0 * 4096 + ks * 1024 + 512) : "memory"); }
        asm volatile("s_waitcnt lgkmcnt(0)" ::: "memory"); __builtin_amdgcn_sched_barrier(0);
#define ATT_PK(k) (bf16x8){lo[k][0], lo[k][1], lo[k][2], lo[k][3], hi[k][0], hi[k][1], hi[k][2], hi[k][3]}
        o[d0] = __builtin_amdgcn_mfma_f32_32x32x16_bf16(pa0, ATT_PK(0), o[d0], 0, 0, 0);
        o[d0] = __builtin_amdgcn_mfma_f32_32x32x16_bf16(pa1, ATT_PK(1), o[d0], 0, 0, 0);
        o[d0] = __builtin_amdgcn_mfma_f32_32x32x16_bf16(pa2, ATT_PK(2), o[d0], 0, 0, 0);
        o[d0] = __builtin_amdgcn_mfma_f32_32x32x16_bf16(pa3, ATT_PK(3), o[d0], 0, 0, 0);
#undef ATT_PK
    }
}
template <int MODE>
__device__ __forceinline__ void attn_core(char* shm, const bf16_t* Qw, const bf16_t* Kh, const bf16_t* Vh, bf16_t* Ow, int q0, const int qw0, int t_lo, int t_hi, const int bias_off, float sinkl2, float slope2, const int tid, const float kn2 = 0.f) {
    const int lane = tid & 63, r32 = lane & 31, hi = lane >> 5; const int wid = __builtin_amdgcn_readfirstlane(tid >> 6);
    const unsigned lds0 = (unsigned)(uintptr_t)shm;
    float* wsf = (float*)(shm + LDS_WS) + wid * 64;
    const lds_cptr shm3 = (lds_cptr)shm;
    const bf16_t* ksrc = Kh + (long)lane * DM + wid * 8;
    const bf16_t* vsrc = Vh + (long)(16 * (wid & 3) + (lane >> 2)) * DM + (wid >> 2) * 32 + (lane & 3) * 8;
    const unsigned kdst = lds0 + LDS_K + wid * 1024, vdst = lds0 + LDS_V + wid * 1024;
#define ATT_DMA_K(t, slot) glds16(ksrc + (long)(t) * 64 * DM, (unsigned)__builtin_amdgcn_readfirstlane(kdst + (slot)))
#define ATT_DMA_V(t, slot) glds16(vsrc + (long)(t) * 64 * DM, (unsigned)__builtin_amdgcn_readfirstlane(vdst + (slot)))
    const int vb0 = (int)(lds0 + LDS_V) + ((lane >> 4) & 1) * 32 + (lane & 3) * 8 + (4 * hi + ((lane & 15) >> 2)) * 64;
    const int n = t_hi - t_lo + 1;
    const int w_hi = (qw0 + 31) >> 6;
    const int w_lo = (MODE == 1) ? ((qw0 - 127 > 0 ? qw0 - 127 : 0) >> 6) : t_lo;
    bf16x8 qr[4];
#pragma unroll
    for (int d0 = 0; d0 < 4; ++d0) qr[d0] = *reinterpret_cast<const bf16x8*>(&Qw[(long)r32 * DM + d0 * 16 + hi * 8]);
    ATT_DMA_K(t_hi, 0); ATT_DMA_V(t_hi, 0);
    if (n > 1) { ATT_DMA_K(t_hi - 1, SLOTB); ATT_DMA_V(t_hi - 1, SLOTB); }
    LAS float* mmp = (LAS float*)(shm3 + LDS_MM); LAS float* qmp = (LAS float*)(shm3 + LDS_QM);
    if (MODE == 0) {
        float qs = 0.f;
#pragma unroll
        for (int d0 = 0; d0 < 4; ++d0)
#pragma unroll
            for (int e = 0; e < 8; ++e) { const float v = bf2f((bf16_t)qr[d0][e]); qs += v * v; }
        { auto rr = __builtin_amdgcn_permlane32_swap(__float_as_uint(qs), __float_as_uint(qs), false, false); qs = __uint_as_float(rr[0]) + __uint_as_float(rr[1]); }
        qs = __builtin_fmaxf(qs, shx<1>(qs)); qs = __builtin_fmaxf(qs, shx<2>(qs)); qs = __builtin_fmaxf(qs, shx<4>(qs)); qs = __builtin_fmaxf(qs, shx<8>(qs)); qs = __builtin_fmaxf(qs, shx<16>(qs));
        if (lane == 0) { qmp[wid] = qs; mmp[wid] = -1e30f; mmp[8 + wid] = -1e30f; mmp[16 + wid] = -1e30f; }
    }
    float bqk = 0.f;
    float mhat = 0.f, l_reg = 0.f; f32x16 o[2]; o[0] = f32x16{}; o[1] = f32x16{}; bool first = true;
    const int q = qw0 + r32;
    const int grp = wid >> 2;
#define ATT_LBAR() asm volatile("s_waitcnt lgkmcnt(0)\n\ts_barrier" ::: "memory")
#define ATT_ISSUE(i2) do { if ((i2) < n) { const int sl_ = ((i2) % 3) * SLOTB; ATT_DMA_K(t_hi - (i2), sl_); ATT_DMA_V(t_hi - (i2), sl_); } } while (0)
    if (grp == 1) { if (n > 1) { ATT_WAIT_BAR(2); } else { ATT_WAIT_BAR(0); } }
#pragma unroll 1
    for (int ti = 0; ti < n; ++ti) {
        const int t = t_hi - ti, sl_cur = (ti % 3) * SLOTB;
        const bool need = (t >= w_lo && t <= w_hi);
        if (MODE == 0 && ti >= 2) {
            if (ti == 2) { const f32x4 qa = *(const LAS f32x4*)qmp, qb_ = *(const LAS f32x4*)(qmp + 4);
                const float qn2 = __builtin_fmaxf(__builtin_fmaxf(__builtin_fmaxf(qa[0], qa[1]), __builtin_fmaxf(qa[2], qa[3])), __builtin_fmaxf(__builtin_fmaxf(qb_[0], qb_[1]), __builtin_fmaxf(qb_[2], qb_[3])));
                bqk = __int_as_float(__builtin_amdgcn_readfirstlane(__float_as_int(sqrtf(qn2 * kn2) * 1.02f + 1.0f))); }
            const LAS float* mp = mmp + ((ti - 2) % 3) * 8; const f32x4 ma = *(const LAS f32x4*)mp, mb = *(const LAS f32x4*)(mp + 4);
            const float mm = __builtin_fminf(__builtin_fminf(__builtin_fminf(ma[0], ma[1]), __builtin_fminf(ma[2], ma[3])), __builtin_fminf(__builtin_fminf(mb[0], mb[1]), __builtin_fminf(mb[2], mb[3])));
            const float bmax = *((const LAS float*)(shm3 + LDS_BIAS) + (t - t_lo) * 64 + 63);
            if (__builtin_amdgcn_readfirstlane((int)(bqk + bmax < mm - 160.f))) break;
        }
        if (grp == 0) { if (ti + 1 < n) { ATT_WAIT_BAR(2); } else { ATT_WAIT_BAR(0); } }
        else { ATT_LBAR(); ATT_ISSUE(ti + 2); }
        f32x16 p0, p1;
        if (need) {
            { const LAS float* bp = (const LAS float*)(shm3 + LDS_BIAS) + bias_off + (t - t_lo) * 64 + 4 * hi;
#pragma unroll
              for (int jj = 0; jj < 4; ++jj) { const f32x4 a = *(const LAS f32x4*)(bp + 8 * jj), b = *(const LAS f32x4*)(bp + 32 + 8 * jj);
                  p0[4 * jj] = a[0] - mhat; p0[4 * jj + 1] = a[1] - mhat; p0[4 * jj + 2] = a[2] - mhat; p0[4 * jj + 3] = a[3] - mhat;
                  p1[4 * jj] = b[0] - mhat; p1[4 * jj + 1] = b[1] - mhat; p1[4 * jj + 2] = b[2] - mhat; p1[4 * jj + 3] = b[3] - mhat; } }
            { const lds_cptr kb = shm3 + LDS_K + sl_cur + hi * 1024 + r32 * 16;
#pragma unroll
              for (int d0 = 0; d0 < 4; ++d0) { const bf16x8 b0 = *(const LAS bf16x8*)(kb + d0 * 2048), b1 = *(const LAS bf16x8*)(kb + d0 * 2048 + 512);
                  p0 = __builtin_amdgcn_mfma_f32_32x32x16_bf16(b0, qr[d0], p0, 0, 0, 0); p1 = __builtin_amdgcn_mfma_f32_32x32x16_bf16(b1, qr[d0], p1, 0, 0, 0); } }
            const float NEG = -__builtin_inff();
            if (MODE == 0) { if (t == w_hi) { const int kb_ = 64 * t + 4 * hi;
#pragma unroll
                for (int r = 0; r < 16; ++r) { const int kv = kb_ + (r & 3) + 8 * (r >> 2); if (kv > q) p0[r] = NEG; if (kv + 32 > q) p1[r] = NEG; } } }
            else { const int kb_ = 64 * t + 4 * hi;
#pragma unroll
                for (int r = 0; r < 16; ++r) { const int kv = kb_ + (r & 3) + 8 * (r >> 2); if ((unsigned)(q - kv) >= 128u) p0[r] = NEG; if ((unsigned)(q - kv - 32) >= 128u) p1[r] = NEG; } }
            const float rm = rowmax(p0, p1);
            if (first || __any(rm > 8.f)) {
                const float dl = first ? __builtin_fmaxf(rm, -1e30f) : __builtin_fmaxf(rm, 0.f); const float f = first ? 1.f : __builtin_amdgcn_exp2f(-dl);
                first = false; mhat += dl; l_reg *= f; if (hi == 0) wsf[r32] = f;
#pragma unroll
                for (int r = 0; r < 16; ++r) { p0[r] -= dl; p1[r] -= dl; }
                asm volatile("s_waitcnt lgkmcnt(0)" ::: "memory");
#pragma unroll
                for (int jj = 0; jj < 4; ++jj) { const f32x4 fv = *(const f32x4*)(wsf + 8 * jj + 4 * hi);
#pragma unroll
                    for (int i2 = 0; i2 < 4; ++i2) { o[0][4 * jj + i2] *= fv[i2]; o[1][4 * jj + i2] *= fv[i2]; } }
            }
            if (MODE == 0) {
                float mn = mhat; mn = __builtin_fminf(mn, shx<1>(mn)); mn = __builtin_fminf(mn, shx<2>(mn)); mn = __builtin_fminf(mn, shx<4>(mn)); mn = __builtin_fminf(mn, shx<8>(mn)); mn = __builtin_fminf(mn, shx<16>(mn));
                if (lane == 0) mmp[(ti % 3) * 8 + wid] = mn; }
        }
        if (grp == 0) { ATT_LBAR(); ATT_ISSUE(ti + 2); }
        else { if (ti + 1 < n) { if (ti + 2 < n) { ATT_WAIT_BAR(2); } else { ATT_WAIT_BAR(0); } } else { ATT_LBAR(); } }
        if (need) {
            const lds_cptr vp = shm3 + LDS_V + sl_cur + ((lane >> 4) & 1) * 32 + (lane & 3) * 8 + (4 * hi + ((lane & 15) >> 2)) * 64;
#define ATT_SB() __builtin_amdgcn_sched_barrier(0)
#define ATT_PIN(x) asm volatile("" : "+v"(x))
#define ATT_VRD(i) do { vlo[i] = vtr(vp + (((i) >> 2) * 4096 + ((i) & 3) * 1024)); vhi[i] = vtr(vp + (((i) >> 2) * 4096 + ((i) & 3) * 1024 + 512)); } while (0)
#define ATT_VF(i) (bf16x8){vlo[i][0], vlo[i][1], vlo[i][2], vlo[i][3], vhi[i][0], vhi[i][1], vhi[i][2], vhi[i][3]}
#define ATT_PIN4(B) asm volatile("" : "+v"(ex[B]), "+v"(ex[B + 1]), "+v"(ex[B + 2]), "+v"(ex[B + 3]))
#define ATT_EX4(P, PB, B) do { ex[B] = __builtin_amdgcn_exp2f(P[PB]); ex[B + 1] = __builtin_amdgcn_exp2f(P[PB + 1]); ex[B + 2] = __builtin_amdgcn_exp2f(P[PB + 2]); ex[B + 3] = __builtin_amdgcn_exp2f(P[PB + 3]); ATT_PIN4(B); } while (0)
#define ATT_PK4(B) (u32x4){cvtpk(ex[B], ex[B + 1]), cvtpk(ex[B + 2], ex[B + 3]), cvtpk(ex[B + 4], ex[B + 5]), cvtpk(ex[B + 6], ex[B + 7])}
#define ATT_SUM4(B) do { sacc += ex[B]; sacc += ex[B + 1]; sacc += ex[B + 2]; sacc += ex[B + 3]; ATT_PIN(sacc); } while (0)
            s16x4 vlo[8], vhi[8]; u32x4 pw0, pw1, pw2, pw3; float sacc = 0.f; float ex[32];
            ATT_VRD(0); ATT_VRD(4);
            ATT_EX4(p0, 0, 0); ATT_EX4(p0, 4, 4); pw0 = ATT_PK4(0); ATT_PIN(pw0); ATT_SB();
            o[0] = __builtin_amdgcn_mfma_f32_32x32x16_bf16(__builtin_bit_cast(bf16x8, pw0), ATT_VF(0), o[0], 0, 0, 0); ATT_VRD(1); ATT_EX4(p0, 8, 8); ATT_SUM4(0); ATT_SB();
            o[1] = __builtin_amdgcn_mfma_f32_32x32x16_bf16(__builtin_bit_cast(bf16x8, pw0), ATT_VF(4), o[1], 0, 0, 0); ATT_VRD(5); ATT_EX4(p0, 12, 12); pw1 = ATT_PK4(8); ATT_PIN(pw1); ATT_SB();
            o[0] = __builtin_amdgcn_mfma_f32_32x32x16_bf16(__builtin_bit_cast(bf16x8, pw1), ATT_VF(1), o[0], 0, 0, 0); ATT_VRD(2); ATT_EX4(p1, 0, 16); ATT_SUM4(4); ATT_SB();
            o[1] = __builtin_amdgcn_mfma_f32_32x32x16_bf16(__builtin_bit_cast(bf16x8, pw1), ATT_VF(5), o[1], 0, 0, 0); ATT_VRD(6); ATT_EX4(p1, 4, 20); pw2 = ATT_PK4(16); ATT_PIN(pw2); ATT_SB();
            o[0] = __builtin_amdgcn_mfma_f32_32x32x16_bf16(__builtin_bit_cast(bf16x8, pw2), ATT_VF(2), o[0], 0, 0, 0); ATT_VRD(3); ATT_EX4(p1, 8, 24); ATT_SUM4(8); ATT_SB();
            o[1] = __builtin_amdgcn_mfma_f32_32x32x16_bf16(__builtin_bit_cast(bf16x8, pw2), ATT_VF(6), o[1], 0, 0, 0); ATT_VRD(7); ATT_EX4(p1, 12, 28); pw3 = ATT_PK4(24); ATT_PIN(pw3); ATT_SB();
            o[0] = __builtin_amdgcn_mfma_f32_32x32x16_bf16(__builtin_bit_cast(bf16x8, pw3), ATT_VF(3), o[0], 0, 0, 0); ATT_SUM4(12); ATT_SUM4(16); ATT_SUM4(20); ATT_SB();
            o[1] = __builtin_amdgcn_mfma_f32_32x32x16_bf16(__builtin_bit_cast(bf16x8, pw3), ATT_VF(7), o[1], 0, 0, 0); ATT_SUM4(24); ATT_SUM4(28); ATT_SB();
            l_reg += sacc;
#undef ATT_SB
#undef ATT_PIN
#undef ATT_VRD
#undef ATT_VF
#undef ATT_EX4
#undef ATT_PK4
#undef ATT_SUM4
#undef ATT_PIN4
        }
    }
    if (grp == 0) { ATT_LBAR(); }
#undef ATT_LBAR
#undef ATT_ISSUE
    { auto rr = __builtin_amdgcn_permlane32_swap(__float_as_uint(l_reg), __float_as_uint(l_reg), false, false); l_reg = __uint_as_float(rr[0]) + __uint_as_float(rr[1]); }
    if (MODE == 1) l_reg += __builtin_amdgcn_exp2f(sinkl2 + slope2 * (float)(qw0 - q0 + r32) - mhat);
    if (hi == 0) wsf[32 + r32] = l_reg;
    asm volatile("s_waitcnt lgkmcnt(0)" ::: "memory");
    float rli[16];
#pragma unroll
    for (int r = 0; r < 16; ++r) rli[r] = __builtin_amdgcn_rcpf(wsf[32 + crow(r, hi)]);
    { bf16_t* stg = (bf16_t*)(shm + LDS_OST) + wid * 2048;
#pragma unroll
      for (int r = 0; r < 16; ++r) { const int orow = crow(r, hi);
#pragma unroll
          for (int d0 = 0; d0 < 2; ++d0) stg[orow * 64 + d0 * 32 + r32] = (bf16_t)(cvtpk(o[d0][r] * rli[r], 0.f) & 0xffffu); }
      asm volatile("s_waitcnt lgkmcnt(0)" ::: "memory");
#pragma unroll
      for (int i = 0; i < 4; ++i) { const int row = i * 8 + (lane >> 3), ch = lane & 7; const u32x4 v = *(const u32x4*)(stg + row * 64 + ch * 8); *(u32x4*)(Ow + (long)row * D + ch * 8) = v; } }
    asm volatile("s_waitcnt vmcnt(0) lgkmcnt(0)\n\ts_barrier" ::: "memory");
#undef ATT_DMA_K
#undef ATT_DMA_V
}
}

__device__ __forceinline__ void p0_tr_item(const float* W, int ld_src, int k0, int n0, bf16_t* d0, bf16_t* d1, bf16_t* d2, int ld_dst, LAS float* scr, int lane) {
    float tv[32];
#pragma unroll
    for (int i = 0; i < 32; ++i) { const int kk = 2 * i + (lane >> 5); tv[i] = W[(size_t)(k0 + kk) * ld_src + n0 + (lane & 31)]; }
#pragma unroll
    for (int i = 0; i < 32; ++i) { const int kk = 2 * i + (lane >> 5); scr[kk * 33 + (lane & 31)] = tv[i]; }
    LDS_WAIT(); asm volatile("" ::: "memory");
    const int c = lane & 7;
#pragma unroll
    for (int j = 0; j < 4; ++j) { const int n = (lane >> 3) + 8 * j; const LAS float* s = scr + (8 * c) * 33 + n;
        u32x4 o; o.x = cvtpk(s[0 * 33], s[1 * 33]); o.y = cvtpk(s[2 * 33], s[3 * 33]); o.z = cvtpk(s[4 * 33], s[5 * 33]); o.w = cvtpk(s[6 * 33], s[7 * 33]);
        *(u32x4*)(d0 + (size_t)n * ld_dst + 8 * c) = o;
        if (d1) *(u32x4*)(d1 + (size_t)n * ld_dst + 8 * c) = o;
        if (d2) *(u32x4*)(d2 + (size_t)n * ld_dst + 8 * c) = o; }
    LDS_WAIT(); asm volatile("" ::: "memory");
}
__device__ __forceinline__ int pair_idx(int lo, int hi) { return lo == 0 ? hi - 1 : (lo == 1 ? hi + 1 : 5); }

__device__ __forceinline__ void phase_p0(Frame& F) {
    __syncthreads();
    {
        LAS float* sc = (LAS float*)F.lds;
        LAS float* red = (LAS float*)(F.lds + 16384);
        float* MOD = (float*)(F.ws + WS_MOD);
        bool have = false;
        for (int task = F.vcu; task < 48; task += F.G) {
            if (!have) { for (int i = F.tid; i < 4096; i += 512) { const float v = F.inp(F_C)[i]; sc[i] = v * sigmoidf_(v); } __syncthreads(); have = true; }
            const int l = task / 24, j0 = (task % 24) * 256;
            const float* wp = F.inp(F_WMOD) + (size_t)l * 1024 * 6144 + j0 + 4 * F.lane;
            f32x4 a0 = {0, 0, 0, 0}, a1 = a0, a2 = a0, a3 = a0;
            const int kbeg = F.wave * 128;
#pragma unroll 8
            for (int k = kbeg; k < kbeg + 128; ++k) { const f32x4 wv = *(const f32x4*)(wp + (size_t)k * 6144);
                a0 += wv * sc[k]; a1 += wv * sc[1024 + k]; a2 += wv * sc[2048 + k]; a3 += wv * sc[3072 + k]; }
            *(LAS f32x4*)(red + (F.wave * 4 + 0) * 256 + 4 * F.lane) = a0; *(LAS f32x4*)(red + (F.wave * 4 + 1) * 256 + 4 * F.lane) = a1;
            *(LAS f32x4*)(red + (F.wave * 4 + 2) * 256 + 4 * F.lane) = a2; *(LAS f32x4*)(red + (F.wave * 4 + 3) * 256 + 4 * F.lane) = a3;
            __syncthreads();
            for (int o = F.tid; o < 1024; o += 512) { const int b = o >> 8, cidx = o & 255; float s = F.inp(F_BMOD)[l * 6144 + j0 + cidx];
#pragma unroll
                for (int w = 0; w < 8; ++w) s += red[(w * 4 + b) * 256 + cidx];
                MOD[(size_t)(l * 4 + b) * 6144 + j0 + cidx] = s; }
            __syncthreads();
        }
        __syncthreads();
    }
    LAS float* scr = (LAS float*)(F.lds + F.wave * 16384);
    const int gw = F.vcu * 8 + F.wave, NGW = F.G * 8;
    bf16_t* WIN = (bf16_t*)(F.ws + WS_WIN); bf16_t* WOUT = (bf16_t*)(F.ws + WS_WOUT); bf16_t* WGU = (bf16_t*)(F.ws + WS_WGU); bf16_t* WDP = (bf16_t*)(F.ws + WS_WDP);
    constexpr int I_IN = 2 * 16 * 64, I_OUT = 2 * 16 * 32, I_GU = 2 * 16 * 2 * 16 * 8, I_DN = 2 * 16 * 4 * 32;
    for (int it = gw; it < I_IN + I_OUT + I_GU + I_DN; it += NGW) {
        int r = it;
        if (r < I_IN) { const int l = r / 1024, kb = (r % 1024) / 64, nb = r % 64;
            p0_tr_item(F.inp(F_WIN) + (size_t)l * 1024 * IN_COLS, IN_COLS, 64 * kb, 32 * nb, WIN + ((size_t)l * 2048 + 32 * nb) * 1024 + 64 * kb, nullptr, nullptr, 1024, scr, F.lane); continue; }
        r -= I_IN;
        if (r < I_OUT) { const int l = r / 512, kb = (r % 512) / 32, nb = r % 32;
            p0_tr_item(F.inp(F_WOUT) + (size_t)l * 1024 * 1024, 1024, 64 * kb, 32 * nb, WOUT + ((size_t)l * 1024 + 32 * nb) * 1024 + 64 * kb, nullptr, nullptr, 1024, scr, F.lane); continue; }
        r -= I_OUT;
        if (r < I_GU) { const int le = r / 256, which = (r % 256) / 128, kb = (r % 128) / 8, nb = r % 8;
            const int j0 = 32 * nb, row = 256 * (j0 >> 7) + (j0 & 127) + which * 128;
            p0_tr_item((which ? F.inp(F_WUP) : F.inp(F_WGATE)) + (size_t)le * 1024 * 256, 256, 64 * kb, j0, WGU + ((size_t)le * 512 + row) * 1024 + 64 * kb, nullptr, nullptr, 1024, scr, F.lane); continue; }
        r -= I_GU;
        { const int le = r / 128, kb = (r % 128) / 32, nb = r % 32; const int l = le >> 4, e = le & 15, g = e >> 2, i = e & 3;
          bf16_t* dst[3]; int nd = 0;
#pragma unroll
          for (int j = 0; j < 4; ++j) { if (j == i) continue; const int lo = i < j ? i : j, hi = i < j ? j : i; const int cls = g * 6 + pair_idx(lo, hi); const int kofs = (i == lo) ? 0 : 256;
              dst[nd++] = WDP + ((size_t)(l * 24 + cls) * 1024 + 32 * nb) * 512 + kofs + 64 * kb; }
          p0_tr_item(F.inp(F_WDOWN) + (size_t)le * 256 * 1024, 1024, 64 * kb, 32 * nb, dst[0], dst[1], dst[2], 512, scr, F.lane); }
    }
}

template <bool PM>
__device__ __forceinline__ void phase_norm1(Frame& F, int l, const float* xin) {
    const bf16_t* Pb = (const bf16_t*)(F.ws + WS_P); const bf16_t* Mb = (const bf16_t*)(F.ws + WS_M); float* XA = (float*)(F.ws + WS_XA);
    LAS float* gpm = (LAS float*)(F.lds + 256);
    const float* MOD = (const float*)(F.ws + WS_MOD) + (size_t)l * 4 * 6144;
    bf16_t* H = (bf16_t*)(F.ws + WS_H); float* CUM = (float*)(F.ws + WS_CUM); float* CTOT = (float*)(F.ws + WS_CTOT);
    LAS float* wtot = (LAS float*)F.lds;
    for (int tile = F.vcu; tile < T / 128; tile += F.G) {
        const int b = tile >> 6, row0 = tile * 128;
        f32x4 g1[4], s1[4], wfc[16];
#pragma unroll
        for (int j = 0; j < 4; ++j) { const int col = 4 * F.lane + 256 * j;
            const f32x4 nm = *(const f32x4*)(F.inp(F_NMIX) + l * 1024 + col), scv = *(const f32x4*)(MOD + b * 6144 + 1024 + col);
            g1[j] = nm * (scv + 1.0f); s1[j] = *(const f32x4*)(MOD + b * 6144 + col);
#pragma unroll
            for (int i = 0; i < 4; ++i) wfc[j * 4 + i] = *(const f32x4*)(F.inp(F_WIN) + ((size_t)l * 1024 + col + i) * IN_COLS + 2048); }
        const f32x4 fb = *(const f32x4*)(F.inp(F_FOXB) + l * 4);
        if (PM) { const float* MODp = (const float*)(F.ws + WS_MOD) + (size_t)(l - 1) * 4 * 6144 + b * 6144;
            for (int i = F.tid; i < 1024; i += 512) { gpm[i] = MODp[2048 + i]; gpm[1024 + i] = MODp[5120 + i]; }
            __syncthreads(); }
        f32x4 run = {0.f, 0.f, 0.f, 0.f}, keep = {0.f, 0.f, 0.f, 0.f};
#pragma unroll 1
        for (int i = 0; i < 16; i += 2) {
            const int row = row0 + F.wave * 16 + i;
            const f32x4* xr0 = (const f32x4*)(xin + (size_t)row * D) + F.lane; const f32x4* xr1 = xr0 + D / 4;
            f32x4 v0[4], v1[4]; float ss0 = 0.f, ss1 = 0.f;
#pragma unroll
            for (int j = 0; j < 4; ++j) { v0[j] = xr0[64 * j]; v1[j] = xr1[64 * j]; }
            if (PM) {
                u32x2 p0[4], p1[4], m0[4], m1[4];
                const u32x2* pr0 = (const u32x2*)(Pb + (size_t)row * D) + F.lane; const u32x2* mr0 = (const u32x2*)(Mb + (size_t)row * D) + F.lane;
#pragma unroll
                for (int j = 0; j < 4; ++j) { p0[j] = pr0[64 * j]; p1[j] = pr0[64 * j + D / 4]; m0[j] = mr0[64 * j]; m1[j] = mr0[64 * j + D / 4]; }
                f32x4* xo0 = (f32x4*)(XA + (size_t)row * D) + F.lane; f32x4* xo1 = xo0 + D / 4;
#pragma unroll
                for (int j = 0; j < 4; ++j) { const f32x4 gm = *(const LAS f32x4*)(gpm + 4 * F.lane + 256 * j), gf = *(const LAS f32x4*)(gpm + 1024 + 4 * F.lane + 256 * j);
                    v0[j] = v0[j] + gm * bf4_to_f32(p0[j]) + gf * bf4_to_f32(m0[j]); v1[j] = v1[j] + gm * bf4_to_f32(p1[j]) + gf * bf4_to_f32(m1[j]);
                    xo0[64 * j] = v0[j]; xo1[64 * j] = v1[j]; }
            }
#pragma unroll
            for (int j = 0; j < 4; ++j) { ss0 += (v0[j].x * v0[j].x + v0[j].y * v0[j].y) + (v0[j].z * v0[j].z + v0[j].w * v0[j].w); ss1 += (v1[j].x * v1[j].x + v1[j].y * v1[j].y) + (v1[j].z * v1[j].z + v1[j].w * v1[j].w); }
            const float rstd0 = 1.0f / sqrtf(wave_sum(ss0) * (1.f / D) + EPS), rstd1 = 1.0f / sqrtf(wave_sum(ss1) * (1.f / D) + EPS);
            f32x4 fa0 = {0.f, 0.f, 0.f, 0.f}, fa1 = {0.f, 0.f, 0.f, 0.f};
            u32x2* o0 = (u32x2*)(H + (size_t)row * D) + F.lane; u32x2* o1 = o0 + D / 4;
#pragma unroll
            for (int j = 0; j < 4; ++j) { const f32x4 h0 = v0[j] * rstd0 * g1[j] + s1[j], h1 = v1[j] * rstd1 * g1[j] + s1[j];
                fa0 += wfc[j * 4 + 0] * h0.x + wfc[j * 4 + 1] * h0.y + wfc[j * 4 + 2] * h0.z + wfc[j * 4 + 3] * h0.w;
                fa1 += wfc[j * 4 + 0] * h1.x + wfc[j * 4 + 1] * h1.y + wfc[j * 4 + 2] * h1.z + wfc[j * 4 + 3] * h1.w;
                u32x2 w; w.x = cvtpk(h0.x, h0.y); w.y = cvtpk(h0.z, h0.w); o0[64 * j] = w; w.x = cvtpk(h1.x, h1.y); w.y = cvtpk(h1.z, h1.w); o1[64 * j] = w; }
            f32x4 lf0, lf1;
#pragma unroll
            for (int e = 0; e < 4; ++e) { const float z0 = wave_sum(fa0[e]) + fb[e], z1 = wave_sum(fa1[e]) + fb[e];
                lf0[e] = fminf(z0, 0.f) - __builtin_amdgcn_logf(1.f + fast_exp(-fabsf(z0))) * 0.6931471805599453f;
                lf1[e] = fminf(z1, 0.f) - __builtin_amdgcn_logf(1.f + fast_exp(-fabsf(z1))) * 0.6931471805599453f; }
            run += lf0; if (F.lane == i) keep = run;
            run += lf1; if (F.lane == i + 1) keep = run;
        }
        if (F.lane == 0) *(LAS f32x4*)(wtot + F.wave * 4) = run;
        __syncthreads();
        f32x4 pre = {0.f, 0.f, 0.f, 0.f}, tot = {0.f, 0.f, 0.f, 0.f};
#pragma unroll
        for (int w = 0; w < 8; ++w) { const f32x4 tv = *(const LAS f32x4*)(wtot + w * 4); if (w < F.wave) pre += tv; tot += tv; }
        if (F.lane < 16) { const int s = (row0 & (SEQ - 1)) + F.wave * 16 + F.lane; const f32x4 cv = keep + pre;
#pragma unroll
            for (int e = 0; e < 4; ++e) CUM[(size_t)(b * 4 + e) * SEQ + s] = cv[e]; }
        if (F.tid == 0) *(f32x4*)(CTOT + (size_t)(b * 64 + (tile & 63)) * 4) = tot;
        __syncthreads();
    }
}

__device__ __forceinline__ void lru_unit(Frame& F, int l, int b, int tt) {
    const bf16_t* PROJ = (const bf16_t*)(F.ws + WS_PROJ);
    float* HLOC = (float*)(F.ws + WS_H); float* PP = HLOC + (size_t)T * 256;
    float* LRUA = (float*)(F.ws + WS_LRUA); float* LRUH = (float*)(F.ws + WS_LRUH);
    LAS bf16_t* xcb = (LAS bf16_t*)F.lds;
    LAS float* gb_ = (LAS float*)(F.lds + 16384);
    const int c = F.tid & 255, sl = F.tid >> 8;
    const int blk = F.wave, kq = F.lane >> 4, nn = F.lane & 15;
    bf16x8 bfr[2][2];
    f32x4 cinit[2][2];
#pragma unroll
    for (int g = 0; g < 2; ++g)
#pragma unroll
        for (int hf = 0; hf < 2; ++hf) { const float* wp = (g ? F.inp(F_LWX) : F.inp(F_LWA)) + ((size_t)(l * 8 + blk) * 32 + 8 * kq) * 32 + 16 * hf + nn;
            u32x4 pk; pk.x = cvtpk(wp[0], wp[32]); pk.y = cvtpk(wp[64], wp[96]); pk.z = cvtpk(wp[128], wp[160]); pk.w = cvtpk(wp[192], wp[224]); bfr[g][hf] = __builtin_bit_cast(bf16x8, pk);
            const float bv = (g ? F.inp(F_LBX) : F.inp(F_LBA))[l * 256 + blk * 32 + 16 * hf + nn]; cinit[g][hf] = (f32x4){bv, bv, bv, bv}; }
    const float cw0 = F.inp(F_CONVW)[(l * 4 + 0) * 256 + c], cw1 = F.inp(F_CONVW)[(l * 4 + 1) * 256 + c], cw2 = F.inp(F_CONVW)[(l * 4 + 2) * 256 + c], cw3 = F.inp(F_CONVW)[(l * 4 + 3) * 256 + c];
    const float cb = F.inp(F_CONVB)[l * 256 + c];
    const float lam = F.inp(F_LAM)[l * 256 + c];
    const float sp = -8.0f * (fmaxf(-lam, 0.f) + log1pf(expf(-fabsf(lam))));
    const int s0 = tt * 128 + sl * 64;
    const bf16_t* xp = PROJ + ((size_t)b * SEQ + s0) * NPROJ + C_XB + c;
    float xm3 = s0 >= 3 ? bf2f(xp[-3 * (long)NPROJ]) : 0.f, xm2 = s0 >= 2 ? bf2f(xp[-2 * (long)NPROJ]) : 0.f, xm1 = s0 >= 1 ? bf2f(xp[-1 * (long)NPROJ]) : 0.f;
    float h = 0.f, P = 1.f;
    bf16_t xr[16];
#pragma unroll
    for (int i = 0; i < 16; ++i) xr[i] = xp[(long)i * NPROJ];
#pragma unroll 1
    for (int sub = 0; sub < 4; ++sub) {
        float xv[16];
#pragma unroll
        for (int i = 0; i < 16; ++i) { const float xc = bf2f(xr[i]); xv[i] = cb + cw0 * xm3 + cw1 * xm2 + cw2 * xm1 + cw3 * xc; xm3 = xm2; xm2 = xm1; xm1 = xc;
            xcb[(sl * 16 + i) * 256 + c] = (bf16_t)(cvtpk(xv[i], 0.f) & 0xffffu); }
        if (sub < 3) {
#pragma unroll
            for (int i = 0; i < 16; ++i) xr[i] = xp[(long)((sub + 1) * 16 + i) * NPROJ]; }
        __syncthreads();
#pragma unroll
        for (int s2 = 0; s2 < 2; ++s2) {
            const bf16x8 af = *(const LAS bf16x8*)(xcb + (s2 * 16 + nn) * 256 + blk * 32 + 8 * kq);
#pragma unroll
            for (int g = 0; g < 2; ++g)
#pragma unroll
                for (int hf = 0; hf < 2; ++hf) { const f32x4 r4 = __builtin_amdgcn_mfma_f32_16x16x32_bf16(af, bfr[g][hf], cinit[g][hf], 0, 0, 0);
                    LAS float* gp = gb_ + ((g * 2 + s2) * 16 + 4 * kq) * 256 + blk * 32 + 16 * hf + nn;
                    gp[0] = r4[0]; gp[256] = r4[1]; gp[512] = r4[2]; gp[768] = r4[3]; }
        }
        __syncthreads();
#pragma unroll
        for (int i = 0; i < 16; ++i) {
            const float ga = gb_[((0 * 2 + sl) * 16 + i) * 256 + c], gx = gb_[((1 * 2 + sl) * 16 + i) * 256 + c];
            const float r = sigmoidf_(ga), ig = sigmoidf_(gx);
            const float la = sp * r; const float a = fast_exp(la);
            const float mult = __builtin_amdgcn_sqrtf(__builtin_fmaxf(1.f - a * a, 0.f));
            const float u = mult * ig * xv[i];
            h = a * h + u; P *= a;
            const size_t off = ((size_t)b * SEQ + s0 + sub * 16 + i) * 256 + c;
            HLOC[off] = h; PP[off] = P;
        }
    }
    const size_t so = ((size_t)(b * 128 + tt * 2 + sl)) * 256 + c;
    LRUA[so] = P; LRUH[so] = h;
    __syncthreads();
}

__device__ __forceinline__ void fox_unit(Frame& F, int l, int b, int h, int qb) {
    const bf16_t* PROJ = (const bf16_t*)(F.ws + WS_PROJ); bf16_t* Y = (bf16_t*)(F.ws + WS_Y);
    const float* CUM = (const float*)(F.ws + WS_CUM) + (size_t)(b * 4 + h) * SEQ; const float* CTOT = (const float*)(F.ws + WS_CTOT);
    LAS float* bias = (LAS float*)(F.lds + att::LDS_BIAS); LAS float* blk = (LAS float*)(F.lds + att::LDS_BLK);
    const int q0 = qb * 256;
    if (F.wave == 0) { const float v = CTOT[(size_t)(b * 64 + F.lane) * 4 + h]; float s = v;
#pragma unroll
        for (int o = 1; o < 64; o <<= 1) { const float t = __int_as_float(__builtin_amdgcn_ds_bpermute(((F.lane - o) & 63) << 2, __float_as_int(s))); if (F.lane >= o) s += t; }
        blk[F.lane] = s - v; }
    __syncthreads();
    const float cref = CUM[q0 + 255] + blk[(q0 + 255) >> 7];
    for (int s = F.tid; s < q0 + 256; s += 512) bias[s] = (cref - (CUM[s] + blk[s >> 7])) * LOG2E;
    __syncthreads();
    float kn2 = 0.f; { const unsigned* km = (const unsigned*)(F.ws + WS_CTL) + CW_KM + l * 128 + (b * 4 + h) * 8;
#pragma unroll
        for (int c = 0; c < 8; ++c) kn2 += __uint_as_float(__hip_atomic_load(km + c, __ATOMIC_RELAXED, __HIP_MEMORY_SCOPE_AGENT)); }
    const size_t rowbase = (size_t)b * SEQ;
    att::attn_core<0>(F.shm, PROJ + (rowbase + q0 + F.wave * 32) * NPROJ + C_QC + h * 64, PROJ + rowbase * NPROJ + C_KC + h * 64, PROJ + rowbase * NPROJ + C_VC + h * 64,
                      Y + (rowbase + q0 + F.wave * 32) * D + 768 + h * 64, q0, q0 + F.wave * 32, 0, (q0 + 255) >> 6, 0, 0.f, 0.f, F.tid, kn2);
}
__device__ __forceinline__ void swa_unit(Frame& F, int l, int b, int kvh, int qb64) {
    const bf16_t* PROJ = (const bf16_t*)(F.ws + WS_PROJ); bf16_t* Y = (bf16_t*)(F.ws + WS_Y);
    LAS float* bias = (LAS float*)(F.lds + att::LDS_BIAS);
    const int q0 = qb64 * 64;
    const int t_lo = (q0 >= 128 ? q0 - 128 : 0) >> 6, t_hi = q0 >> 6, n = t_hi - t_lo + 1;
    for (int i = F.tid; i < 4 * 192; i += 512) { const int hh = i / 192, j = i - hh * 192; const float sl = exp2f(-(float)(kvh * 4 + hh + 1)) * LOG2E;
        if (j < n * 64) bias[i] = sl * (float)(64 * t_lo + j - q0); }
    __syncthreads();
    const int h = kvh * 4 + (F.wave >> 1), qw0 = q0 + 32 * (F.wave & 1);
    const float slope2 = exp2f(-(float)(h + 1)) * LOG2E;
    const size_t rowbase = (size_t)b * SEQ;
    att::attn_core<1>(F.shm, PROJ + (rowbase + qw0) * NPROJ + C_QA + h * 64, PROJ + rowbase * NPROJ + C_KA + kvh * 64, PROJ + rowbase * NPROJ + C_VA + kvh * 64,
                      Y + (rowbase + qw0) * D + h * 64, q0, qw0, t_lo, t_hi, (F.wave >> 1) * 192, F.inp(F_SINKS)[l * 8 + h] * LOG2E, slope2, F.tid);
}
__device__ __forceinline__ void phase_mixer(Frame& F, int l, int qsel) {
    unsigned* qhead = (unsigned*)(F.ws + WS_CTL) + CW_Q + qsel * 64;
    LAS unsigned* qslot = (LAS unsigned*)(F.lds + LDSCTL_OFF + 16);
#pragma unroll 1
    for (;;) {
        frame_refresh(F);
        if (F.tid == 0) qslot[0] = __hip_atomic_fetch_add(qhead, 1u, __ATOMIC_RELAXED, __HIP_MEMORY_SCOPE_AGENT);
        __syncthreads();
        const int u = __builtin_amdgcn_readfirstlane((int)qslot[0]);
        __syncthreads();
        if (u >= 512 + 256 + 1024) break;
        if (u < 512) { if (PH(11)) fox_unit(F, l, (u & 15) >> 2, u & 3, 31 - (u >> 4)); }
        else if (u < 768) { if (PH(10)) lru_unit(F, l, (u - 512) >> 6, (u - 512) & 63); }
        else { if (PH(12)) { const int v = u - 768; swa_unit(F, l, v >> 8, (v >> 7) & 1, v & 127); } }
    }
}

__device__ __forceinline__ void phase_ynorm(Frame& F, int l, bf16_t* YO) {
    const bf16_t* Y = (const bf16_t*)(F.ws + WS_Y); const bf16_t* PROJ = (const bf16_t*)(F.ws + WS_PROJ);
    const float* HLOC = (const float*)(F.ws + WS_H); const float* PP = HLOC + (size_t)T * 256;
    const float* LRUA = (const float*)(F.ws + WS_LRUA); const float* LRUH = (const float*)(F.ws + WS_LRUH);
    LAS float* cs = (LAS float*)F.lds;
    LAS float* carry = (LAS float*)(F.lds + 4096);
    const float* og = F.inp(F_OGAIN) + l * 1024;
    for (int tile = F.vcu; tile < T / 128; tile += F.G) {
        const int b = tile >> 6, tt = tile & 63, j0 = 2 * tt;
        { const int c = F.tid & 255, seg = F.tid >> 8; const int jb = seg ? j0 / 2 : 0, je = seg ? j0 : j0 / 2;
          float A = 1.f, Hh = 0.f;
          for (int j = jb; j < je; ++j) { const size_t so = (size_t)(b * 128 + j) * 256 + c; const float aj = LRUA[so], hj = LRUH[so]; Hh = aj * Hh + hj; A *= aj; }
          cs[(seg * 2 + 0) * 256 + c] = A; cs[(seg * 2 + 1) * 256 + c] = Hh; }
        __syncthreads();
        if (F.tid < 256) { const int c = F.tid; const float c0 = cs[(2 + 0) * 256 + c] * cs[(0 + 1) * 256 + c] + cs[(2 + 1) * 256 + c];
            const size_t so = (size_t)(b * 128 + j0) * 256 + c; carry[c] = c0; carry[256 + c] = LRUA[so] * c0 + LRUH[so]; }
        __syncthreads();
#pragma unroll 1
        for (int i = 0; i < 16; i += 2) {
            u32x4 ya[2]; u32x2 yc[2], gb[2]; f32x4 hl[2], pp[2], cr[2];
#pragma unroll
            for (int k = 0; k < 2; ++k) { const int rl = F.wave * 16 + i + k; const size_t row = (size_t)tile * 128 + rl; const bf16_t* yr = Y + row * D;
                ya[k] = *(const u32x4*)(yr + 8 * F.lane); yc[k] = *(const u32x2*)(yr + 768 + 4 * F.lane);
                hl[k] = *(const f32x4*)(HLOC + row * 256 + 4 * F.lane); pp[k] = *(const f32x4*)(PP + row * 256 + 4 * F.lane);
                gb[k] = *(const u32x2*)(PROJ + row * NPROJ + C_GB + 4 * F.lane); cr[k] = *(const LAS f32x4*)(carry + (rl >> 6) * 256 + 4 * F.lane); }
#pragma unroll
            for (int k = 0; k < 2; ++k) { const int rl = F.wave * 16 + i + k; const size_t row = (size_t)tile * 128 + rl; bf16_t* yr = YO + row * D;
                float fa[8]; fa[0] = __uint_as_float(ya[k].x << 16); fa[1] = __uint_as_float(ya[k].x & 0xffff0000u); fa[2] = __uint_as_float(ya[k].y << 16); fa[3] = __uint_as_float(ya[k].y & 0xffff0000u);
                fa[4] = __uint_as_float(ya[k].z << 16); fa[5] = __uint_as_float(ya[k].z & 0xffff0000u); fa[6] = __uint_as_float(ya[k].w << 16); fa[7] = __uint_as_float(ya[k].w & 0xffff0000u);
                float sa = 0.f;
#pragma unroll
                for (int e = 0; e < 8; ++e) sa += fa[e] * fa[e];
                float fc[4]; fc[0] = __uint_as_float(yc[k].x << 16); fc[1] = __uint_as_float(yc[k].x & 0xffff0000u); fc[2] = __uint_as_float(yc[k].y << 16); fc[3] = __uint_as_float(yc[k].y & 0xffff0000u);
                const float sc_ = fc[0] * fc[0] + fc[1] * fc[1] + fc[2] * fc[2] + fc[3] * fc[3];
                float fb[4]; { const f32x4 hh = hl[k] + pp[k] * cr[k];
                    fb[0] = hh.x * gelu_tanh(__uint_as_float(gb[k].x << 16)); fb[1] = hh.y * gelu_tanh(__uint_as_float(gb[k].x & 0xffff0000u));
                    fb[2] = hh.z * gelu_tanh(__uint_as_float(gb[k].y << 16)); fb[3] = hh.w * gelu_tanh(__uint_as_float(gb[k].y & 0xffff0000u)); }
                const float sb = fb[0] * fb[0] + fb[1] * fb[1] + fb[2] * fb[2] + fb[3] * fb[3];
                const float ra = 1.0f / sqrtf(wave_sum(sa) * (1.f / 512.f) + EPS), rb = 1.0f / sqrtf(wave_sum(sb) * (1.f / 256.f) + EPS), rc = 1.0f / sqrtf(wave_sum(sc_) * (1.f / 256.f) + EPS);
                { const f32x4 g0 = *(const f32x4*)(og + 8 * F.lane), g1 = *(const f32x4*)(og + 8 * F.lane + 4);
                  u32x4 w; w.x = cvtpk(fa[0] * ra * g0.x, fa[1] * ra * g0.y); w.y = cvtpk(fa[2] * ra * g0.z, fa[3] * ra * g0.w); w.z = cvtpk(fa[4] * ra * g1.x, fa[5] * ra * g1.y); w.w = cvtpk(fa[6] * ra * g1.z, fa[7] * ra * g1.w);
                  *(u32x4*)(yr + 8 * F.lane) = w; }
                { const f32x4 g = *(const f32x4*)(og + 512 + 4 * F.lane); u32x2 w; w.x = cvtpk(fb[0] * rb * g.x, fb[1] * rb * g.y); w.y = cvtpk(fb[2] * rb * g.z, fb[3] * rb * g.w); *(u32x2*)(yr + 512 + 4 * F.lane) = w; }
                { const f32x4 g = *(const f32x4*)(og + 768 + 4 * F.lane); u32x2 w; w.x = cvtpk(fc[0] * rc * g.x, fc[1] * rc * g.y); w.y = cvtpk(fc[2] * rc * g.z, fc[3] * rc * g.w); *(u32x2*)(yr + 768 + 4 * F.lane) = w; }
            }
        }
        __syncthreads();
    }
}

template <int N, int MASK> __device__ __forceinline__ void tr_step(float (&v)[40], bool upper) {
#pragma unroll
    for (int i = 0; i < N / 2; ++i) { const float a = v[i], b = v[i + N / 2]; const float send = upper ? a : b, kp = upper ? b : a; float rcv;
        if constexpr (MASK == 32) { auto rr = __builtin_amdgcn_permlane32_swap(__float_as_uint(send), __float_as_uint(send), false, false); rcv = upper ? __uint_as_float(rr[0]) : __uint_as_float(rr[1]); }
        else rcv = shx<MASK>(send);
        v[i] = kp + rcv; }
}
__device__ __forceinline__ void phase_norm2_router(Frame& F, int l, const float* xa, unsigned* cnt) {
    const float* MOD = (const float*)(F.ws + WS_MOD) + (size_t)l * 4 * 6144;
    bf16_t* H = (bf16_t*)(F.ws + WS_H);
    LEntry* list = (LEntry*)(F.ws + WS_LIST);
    LAS float* wr = (LAS float*)F.lds;
    LAS float* gs = (LAS float*)(F.lds + 81920);
    LAS float* lg = (LAS float*)(F.lds + 90112);
    LAS int* tcls = (LAS int*)(F.lds + 92672);
    LAS float* tw = (LAS float*)(F.lds + 93184);
    LAS int* trank = (LAS int*)(F.lds + 94208);
    LAS unsigned* lcnt = (LAS unsigned*)(F.lds + 94720);
    LAS unsigned* lbase = (LAS unsigned*)(F.lds + 94848);
    const bf16_t* Pb = (const bf16_t*)(F.ws + WS_P); LAS float* gmv = (LAS float*)(F.lds + 98304);
    for (int i = F.tid; i < 1024 * 4; i += 512) { const int k = i >> 2, e = i & 3; wr[e * 1024 + k] = F.inp(F_WRG)[(size_t)l * 4096 + i]; }
    for (int i = F.tid; i < 1024 * 16; i += 512) { const int k = i >> 4, e = i & 15; wr[(4 + e) * 1024 + k] = F.inp(F_WRE)[(size_t)l * 16384 + i]; }
    int cur_b = -1;
    for (int tile = F.vcu; tile < T / 128; tile += F.G) {
        const int b = tile >> 6;
        __syncthreads();
        if (b != cur_b) { for (int i = F.tid; i < 1024; i += 512) { gs[i] = F.inp(F_NFFN)[l * 1024 + i] * (1.f + MOD[b * 6144 + 4096 + i]); gs[1024 + i] = MOD[b * 6144 + 3072 + i]; gmv[i] = MOD[b * 6144 + 2048 + i]; } cur_b = b; }
        if (F.tid < NCLS) lcnt[F.tid] = 0u;
        __syncthreads();
#pragma unroll 1
        for (int grp = 0; grp < 8; ++grp) {
            const size_t row0 = (size_t)tile * 128 + F.wave * 16 + grp * 2;
            f32x4 hv[2][4];
#pragma unroll
            for (int r = 0; r < 2; ++r) { const f32x4* xr = (const f32x4*)(xa + (row0 + r) * D) + F.lane;
#pragma unroll
                for (int j = 0; j < 4; ++j) hv[r][j] = xr[64 * j]; }
            { u32x2 pv_[2][4];
#pragma unroll
              for (int r = 0; r < 2; ++r) { const u32x2* pr = (const u32x2*)(Pb + (row0 + r) * D) + F.lane;
#pragma unroll
                  for (int j = 0; j < 4; ++j) pv_[r][j] = pr[64 * j]; }
#pragma unroll
              for (int j = 0; j < 4; ++j) { const f32x4 gm = *(const LAS f32x4*)(gmv + 4 * F.lane + 256 * j);
                  hv[0][j] = hv[0][j] + gm * bf4_to_f32(pv_[0][j]); hv[1][j] = hv[1][j] + gm * bf4_to_f32(pv_[1][j]); } }
#pragma unroll
            for (int r = 0; r < 2; ++r) { float ss = 0.f;
#pragma unroll
                for (int j = 0; j < 4; ++j) ss += (hv[r][j].x * hv[r][j].x + hv[r][j].y * hv[r][j].y) + (hv[r][j].z * hv[r][j].z + hv[r][j].w * hv[r][j].w);
                const float rstd = 1.0f / sqrtf(wave_sum(ss) * (1.f / D) + EPS);
                u32x2* o8 = (u32x2*)(H + (row0 + r) * D) + F.lane;
#pragma unroll
                for (int j = 0; j < 4; ++j) { const f32x4 g = *(const LAS f32x4*)(gs + 4 * F.lane + 256 * j), s = *(const LAS f32x4*)(gs + 1024 + 4 * F.lane + 256 * j);
                    hv[r][j] = hv[r][j] * rstd * g + s; u32x2 w; w.x = cvtpk(hv[r][j].x, hv[r][j].y); w.y = cvtpk(hv[r][j].z, hv[r][j].w); o8[64 * j] = w; } }
            float acc[40];
#pragma unroll
            for (int e = 0; e < 20; ++e) { float a0 = 0.f, a1 = 0.f;
#pragma unroll
                for (int j = 0; j < 4; ++j) { const f32x4 w = *(const LAS f32x4*)(wr + e * 1024 + 4 * F.lane + 256 * j);
                    a0 += hv[0][j].x * w.x + hv[0][j].y * w.y + hv[0][j].z * w.z + hv[0][j].w * w.w;
                    a1 += hv[1][j].x * w.x + hv[1][j].y * w.y + hv[1][j].z * w.z + hv[1][j].w * w.w; }
                acc[e] = a0; acc[20 + e] = a1; }
            tr_step<40, 32>(acc, (F.lane & 32) != 0); tr_step<20, 16>(acc, (F.lane & 16) != 0); tr_step<10, 8>(acc, (F.lane & 8) != 0);
#pragma unroll
            for (int i = 0; i < 5; ++i) { acc[i] += shx<4>(acc[i]); acc[i] += shx<2>(acc[i]); acc[i] += shx<1>(acc[i]); }
            if ((F.lane & 7) == 0) { const int v0 = 5 * (F.lane >> 3);
#pragma unroll
                for (int i = 0; i < 5; ++i) lg[F.wave * 40 + v0 + i] = acc[i]; }
            LDS_WAIT();
            if (F.lane < 2) {
                const LAS float* q = lg + F.wave * 40 + F.lane * 20;
                float gl[4];
#pragma unroll
                for (int j = 0; j < 4; ++j) gl[j] = q[j] + F.inp(F_BRG)[l * 4 + j];
                int gsel = 0; float gm = gl[0];
#pragma unroll
                for (int j = 1; j < 4; ++j) if (gl[j] > gm) { gm = gl[j]; gsel = j; }
                float den = 0.f;
#pragma unroll
                for (int j = 0; j < 4; ++j) den += expf(gl[j] - gm);
                const float gp = 1.0f / den;
                float el[4];
#pragma unroll
                for (int j = 0; j < 4; ++j) el[j] = q[4 + 4 * gsel + j] + F.inp(F_BRE)[l * 16 + gsel * 4 + j];
                int i1 = 0; float m1 = el[0];
#pragma unroll
                for (int j = 1; j < 4; ++j) if (el[j] > m1) { m1 = el[j]; i1 = j; }
                int i2 = -1; float m2 = -__builtin_inff();
#pragma unroll
                for (int j = 0; j < 4; ++j) if (j != i1 && el[j] > m2) { m2 = el[j]; i2 = j; }
                const float e2 = expf(m2 - m1); const float w1 = gp / (1.f + e2), w2 = gp * e2 / (1.f + e2);
                const int lo = i1 < i2 ? i1 : i2, hi = i1 < i2 ? i2 : i1;
                const int rl = F.wave * 16 + grp * 2 + F.lane;
                tcls[rl] = gsel * 6 + pair_idx(lo, hi); tw[rl * 2] = (i1 < i2) ? w1 : w2; tw[rl * 2 + 1] = (i1 < i2) ? w2 : w1;
            }
        }
        __syncthreads();
        if (F.tid < 128) trank[F.tid] = (int)atomicAdd((unsigned*)&lcnt[tcls[F.tid]], 1u);
        __syncthreads();
        if (F.tid < NCLS) lbase[F.tid] = lcnt[F.tid] ? __hip_atomic_fetch_add(cnt + 64 * F.tid, lcnt[F.tid], __ATOMIC_RELAXED, __HIP_MEMORY_SCOPE_AGENT) : 0u;
        __syncthreads();
        if (F.tid < 128) { const int cls = tcls[F.tid]; const unsigned pos = lbase[cls] + (unsigned)trank[F.tid];
            LEntry e; e.tok = tile * 128 + F.tid; e.w0 = tw[F.tid * 2]; e.w1 = tw[F.tid * 2 + 1]; e.pad = 0; list[(size_t)cls * LCAP + pos] = e; }
    }
    __syncthreads();
}

__device__ __forceinline__ int build_tile_table(Frame& F, int l) {
    unsigned* cnt = (unsigned*)(F.ws + WS_CTL) + CW_CNT + l * NCLS * 64;
    LAS int* tt = (LAS int*)(F.lds + TT_OFF); LAS int* ntl = (LAS int*)(F.lds + TT_OFF + 1024);
    __syncthreads();
    if (F.tid == 0) { int nt = 0;
        for (int c = 0; c < NCLS; ++c) { const unsigned n = __hip_atomic_load(cnt + 64 * c, __ATOMIC_RELAXED, __HIP_MEMORY_SCOPE_AGENT); const int k = (int)((n + 255u) >> 8);
            for (int j = 0; j < k; ++j) tt[nt++] = c | ((j * 256) << 8); }
        ntl[0] = nt; }
    __syncthreads();
    return ntl[0];
}

__device__ __forceinline__ void phase_final(Frame& F, const float* xa, int lp) {
    const bf16_t* Pb = (const bf16_t*)(F.ws + WS_P); const bf16_t* Mb = (const bf16_t*)(F.ws + WS_M); const float* MODp = (const float*)(F.ws + WS_MOD) + (size_t)lp * 4 * 6144;
    const int gw = F.vcu * 8 + F.wave, NGW = F.G * 8;
    f32x4 g[4];
#pragma unroll
    for (int j = 0; j < 4; ++j) g[j] = *(const f32x4*)(F.inp(F_NFIN) + 4 * F.lane + 256 * j);
#pragma unroll 1
    for (int row = gw; row < T; row += 2 * NGW) {
        const f32x4* xr0 = (const f32x4*)(xa + (size_t)row * D) + F.lane; const f32x4* xr1 = (const f32x4*)(xa + (size_t)(row + NGW) * D) + F.lane;
        f32x4 v0[4], v1[4]; float ss0 = 0.f, ss1 = 0.f;
#pragma unroll
        for (int j = 0; j < 4; ++j) { v0[j] = xr0[64 * j]; v1[j] = xr1[64 * j]; }
        { const int r1 = row + NGW; const float* g0p = MODp + (row >> 13) * 6144; const float* g1p = MODp + (r1 >> 13) * 6144;
          const u32x2* pa = (const u32x2*)(Pb + (size_t)row * D) + F.lane; const u32x2* pb = (const u32x2*)(Pb + (size_t)r1 * D) + F.lane;
          const u32x2* ma = (const u32x2*)(Mb + (size_t)row * D) + F.lane; const u32x2* mb = (const u32x2*)(Mb + (size_t)r1 * D) + F.lane;
#pragma unroll
          for (int j = 0; j < 4; ++j) { const int col = 4 * F.lane + 256 * j;
              v0[j] = v0[j] + *(const f32x4*)(g0p + 2048 + col) * bf4_to_f32(pa[64 * j]) + *(const f32x4*)(g0p + 5120 + col) * bf4_to_f32(ma[64 * j]);
              v1[j] = v1[j] + *(const f32x4*)(g1p + 2048 + col) * bf4_to_f32(pb[64 * j]) + *(const f32x4*)(g1p + 5120 + col) * bf4_to_f32(mb[64 * j]); } }
#pragma unroll
        for (int j = 0; j < 4; ++j) { ss0 += (v0[j].x * v0[j].x + v0[j].y * v0[j].y) + (v0[j].z * v0[j].z + v0[j].w * v0[j].w); ss1 += (v1[j].x * v1[j].x + v1[j].y * v1[j].y) + (v1[j].z * v1[j].z + v1[j].w * v1[j].w); }
        const float rstd0 = 1.0f / sqrtf(wave_sum(ss0) * (1.f / D) + EPS), rstd1 = 1.0f / sqrtf(wave_sum(ss1) * (1.f / D) + EPS);
        f32x4* o0 = (f32x4*)(F.out + (size_t)row * D) + F.lane; f32x4* o1 = (f32x4*)(F.out + (size_t)(row + NGW) * D) + F.lane;
#pragma unroll
        for (int j = 0; j < 4; ++j) { o0[64 * j] = v0[j] * rstd0 * g[j]; o1[64 * j] = v1[j] * rstd1 * g[j]; }
    }
}

__global__ void __launch_bounds__(512, 2) mk_fwd(const Args args) {
    extern __shared__ __attribute__((aligned(16))) unsigned char lds[];
    Frame F;
    F.lds = (LAS unsigned char*)lds; F.shm = (char*)lds;
    F.tid = threadIdx.x; F.lane = F.tid & 63; F.wave = __builtin_amdgcn_readfirstlane(F.tid >> 6);
    F.G = 256; { const int bx = blockIdx.x; __builtin_assume(bx >= 0 && bx < 256); F.vcu = (bx % 8) * 32 + bx / 8; }
    for (int u = F.tid; u < (LDS_BYTES - LDSCTL_OFF) / 4; u += 512) ((LAS unsigned*)(F.lds + LDSCTL_OFF))[u] = 0u;
    __syncthreads();
    F.wave_s = __builtin_amdgcn_readfirstlane((int)threadIdx.x >> 6);
#define REFRESH() frame_refresh(F)
    REFRESH();
    unsigned* ctl = (unsigned*)(F.ws + WS_CTL);
    XcdBarrier bar = xcd_barrier_post(ctl + CW_BAR, (volatile LAS unsigned*)(F.lds + MISC_OFF) + 8);

    for (int rep = 0; rep < DUP(0); ++rep) if (PH(0)) phase_p0(F);
    xcd_barrier(bar, F.tid);
    float* XA = (float*)(F.ws + WS_XA);
    for (int l = 0; l < DEPTH; ++l) {
        const float* xin = (l <= 1) ? F.inp(F_X) : XA;
        const float* xbase = (l == 0) ? F.inp(F_X) : XA;
        const float* MODl = (const float*)(F.ws + WS_MOD) + (size_t)l * 4 * 6144;
        REFRESH();
        for (int rep = 0; rep < DUP(1); ++rep) if (PH(1)) { if (l == 0) phase_norm1<false>(F, l, xin); else phase_norm1<true>(F, l, xin); }
        xcd_barrier(bar, F.tid);
        REFRESH();
        for (int rep = 0; rep < DUP(2); ++rep) if (PH(2)) { pg8::DenseOrder S; S.init(T, NPROJ, F.G, (int)blockIdx.x, F.ws + WS_WIN + (size_t)l * 2048 * 1024 * 2, 2048u, G1REP);
          EpiProj E{(bf16_t*)(F.ws + WS_PROJ), (unsigned*)(F.ws + WS_CTL) + CW_KM + l * 128};
          pg8::gemm_phase<EpiProj, pg8::DenseOrder, true>(F.tid, F.lds, (const char*)(F.ws + WS_H), 2048u, 2048u, 1024, S, E); }
        xcd_barrier(bar, F.tid);
        REFRESH();
        for (int rep = 0; rep < DUP(3); ++rep) if (PH(3)) { phase_mixer(F, l, l + 2 * rep); if (rep + 1 < DUP(3)) xcd_barrier(bar, F.tid); }
        xcd_barrier(bar, F.tid);
        REFRESH();
        for (int rep = 0; rep < DUP(4); ++rep) if (PH(4)) phase_ynorm(F, l, (rep + 1 < DUP(4)) ? (bf16_t*)F.out : (bf16_t*)(F.ws + WS_Y));
        xcd_barrier(bar, F.tid);
        REFRESH();
        for (int rep = 0; rep < DUP(5); ++rep) if (PH(5)) { pg8::DenseOrder S; S.init(T, D, F.G, (int)blockIdx.x, F.ws + WS_WOUT + (size_t)l * 1024 * 1024 * 2, 2048u, (l == 0) ? G2REP : 1);
          EpiP E{(bf16_t*)(F.ws + WS_P)};
          pg8::gemm_phase<EpiP, pg8::DenseOrder, true>(F.tid, F.lds, (const char*)(F.ws + WS_Y), 2048u, 2048u, 1024, S, E); }
        xcd_barrier(bar, F.tid);
        REFRESH();
        for (int rep = 0; rep < DUP(6); ++rep) if (PH(6)) phase_norm2_router(F, l, xbase, (unsigned*)(F.ws + WS_CTL) + ((rep + 1 < DUP(6)) ? 32768 + l * NCLS * 64 : CW_CNT + l * NCLS * 64));
        xcd_barrier(bar, F.tid);
        REFRESH();
        const int ntiles = build_tile_table(F, l);
        const LEntry* list = (const LEntry*)(F.ws + WS_LIST); const unsigned* cnt = (const unsigned*)(F.ws + WS_CTL) + CW_CNT + l * NCLS * 64;
        for (int rep = 0; rep < DUP(7); ++rep) if (PH(7)) { MoeUpOrder S{ntiles * 4, F.G, (int)blockIdx.x, (const LAS int*)(F.lds + TT_OFF), (const char*)(F.ws + WS_WGU + (size_t)l * 16 * 512 * 1024 * 2), list, cnt};
          EpiUp E{(bf16_t*)(F.ws + WS_PROJ), list, cnt};
          pg8::gemm_phase<EpiUp, MoeUpOrder, true>(F.tid, F.lds, (const char*)(F.ws + WS_H), 2048u, 2048u, 1024, S, E); }
        xcd_barrier(bar, F.tid);
        REFRESH();
        for (int rep = 0; rep < DUP(8); ++rep) if (PH(8)) { MoeDownOrder S{ntiles * 4, F.G, (int)blockIdx.x, (const LAS int*)(F.lds + TT_OFF), (const char*)(F.ws + WS_WDP + (size_t)l * 24 * 1024 * 512 * 2)};
          EpiDown E{(bf16_t*)(F.ws + WS_M), list, cnt};
          pg8::gemm_phase<EpiDown, MoeDownOrder, true>(F.tid, F.lds, (const char*)(F.ws + WS_PROJ), 1024u, 1024u, 512, S, E); }
        xcd_barrier(bar, F.tid);
    }
        REFRESH();
    for (int rep = 0; rep < DUP(9); ++rep) if (PH(9)) phase_final(F, (DEPTH == 1) ? F.inp(F_X) : XA, DEPTH - 1);
}

extern "C" void kernel_launch(void* const* d_in, const int* in_sizes, int n_in, void* d_out, int out_size, void* d_ws, size_t ws_size, hipStream_t stream) {
    static int grid = 0;
    if (grid == 0) {
        if (n_in != 26 || in_sizes[0] != T * D || out_size != T * D || ws_size < WS_END) { fprintf(stderr, "kernel_launch: unexpected shapes (n_in %d, in0 %d, out %d, ws %zu)\n", n_in, n_in > 0 ? in_sizes[0] : -1, out_size, ws_size); grid = -1; return; }
        int dev = 0, cus = 0, per_cu = 0;
        if (hipGetDevice(&dev) != hipSuccess || hipDeviceGetAttribute(&cus, hipDeviceAttributeMultiprocessorCount, dev) != hipSuccess) { grid = -1; return; }
        if (hipFuncSetAttribute((const void*)mk_fwd, hipFuncAttributeMaxDynamicSharedMemorySize, LDS_BYTES) != hipSuccess) { fprintf(stderr, "kernel_launch: hipFuncSetAttribute failed\n"); grid = -1; return; }
        if (hipOccupancyMaxActiveBlocksPerMultiprocessor(&per_cu, (const void*)mk_fwd, 512, LDS_BYTES) != hipSuccess || per_cu < 1) fprintf(stderr, "kernel_launch: occupancy query reports %d\n", per_cu);
        (void)hipGetLastError();
        if (cus != 256) fprintf(stderr, "kernel_launch: built for 256 CUs, device reports %d\n", cus);
        grid = 256;
    }
    if (grid < 0) return;
    (void)hipMemsetAsync((char*)d_ws + WS_CTL, 0, CTL_ZERO_BYTES, stream);
    Args a{};
    for (int i = 0; i < 26; ++i) a.in[i] = (const float*)d_in[i];
    a.out = (float*)d_out; a.ws = (unsigned char*)d_ws;
    hipLaunchKernelGGL(mk_fwd, dim3(grid), dim3(512), LDS_BYTES, stream, a);
}
```

```cpp
#include <hip/hip_runtime.h>
#include <hip/hip_bf16.h>
#include <cstdio>
#include <cstdint>

#define GAS __attribute__((address_space(1)))
#define LAS __attribute__((address_space(3)))
typedef unsigned short bf16_t;
typedef short bf16x8 __attribute__((ext_vector_type(8)));
typedef short s16x4 __attribute__((ext_vector_type(4)));
typedef float f32x2 __attribute__((ext_vector_type(2)));
typedef float f32x4 __attribute__((ext_vector_type(4)));
typedef float f32x16 __attribute__((ext_vector_type(16)));
typedef unsigned u32x2 __attribute__((ext_vector_type(2)));
typedef unsigned u32x4 __attribute__((ext_vector_type(4)));
typedef __bf16 bf16x2_t __attribute__((ext_vector_type(2)));

#ifndef DUP_MASK
#define DUP_MASK 0x0u
#endif
#define DUP(n) (1 + (int)((DUP_MASK >> (n)) & 1u))
#ifndef G2REP
#define G2REP 1
#endif
#ifndef G1REP
#define G1REP 1
#endif
#ifndef UPREP
#define UPREP 1
#endif
#ifndef PH_MASK
#define PH_MASK 0xFFFFFFFFu
#endif
#define PH(n) ((PH_MASK >> (n)) & 1u)
constexpr int D = 1024, NB = 4, SEQ = 8192, T = NB * SEQ, DEPTH = 2;
constexpr int IN_COLS = 2052, NPROJ = 2048;
constexpr int C_QA = 0, C_KA = 512, C_VA = 640, C_XB = 768, C_GB = 1024, C_QC = 1280, C_KC = 1536, C_VC = 1792;
constexpr int NCLS = 24, LCAP = 32768;
constexpr float EPS = 1e-6f;
constexpr float LOG2E = 1.4426950408889634f;
constexpr float C2 = 0.125f * 1.4426950408889634f;

constexpr size_t MiB = 1u << 20;
constexpr size_t WS_CTL = 0, CTL_ZERO_BYTES = 1 * MiB;
constexpr size_t WS_MOD = 1 * MiB;
constexpr size_t WS_CUM = WS_MOD + 256 * 1024;
constexpr size_t WS_CTOT = WS_CUM + 512 * 1024;
constexpr size_t WS_LRUA = 2 * MiB;
constexpr size_t WS_LRUH = WS_LRUA + 512 * 1024;
constexpr size_t WS_LIST = 4 * MiB;
constexpr size_t WS_WIN = 16 * MiB;
constexpr size_t WS_WOUT = 24 * MiB;
constexpr size_t WS_WGU = 28 * MiB;
constexpr size_t WS_WDP = 60 * MiB;
constexpr size_t WS_XA = 108 * MiB;
constexpr size_t WS_H = 236 * MiB;
constexpr size_t WS_PROJ = 300 * MiB;
constexpr size_t WS_Y = 428 * MiB;
constexpr size_t WS_P = WS_PROJ + 64 * MiB;
constexpr size_t WS_M = WS_Y;
constexpr size_t WS_END = 492 * MiB;
constexpr int CW_BAR = 4096;
constexpr int CW_KM = 20480;
constexpr int CW_Q = 21504;
constexpr int CW_CNT = 16384;

struct LEntry { int tok; float w0, w1; int pad; };

constexpr int RING_BYTES = 131072;
constexpr int LDSCTL_OFF = RING_BYTES;
constexpr int MISC_OFF = LDSCTL_OFF + 320;
constexpr int TT_OFF = LDSCTL_OFF + 1024;
constexpr int LDS_BYTES = 147456;

__device__ __forceinline__ unsigned cvtpk(float lo, float hi) { f32x2 v = {lo, hi}; bf16x2_t b = __builtin_convertvector(v, bf16x2_t); return __builtin_bit_cast(unsigned, b); }
__device__ __forceinline__ float bf2f(bf16_t v) { return __builtin_bit_cast(float, (unsigned)v << 16); }
__device__ __forceinline__ f32x4 bf4_to_f32(u32x2 v) { return (f32x4){__uint_as_float(v.x << 16), __uint_as_float(v.x & 0xffff0000u), __uint_as_float(v.y << 16), __uint_as_float(v.y & 0xffff0000u)}; }
template <int M> __device__ __forceinline__ float shx(float v) {
    return __int_as_float(__builtin_amdgcn_ds_swizzle(__float_as_int(v), (M << 10) | 0x1f));
}
__device__ __forceinline__ float wave_sum(float v) {
    v += shx<1>(v); v += shx<2>(v); v += shx<4>(v); v += shx<8>(v); v += shx<16>(v);
    auto rr = __builtin_amdgcn_permlane32_swap(__float_as_uint(v), __float_as_uint(v), false, false);
    return __uint_as_float(rr[0]) + __uint_as_float(rr[1]);
}
__device__ __forceinline__ float fast_exp(float x) { return __builtin_amdgcn_exp2f(x * LOG2E); }
__device__ __forceinline__ float sigmoidf_(float x) { return __builtin_amdgcn_rcpf(1.f + fast_exp(-x)); }
__device__ __forceinline__ float gelu_tanh(float x) {
    const float u = 0.7978845608028654f * (x + 0.044715f * x * x * x);
    const float e = fast_exp(2.f * u);
    const float th = 1.f - 2.f * __builtin_amdgcn_rcpf(e + 1.f);
    return 0.5f * x * (1.f + th);
}
#define LDS_WAIT() asm volatile("s_waitcnt lgkmcnt(0)" ::: "memory")
#define VM_WAIT() asm volatile("s_waitcnt vmcnt(0)" ::: "memory")

namespace pg8 {
constexpr int BM = 256, BK = 64, HALF = 128, HTB = HALF * BK * 2, STAGE_BYTES = 8 * HTB, NXCD = 8, WGM = 8;
__host__ __device__ __forceinline__ int lds_byte(int r, int c) { const int st = (r >> 4) * 2 + (c >> 5), rr = r & 15, cc = c & 31, ob = rr * 64 + cc * 2; return st * 1024 + (ob ^ (((ob >> 9) & 1) << 5)); }
__host__ __device__ __forceinline__ void stage_rc(int b, int& R, int& C) { const int st = b / 1024, sb = b % 1024, swz = sb ^ (((sb >> 9) & 1) << 5); R = (st >> 1) * 16 + swz / 64; C = (st & 1) * 32 + (swz % 64) / 2; }
__host__ __device__ __forceinline__ int perm32(int rho) { const int n = rho >> 4, i = rho & 15; return 8 * (i >> 2) + 4 * n + (i & 3); }

struct GUnit { int a0; const char* bb; int e0, e1, e2, e3; };

__device__ __forceinline__ int xcd_remap(int L, int nwg) {
    const int q = nwg / NXCD, r = nwg % NXCD, xcd = L % NXCD, off = L / NXCD;
    return (xcd < r ? xcd * (q + 1) : r * (q + 1) + (xcd - r) * q) + off;
}

struct DenseOrder {
    int nM, nN, nwg, G, c, rep; const char* Bt; unsigned pitchB;
    __device__ __forceinline__ void init(int M, int N, int G_, int c_, const void* Bt_, unsigned pitchB_, int rep_ = 1) { nM = M / BM; nN = N / BM; nwg = nM * nN; G = G_; c = c_; Bt = (const char*)Bt_; pitchB = pitchB_; rep = rep_; }
    __device__ __forceinline__ bool next(int i, GUnit& u) const {
        const long L = (long)i * G + c; if (L >= (long)nwg * rep) return false;
        const int wgid = xcd_remap((int)(L % nwg), nwg);
        const int nig = WGM * nN, gid = wgid / nig, fm = gid * WGM, gsz = (nM - fm) < WGM ? (nM - fm) : WGM;
        const int pm = fm + ((wgid % nig) % gsz), pn = (wgid % nig) / gsz;
        u.a0 = pm * BM; u.bb = Bt + (size_t)pn * BM * pitchB; u.e0 = pm; u.e1 = pn; u.e2 = 0; u.e3 = 0; return true;
    }
    __device__ __forceinline__ unsigned arow(const GUnit& u, int r) const { return (unsigned)(u.a0 + r); }
};

#define PG8_SA(b, h) (((b) * 2 + (h)) * HTB)
#define PG8_SB(b, h) ((4 + (b) * 2 + (h)) * HTB)
#define PG8_STG(bufoff, gptr, v0, v1) do { \
        __builtin_amdgcn_global_load_lds((const unsigned*)((const char*)(gptr) + (v0)), (LAS unsigned*)(lds + (bufoff) + ldsw), 16, 0, 0); \
        __builtin_amdgcn_global_load_lds((const unsigned*)((const char*)(gptr) + (v1)), (LAS unsigned*)(lds + (bufoff) + ldsw + 8192), 16, 0, 0); } while (0)
#define PG8_STGA(bufoff, kb, vo) PG8_STG(bufoff, Abase + (kb), (vo)[0], (vo)[1])
#define PG8_STGB(bufoff, bp) PG8_STG(bufoff, bp, voffB[0], voffB[1])
#define PG8_LDA(dst, b, h) do { _Pragma("unroll") for (int m = 0; m < 4; ++m) _Pragma("unroll") for (int k = 0; k < 2; ++k) dst[m][k] = *(const LAS bf16x8*)(lds + PG8_SA(b, h) + aoff + m * 2048 + k * 1024); } while (0)
#define PG8_LDB(dst, b, h) do { _Pragma("unroll") for (int n = 0; n < 2; ++n) _Pragma("unroll") for (int k = 0; k < 2; ++k) dst[n][k] = *(const LAS bf16x8*)(lds + PG8_SB(b, h) + boff + n * 2048 + k * 1024); } while (0)
#define PG8_MMA(ai, bj, At, Bt) do { __builtin_amdgcn_s_setprio(1); _Pragma("unroll") for (int m = 0; m < 4; ++m) _Pragma("unroll") for (int n = 0; n < 2; ++n) _Pragma("unroll") for (int k = 0; k < 2; ++k) \
        acc[ai][bj][m][n] = __builtin_amdgcn_mfma_f32_16x16x32_bf16(Bt[n][k], At[m][k], acc[ai][bj][m][n], 0, 0, 0); __builtin_amdgcn_s_setprio(0); } while (0)
#define PG8_WAIT_V(n) asm volatile("s_waitcnt vmcnt(" #n ")" ::: "memory")
#define PG8_WAIT_L(n) asm volatile("s_waitcnt lgkmcnt(" #n ")" ::: "memory")
#define PG8_BAR __builtin_amdgcn_s_barrier()
#define PG8_SCHED __builtin_amdgcn_sched_barrier(0)

template <class Epi, class Sched, bool ALIGN_EPI>
__device__ __forceinline__ void gemm_phase(const int tid, LAS unsigned char* lds, const char* Abase, unsigned pitchA, unsigned pitchB, int K, const Sched& S, const Epi& E) {
    const int wid = __builtin_amdgcn_readfirstlane(tid >> 6), lane = tid & 63, wr = wid >> 2, wc = wid & 3, fr = lane & 15, fq = lane >> 4;
    const int nt = K / BK;
    int RA[2]; unsigned cA2[2], voffB[2];
#pragma unroll
    for (int i = 0; i < 2; ++i) { int R, C; stage_rc(tid * 16 + i * 8192, R, C); const int Rb = Epi::PERM ? ((R & ~31) + perm32(R & 31)) : R;
        RA[i] = R; cA2[i] = (unsigned)C * 2u; voffB[i] = (unsigned)Rb * pitchB + (unsigned)C * 2u; }
    const unsigned hstepB = (unsigned)HALF * pitchB;
    const unsigned ldsw = (unsigned)wid * 1024u;
    const int aoff = lds_byte(wr * 64 + fr, fq * 8), boff = lds_byte(wc * 32 + fr, fq * 8);
    GUnit cur, nxt; int ui = 0;
    if (!S.next(0, cur)) return;
    f32x4 acc[2][2][4][2];
#pragma unroll
    for (int a = 0; a < 2; ++a)
#pragma unroll
        for (int b = 0; b < 2; ++b)
#pragma unroll
            for (int m = 0; m < 4; ++m)
#pragma unroll
                for (int n = 0; n < 2; ++n) acc[a][b][m][n] = (f32x4){0.f, 0.f, 0.f, 0.f};
    bf16x8 At[4][2], B0[2][2], B1[2][2];
    unsigned voA[2][2];
#pragma unroll
    for (int h = 0; h < 2; ++h)
#pragma unroll
        for (int i = 0; i < 2; ++i) voA[h][i] = S.arow(cur, h * HALF + RA[i]) * pitchA + cA2[i];
    const char* cB = cur.bb;
    const unsigned kstep = BK * 2;
    PG8_STGB(PG8_SB(0, 0), cB); PG8_STGB(PG8_SB(0, 1), cB + hstepB); PG8_STGA(PG8_SA(0, 0), 0, voA[0]); PG8_STGA(PG8_SA(0, 1), 0, voA[1]);
    if (wr == 1) PG8_BAR;
    PG8_WAIT_V(2); PG8_BAR;
    PG8_STGB(PG8_SB(1, 0), cB + kstep); PG8_STGA(PG8_SA(1, 0), kstep, voA[0]); PG8_STGB(PG8_SB(1, 1), cB + hstepB + kstep);
    PG8_WAIT_V(6); PG8_BAR;
    for (;;) {
        const bool has_next = S.next(ui + 1, nxt);
        const char* nB = has_next ? nxt.bb : cB;
        for (int t = 0; t < nt; t += 2) {
            const bool last = (t == nt - 2);
            const unsigned kb1 = (unsigned)(t + 1) * kstep;
            const unsigned kb2 = last ? 0u : (unsigned)(t + 2) * kstep, kb3 = kb2 + kstep;
            const char* b2 = last ? nB : cB + (size_t)(t + 2) * kstep; const char* b3 = b2 + kstep;
            PG8_LDB(B0, 0, 0); PG8_LDB(B1, 0, 1); PG8_SCHED; PG8_LDA(At, 0, 0); PG8_STGA(PG8_SA(1, 1), kb1, voA[1]);
            if (last && has_next) {
#pragma unroll
                for (int h = 0; h < 2; ++h)
#pragma unroll
                    for (int i = 0; i < 2; ++i) voA[h][i] = S.arow(nxt, h * HALF + RA[i]) * pitchA + cA2[i]; }
            PG8_WAIT_V(8); PG8_WAIT_L(0); PG8_BAR; PG8_MMA(0, 0, At, B0); PG8_MMA(0, 1, At, B1); PG8_BAR; PG8_SCHED;
            PG8_LDA(At, 0, 1); PG8_STGB(PG8_SB(0, 0), b2); PG8_STGB(PG8_SB(0, 1), b2 + hstepB); PG8_STGA(PG8_SA(0, 0), kb2, voA[0]);
            PG8_WAIT_V(8); PG8_WAIT_L(0); PG8_BAR; PG8_MMA(1, 0, At, B0); PG8_MMA(1, 1, At, B1); PG8_BAR; PG8_SCHED;
            PG8_LDB(B0, 1, 0); PG8_LDB(B1, 1, 1); PG8_SCHED; PG8_LDA(At, 1, 0); PG8_STGA(PG8_SA(0, 1), kb2, voA[1]);
            PG8_WAIT_V(8); PG8_WAIT_L(0); PG8_BAR; PG8_MMA(0, 0, At, B0); PG8_MMA(0, 1, At, B1); PG8_BAR; PG8_SCHED;
            PG8_LDA(At, 1, 1); PG8_STGB(PG8_SB(1, 0), b3); PG8_STGB(PG8_SB(1, 1), b3 + hstepB); PG8_STGA(PG8_SA(1, 0), kb3, voA[0]);
            PG8_WAIT_V(8); PG8_WAIT_L(0); PG8_BAR; PG8_MMA(1, 0, At, B0); PG8_MMA(1, 1, At, B1); PG8_BAR; PG8_SCHED;
        }
        if constexpr (ALIGN_EPI) { if (wr == 0) PG8_BAR; }
        E(acc, cur, wr, wc, fr, fq);
        if (!has_next) break;
#pragma unroll
        for (int a = 0; a < 2; ++a)
#pragma unroll
            for (int b = 0; b < 2; ++b)
#pragma unroll
                for (int m = 0; m < 4; ++m)
#pragma unroll
                    for (int n = 0; n < 2; ++n) acc[a][b][m][n] = (f32x4){0.f, 0.f, 0.f, 0.f};
        cur = nxt; cB = nB; ++ui;
        if constexpr (ALIGN_EPI) { if (wr == 1) PG8_BAR; }
    }
    PG8_WAIT_V(0);
    if constexpr (!ALIGN_EPI) { if (wr == 0) PG8_BAR; }
    PG8_BAR;
}
}

#define XB_TMO      128
#define XB_XCNT(j)  (256  + 64 * (j))
#define XB_XSUB(j)  (1280 + 64 * (j))
#define XB_XGEN(j)  (2304 + 64 * (j))
#define XB_TOP      3328
#define XB_TOPGEN   3392
#define XCD_BAR_WORDS 3456
#define XB_SPIN_CAP (1u << 18)
__device__ __forceinline__ unsigned xb_ld(unsigned* p)              { return __hip_atomic_load(p, __ATOMIC_RELAXED, __HIP_MEMORY_SCOPE_AGENT); }
__device__ __forceinline__ unsigned xb_add(unsigned* p, unsigned v) { return __hip_atomic_fetch_add(p, v, __ATOMIC_RELAXED, __HIP_MEMORY_SCOPE_AGENT); }
__device__ __forceinline__ unsigned xb_xcc_id() { return (unsigned)__builtin_amdgcn_s_getreg((3 << 11) | 20) & 0xFu; }
#define XB_SPIN(cond, bar) do { unsigned _sp = 0; while (cond) { __builtin_amdgcn_s_sleep(1); \
    if ((++_sp & 255u) == 0u) { if (xb_ld(&(bar)[XB_TMO])) break; if (_sp > XB_SPIN_CAP) { atomicAdd(&(bar)[XB_TMO], 1u); break; } } } } while (0)
struct XcdBarrier { unsigned* bar; unsigned x; volatile LAS unsigned* st; };
__device__ __forceinline__ XcdBarrier xcd_barrier_post(unsigned* bar, volatile LAS unsigned* st) {
    XcdBarrier b; b.bar = bar; b.x = xb_xcc_id(); b.st = st;
    if (threadIdx.x == 0) (void)xb_add(&bar[XB_XCNT(b.x)], 1u);
    return b;
}
__device__ __forceinline__ void xcd_barrier_complete(unsigned* bar, unsigned x, unsigned& nloc, unsigned& nx) {
    const unsigned G = gridDim.x * gridDim.y * gridDim.z;
    unsigned sum, cnt, mine, sp = 0u;
    for (;;) {
        sum = 0u; cnt = 0u; mine = 0u;
#pragma unroll
        for (unsigned j = 0; j < 16; ++j) { const unsigned c = xb_ld(&bar[XB_XCNT(j)]); sum += c; cnt += (c > 0u) ? 1u : 0u; mine = (j == x) ? c : mine; }
        if (sum == G) break;
        __builtin_amdgcn_s_sleep(1);
        if ((++sp & 255u) == 0u) { if (xb_ld(&bar[XB_TMO])) break; if (sp > XB_SPIN_CAP) { atomicAdd(&bar[XB_TMO], 1u); break; } }
    }
    nloc = mine > 0u ? mine : 1u; nx = cnt > 0u ? cnt : 1u;
}
__device__ __forceinline__ void xcd_barrier(const XcdBarrier& b, const int tid) {
    asm volatile("s_waitcnt vmcnt(0)" ::: "memory");
    __syncthreads();
    if (tid == 0) {
        unsigned* bar = b.bar; const unsigned bx_ = xb_xcc_id();
        __builtin_amdgcn_s_waitcnt(0);
        unsigned nloc = b.st[0], nx = b.st[1];
        if (nloc == 0u) { xcd_barrier_complete(bar, bx_, nloc, nx); b.st[0] = nloc; b.st[1] = nx; }
        const unsigned old = xb_add(&bar[XB_XSUB(bx_)], 1u);
        const unsigned gen = old / nloc;
        if (old + 1u == (gen + 1u) * nloc) {
            __builtin_amdgcn_fence(__ATOMIC_RELEASE, "agent");
            asm volatile("s_waitcnt vmcnt(0)" ::: "memory");
            const unsigned og = xb_add(&bar[XB_TOP], 1u);
            const unsigned tg = og / nx;
            if (og + 1u == (tg + 1u) * nx) xb_add(&bar[XB_TOPGEN], 1u);
            else XB_SPIN(xb_ld(&bar[XB_TOPGEN]) == tg, bar);
            __builtin_amdgcn_fence(__ATOMIC_ACQUIRE, "agent");
            xb_add(&bar[XB_XGEN(bx_)], 1u);
            asm volatile("s_waitcnt vmcnt(0)" ::: "memory");
        } else {
            XB_SPIN(xb_ld(&bar[XB_XGEN(bx_)]) == gen, bar);
            __builtin_amdgcn_fence(__ATOMIC_ACQUIRE, "agent");
            asm volatile("s_waitcnt vmcnt(0)" ::: "memory");
        }
    }
    __syncthreads();
}

__device__ __forceinline__ const void* launder_ptr(const void* p) {
    unsigned lo = (unsigned)(uintptr_t)p, hi = (unsigned)((uintptr_t)p >> 32);
    asm volatile("" : "+v"(lo), "+v"(hi));
    lo = __builtin_amdgcn_readfirstlane(lo); hi = __builtin_amdgcn_readfirstlane(hi);
    return (const void*)(((uintptr_t)hi << 32) | (uintptr_t)lo);
}
struct Args { const float* in[26]; float* out; unsigned char* ws; };

__device__ __forceinline__ const void* karg_ptr(int idx) {
    const unsigned long long ka = (unsigned long long)__builtin_amdgcn_kernarg_segment_ptr();
    unsigned long long v; asm volatile("s_load_dwordx2 %0, %1, %2\n\ts_waitcnt lgkmcnt(0)" : "=s"(v) : "s"(ka), "s"(idx * 8) : "memory");
    return (const void*)(GAS const void*)(uintptr_t)v;
}
struct Frame {
    LAS unsigned char* lds; char* shm;
    int tid, lane, wave, vcu, G;
    float* out; unsigned char* ws; int wave_s;
    __device__ __forceinline__ const float* inp(int i) const { return (const float*)karg_ptr(i); }
};
__device__ __forceinline__ void frame_refresh(Frame& F) {
    asm volatile("" ::: "memory");
    int t_; asm volatile("v_mbcnt_lo_u32_b32 %0, -1, 0\n\tv_mbcnt_hi_u32_b32 %0, -1, %0" : "=v"(t_)); t_ |= (F.wave_s << 6);
    F.tid = t_; F.lane = t_ & 63; F.wave = __builtin_amdgcn_readfirstlane(t_ >> 6);
    F.out = (float*)karg_ptr(26); F.ws = (unsigned char*)karg_ptr(27);
}
#define F_X 0
#define F_C 1
#define F_WMOD 2
#define F_BMOD 3
#define F_NMIX 4
#define F_NFFN 5
#define F_WIN 6
#define F_WOUT 7
#define F_OGAIN 8
#define F_SINKS 9
#define F_CONVW 10
#define F_CONVB 11
#define F_LWA 12
#define F_LBA 13
#define F_LWX 14
#define F_LBX 15
#define F_LAM 16
#define F_FOXB 17
#define F_WRG 18
#define F_BRG 19
#define F_WRE 20
#define F_BRE 21
#define F_WGATE 22
#define F_WUP 23
#define F_WDOWN 24
#define F_NFIN 25

struct EpiProj {
    static constexpr bool PERM = true;
    bf16_t* O; unsigned* km;
    __device__ __forceinline__ void operator()(const f32x4 (&acc)[2][2][4][2], const pg8::GUnit& u, int wr, int wc, int fr, int fq) const {
        const int row0 = u.e0 * 256 + wr * 64 + fr, pn = u.e1;
        const float sc = (pn == 0 || pn == 1 || pn == 5) ? C2 : 1.f;
        const int col0 = pn * 256 + wc * 32 + 8 * fq;
#pragma unroll
        for (int ai = 0; ai < 2; ++ai)
#pragma unroll
            for (int m = 0; m < 4; ++m) { bf16_t* rowp = O + (size_t)(row0 + ai * 128 + m * 16) * NPROJ + col0;
#pragma unroll
                for (int bj = 0; bj < 2; ++bj) { const f32x4 v0 = acc[ai][bj][m][0] * sc, v1 = acc[ai][bj][m][1] * sc;
                    u32x4 w; w.x = cvtpk(v0[0], v0[1]); w.y = cvtpk(v0[2], v0[3]); w.z = cvtpk(v1[0], v1[1]); w.w = cvtpk(v1[2], v1[3]);
                    *(u32x4*)(rowp + bj * 128) = w; } }
        if (pn == 6) {
            const int b = u.e0 >> 5;
#pragma unroll
            for (int bj = 0; bj < 2; ++bj) { float mx = 0.f;
#pragma unroll
                for (int ai = 0; ai < 2; ++ai)
#pragma unroll
                    for (int m = 0; m < 4; ++m) { const f32x4 v0 = acc[ai][bj][m][0], v1 = acc[ai][bj][m][1];
                        mx = __builtin_fmaxf(mx, (v0[0] * v0[0] + v0[1] * v0[1]) + (v0[2] * v0[2] + v0[3] * v0[3]) + (v1[0] * v1[0] + v1[1] * v1[1]) + (v1[2] * v1[2] + v1[3] * v1[3])); }
                mx = __builtin_fmaxf(mx, shx<1>(mx)); mx = __builtin_fmaxf(mx, shx<2>(mx)); mx = __builtin_fmaxf(mx, shx<4>(mx)); mx = __builtin_fmaxf(mx, shx<8>(mx));
                if (fr == 0) atomicMax(km + ((b * 4 + 2 * bj + (wc >> 1)) * 8 + 4 * (wc & 1) + fq), __float_as_uint(mx)); }
        }
    }
};
struct EpiP {
    static constexpr bool PERM = true;
    bf16_t* P;
    __device__ __forceinline__ void operator()(const f32x4 (&acc)[2][2][4][2], const pg8::GUnit& u, int wr, int wc, int fr, int fq) const {
        const int row0 = u.e0 * 256 + wr * 64 + fr, col0 = u.e1 * 256 + wc * 32 + 8 * fq;
#pragma unroll
        for (int ai = 0; ai < 2; ++ai)
#pragma unroll
            for (int m = 0; m < 4; ++m) { bf16_t* rowp = P + (size_t)(row0 + ai * 128 + m * 16) * D + col0;
#pragma unroll
                for (int bj = 0; bj < 2; ++bj) { const f32x4 v0 = acc[ai][bj][m][0], v1 = acc[ai][bj][m][1];
                    u32x4 w; w.x = cvtpk(v0[0], v0[1]); w.y = cvtpk(v0[2], v0[3]); w.z = cvtpk(v1[0], v1[1]); w.w = cvtpk(v1[2], v1[3]);
                    *(u32x4*)(rowp + bj * 128) = w; } }
    }
};
struct EpiUp {
    static constexpr bool PERM = true;
    bf16_t* HID; const LEntry* list; const unsigned* cnt;
    __device__ __forceinline__ void operator()(const f32x4 (&acc)[2][2][4][2], const pg8::GUnit& u, int wr, int wc, int fr, int fq) const {
        const int pn = u.e1, slot = pn >> 1, pnl = pn & 1, cls = u.e2;
        const unsigned n = __hip_atomic_load(cnt + 64 * cls, __ATOMIC_RELAXED, __HIP_MEMORY_SCOPE_AGENT);
        const int colh = 256 * slot + 128 * pnl + wc * 32 + 8 * fq;
        float wrow[8];
#pragma unroll
        for (int k = 0; k < 8; ++k) { const int r = (k >> 2) * 128 + wr * 64 + (k & 3) * 16 + fr; const unsigned pos = (unsigned)(u.e3 + r);
            const LEntry* e = list + (size_t)cls * LCAP + (pos < n ? pos : 0u); const float w = slot ? e->w1 : e->w0; wrow[k] = pos < n ? w : 0.f; }
#pragma unroll
        for (int ai = 0; ai < 2; ++ai)
#pragma unroll
            for (int m = 0; m < 4; ++m) { const int r = ai * 128 + wr * 64 + m * 16 + fr; const float w = wrow[ai * 4 + m];
                float h[8];
#pragma unroll
                for (int nn = 0; nn < 2; ++nn)
#pragma unroll
                    for (int i = 0; i < 4; ++i) { const float g = acc[ai][0][m][nn][i], up = acc[ai][1][m][nn][i]; h[nn * 4 + i] = g * sigmoidf_(g) * up * w; }
                u32x4 o; o.x = cvtpk(h[0], h[1]); o.y = cvtpk(h[2], h[3]); o.z = cvtpk(h[4], h[5]); o.w = cvtpk(h[6], h[7]);
                *(u32x4*)(HID + (size_t)(u.e0 * 256 + r) * 512 + colh) = o; }
    }
};
struct EpiDown {
    static constexpr bool PERM = true;
    bf16_t* M; const LEntry* list; const unsigned* cnt;
    __device__ __forceinline__ void operator()(const f32x4 (&acc)[2][2][4][2], const pg8::GUnit& u, int wr, int wc, int fr, int fq) const {
        const int cls = u.e2, col0 = u.e1 * 256 + wc * 32 + 8 * fq;
        const unsigned n = __hip_atomic_load(cnt + 64 * cls, __ATOMIC_RELAXED, __HIP_MEMORY_SCOPE_AGENT);
        int tok[8];
#pragma unroll
        for (int k = 0; k < 8; ++k) { const int r = (k >> 2) * 128 + wr * 64 + (k & 3) * 16 + fr; const unsigned pos = (unsigned)(u.e3 + r);
            const int t = list[(size_t)cls * LCAP + (pos < n ? pos : 0u)].tok; tok[k] = pos < n ? t : -1; }
#pragma unroll
        for (int k = 0; k < 8; ++k) { const int ai = k >> 2, m = k & 3;
            if (tok[k] >= 0) { bf16_t* rowp = M + (size_t)tok[k] * D + col0;
#pragma unroll
                for (int bj = 0; bj < 2; ++bj) { const f32x4 v0 = acc[ai][bj][m][0], v1 = acc[ai][bj][m][1];
                    u32x4 w; w.x = cvtpk(v0[0], v0[1]); w.y = cvtpk(v0[2], v0[3]); w.z = cvtpk(v1[0], v1[1]); w.w = cvtpk(v1[2], v1[3]);
                    *(u32x4*)(rowp + bj * 128) = w; } } }
    }
};

__device__ __forceinline__ void pair_of(int p, int& lo, int& hi) { lo = p < 3 ? 0 : (p < 5 ? 1 : 2); hi = p < 3 ? p + 1 : (p < 5 ? p - 1 : 3); }
struct MoeUpOrder {
    int nunits, G, c; const LAS int* tt; const char* WGU; const LEntry* list; const unsigned* cnt;
    __device__ __forceinline__ bool next(int i, pg8::GUnit& u) const {
        const long L = (long)i * G + c; if (L >= (long)nunits * UPREP) return false;
        const int wgid = pg8::xcd_remap((int)(L % nunits), nunits); const int tile = wgid >> 2, pn = wgid & 3; const int e = tt[tile];
        const int cls = e & 255; u.e0 = tile; u.e1 = pn; u.e2 = cls; u.e3 = e >> 8; u.a0 = 0;
        int lo, hi; pair_of(cls % 6, lo, hi); const int ex = (cls / 6) * 4 + ((pn >> 1) ? hi : lo);
        u.bb = WGU + ((size_t)ex * 512 + (size_t)(pn & 1) * 256) * 2048; return true;
    }
    __device__ __forceinline__ unsigned arow(const pg8::GUnit& u, int r) const {
        const unsigned n = __hip_atomic_load(cnt + 64 * u.e2, __ATOMIC_RELAXED, __HIP_MEMORY_SCOPE_AGENT); const unsigned pos = (unsigned)(u.e3 + r);
        return (unsigned)list[(size_t)u.e2 * LCAP + (pos < n ? pos : 0u)].tok;
    }
};
struct MoeDownOrder {
    int nunits, G, c; const LAS int* tt; const char* WDP;
    __device__ __forceinline__ bool next(int i, pg8::GUnit& u) const {
        const long L = (long)i * G + c; if (L >= nunits) return false;
        const int wgid = pg8::xcd_remap((int)L, nunits); const int tile = wgid >> 2, pn = wgid & 3; const int e = tt[tile];
        const int cls = e & 255; u.e0 = tile; u.e1 = pn; u.e2 = cls; u.e3 = e >> 8; u.a0 = tile * 256;
        u.bb = WDP + ((size_t)cls * 1024 + (size_t)pn * 256) * 1024; return true;
    }
    __device__ __forceinline__ unsigned arow(const pg8::GUnit& u, int r) const { return (unsigned)(u.a0 + r); }
};

namespace att {
constexpr int DM = NPROJ;
constexpr int SLOTB = 8192;
constexpr int LDS_K = 0, LDS_V = 3 * SLOTB, LDS_WS = 6 * SLOTB, LDS_OST = LDS_WS + 2048, LDS_BIAS = LDS_OST + 8 * 4096, LDS_BLK = LDS_BIAS + 32768, LDS_MM = LDS_BLK + 256  , LDS_QM = LDS_MM + 96  , LDS_END = LDS_QM + 32;
static_assert(LDS_END <= RING_BYTES, "attention LDS");
typedef LAS const char* lds_cptr;
__device__ __forceinline__ int crow(int r, int hi) { return (r & 3) + 8 * (r >> 2) + 4 * hi; }
__device__ __forceinline__ void glds16(const void* gsrc, unsigned lds_dst) { unsigned keep;
    asm volatile("s_mov_b32 %0, m0\n\ts_mov_b32 m0, %2\n\ts_nop 0\n\tglobal_load_lds_dwordx4 %1, off\n\ts_mov_b32 m0, %0" : "=&s"(keep) : "v"(gsrc), "s"(lds_dst) : "memory"); }
__device__ __forceinline__ float max3f(float a, float b, float c) { return __builtin_fmaxf(__builtin_fmaxf(a, b), c); }
#define ATT_WAIT_BAR(N) asm volatile("s_waitcnt vmcnt(" #N ") lgkmcnt(0)\n\ts_barrier" ::: "memory")
typedef short v4i16_t __attribute__((ext_vector_type(4)));
__device__ __forceinline__ s16x4 vtr(lds_cptr p) { return __builtin_bit_cast(s16x4, __builtin_amdgcn_ds_read_tr16_b64_v4i16((LAS v4i16_t*)p)); }
__device__ __forceinline__ float rowmax(const f32x16& p0, const f32x16& p1) {
    float a = max3f(p0[0], p0[1], p1[0]), b = max3f(p0[2], p0[3], p1[1]); a = max3f(a, p1[2], p1[3]);
#pragma unroll
    for (int r = 4; r < 16; r += 4) { a = max3f(a, p0[r], p0[r + 1]); b = max3f(b, p0[r + 2], p0[r + 3]); a = max3f(a, p1[r], p1[r + 1]); b = max3f(b, p1[r + 2], p1[r + 3]); }
    const float m = __builtin_fmaxf(a, b);
    auto rr = __builtin_amdgcn_permlane32_swap(__float_as_uint(m), __float_as_uint(m), false, false);
    return __builtin_fmaxf(__uint_as_float(rr[0]), __uint_as_float(rr[1]));
}
__device__ __forceinline__ void pv(f32x16* o, int vb, bf16x8 pa0, bf16x8 pa1, bf16x8 pa2, bf16x8 pa3) {
#pragma unroll
    for (int d0 = 0; d0 < 2; ++d0) { s16x4 lo[4], hi[4];
#pragma unroll
        for (int ks = 0; ks < 4; ++ks) {
            asm volatile("ds_read_b64_tr_b16 %0,%1 offset:%c2" : "=&v"(lo[ks]) : "v"(vb), "i"(d0 * 4096 + ks * 1024) : "memory");
            asm volatile("ds_read_b64_tr_b16 %0,%1 offset:%c2" : "=&v"(hi[ks]) : "v"(vb), "i"(d0 * 4096 + ks * 1024 + 512) : "memory"); }
        asm volatile("s_waitcnt lgkmcnt(0)" ::: "memory"); __builtin_amdgcn_sched_barrier(0);
#define ATT_PK(k) (bf16x8){lo[k][0], lo[k][1], lo[k][2], lo[k][3], hi[k][0], hi[k][1], hi[k][2], hi[k][3]}
        o[d0] = __builtin_amdgcn_mfma_f32_32x32x16_bf16(pa0, ATT_PK(0), o[d0], 0, 0, 0);
        o[d0] = __builtin_amdgcn_mfma_f32_32x32x16_bf16(pa1, ATT_PK(1), o[d0], 0, 0, 0);
        o[d0] = __builtin_amdgcn_mfma_f32_32x32x16_bf16(pa2, ATT_PK(2), o[d0], 0, 0, 0);
        o[d0] = __builtin_amdgcn_mfma_f32_32x32x16_bf16(pa3, ATT_PK(3), o[d0], 0, 0, 0);
#undef ATT_PK
    }
}
template <int MODE>
__device__ __forceinline__ void attn_core(char* shm, const bf16_t* Qw, const bf16_t* Kh, const bf16_t* Vh, bf16_t* Ow, int q0, const int qw0, int t_lo, int t_hi, const int bias_off, float sinkl2, float slope2, const int tid, const float kn2 = 0.f) {
    const int lane = tid & 63, r32 = lane & 31, hi = lane >> 5; const int wid = __builtin_amdgcn_readfirstlane(tid >> 6);
    const unsigned lds0 = (unsigned)(uintptr_t)shm;
    float* wsf = (float*)(shm + LDS_WS) + wid * 64;
    const lds_cptr shm3 = (lds_cptr)shm;
    const bf16_t* ksrc = Kh + (long)lane * DM + wid * 8;
    const bf16_t* vsrc = Vh + (long)(16 * (wid & 3) + (lane >> 2)) * DM + (wid >> 2) * 32 + (lane & 3) * 8;
    const unsigned kdst = lds0 + LDS_K + wid * 1024, vdst = lds0 + LDS_V + wid * 1024;
#define ATT_DMA_K(t, slot) glds16(ksrc + (long)(t) * 64 * DM, (unsigned)__builtin_amdgcn_readfirstlane(kdst + (slot)))
#define ATT_DMA_V(t, slot) glds16(vsrc + (long)(t) * 64 * DM, (unsigned)__builtin_amdgcn_readfirstlane(vdst + (slot)))
    const int vb0 = (int)(lds0 + LDS_V) + ((lane >> 4) & 1) * 32 + (lane & 3) * 8 + (4 * hi + ((lane & 15) >> 2)) * 64;
    const int n = t_hi - t_lo + 1;
    const int w_hi = (qw0 + 31) >> 6;
    const int w_lo = (MODE == 1) ? ((qw0 - 127 > 0 ? qw0 - 127 : 0) >> 6) : t_lo;
    bf16x8 qr[4];
#pragma unroll
    for (int d0 = 0; d0 < 4; ++d0) qr[d0] = *reinterpret_cast<const bf16x8*>(&Qw[(long)r32 * DM + d0 * 16 + hi * 8]);
    ATT_DMA_K(t_hi, 0); ATT_DMA_V(t_hi, 0);
    if (n > 1) { ATT_DMA_K(t_hi - 1, SLOTB); ATT_DMA_V(t_hi - 1, SLOTB); }
    LAS float* mmp = (LAS float*)(shm3 + LDS_MM); LAS float* qmp = (LAS float*)(shm3 + LDS_QM);
    if (MODE == 0) {
        float qs = 0.f;
#pragma unroll
        for (int d0 = 0; d0 < 4; ++d0)
#pragma unroll
            for (int e = 0; e < 8; ++e) { const float v = bf2f((bf16_t)qr[d0][e]); qs += v * v; }
        { auto rr = __builtin_amdgcn_permlane32_swap(__float_as_uint(qs), __float_as_uint(qs), false, false); qs = __uint_as_float(rr[0]) + __uint_as_float(rr[1]); }
        qs = __builtin_fmaxf(qs, shx<1>(qs)); qs = __builtin_fmaxf(qs, shx<2>(qs)); qs = __builtin_fmaxf(qs, shx<4>(qs)); qs = __builtin_fmaxf(qs, shx<8>(qs)); qs = __builtin_fmaxf(qs, shx<16>(qs));
        if (lane == 0) { qmp[wid] = qs; mmp[wid] = -1e30f; mmp[8 + wid] = -1e30f; mmp[16 + wid] = -1e30f; }
    }
    float bqk = 0.f;
    float mhat = 0.f, l_reg = 0.f; f32x16 o[2]; o[0] = f32x16{}; o[1] = f32x16{}; bool first = true;
    float ex[32]; bool pend = false;
#pragma unroll
    for (int r = 0; r < 32; ++r) ex[r] = 0.f;
    const int q = qw0 + r32;
    const int grp = wid >> 2;
#define ATT_LBAR() asm volatile("s_waitcnt lgkmcnt(0)\n\ts_barrier" ::: "memory")
#define ATT_ISSUE(i2) do { if ((i2) < n) { const int sl_ = ((i2) % 3) * SLOTB; ATT_DMA_K(t_hi - (i2), sl_); ATT_DMA_V(t_hi - (i2), sl_); } } while (0)
    if (grp == 1) { if (n > 1) { ATT_WAIT_BAR(2); } else { ATT_WAIT_BAR(0); } }
#pragma unroll 1
    for (int ti = 0; ti < n; ++ti) {
        const int t = t_hi - ti, sl_cur = (ti % 3) * SLOTB;
        const bool need = (t >= w_lo && t <= w_hi);
        if (MODE == 0 && ti >= 2 && (ti & 3) == 2) {
            if (ti == 2) { const f32x4 qa = *(const LAS f32x4*)qmp, qb_ = *(const LAS f32x4*)(qmp + 4);
                const float qn2 = __builtin_fmaxf(__builtin_fmaxf(__builtin_fmaxf(qa[0], qa[1]), __builtin_fmaxf(qa[2], qa[3])), __builtin_fmaxf(__builtin_fmaxf(qb_[0], qb_[1]), __builtin_fmaxf(qb_[2], qb_[3])));
                bqk = __int_as_float(__builtin_amdgcn_readfirstlane(__float_as_int(sqrtf(qn2 * kn2) * 1.02f + 1.0f))); }
            const LAS float* mp = mmp + ((ti - 2) % 3) * 8; const f32x4 ma = *(const LAS f32x4*)mp, mb = *(const LAS f32x4*)(mp + 4);
            const float mm = __builtin_fminf(__builtin_fminf(__builtin_fminf(ma[0], ma[1]), __builtin_fminf(ma[2], ma[3])), __builtin_fminf(__builtin_fminf(mb[0], mb[1]), __builtin_fminf(mb[2], mb[3])));
            const float bmax = *((const LAS float*)(shm3 + LDS_BIAS) + (t - t_lo) * 64 + 63);
            if (__builtin_amdgcn_readfirstlane((int)(bqk + bmax < mm - 160.f))) break;
        }
        if (grp == 0) { if (ti + 1 < n) { ATT_WAIT_BAR(2); } else { ATT_WAIT_BAR(0); } }
        else { ATT_LBAR(); ATT_ISSUE(ti + 2); }
        f32x16 p0, p1;
        if (need) {
            { const LAS float* bp = (const LAS float*)(shm3 + LDS_BIAS) + bias_off + (t - t_lo) * 64 + 4 * hi;
#pragma unroll
              for (int jj = 0; jj < 4; ++jj) { const f32x4 a = *(const LAS f32x4*)(bp + 8 * jj), b = *(const LAS f32x4*)(bp + 32 + 8 * jj);
                  p0[4 * jj] = a[0] - mhat; p0[4 * jj + 1] = a[1] - mhat; p0[4 * jj + 2] = a[2] - mhat; p0[4 * jj + 3] = a[3] - mhat;
                  p1[4 * jj] = b[0] - mhat; p1[4 * jj + 1] = b[1] - mhat; p1[4 * jj + 2] = b[2] - mhat; p1[4 * jj + 3] = b[3] - mhat; } }
            { const lds_cptr kb = shm3 + LDS_K + sl_cur + hi * 1024 + r32 * 16;
              bf16x8 kf0[4], kf1[4];
#pragma unroll
              for (int d0 = 0; d0 < 4; ++d0) { kf0[d0] = *(const LAS bf16x8*)(kb + d0 * 2048); kf1[d0] = *(const LAS bf16x8*)(kb + d0 * 2048 + 512); }
              float sacc = 0.f;
#define ATT_QS4(B) do { sacc += ex[B]; sacc += ex[B + 1]; sacc += ex[B + 2]; sacc += ex[B + 3]; asm volatile("" : "+v"(sacc)); __builtin_amdgcn_sched_barrier(0); } while (0)
              p0 = __builtin_amdgcn_mfma_f32_32x32x16_bf16(kf0[0], qr[0], p0, 0, 0, 0); ATT_QS4(0);
              p1 = __builtin_amdgcn_mfma_f32_32x32x16_bf16(kf1[0], qr[0], p1, 0, 0, 0); ATT_QS4(4);
              p0 = __builtin_amdgcn_mfma_f32_32x32x16_bf16(kf0[1], qr[1], p0, 0, 0, 0); ATT_QS4(8);
              p1 = __builtin_amdgcn_mfma_f32_32x32x16_bf16(kf1[1], qr[1], p1, 0, 0, 0); ATT_QS4(12);
              p0 = __builtin_amdgcn_mfma_f32_32x32x16_bf16(kf0[2], qr[2], p0, 0, 0, 0); ATT_QS4(16);
              p1 = __builtin_amdgcn_mfma_f32_32x32x16_bf16(kf1[2], qr[2], p1, 0, 0, 0); ATT_QS4(20);
              p0 = __builtin_amdgcn_mfma_f32_32x32x16_bf16(kf0[3], qr[3], p0, 0, 0, 0); ATT_QS4(24);
              p1 = __builtin_amdgcn_mfma_f32_32x32x16_bf16(kf1[3], qr[3], p1, 0, 0, 0); ATT_QS4(28);
#undef ATT_QS4
              if (pend) { l_reg += sacc; pend = false; } }
            const float NEG = -__builtin_inff();
            if (MODE == 0) { if (t == w_hi) { const int kb_ = 64 * t + 4 * hi;
#pragma unroll
                for (int r = 0; r < 16; ++r) { const int kv = kb_ + (r & 3) + 8 * (r >> 2); if (kv > q) p0[r] = NEG; if (kv + 32 > q) p1[r] = NEG; } } }
            else { const int kb_ = 64 * t + 4 * hi;
#pragma unroll
                for (int r = 0; r < 16; ++r) { const int kv = kb_ + (r & 3) + 8 * (r >> 2); if ((unsigned)(q - kv) >= 128u) p0[r] = NEG; if ((unsigned)(q - kv - 32) >= 128u) p1[r] = NEG; } }
            const float rm = rowmax(p0, p1);
            if (first || __any(rm > 8.f)) {
                const float dl = first ? __builtin_fmaxf(rm, -1e30f) : __builtin_fmaxf(rm, 0.f); const float f = first ? 1.f : __builtin_amdgcn_exp2f(-dl);
                first = false; mhat += dl; l_reg *= f; if (hi == 0) wsf[r32] = f;
#pragma unroll
                for (int r = 0; r < 16; ++r) { p0[r] -= dl; p1[r] -= dl; }
                asm volatile("s_waitcnt lgkmcnt(0)" ::: "memory");
#pragma unroll
                for (int jj = 0; jj < 4; ++jj) { const f32x4 fv = *(const f32x4*)(wsf + 8 * jj + 4 * hi);
#pragma unroll
                    for (int i2 = 0; i2 < 4; ++i2) { o[0][4 * jj + i2] *= fv[i2]; o[1][4 * jj + i2] *= fv[i2]; } }
            }
            if (MODE == 0 && (ti & 3) == 0) {
                float mn = mhat; mn = __builtin_fminf(mn, shx<1>(mn)); mn = __builtin_fminf(mn, shx<2>(mn)); mn = __builtin_fminf(mn, shx<4>(mn)); mn = __builtin_fminf(mn, shx<8>(mn)); mn = __builtin_fminf(mn, shx<16>(mn));
                if (lane == 0) mmp[(ti % 3) * 8 + wid] = mn; }
        }
        if (grp == 0) { ATT_LBAR(); ATT_ISSUE(ti + 2); }
        else { if (ti + 1 < n) { if (ti + 2 < n) { ATT_WAIT_BAR(2); } else { ATT_WAIT_BAR(0); } } else { ATT_LBAR(); } }
        if (need) {
            const lds_cptr vp = shm3 + LDS_V + sl_cur + ((lane >> 4) & 1) * 32 + (lane & 3) * 8 + (4 * hi + ((lane & 15) >> 2)) * 64;
#define ATT_SB() __builtin_amdgcn_sched_barrier(0)
#define ATT_PIN(x) asm volatile("" : "+v"(x))
#define ATT_VRD(i) do { vlo[i] = vtr(vp + (((i) >> 2) * 4096 + ((i) & 3) * 1024)); vhi[i] = vtr(vp + (((i) >> 2) * 4096 + ((i) & 3) * 1024 + 512)); } while (0)
#define ATT_VF(i) (bf16x8){vlo[i][0], vlo[i][1], vlo[i][2], vlo[i][3], vhi[i][0], vhi[i][1], vhi[i][2], vhi[i][3]}
#define ATT_PIN4(B) asm volatile("" : "+v"(ex[B]), "+v"(ex[B + 1]), "+v"(ex[B + 2]), "+v"(ex[B + 3]))
#define ATT_EX4(P, PB, B) do { ex[B] = __builtin_amdgcn_exp2f(P[PB]); ex[B + 1] = __builtin_amdgcn_exp2f(P[PB + 1]); ex[B + 2] = __builtin_amdgcn_exp2f(P[PB + 2]); ex[B + 3] = __builtin_amdgcn_exp2f(P[PB + 3]); ATT_PIN4(B); } while (0)
#define ATT_PK4(B) (u32x4){cvtpk(ex[B], ex[B + 1]), cvtpk(ex[B + 2], ex[B + 3]), cvtpk(ex[B + 4], ex[B + 5]), cvtpk(ex[B + 6], ex[B + 7])}
#define ATT_SUM4(B) do { sacc += ex[B]; sacc += ex[B + 1]; sacc += ex[B + 2]; sacc += ex[B + 3]; ATT_PIN(sacc); } while (0)
            s16x4 vlo[8], vhi[8]; u32x4 pw0, pw1, pw2, pw3;
            ATT_VRD(0); ATT_VRD(4);
            ATT_EX4(p0, 0, 0); ATT_EX4(p0, 4, 4); pw0 = ATT_PK4(0); ATT_PIN(pw0); ATT_SB();
            o[0] = __builtin_amdgcn_mfma_f32_32x32x16_bf16(__builtin_bit_cast(bf16x8, pw0), ATT_VF(0), o[0], 0, 0, 0); ATT_VRD(1); ATT_EX4(p0, 8, 8); ATT_SB();
            o[1] = __builtin_amdgcn_mfma_f32_32x32x16_bf16(__builtin_bit_cast(bf16x8, pw0), ATT_VF(4), o[1], 0, 0, 0); ATT_VRD(5); ATT_EX4(p0, 12, 12); pw1 = ATT_PK4(8); ATT_PIN(pw1); ATT_SB();
            o[0] = __builtin_amdgcn_mfma_f32_32x32x16_bf16(__builtin_bit_cast(bf16x8, pw1), ATT_VF(1), o[0], 0, 0, 0); ATT_VRD(2); ATT_EX4(p1, 0, 16); ATT_SB();
            o[1] = __builtin_amdgcn_mfma_f32_32x32x16_bf16(__builtin_bit_cast(bf16x8, pw1), ATT_VF(5), o[1], 0, 0, 0); ATT_VRD(6); ATT_EX4(p1, 4, 20); pw2 = ATT_PK4(16); ATT_PIN(pw2); ATT_SB();
            o[0] = __builtin_amdgcn_mfma_f32_32x32x16_bf16(__builtin_bit_cast(bf16x8, pw2), ATT_VF(2), o[0], 0, 0, 0); ATT_VRD(3); ATT_EX4(p1, 8, 24); ATT_SB();
            o[1] = __builtin_amdgcn_mfma_f32_32x32x16_bf16(__builtin_bit_cast(bf16x8, pw2), ATT_VF(6), o[1], 0, 0, 0); ATT_VRD(7); ATT_EX4(p1, 12, 28); pw3 = ATT_PK4(24); ATT_PIN(pw3); ATT_SB();
            o[0] = __builtin_amdgcn_mfma_f32_32x32x16_bf16(__builtin_bit_cast(bf16x8, pw3), ATT_VF(3), o[0], 0, 0, 0); ATT_SB();
            o[1] = __builtin_amdgcn_mfma_f32_32x32x16_bf16(__builtin_bit_cast(bf16x8, pw3), ATT_VF(7), o[1], 0, 0, 0); ATT_SB();
            pend = true;
#undef ATT_SB
#undef ATT_PIN
#undef ATT_VRD
#undef ATT_VF
#undef ATT_EX4
#undef ATT_PK4
#undef ATT_SUM4
#undef ATT_PIN4
        }
    }
    if (pend) { float sacc = 0.f;
#pragma unroll
        for (int r = 0; r < 32; ++r) sacc += ex[r];
        l_reg += sacc; }
    if (grp == 0) { ATT_LBAR(); }
#undef ATT_LBAR
#undef ATT_ISSUE
    { auto rr = __builtin_amdgcn_permlane32_swap(__float_as_uint(l_reg), __float_as_uint(l_reg), false, false); l_reg = __uint_as_float(rr[0]) + __uint_as_float(rr[1]); }
    if (MODE == 1) l_reg += __builtin_amdgcn_exp2f(sinkl2 + slope2 * (float)(qw0 - q0 + r32) - mhat);
    if (hi == 0) wsf[32 + r32] = l_reg;
    asm volatile("s_waitcnt lgkmcnt(0)" ::: "memory");
    float rli[16];
#pragma unroll
    for (int r = 0; r < 16; ++r) rli[r] = __builtin_amdgcn_rcpf(wsf[32 + crow(r, hi)]);
    { bf16_t* stg = (bf16_t*)(shm + LDS_OST) + wid * 2048;
#pragma unroll
      for (int r = 0; r < 16; ++r) { const int orow = crow(r, hi);
#pragma unroll
          for (int d0 = 0; d0 < 2; ++d0) stg[orow * 64 + d0 * 32 + r32] = (bf16_t)(cvtpk(o[d0][r] * rli[r], 0.f) & 0xffffu); }
      asm volatile("s_waitcnt lgkmcnt(0)" ::: "memory");
#pragma unroll
      for (int i = 0; i < 4; ++i) { const int row = i * 8 + (lane >> 3), ch = lane & 7; const u32x4 v = *(const u32x4*)(stg + row * 64 + ch * 8); *(u32x4*)(Ow + (long)row * D + ch * 8) = v; } }
    asm volatile("s_waitcnt vmcnt(0) lgkmcnt(0)\n\ts_barrier" ::: "memory");
#undef ATT_DMA_K
#undef ATT_DMA_V
}
}

__device__ __forceinline__ void p0_tr_item(const float* W, int ld_src, int k0, int n0, bf16_t* d0, bf16_t* d1, bf16_t* d2, int ld_dst, LAS float* scr, int lane) {
    float tv[32];
#pragma unroll
    for (int i = 0; i < 32; ++i) { const int kk = 2 * i + (lane >> 5); tv[i] = W[(size_t)(k0 + kk) * ld_src + n0 + (lane & 31)]; }
#pragma unroll
    for (int i = 0; i < 32; ++i) { const int kk = 2 * i + (lane >> 5); scr[kk * 33 + (lane & 31)] = tv[i]; }
    LDS_WAIT(); asm volatile("" ::: "memory");
    const int c = lane & 7;
#pragma unroll
    for (int j = 0; j < 4; ++j) { const int n = (lane >> 3) + 8 * j; const LAS float* s = scr + (8 * c) * 33 + n;
        u32x4 o; o.x = cvtpk(s[0 * 33], s[1 * 33]); o.y = cvtpk(s[2 * 33], s[3 * 33]); o.z = cvtpk(s[4 * 33], s[5 * 33]); o.w = cvtpk(s[6 * 33], s[7 * 33]);
        *(u32x4*)(d0 + (size_t)n * ld_dst + 8 * c) = o;
        if (d1) *(u32x4*)(d1 + (size_t)n * ld_dst + 8 * c) = o;
        if (d2) *(u32x4*)(d2 + (size_t)n * ld_dst + 8 * c) = o; }
    LDS_WAIT(); asm volatile("" ::: "memory");
}
__device__ __forceinline__ int pair_idx(int lo, int hi) { return lo == 0 ? hi - 1 : (lo == 1 ? hi + 1 : 5); }

__device__ __forceinline__ void phase_p0(Frame& F) {
    __syncthreads();
    {
        LAS float* sc = (LAS float*)F.lds;
        LAS float* red = (LAS float*)(F.lds + 16384);
        float* MOD = (float*)(F.ws + WS_MOD);
        bool have = false;
        for (int task = F.vcu; task < 48; task += F.G) {
            if (!have) { for (int i = F.tid; i < 4096; i += 512) { const float v = F.inp(F_C)[i]; sc[i] = v * sigmoidf_(v); } __syncthreads(); have = true; }
            const int l = task / 24, j0 = (task % 24) * 256;
            const float* wp = F.inp(F_WMOD) + (size_t)l * 1024 * 6144 + j0 + 4 * F.lane;
            f32x4 a0 = {0, 0, 0, 0}, a1 = a0, a2 = a0, a3 = a0;
            const int kbeg = F.wave * 128;
#pragma unroll 8
            for (int k = kbeg; k < kbeg + 128; ++k) { const f32x4 wv = *(const f32x4*)(wp + (size_t)k * 6144);
                a0 += wv * sc[k]; a1 += wv * sc[1024 + k]; a2 += wv * sc[2048 + k]; a3 += wv * sc[3072 + k]; }
            *(LAS f32x4*)(red + (F.wave * 4 + 0) * 256 + 4 * F.lane) = a0; *(LAS f32x4*)(red + (F.wave * 4 + 1) * 256 + 4 * F.lane) = a1;
            *(LAS f32x4*)(red + (F.wave * 4 + 2) * 256 + 4 * F.lane) = a2; *(LAS f32x4*)(red + (F.wave * 4 + 3) * 256 + 4 * F.lane) = a3;
            __syncthreads();
            for (int o = F.tid; o < 1024; o += 512) { const int b = o >> 8, cidx = o & 255; float s = F.inp(F_BMOD)[l * 6144 + j0 + cidx];
#pragma unroll
                for (int w = 0; w < 8; ++w) s += red[(w * 4 + b) * 256 + cidx];
                MOD[(size_t)(l * 4 + b) * 6144 + j0 + cidx] = s; }
            __syncthreads();
        }
        __syncthreads();
    }
    LAS float* scr = (LAS float*)(F.lds + F.wave * 16384);
    const int gw = F.vcu * 8 + F.wave, NGW = F.G * 8;
    bf16_t* WIN = (bf16_t*)(F.ws + WS_WIN); bf16_t* WOUT = (bf16_t*)(F.ws + WS_WOUT); bf16_t* WGU = (bf16_t*)(F.ws + WS_WGU); bf16_t* WDP = (bf16_t*)(F.ws + WS_WDP);
    constexpr int I_IN = 2 * 16 * 64, I_OUT = 2 * 16 * 32, I_GU = 2 * 16 * 2 * 16 * 8, I_DN = 2 * 16 * 4 * 32;
    for (int it = gw; it < I_IN + I_OUT + I_GU + I_DN; it += NGW) {
        int r = it;
        if (r < I_IN) { const int l = r / 1024, kb = (r % 1024) / 64, nb = r % 64;
            p0_tr_item(F.inp(F_WIN) + (size_t)l * 1024 * IN_COLS, IN_COLS, 64 * kb, 32 * nb, WIN + ((size_t)l * 2048 + 32 * nb) * 1024 + 64 * kb, nullptr, nullptr, 1024, scr, F.lane); continue; }
        r -= I_IN;
        if (r < I_OUT) { const int l = r / 512, kb = (r % 512) / 32, nb = r % 32;
            p0_tr_item(F.inp(F_WOUT) + (size_t)l * 1024 * 1024, 1024, 64 * kb, 32 * nb, WOUT + ((size_t)l * 1024 + 32 * nb) * 1024 + 64 * kb, nullptr, nullptr, 1024, scr, F.lane); continue; }
        r -= I_OUT;
        if (r < I_GU) { const int le = r / 256, which = (r % 256) / 128, kb = (r % 128) / 8, nb = r % 8;
            const int j0 = 32 * nb, row = 256 * (j0 >> 7) + (j0 & 127) + which * 128;
            p0_tr_item((which ? F.inp(F_WUP) : F.inp(F_WGATE)) + (size_t)le * 1024 * 256, 256, 64 * kb, j0, WGU + ((size_t)le * 512 + row) * 1024 + 64 * kb, nullptr, nullptr, 1024, scr, F.lane); continue; }
        r -= I_GU;
        { const int le = r / 128, kb = (r % 128) / 32, nb = r % 32; const int l = le >> 4, e = le & 15, g = e >> 2, i = e & 3;
          bf16_t* dst[3]; int nd = 0;
#pragma unroll
          for (int j = 0; j < 4; ++j) { if (j == i) continue; const int lo = i < j ? i : j, hi = i < j ? j : i; const int cls = g * 6 + pair_idx(lo, hi); const int kofs = (i == lo) ? 0 : 256;
              dst[nd++] = WDP + ((size_t)(l * 24 + cls) * 1024 + 32 * nb) * 512 + kofs + 64 * kb; }
          p0_tr_item(F.inp(F_WDOWN) + (size_t)le * 256 * 1024, 1024, 64 * kb, 32 * nb, dst[0], dst[1], dst[2], 512, scr, F.lane); }
    }
}

template <bool PM>
__device__ __forceinline__ void phase_norm1(Frame& F, int l, const float* xin) {
    const bf16_t* Pb = (const bf16_t*)(F.ws + WS_P); const bf16_t* Mb = (const bf16_t*)(F.ws + WS_M); float* XA = (float*)(F.ws + WS_XA);
    LAS float* gpm = (LAS float*)(F.lds + 256);
    const float* MOD = (const float*)(F.ws + WS_MOD) + (size_t)l * 4 * 6144;
    bf16_t* H = (bf16_t*)(F.ws + WS_H); float* CUM = (float*)(F.ws + WS_CUM); float* CTOT = (float*)(F.ws + WS_CTOT);
    LAS float* wtot = (LAS float*)F.lds;
    for (int tile = F.vcu; tile < T / 128; tile += F.G) {
        const int b = tile >> 6, row0 = tile * 128;
        f32x4 g1[4], s1[4], wfc[16];
#pragma unroll
        for (int j = 0; j < 4; ++j) { const int col = 4 * F.lane + 256 * j;
            const f32x4 nm = *(const f32x4*)(F.inp(F_NMIX) + l * 1024 + col), scv = *(const f32x4*)(MOD + b * 6144 + 1024 + col);
            g1[j] = nm * (scv + 1.0f); s1[j] = *(const f32x4*)(MOD + b * 6144 + col);
#pragma unroll
            for (int i = 0; i < 4; ++i) wfc[j * 4 + i] = *(const f32x4*)(F.inp(F_WIN) + ((size_t)l * 1024 + col + i) * IN_COLS + 2048); }
        const f32x4 fb = *(const f32x4*)(F.inp(F_FOXB) + l * 4);
        if (PM) { const float* MODp = (const float*)(F.ws + WS_MOD) + (size_t)(l - 1) * 4 * 6144 + b * 6144;
            for (int i = F.tid; i < 1024; i += 512) { gpm[i] = MODp[2048 + i]; gpm[1024 + i] = MODp[5120 + i]; }
            __syncthreads(); }
        f32x4 run = {0.f, 0.f, 0.f, 0.f}, keep = {0.f, 0.f, 0.f, 0.f};
#pragma unroll 1
        for (int i = 0; i < 16; i += 2) {
            const int row = row0 + F.wave * 16 + i;
            const f32x4* xr0 = (const f32x4*)(xin + (size_t)row * D) + F.lane; const f32x4* xr1 = xr0 + D / 4;
            f32x4 v0[4], v1[4]; float ss0 = 0.f, ss1 = 0.f;
#pragma unroll
            for (int j = 0; j < 4; ++j) { v0[j] = xr0[64 * j]; v1[j] = xr1[64 * j]; }
            if (PM) {
                u32x2 p0[4], p1[4], m0[4], m1[4];
                const u32x2* pr0 = (const u32x2*)(Pb + (size_t)row * D) + F.lane; const u32x2* mr0 = (const u32x2*)(Mb + (size_t)row * D) + F.lane;
#pragma unroll
                for (int j = 0; j < 4; ++j) { p0[j] = pr0[64 * j]; p1[j] = pr0[64 * j + D / 4]; m0[j] = mr0[64 * j]; m1[j] = mr0[64 * j + D / 4]; }
                f32x4* xo0 = (f32x4*)(XA + (size_t)row * D) + F.lane; f32x4* xo1 = xo0 + D / 4;
#pragma unroll
                for (int j = 0; j < 4; ++j) { const f32x4 gm = *(const LAS f32x4*)(gpm + 4 * F.lane + 256 * j), gf = *(const LAS f32x4*)(gpm + 1024 + 4 * F.lane + 256 * j);
                    v0[j] = v0[j] + gm * bf4_to_f32(p0[j]) + gf * bf4_to_f32(m0[j]); v1[j] = v1[j] + gm * bf4_to_f32(p1[j]) + gf * bf4_to_f32(m1[j]);
                    xo0[64 * j] = v0[j]; xo1[64 * j] = v1[j]; }
            }
#pragma unroll
            for (int j = 0; j < 4; ++j) { ss0 += (v0[j].x * v0[j].x + v0[j].y * v0[j].y) + (v0[j].z * v0[j].z + v0[j].w * v0[j].w); ss1 += (v1[j].x * v1[j].x + v1[j].y * v1[j].y) + (v1[j].z * v1[j].z + v1[j].w * v1[j].w); }
            const float rstd0 = 1.0f / sqrtf(wave_sum(ss0) * (1.f / D) + EPS), rstd1 = 1.0f / sqrtf(wave_sum(ss1) * (1.f / D) + EPS);
            f32x4 fa0 = {0.f, 0.f, 0.f, 0.f}, fa1 = {0.f, 0.f, 0.f, 0.f};
            u32x2* o0 = (u32x2*)(H + (size_t)row * D) + F.lane; u32x2* o1 = o0 + D / 4;
#pragma unroll
            for (int j = 0; j < 4; ++j) { const f32x4 h0 = v0[j] * rstd0 * g1[j] + s1[j], h1 = v1[j] * rstd1 * g1[j] + s1[j];
                fa0 += wfc[j * 4 + 0] * h0.x + wfc[j * 4 + 1] * h0.y + wfc[j * 4 + 2] * h0.z + wfc[j * 4 + 3] * h0.w;
                fa1 += wfc[j * 4 + 0] * h1.x + wfc[j * 4 + 1] * h1.y + wfc[j * 4 + 2] * h1.z + wfc[j * 4 + 3] * h1.w;
                u32x2 w; w.x = cvtpk(h0.x, h0.y); w.y = cvtpk(h0.z, h0.w); o0[64 * j] = w; w.x = cvtpk(h1.x, h1.y); w.y = cvtpk(h1.z, h1.w); o1[64 * j] = w; }
            f32x4 lf0, lf1;
#pragma unroll
            for (int e = 0; e < 4; ++e) { const float z0 = wave_sum(fa0[e]) + fb[e], z1 = wave_sum(fa1[e]) + fb[e];
                lf0[e] = fminf(z0, 0.f) - __builtin_amdgcn_logf(1.f + fast_exp(-fabsf(z0))) * 0.6931471805599453f;
                lf1[e] = fminf(z1, 0.f) - __builtin_amdgcn_logf(1.f + fast_exp(-fabsf(z1))) * 0.6931471805599453f; }
            run += lf0; if (F.lane == i) keep = run;
            run += lf1; if (F.lane == i + 1) keep = run;
        }
        if (F.lane == 0) *(LAS f32x4*)(wtot + F.wave * 4) = run;
        __syncthreads();
        f32x4 pre = {0.f, 0.f, 0.f, 0.f}, tot = {0.f, 0.f, 0.f, 0.f};
#pragma unroll
        for (int w = 0; w < 8; ++w) { const f32x4 tv = *(const LAS f32x4*)(wtot + w * 4); if (w < F.wave) pre += tv; tot += tv; }
        if (F.lane < 16) { const int s = (row0 & (SEQ - 1)) + F.wave * 16 + F.lane; const f32x4 cv = keep + pre;
#pragma unroll
            for (int e = 0; e < 4; ++e) CUM[(size_t)(b * 4 + e) * SEQ + s] = cv[e]; }
        if (F.tid == 0) *(f32x4*)(CTOT + (size_t)(b * 64 + (tile & 63)) * 4) = tot;
        __syncthreads();
    }
}

__device__ __forceinline__ void lru_unit(Frame& F, int l, int b, int tt) {
    const bf16_t* PROJ = (const bf16_t*)(F.ws + WS_PROJ);
    float* HLOC = (float*)(F.ws + WS_H); float* PP = HLOC + (size_t)T * 256;
    float* LRUA = (float*)(F.ws + WS_LRUA); float* LRUH = (float*)(F.ws + WS_LRUH);
    LAS bf16_t* xcb = (LAS bf16_t*)F.lds;
    LAS float* gb_ = (LAS float*)(F.lds + 16384);
    const int c = F.tid & 255, sl = F.tid >> 8;
    const int blk = F.wave, kq = F.lane >> 4, nn = F.lane & 15;
    bf16x8 bfr[2][2];
    f32x4 cinit[2][2];
#pragma unroll
    for (int g = 0; g < 2; ++g)
#pragma unroll
        for (int hf = 0; hf < 2; ++hf) { const float* wp = (g ? F.inp(F_LWX) : F.inp(F_LWA)) + ((size_t)(l * 8 + blk) * 32 + 8 * kq) * 32 + 16 * hf + nn;
            u32x4 pk; pk.x = cvtpk(wp[0], wp[32]); pk.y = cvtpk(wp[64], wp[96]); pk.z = cvtpk(wp[128], wp[160]); pk.w = cvtpk(wp[192], wp[224]); bfr[g][hf] = __builtin_bit_cast(bf16x8, pk);
            const float bv = (g ? F.inp(F_LBX) : F.inp(F_LBA))[l * 256 + blk * 32 + 16 * hf + nn]; cinit[g][hf] = (f32x4){bv, bv, bv, bv}; }
    const float cw0 = F.inp(F_CONVW)[(l * 4 + 0) * 256 + c], cw1 = F.inp(F_CONVW)[(l * 4 + 1) * 256 + c], cw2 = F.inp(F_CONVW)[(l * 4 + 2) * 256 + c], cw3 = F.inp(F_CONVW)[(l * 4 + 3) * 256 + c];
    const float cb = F.inp(F_CONVB)[l * 256 + c];
    const float lam = F.inp(F_LAM)[l * 256 + c];
    const float sp = -8.0f * (fmaxf(-lam, 0.f) + log1pf(expf(-fabsf(lam))));
    const int s0 = tt * 128 + sl * 64;
    const bf16_t* xp = PROJ + ((size_t)b * SEQ + s0) * NPROJ + C_XB + c;
    float xm3 = s0 >= 3 ? bf2f(xp[-3 * (long)NPROJ]) : 0.f, xm2 = s0 >= 2 ? bf2f(xp[-2 * (long)NPROJ]) : 0.f, xm1 = s0 >= 1 ? bf2f(xp[-1 * (long)NPROJ]) : 0.f;
    float h = 0.f, P = 1.f;
    bf16_t xr[16];
#pragma unroll
    for (int i = 0; i < 16; ++i) xr[i] = xp[(long)i * NPROJ];
#pragma unroll 1
    for (int sub = 0; sub < 4; ++sub) {
        float xv[16];
#pragma unroll
        for (int i = 0; i < 16; ++i) { const float xc = bf2f(xr[i]); xv[i] = cb + cw0 * xm3 + cw1 * xm2 + cw2 * xm1 + cw3 * xc; xm3 = xm2; xm2 = xm1; xm1 = xc;
            xcb[(sl * 16 + i) * 256 + c] = (bf16_t)(cvtpk(xv[i], 0.f) & 0xffffu); }
        if (sub < 3) {
#pragma unroll
            for (int i = 0; i < 16; ++i) xr[i] = xp[(long)((sub + 1) * 16 + i) * NPROJ]; }
        __syncthreads();
#pragma unroll
        for (int s2 = 0; s2 < 2; ++s2) {
            const bf16x8 af = *(const LAS bf16x8*)(xcb + (s2 * 16 + nn) * 256 + blk * 32 + 8 * kq);
#pragma unroll
            for (int g = 0; g < 2; ++g)
#pragma unroll
                for (int hf = 0; hf < 2; ++hf) { const f32x4 r4 = __builtin_amdgcn_mfma_f32_16x16x32_bf16(af, bfr[g][hf], cinit[g][hf], 0, 0, 0);
                    LAS float* gp = gb_ + ((g * 2 + s2) * 16 + 4 * kq) * 256 + blk * 32 + 16 * hf + nn;
                    gp[0] = r4[0]; gp[256] = r4[1]; gp[512] = r4[2]; gp[768] = r4[3]; }
        }
        __syncthreads();
#pragma unroll
        for (int i = 0; i < 16; ++i) {
            const float ga = gb_[((0 * 2 + sl) * 16 + i) * 256 + c], gx = gb_[((1 * 2 + sl) * 16 + i) * 256 + c];
            const float r = sigmoidf_(ga), ig = sigmoidf_(gx);
            const float la = sp * r; const float a = fast_exp(la);
            const float mult = __builtin_amdgcn_sqrtf(__builtin_fmaxf(1.f - a * a, 0.f));
            const float u = mult * ig * xv[i];
            h = a * h + u; P *= a;
            const size_t off = ((size_t)b * SEQ + s0 + sub * 16 + i) * 256 + c;
            HLOC[off] = h; PP[off] = P;
        }
    }
    const size_t so = ((size_t)(b * 128 + tt * 2 + sl)) * 256 + c;
    LRUA[so] = P; LRUH[so] = h;
    __syncthreads();
}

__device__ __forceinline__ void fox_unit(Frame& F, int l, int b, int h, int qb) {
    const bf16_t* PROJ = (const bf16_t*)(F.ws + WS_PROJ); bf16_t* Y = (bf16_t*)(F.ws + WS_Y);
    const float* CUM = (const float*)(F.ws + WS_CUM) + (size_t)(b * 4 + h) * SEQ; const float* CTOT = (const float*)(F.ws + WS_CTOT);
    LAS float* bias = (LAS float*)(F.lds + att::LDS_BIAS); LAS float* blk = (LAS float*)(F.lds + att::LDS_BLK);
    const int q0 = qb * 256;
    if (F.wave == 0) { const float v = CTOT[(size_t)(b * 64 + F.lane) * 4 + h]; float s = v;
#pragma unroll
        for (int o = 1; o < 64; o <<= 1) { const float t = __int_as_float(__builtin_amdgcn_ds_bpermute(((F.lane - o) & 63) << 2, __float_as_int(s))); if (F.lane >= o) s += t; }
        blk[F.lane] = s - v; }
    __syncthreads();
    const float cref = CUM[q0 + 255] + blk[(q0 + 255) >> 7];
    for (int s = F.tid; s < q0 + 256; s += 512) bias[s] = (cref - (CUM[s] + blk[s >> 7])) * LOG2E;
    __syncthreads();
    float kn2 = 0.f; { const unsigned* km = (const unsigned*)(F.ws + WS_CTL) + CW_KM + l * 128 + (b * 4 + h) * 8;
#pragma unroll
        for (int c = 0; c < 8; ++c) kn2 += __uint_as_float(__hip_atomic_load(km + c, __ATOMIC_RELAXED, __HIP_MEMORY_SCOPE_AGENT)); }
    const size_t rowbase = (size_t)b * SEQ;
    att::attn_core<0>(F.shm, PROJ + (rowbase + q0 + F.wave * 32) * NPROJ + C_QC + h * 64, PROJ + rowbase * NPROJ + C_KC + h * 64, PROJ + rowbase * NPROJ + C_VC + h * 64,
                      Y + (rowbase + q0 + F.wave * 32) * D + 768 + h * 64, q0, q0 + F.wave * 32, 0, (q0 + 255) >> 6, 0, 0.f, 0.f, F.tid, kn2);
}
__device__ __forceinline__ void swa_unit(Frame& F, int l, int b, int kvh, int qb64) {
    const bf16_t* PROJ = (const bf16_t*)(F.ws + WS_PROJ); bf16_t* Y = (bf16_t*)(F.ws + WS_Y);
    LAS float* bias = (LAS float*)(F.lds + att::LDS_BIAS);
    const int q0 = qb64 * 64;
    const int t_lo = (q0 >= 128 ? q0 - 128 : 0) >> 6, t_hi = q0 >> 6, n = t_hi - t_lo + 1;
    for (int i = F.tid; i < 4 * 192; i += 512) { const int hh = i / 192, j = i - hh * 192; const float sl = exp2f(-(float)(kvh * 4 + hh + 1)) * LOG2E;
        if (j < n * 64) bias[i] = sl * (float)(64 * t_lo + j - q0); }
    __syncthreads();
    const int h = kvh * 4 + (F.wave >> 1), qw0 = q0 + 32 * (F.wave & 1);
    const float slope2 = exp2f(-(float)(h + 1)) * LOG2E;
    const size_t rowbase = (size_t)b * SEQ;
    att::attn_core<1>(F.shm, PROJ + (rowbase + qw0) * NPROJ + C_QA + h * 64, PROJ + rowbase * NPROJ + C_KA + kvh * 64, PROJ + rowbase * NPROJ + C_VA + kvh * 64,
                      Y + (rowbase + qw0) * D + h * 64, q0, qw0, t_lo, t_hi, (F.wave >> 1) * 192, F.inp(F_SINKS)[l * 8 + h] * LOG2E, slope2, F.tid);
}
__device__ __forceinline__ void phase_mixer(Frame& F, int l, int qsel) {
    unsigned* qhead = (unsigned*)(F.ws + WS_CTL) + CW_Q + qsel * 64;
    LAS unsigned* qslot = (LAS unsigned*)(F.lds + LDSCTL_OFF + 16);
#pragma unroll 1
    for (;;) {
        frame_refresh(F);
        if (F.tid == 0) qslot[0] = __hip_atomic_fetch_add(qhead, 1u, __ATOMIC_RELAXED, __HIP_MEMORY_SCOPE_AGENT);
        __syncthreads();
        const int u = __builtin_amdgcn_readfirstlane((int)qslot[0]);
        __syncthreads();
        if (u >= 512 + 256 + 1024) break;
        if (u < 512) { if (PH(11)) fox_unit(F, l, (u & 15) >> 2, u & 3, 31 - (u >> 4)); }
        else if (u < 768) { if (PH(10)) lru_unit(F, l, (u - 512) >> 6, (u - 512) & 63); }
        else { if (PH(12)) { const int v = u - 768; swa_unit(F, l, v >> 8, (v >> 7) & 1, v & 127); } }
    }
}

__device__ __forceinline__ void phase_ynorm(Frame& F, int l, bf16_t* YO) {
    const bf16_t* Y = (const bf16_t*)(F.ws + WS_Y); const bf16_t* PROJ = (const bf16_t*)(F.ws + WS_PROJ);
    const float* HLOC = (const float*)(F.ws + WS_H); const float* PP = HLOC + (size_t)T * 256;
    const float* LRUA = (const float*)(F.ws + WS_LRUA); const float* LRUH = (const float*)(F.ws + WS_LRUH);
    LAS float* cs = (LAS float*)F.lds;
    LAS float* carry = (LAS float*)(F.lds + 4096);
    const float* og = F.inp(F_OGAIN) + l * 1024;
    for (int tile = F.vcu; tile < T / 128; tile += F.G) {
        const int b = tile >> 6, tt = tile & 63, j0 = 2 * tt;
        { const int c = F.tid & 255, seg = F.tid >> 8; const int jb = seg ? j0 / 2 : 0, je = seg ? j0 : j0 / 2;
          float A = 1.f, Hh = 0.f;
          int j = jb;
          for (; j + 8 <= je; j += 8) {
              float aj[8], hj[8];
#pragma unroll
              for (int k = 0; k < 8; ++k) { const size_t so = (size_t)(b * 128 + j + k) * 256 + c; aj[k] = LRUA[so]; hj[k] = LRUH[so]; }
#pragma unroll
              for (int k = 0; k < 8; ++k) { Hh = aj[k] * Hh + hj[k]; A *= aj[k]; } }
          for (; j < je; ++j) { const size_t so = (size_t)(b * 128 + j) * 256 + c; const float aj = LRUA[so], hj = LRUH[so]; Hh = aj * Hh + hj; A *= aj; }
          cs[(seg * 2 + 0) * 256 + c] = A; cs[(seg * 2 + 1) * 256 + c] = Hh; }
        __syncthreads();
        if (F.tid < 256) { const int c = F.tid; const float c0 = cs[(2 + 0) * 256 + c] * cs[(0 + 1) * 256 + c] + cs[(2 + 1) * 256 + c];
            const size_t so = (size_t)(b * 128 + j0) * 256 + c; carry[c] = c0; carry[256 + c] = LRUA[so] * c0 + LRUH[so]; }
        __syncthreads();
#pragma unroll 1
        for (int i = 0; i < 16; i += 2) {
            u32x4 ya[2]; u32x2 yc[2], gb[2]; f32x4 hl[2], pp[2], cr[2];
#pragma unroll
            for (int k = 0; k < 2; ++k) { const int rl = F.wave * 16 + i + k; const size_t row = (size_t)tile * 128 + rl; const bf16_t* yr = Y + row * D;
                ya[k] = *(const u32x4*)(yr + 8 * F.lane); yc[k] = *(const u32x2*)(yr + 768 + 4 * F.lane);
                hl[k] = *(const f32x4*)(HLOC + row * 256 + 4 * F.lane); pp[k] = *(const f32x4*)(PP + row * 256 + 4 * F.lane);
                gb[k] = *(const u32x2*)(PROJ + row * NPROJ + C_GB + 4 * F.lane); cr[k] = *(const LAS f32x4*)(carry + (rl >> 6) * 256 + 4 * F.lane); }
#pragma unroll
            for (int k = 0; k < 2; ++k) { const int rl = F.wave * 16 + i + k; const size_t row = (size_t)tile * 128 + rl; bf16_t* yr = YO + row * D;
                float fa[8]; fa[0] = __uint_as_float(ya[k].x << 16); fa[1] = __uint_as_float(ya[k].x & 0xffff0000u); fa[2] = __uint_as_float(ya[k].y << 16); fa[3] = __uint_as_float(ya[k].y & 0xffff0000u);
                fa[4] = __uint_as_float(ya[k].z << 16); fa[5] = __uint_as_float(ya[k].z & 0xffff0000u); fa[6] = __uint_as_float(ya[k].w << 16); fa[7] = __uint_as_float(ya[k].w & 0xffff0000u);
                float sa = 0.f;
#pragma unroll
                for (int e = 0; e < 8; ++e) sa += fa[e] * fa[e];
                float fc[4]; fc[0] = __uint_as_float(yc[k].x << 16); fc[1] = __uint_as_float(yc[k].x & 0xffff0000u); fc[2] = __uint_as_float(yc[k].y << 16); fc[3] = __uint_as_float(yc[k].y & 0xffff0000u);
                const float sc_ = fc[0] * fc[0] + fc[1] * fc[1] + fc[2] * fc[2] + fc[3] * fc[3];
                float fb[4]; { const f32x4 hh = hl[k] + pp[k] * cr[k];
                    fb[0] = hh.x * gelu_tanh(__uint_as_float(gb[k].x << 16)); fb[1] = hh.y * gelu_tanh(__uint_as_float(gb[k].x & 0xffff0000u));
                    fb[2] = hh.z * gelu_tanh(__uint_as_float(gb[k].y << 16)); fb[3] = hh.w * gelu_tanh(__uint_as_float(gb[k].y & 0xffff0000u)); }
                const float sb = fb[0] * fb[0] + fb[1] * fb[1] + fb[2] * fb[2] + fb[3] * fb[3];
                const float ra = 1.0f / sqrtf(wave_sum(sa) * (1.f / 512.f) + EPS), rb = 1.0f / sqrtf(wave_sum(sb) * (1.f / 256.f) + EPS), rc = 1.0f / sqrtf(wave_sum(sc_) * (1.f / 256.f) + EPS);
                { const f32x4 g0 = *(const f32x4*)(og + 8 * F.lane), g1 = *(const f32x4*)(og + 8 * F.lane + 4);
                  u32x4 w; w.x = cvtpk(fa[0] * ra * g0.x, fa[1] * ra * g0.y); w.y = cvtpk(fa[2] * ra * g0.z, fa[3] * ra * g0.w); w.z = cvtpk(fa[4] * ra * g1.x, fa[5] * ra * g1.y); w.w = cvtpk(fa[6] * ra * g1.z, fa[7] * ra * g1.w);
                  *(u32x4*)(yr + 8 * F.lane) = w; }
                { const f32x4 g = *(const f32x4*)(og + 512 + 4 * F.lane); u32x2 w; w.x = cvtpk(fb[0] * rb * g.x, fb[1] * rb * g.y); w.y = cvtpk(fb[2] * rb * g.z, fb[3] * rb * g.w); *(u32x2*)(yr + 512 + 4 * F.lane) = w; }
                { const f32x4 g = *(const f32x4*)(og + 768 + 4 * F.lane); u32x2 w; w.x = cvtpk(fc[0] * rc * g.x, fc[1] * rc * g.y); w.y = cvtpk(fc[2] * rc * g.z, fc[3] * rc * g.w); *(u32x2*)(yr + 768 + 4 * F.lane) = w; }
            }
        }
        __syncthreads();
    }
}

template <int N, int MASK> __device__ __forceinline__ void tr_step(float (&v)[40], bool upper) {
#pragma unroll
    for (int i = 0; i < N / 2; ++i) { const float a = v[i], b = v[i + N / 2]; const float send = upper ? a : b, kp = upper ? b : a; float rcv;
        if constexpr (MASK == 32) { auto rr = __builtin_amdgcn_permlane32_swap(__float_as_uint(send), __float_as_uint(send), false, false); rcv = upper ? __uint_as_float(rr[0]) : __uint_as_float(rr[1]); }
        else rcv = shx<MASK>(send);
        v[i] = kp + rcv; }
}
__device__ __forceinline__ void phase_norm2_router(Frame& F, int l, const float* xa, unsigned* cnt) {
    const float* MOD = (const float*)(F.ws + WS_MOD) + (size_t)l * 4 * 6144;
    bf16_t* H = (bf16_t*)(F.ws + WS_H);
    LEntry* list = (LEntry*)(F.ws + WS_LIST);
    LAS float* wr = (LAS float*)F.lds;
    LAS float* gs = (LAS float*)(F.lds + 81920);
    LAS float* lg = (LAS float*)(F.lds + 90112);
    LAS int* tcls = (LAS int*)(F.lds + 92672);
    LAS float* tw = (LAS float*)(F.lds + 93184);
    LAS int* trank = (LAS int*)(F.lds + 94208);
    LAS unsigned* lcnt = (LAS unsigned*)(F.lds + 94720);
    LAS unsigned* lbase = (LAS unsigned*)(F.lds + 94848);
    const bf16_t* Pb = (const bf16_t*)(F.ws + WS_P); LAS float* gmv = (LAS float*)(F.lds + 98304);
    for (int i = F.tid; i < 1024 * 4; i += 512) { const int k = i >> 2, e = i & 3; wr[e * 1024 + k] = F.inp(F_WRG)[(size_t)l * 4096 + i]; }
    for (int i = F.tid; i < 1024 * 16; i += 512) { const int k = i >> 4, e = i & 15; wr[(4 + e) * 1024 + k] = F.inp(F_WRE)[(size_t)l * 16384 + i]; }
    int cur_b = -1;
    for (int tile = F.vcu; tile < T / 128; tile += F.G) {
        const int b = tile >> 6;
        __syncthreads();
        if (b != cur_b) { for (int i = F.tid; i < 1024; i += 512) { gs[i] = F.inp(F_NFFN)[l * 1024 + i] * (1.f + MOD[b * 6144 + 4096 + i]); gs[1024 + i] = MOD[b * 6144 + 3072 + i]; gmv[i] = MOD[b * 6144 + 2048 + i]; } cur_b = b; }
        if (F.tid < NCLS) lcnt[F.tid] = 0u;
        __syncthreads();
#pragma unroll 1
        for (int grp = 0; grp < 8; ++grp) {
            const size_t row0 = (size_t)tile * 128 + F.wave * 16 + grp * 2;
            f32x4 hv[2][4];
#pragma unroll
            for (int r = 0; r < 2; ++r) { const f32x4* xr = (const f32x4*)(xa + (row0 + r) * D) + F.lane;
#pragma unroll
                for (int j = 0; j < 4; ++j) hv[r][j] = xr[64 * j]; }
            { u32x2 pv_[2][4];
#pragma unroll
              for (int r = 0; r < 2; ++r) { const u32x2* pr = (const u32x2*)(Pb + (row0 + r) * D) + F.lane;
#pragma unroll
                  for (int j = 0; j < 4; ++j) pv_[r][j] = pr[64 * j]; }
#pragma unroll
              for (int j = 0; j < 4; ++j) { const f32x4 gm = *(const LAS f32x4*)(gmv + 4 * F.lane + 256 * j);
                  hv[0][j] = hv[0][j] + gm * bf4_to_f32(pv_[0][j]); hv[1][j] = hv[1][j] + gm * bf4_to_f32(pv_[1][j]); } }
#pragma unroll
            for (int r = 0; r < 2; ++r) { float ss = 0.f;
#pragma unroll
                for (int j = 0; j < 4; ++j) ss += (hv[r][j].x * hv[r][j].x + hv[r][j].y * hv[r][j].y) + (hv[r][j].z * hv[r][j].z + hv[r][j].w * hv[r][j].w);
                const float rstd = 1.0f / sqrtf(wave_sum(ss) * (1.f / D) + EPS);
                u32x2* o8 = (u32x2*)(H + (row0 + r) * D) + F.lane;
#pragma unroll
                for (int j = 0; j < 4; ++j) { const f32x4 g = *(const LAS f32x4*)(gs + 4 * F.lane + 256 * j), s = *(const LAS f32x4*)(gs + 1024 + 4 * F.lane + 256 * j);
                    hv[r][j] = hv[r][j] * rstd * g + s; u32x2 w; w.x = cvtpk(hv[r][j].x, hv[r][j].y); w.y = cvtpk(hv[r][j].z, hv[r][j].w); o8[64 * j] = w; } }
            float acc[40];
#pragma unroll
            for (int e = 0; e < 20; ++e) { float a0 = 0.f, a1 = 0.f;
#pragma unroll
                for (int j = 0; j < 4; ++j) { const f32x4 w = *(const LAS f32x4*)(wr + e * 1024 + 4 * F.lane + 256 * j);
                    a0 += hv[0][j].x * w.x + hv[0][j].y * w.y + hv[0][j].z * w.z + hv[0][j].w * w.w;
                    a1 += hv[1][j].x * w.x + hv[1][j].y * w.y + hv[1][j].z * w.z + hv[1][j].w * w.w; }
                acc[e] = a0; acc[20 + e] = a1; }
            tr_step<40, 32>(acc, (F.lane & 32) != 0); tr_step<20, 16>(acc, (F.lane & 16) != 0); tr_step<10, 8>(acc, (F.lane & 8) != 0);
#pragma unroll
            for (int i = 0; i < 5; ++i) { acc[i] += shx<4>(acc[i]); acc[i] += shx<2>(acc[i]); acc[i] += shx<1>(acc[i]); }
            if ((F.lane & 7) == 0) { const int v0 = 5 * (F.lane >> 3);
#pragma unroll
                for (int i = 0; i < 5; ++i) lg[F.wave * 40 + v0 + i] = acc[i]; }
            LDS_WAIT();
            if (F.lane < 2) {
                const LAS float* q = lg + F.wave * 40 + F.lane * 20;
                float gl[4];
#pragma unroll
                for (int j = 0; j < 4; ++j) gl[j] = q[j] + F.inp(F_BRG)[l * 4 + j];
                int gsel = 0; float gm = gl[0];
#pragma unroll
                for (int j = 1; j < 4; ++j) if (gl[j] > gm) { gm = gl[j]; gsel = j; }
                float den = 0.f;
#pragma unroll
                for (int j = 0; j < 4; ++j) den += expf(gl[j] - gm);
                const float gp = 1.0f / den;
                float el[4];
#pragma unroll
                for (int j = 0; j < 4; ++j) el[j] = q[4 + 4 * gsel + j] + F.inp(F_BRE)[l * 16 + gsel * 4 + j];
                int i1 = 0; float m1 = el[0];
#pragma unroll
                for (int j = 1; j < 4; ++j) if (el[j] > m1) { m1 = el[j]; i1 = j; }
                int i2 = -1; float m2 = -__builtin_inff();
#pragma unroll
                for (int j = 0; j < 4; ++j) if (j != i1 && el[j] > m2) { m2 = el[j]; i2 = j; }
                const float e2 = expf(m2 - m1); const float w1 = gp / (1.f + e2), w2 = gp * e2 / (1.f + e2);
                const int lo = i1 < i2 ? i1 : i2, hi = i1 < i2 ? i2 : i1;
                const int rl = F.wave * 16 + grp * 2 + F.lane;
                tcls[rl] = gsel * 6 + pair_idx(lo, hi); tw[rl * 2] = (i1 < i2) ? w1 : w2; tw[rl * 2 + 1] = (i1 < i2) ? w2 : w1;
            }
        }
        __syncthreads();
        if (F.tid < 128) trank[F.tid] = (int)atomicAdd((unsigned*)&lcnt[tcls[F.tid]], 1u);
        __syncthreads();
        if (F.tid < NCLS) lbase[F.tid] = lcnt[F.tid] ? __hip_atomic_fetch_add(cnt + 64 * F.tid, lcnt[F.tid], __ATOMIC_RELAXED, __HIP_MEMORY_SCOPE_AGENT) : 0u;
        __syncthreads();
        if (F.tid < 128) { const int cls = tcls[F.tid]; const unsigned pos = lbase[cls] + (unsigned)trank[F.tid];
            LEntry e; e.tok = tile * 128 + F.tid; e.w0 = tw[F.tid * 2]; e.w1 = tw[F.tid * 2 + 1]; e.pad = 0; list[(size_t)cls * LCAP + pos] = e; }
    }
    __syncthreads();
}

__device__ __forceinline__ int build_tile_table(Frame& F, int l) {
    unsigned* cnt = (unsigned*)(F.ws + WS_CTL) + CW_CNT + l * NCLS * 64;
    LAS int* tt = (LAS int*)(F.lds + TT_OFF); LAS int* ntl = (LAS int*)(F.lds + TT_OFF + 1024);
    __syncthreads();
    if (F.tid == 0) { int nt = 0;
        for (int c = 0; c < NCLS; ++c) { const unsigned n = __hip_atomic_load(cnt + 64 * c, __ATOMIC_RELAXED, __HIP_MEMORY_SCOPE_AGENT); const int k = (int)((n + 255u) >> 8);
            for (int j = 0; j < k; ++j) tt[nt++] = c | ((j * 256) << 8); }
        ntl[0] = nt; }
    __syncthreads();
    return ntl[0];
}

__device__ __forceinline__ void phase_final(Frame& F, const float* xa, int lp) {
    const bf16_t* Pb = (const bf16_t*)(F.ws + WS_P); const bf16_t* Mb = (const bf16_t*)(F.ws + WS_M); const float* MODp = (const float*)(F.ws + WS_MOD) + (size_t)lp * 4 * 6144;
    const int gw = F.vcu * 8 + F.wave;
    const int rbase = gw * 16; const float* gp = MODp + (rbase >> 13) * 6144;
    f32x4 g[4], gm[4], gf[4];
#pragma unroll
    for (int j = 0; j < 4; ++j) { const int col = 4 * F.lane + 256 * j; g[j] = *(const f32x4*)(F.inp(F_NFIN) + col); gm[j] = *(const f32x4*)(gp + 2048 + col); gf[j] = *(const f32x4*)(gp + 5120 + col); }
#pragma unroll 1
    for (int i = 0; i < 16; i += 2) {
        const int row = rbase + i;
        const f32x4* xr0 = (const f32x4*)(xa + (size_t)row * D) + F.lane; const f32x4* xr1 = xr0 + D / 4;
        const u32x2* pa = (const u32x2*)(Pb + (size_t)row * D) + F.lane; const u32x2* ma = (const u32x2*)(Mb + (size_t)row * D) + F.lane;
        f32x4 v0[4], v1[4]; u32x2 p0[4], p1[4], m0[4], m1[4]; float ss0 = 0.f, ss1 = 0.f;
#pragma unroll
        for (int j = 0; j < 4; ++j) { v0[j] = xr0[64 * j]; v1[j] = xr1[64 * j]; p0[j] = pa[64 * j]; p1[j] = pa[64 * j + D / 4]; m0[j] = ma[64 * j]; m1[j] = ma[64 * j + D / 4]; }
#pragma unroll
        for (int j = 0; j < 4; ++j) { v0[j] = v0[j] + gm[j] * bf4_to_f32(p0[j]) + gf[j] * bf4_to_f32(m0[j]); v1[j] = v1[j] + gm[j] * bf4_to_f32(p1[j]) + gf[j] * bf4_to_f32(m1[j]);
            ss0 += (v0[j].x * v0[j].x + v0[j].y * v0[j].y) + (v0[j].z * v0[j].z + v0[j].w * v0[j].w); ss1 += (v1[j].x * v1[j].x + v1[j].y * v1[j].y) + (v1[j].z * v1[j].z + v1[j].w * v1[j].w); }
        const float rstd0 = 1.0f / sqrtf(wave_sum(ss0) * (1.f / D) + EPS), rstd1 = 1.0f / sqrtf(wave_sum(ss1) * (1.f / D) + EPS);
        f32x4* o0 = (f32x4*)(F.out + (size_t)row * D) + F.lane; f32x4* o1 = o0 + D / 4;
#pragma unroll
        for (int j = 0; j < 4; ++j) { o0[64 * j] = v0[j] * rstd0 * g[j]; o1[64 * j] = v1[j] * rstd1 * g[j]; }
    }
}

__global__ void __launch_bounds__(512, 2) mk_fwd(const Args args) {
    extern __shared__ __attribute__((aligned(16))) unsigned char lds[];
    Frame F;
    F.lds = (LAS unsigned char*)lds; F.shm = (char*)lds;
    F.tid = threadIdx.x; F.lane = F.tid & 63; F.wave = __builtin_amdgcn_readfirstlane(F.tid >> 6);
    F.G = 256; { const int bx = blockIdx.x; __builtin_assume(bx >= 0 && bx < 256); F.vcu = (bx % 8) * 32 + bx / 8; }
    for (int u = F.tid; u < (LDS_BYTES - LDSCTL_OFF) / 4; u += 512) ((LAS unsigned*)(F.lds + LDSCTL_OFF))[u] = 0u;
    __syncthreads();
    F.wave_s = __builtin_amdgcn_readfirstlane((int)threadIdx.x >> 6);
#define REFRESH() frame_refresh(F)
    REFRESH();
    unsigned* ctl = (unsigned*)(F.ws + WS_CTL);
    XcdBarrier bar = xcd_barrier_post(ctl + CW_BAR, (volatile LAS unsigned*)(F.lds + MISC_OFF) + 8);

    for (int rep = 0; rep < DUP(0); ++rep) if (PH(0)) phase_p0(F);
    xcd_barrier(bar, F.tid);
    float* XA = (float*)(F.ws + WS_XA);
    for (int l = 0; l < DEPTH; ++l) {
        const float* xin = (l <= 1) ? F.inp(F_X) : XA;
        const float* xbase = (l == 0) ? F.inp(F_X) : XA;
        const float* MODl = (const float*)(F.ws + WS_MOD) + (size_t)l * 4 * 6144;
        REFRESH();
        for (int rep = 0; rep < DUP(1); ++rep) if (PH(1)) { if (l == 0) phase_norm1<false>(F, l, xin); else phase_norm1<true>(F, l, xin); }
        xcd_barrier(bar, F.tid);
        REFRESH();
        for (int rep = 0; rep < DUP(2); ++rep) if (PH(2)) { pg8::DenseOrder S; S.init(T, NPROJ, F.G, (int)blockIdx.x, F.ws + WS_WIN + (size_t)l * 2048 * 1024 * 2, 2048u, G1REP);
          EpiProj E{(bf16_t*)(F.ws + WS_PROJ), (unsigned*)(F.ws + WS_CTL) + CW_KM + l * 128};
          pg8::gemm_phase<EpiProj, pg8::DenseOrder, true>(F.tid, F.lds, (const char*)(F.ws + WS_H), 2048u, 2048u, 1024, S, E); }
        xcd_barrier(bar, F.tid);
        REFRESH();
        for (int rep = 0; rep < DUP(3); ++rep) if (PH(3)) { phase_mixer(F, l, l + 2 * rep); if (rep + 1 < DUP(3)) xcd_barrier(bar, F.tid); }
        xcd_barrier(bar, F.tid);
        REFRESH();
        for (int rep = 0; rep < DUP(4); ++rep) if (PH(4)) phase_ynorm(F, l, (rep + 1 < DUP(4)) ? (bf16_t*)F.out : (bf16_t*)(F.ws + WS_Y));
        xcd_barrier(bar, F.tid);
        REFRESH();
        for (int rep = 0; rep < DUP(5); ++rep) if (PH(5)) { pg8::DenseOrder S; S.init(T, D, F.G, (int)blockIdx.x, F.ws + WS_WOUT + (size_t)l * 1024 * 1024 * 2, 2048u, (l == 0) ? G2REP : 1);
          EpiP E{(bf16_t*)(F.ws + WS_P)};
          pg8::gemm_phase<EpiP, pg8::DenseOrder, true>(F.tid, F.lds, (const char*)(F.ws + WS_Y), 2048u, 2048u, 1024, S, E); }
        xcd_barrier(bar, F.tid);
        REFRESH();
        for (int rep = 0; rep < DUP(6); ++rep) if (PH(6)) phase_norm2_router(F, l, xbase, (unsigned*)(F.ws + WS_CTL) + ((rep + 1 < DUP(6)) ? 32768 + l * NCLS * 64 : CW_CNT + l * NCLS * 64));
        xcd_barrier(bar, F.tid);
        REFRESH();
        const int ntiles = build_tile_table(F, l);
        const LEntry* list = (const LEntry*)(F.ws + WS_LIST); const unsigned* cnt = (const unsigned*)(F.ws + WS_CTL) + CW_CNT + l * NCLS * 64;
        for (int rep = 0; rep < DUP(7); ++rep) if (PH(7)) { MoeUpOrder S{ntiles * 4, F.G, (int)blockIdx.x, (const LAS int*)(F.lds + TT_OFF), (const char*)(F.ws + WS_WGU + (size_t)l * 16 * 512 * 1024 * 2), list, cnt};
          EpiUp E{(bf16_t*)(F.ws + WS_PROJ), list, cnt};
          pg8::gemm_phase<EpiUp, MoeUpOrder, true>(F.tid, F.lds, (const char*)(F.ws + WS_H), 2048u, 2048u, 1024, S, E); }
        xcd_barrier(bar, F.tid);
        REFRESH();
        for (int rep = 0; rep < DUP(8); ++rep) if (PH(8)) { MoeDownOrder S{ntiles * 4, F.G, (int)blockIdx.x, (const LAS int*)(F.lds + TT_OFF), (const char*)(F.ws + WS_WDP + (size_t)l * 24 * 1024 * 512 * 2)};
          EpiDown E{(bf16_t*)(F.ws + WS_M), list, cnt};
          pg8::gemm_phase<EpiDown, MoeDownOrder, true>(F.tid, F.lds, (const char*)(F.ws + WS_PROJ), 1024u, 1024u, 512, S, E); }
        xcd_barrier(bar, F.tid);
    }
        REFRESH();
    for (int rep = 0; rep < DUP(9); ++rep) if (PH(9)) phase_final(F, (DEPTH == 1) ? F.inp(F_X) : XA, DEPTH - 1);
}

extern "C" void kernel_launch(void* const* d_in, const int* in_sizes, int n_in, void* d_out, int out_size, void* d_ws, size_t ws_size, hipStream_t stream) {
    static int grid = 0;
    if (grid == 0) {
        if (n_in != 26 || in_sizes[0] != T * D || out_size != T * D || ws_size < WS_END) { fprintf(stderr, "kernel_launch: unexpected shapes (n_in %d, in0 %d, out %d, ws %zu)\n", n_in, n_in > 0 ? in_sizes[0] : -1, out_size, ws_size); grid = -1; return; }
        int dev = 0, cus = 0, per_cu = 0;
        if (hipGetDevice(&dev) != hipSuccess || hipDeviceGetAttribute(&cus, hipDeviceAttributeMultiprocessorCount, dev) != hipSuccess) { grid = -1; return; }
        if (hipFuncSetAttribute((const void*)mk_fwd, hipFuncAttributeMaxDynamicSharedMemorySize, LDS_BYTES) != hipSuccess) { fprintf(stderr, "kernel_launch: hipFuncSetAttribute failed\n"); grid = -1; return; }
        if (hipOccupancyMaxActiveBlocksPerMultiprocessor(&per_cu, (const void*)mk_fwd, 512, LDS_BYTES) != hipSuccess || per_cu < 1) fprintf(stderr, "kernel_launch: occupancy query reports %d\n", per_cu);
        (void)hipGetLastError();
        if (cus != 256) fprintf(stderr, "kernel_launch: built for 256 CUs, device reports %d\n", cus);
        grid = 256;
    }
    if (grid < 0) return;
    (void)hipMemsetAsync((char*)d_ws + WS_CTL, 0, CTL_ZERO_BYTES, stream);
    Args a{};
    for (int i = 0; i < 26; ++i) a.in[i] = (const float*)d_in[i];
    a.out = (float*)d_out; a.ws = (unsigned char*)d_ws;
    hipLaunchKernelGGL(mk_fwd, dim3(grid), dim3(512), LDS_BYTES, stream, a);
}
```

```cpp
#include <hip/hip_runtime.h>
#include <hip/hip_bf16.h>
#include <cstdio>
#include <cstdint>

#define GAS __attribute__((address_space(1)))
#define LAS __attribute__((address_space(3)))
typedef unsigned short bf16_t;
typedef short bf16x8 __attribute__((ext_vector_type(8)));
typedef short s16x4 __attribute__((ext_vector_type(4)));
typedef float f32x2 __attribute__((ext_vector_type(2)));
typedef float f32x4 __attribute__((ext_vector_type(4)));
typedef float f32x16 __attribute__((ext_vector_type(16)));
typedef unsigned u32x2 __attribute__((ext_vector_type(2)));
typedef unsigned u32x4 __attribute__((ext_vector_type(4)));
typedef __bf16 bf16x2_t __attribute__((ext_vector_type(2)));

#ifndef DUP_MASK
#define DUP_MASK 0x0u
#endif
#define DUP(n) (1 + (int)((DUP_MASK >> (n)) & 1u))
#ifndef G2REP
#define G2REP 1
#endif
#ifndef G1REP
#define G1REP 1
#endif
#ifndef UPREP
#define UPREP 1
#endif
#ifndef PH_MASK
#define PH_MASK 0xFFFFFFFFu
#endif
#define PH(n) ((PH_MASK >> (n)) & 1u)
constexpr int D = 1024, NB = 4, SEQ = 8192, T = NB * SEQ, DEPTH = 2;
constexpr int IN_COLS = 2052, NPROJ = 2048;
constexpr int C_QA = 0, C_KA = 512, C_VA = 640, C_XB = 768, C_GB = 1024, C_QC = 1280, C_KC = 1536, C_VC = 1792;
constexpr int NCLS = 24, LCAP = 32768;
constexpr float EPS = 1e-6f;
constexpr float LOG2E = 1.4426950408889634f;
constexpr float C2 = 0.125f * 1.4426950408889634f;

constexpr size_t MiB = 1u << 20;
constexpr size_t WS_CTL = 0, CTL_ZERO_BYTES = 1 * MiB;
constexpr size_t WS_MOD = 1 * MiB;
constexpr size_t WS_CUM = WS_MOD + 256 * 1024;
constexpr size_t WS_CTOT = WS_CUM + 512 * 1024;
constexpr size_t WS_LRUA = 2 * MiB;
constexpr size_t WS_LRUH = WS_LRUA + 512 * 1024;
constexpr size_t WS_LIST = 4 * MiB;
constexpr size_t WS_WIN = 16 * MiB;
constexpr size_t WS_WOUT = 24 * MiB;
constexpr size_t WS_WGU = 28 * MiB;
constexpr size_t WS_WDP = 60 * MiB;
constexpr size_t WS_XA = 108 * MiB;
constexpr size_t WS_H = 236 * MiB;
constexpr size_t WS_PROJ = 300 * MiB;
constexpr size_t WS_Y = 428 * MiB;
constexpr size_t WS_P = WS_PROJ + 64 * MiB;
constexpr size_t WS_M = WS_Y;
constexpr size_t WS_END = 492 * MiB;
constexpr int CW_BAR = 4096;
constexpr int CW_KM = 20480;
constexpr int CW_Q = 21504;
constexpr int CW_CNT = 16384;

struct LEntry { int tok; float w0, w1; int pad; };

constexpr int RING_BYTES = 131072;
constexpr int LDSCTL_OFF = RING_BYTES;
constexpr int MISC_OFF = LDSCTL_OFF + 320;
constexpr int TT_OFF = LDSCTL_OFF + 1024;
constexpr int LDS_BYTES = 147456;

__device__ __forceinline__ unsigned cvtpk(float lo, float hi) { f32x2 v = {lo, hi}; bf16x2_t b = __builtin_convertvector(v, bf16x2_t); return __builtin_bit_cast(unsigned, b); }
__device__ __forceinline__ float bf2f(bf16_t v) { return __builtin_bit_cast(float, (unsigned)v << 16); }
__device__ __forceinline__ f32x4 bf4_to_f32(u32x2 v) { return (f32x4){__uint_as_float(v.x << 16), __uint_as_float(v.x & 0xffff0000u), __uint_as_float(v.y << 16), __uint_as_float(v.y & 0xffff0000u)}; }
template <int M> __device__ __forceinline__ float shx(float v) {
    return __int_as_float(__builtin_amdgcn_ds_swizzle(__float_as_int(v), (M << 10) | 0x1f));
}
__device__ __forceinline__ float wave_sum(float v) {
    v += shx<1>(v); v += shx<2>(v); v += shx<4>(v); v += shx<8>(v); v += shx<16>(v);
    auto rr = __builtin_amdgcn_permlane32_swap(__float_as_uint(v), __float_as_uint(v), false, false);
    return __uint_as_float(rr[0]) + __uint_as_float(rr[1]);
}
__device__ __forceinline__ float fast_exp(float x) { return __builtin_amdgcn_exp2f(x * LOG2E); }
__device__ __forceinline__ float sigmoidf_(float x) { return __builtin_amdgcn_rcpf(1.f + fast_exp(-x)); }
__device__ __forceinline__ float gelu_tanh(float x) {
    const float u = 0.7978845608028654f * (x + 0.044715f * x * x * x);
    const float e = fast_exp(2.f * u);
    const float th = 1.f - 2.f * __builtin_amdgcn_rcpf(e + 1.f);
    return 0.5f * x * (1.f + th);
}
#define LDS_WAIT() asm volatile("s_waitcnt lgkmcnt(0)" ::: "memory")
#define VM_WAIT() asm volatile("s_waitcnt vmcnt(0)" ::: "memory")

namespace pg8 {
constexpr int BM = 256, BK = 64, HALF = 128, HTB = HALF * BK * 2, STAGE_BYTES = 8 * HTB, NXCD = 8, WGM = 8;
__host__ __device__ __forceinline__ int lds_byte(int r, int c) { const int st = (r >> 4) * 2 + (c >> 5), rr = r & 15, cc = c & 31, ob = rr * 64 + cc * 2; return st * 1024 + (ob ^ (((ob >> 9) & 1) << 5)); }
__host__ __device__ __forceinline__ void stage_rc(int b, int& R, int& C) { const int st = b / 1024, sb = b % 1024, swz = sb ^ (((sb >> 9) & 1) << 5); R = (st >> 1) * 16 + swz / 64; C = (st & 1) * 32 + (swz % 64) / 2; }
__host__ __device__ __forceinline__ int perm32(int rho) { const int n = rho >> 4, i = rho & 15; return 8 * (i >> 2) + 4 * n + (i & 3); }

struct GUnit { int a0; const char* bb; int e0, e1, e2, e3; };

__device__ __forceinline__ int xcd_remap(int L, int nwg) {
    const int q = nwg / NXCD, r = nwg % NXCD, xcd = L % NXCD, off = L / NXCD;
    return (xcd < r ? xcd * (q + 1) : r * (q + 1) + (xcd - r) * q) + off;
}

struct DenseOrder {
    int nM, nN, nwg, G, c, rep; const char* Bt; unsigned pitchB;
    __device__ __forceinline__ void init(int M, int N, int G_, int c_, const void* Bt_, unsigned pitchB_, int rep_ = 1) { nM = M / BM; nN = N / BM; nwg = nM * nN; G = G_; c = c_; Bt = (const char*)Bt_; pitchB = pitchB_; rep = rep_; }
    __device__ __forceinline__ bool next(int i, GUnit& u) const {
        const long L = (long)i * G + c; if (L >= (long)nwg * rep) return false;
        const int wgid = xcd_remap((int)(L % nwg), nwg);
        const int nig = WGM * nN, gid = wgid / nig, fm = gid * WGM, gsz = (nM - fm) < WGM ? (nM - fm) : WGM;
        const int pm = fm + ((wgid % nig) % gsz), pn = (wgid % nig) / gsz;
        u.a0 = pm * BM; u.bb = Bt + (size_t)pn * BM * pitchB; u.e0 = pm; u.e1 = pn; u.e2 = 0; u.e3 = 0; return true;
    }
    __device__ __forceinline__ unsigned arow(const GUnit& u, int r) const { return (unsigned)(u.a0 + r); }
};

#define PG8_SA(b, h) (((b) * 2 + (h)) * HTB)
#define PG8_SB(b, h) ((4 + (b) * 2 + (h)) * HTB)
#define PG8_STG(bufoff, gptr, v0, v1) do { \
        __builtin_amdgcn_global_load_lds((const unsigned*)((const char*)(gptr) + (v0)), (LAS unsigned*)(lds + (bufoff) + ldsw), 16, 0, 0); \
        __builtin_amdgcn_global_load_lds((const unsigned*)((const char*)(gptr) + (v1)), (LAS unsigned*)(lds + (bufoff) + ldsw + 8192), 16, 0, 0); } while (0)
#define PG8_STGA(bufoff, kb, vo) PG8_STG(bufoff, Abase + (kb), (vo)[0], (vo)[1])
#define PG8_STGB(bufoff, bp) PG8_STG(bufoff, bp, voffB[0], voffB[1])
#define PG8_LDA(dst, b, h) do { _Pragma("unroll") for (int m = 0; m < 4; ++m) _Pragma("unroll") for (int k = 0; k < 2; ++k) dst[m][k] = *(const LAS bf16x8*)(lds + PG8_SA(b, h) + aoff + m * 2048 + k * 1024); } while (0)
#define PG8_LDB(dst, b, h) do { _Pragma("unroll") for (int n = 0; n < 2; ++n) _Pragma("unroll") for (int k = 0; k < 2; ++k) dst[n][k] = *(const LAS bf16x8*)(lds + PG8_SB(b, h) + boff + n * 2048 + k * 1024); } while (0)
#define PG8_MMA(ai, bj, At, Bt) do { __builtin_amdgcn_s_setprio(1); _Pragma("unroll") for (int m = 0; m < 4; ++m) _Pragma("unroll") for (int n = 0; n < 2; ++n) _Pragma("unroll") for (int k = 0; k < 2; ++k) \
        acc[ai][bj][m][n] = __builtin_amdgcn_mfma_f32_16x16x32_bf16(Bt[n][k], At[m][k], acc[ai][bj][m][n], 0, 0, 0); __builtin_amdgcn_s_setprio(0); } while (0)
#define PG8_WAIT_V(n) asm volatile("s_waitcnt vmcnt(" #n ")" ::: "memory")
#define PG8_WAIT_L(n) asm volatile("s_waitcnt lgkmcnt(" #n ")" ::: "memory")
#define PG8_BAR __builtin_amdgcn_s_barrier()
#define PG8_SCHED __builtin_amdgcn_sched_barrier(0)

template <class Epi, class Sched, bool ALIGN_EPI>
__device__ __forceinline__ void gemm_phase(const int tid, LAS unsigned char* lds, const char* Abase, unsigned pitchA, unsigned pitchB, int K, const Sched& S, const Epi& E) {
    const int wid = __builtin_amdgcn_readfirstlane(tid >> 6), lane = tid & 63, wr = wid >> 2, wc = wid & 3, fr = lane & 15, fq = lane >> 4;
    const int nt = K / BK;
    int RA[2]; unsigned cA2[2], voffB[2];
#pragma unroll
    for (int i = 0; i < 2; ++i) { int R, C; stage_rc(tid * 16 + i * 8192, R, C); const int Rb = Epi::PERM ? ((R & ~31) + perm32(R & 31)) : R;
        RA[i] = R; cA2[i] = (unsigned)C * 2u; voffB[i] = (unsigned)Rb * pitchB + (unsigned)C * 2u; }
    const unsigned hstepB = (unsigned)HALF * pitchB;
    const unsigned ldsw = (unsigned)wid * 1024u;
    const int aoff = lds_byte(wr * 64 + fr, fq * 8), boff = lds_byte(wc * 32 + fr, fq * 8);
    GUnit cur, nxt; int ui = 0;
    if (!S.next(0, cur)) return;
    f32x4 acc[2][2][4][2];
#pragma unroll
    for (int a = 0; a < 2; ++a)
#pragma unroll
        for (int b = 0; b < 2; ++b)
#pragma unroll
            for (int m = 0; m < 4; ++m)
#pragma unroll
                for (int n = 0; n < 2; ++n) acc[a][b][m][n] = (f32x4){0.f, 0.f, 0.f, 0.f};
    bf16x8 At[4][2], B0[2][2], B1[2][2];
    unsigned voA[2][2];
#pragma unroll
    for (int h = 0; h < 2; ++h)
#pragma unroll
        for (int i = 0; i < 2; ++i) voA[h][i] = S.arow(cur, h * HALF + RA[i]) * pitchA + cA2[i];
    const char* cB = cur.bb;
    const unsigned kstep = BK * 2;
    PG8_STGB(PG8_SB(0, 0), cB); PG8_STGB(PG8_SB(0, 1), cB + hstepB); PG8_STGA(PG8_SA(0, 0), 0, voA[0]); PG8_STGA(PG8_SA(0, 1), 0, voA[1]);
    if (wr == 1) PG8_BAR;
    PG8_WAIT_V(2); PG8_BAR;
    PG8_STGB(PG8_SB(1, 0), cB + kstep); PG8_STGA(PG8_SA(1, 0), kstep, voA[0]); PG8_STGB(PG8_SB(1, 1), cB + hstepB + kstep);
    PG8_WAIT_V(6); PG8_BAR;
    for (;;) {
        const bool has_next = S.next(ui + 1, nxt);
        const char* nB = has_next ? nxt.bb : cB;
        for (int t = 0; t < nt; t += 2) {
            const bool last = (t == nt - 2);
            const unsigned kb1 = (unsigned)(t + 1) * kstep;
            const unsigned kb2 = last ? 0u : (unsigned)(t + 2) * kstep, kb3 = kb2 + kstep;
            const char* b2 = last ? nB : cB + (size_t)(t + 2) * kstep; const char* b3 = b2 + kstep;
            PG8_LDB(B0, 0, 0); PG8_LDB(B1, 0, 1); PG8_SCHED; PG8_LDA(At, 0, 0); PG8_STGA(PG8_SA(1, 1), kb1, voA[1]);
            if (last && has_next) {
#pragma unroll
                for (int h = 0; h < 2; ++h)
#pragma unroll
                    for (int i = 0; i < 2; ++i) voA[h][i] = S.arow(nxt, h * HALF + RA[i]) * pitchA + cA2[i]; }
            PG8_WAIT_V(8); PG8_WAIT_L(0); PG8_BAR; PG8_MMA(0, 0, At, B0); PG8_MMA(0, 1, At, B1); PG8_BAR; PG8_SCHED;
            PG8_LDA(At, 0, 1); PG8_STGB(PG8_SB(0, 0), b2); PG8_STGB(PG8_SB(0, 1), b2 + hstepB); PG8_STGA(PG8_SA(0, 0), kb2, voA[0]);
            PG8_WAIT_V(8); PG8_WAIT_L(0); PG8_BAR; PG8_MMA(1, 0, At, B0); PG8_MMA(1, 1, At, B1); PG8_BAR; PG8_SCHED;
            PG8_LDB(B0, 1, 0); PG8_LDB(B1, 1, 1); PG8_SCHED; PG8_LDA(At, 1, 0); PG8_STGA(PG8_SA(0, 1), kb2, voA[1]);
            PG8_WAIT_V(8); PG8_WAIT_L(0); PG8_BAR; PG8_MMA(0, 0, At, B0); PG8_MMA(0, 1, At, B1); PG8_BAR; PG8_SCHED;
            PG8_LDA(At, 1, 1); PG8_STGB(PG8_SB(1, 0), b3); PG8_STGB(PG8_SB(1, 1), b3 + hstepB); PG8_STGA(PG8_SA(1, 0), kb3, voA[0]);
            PG8_WAIT_V(8); PG8_WAIT_L(0); PG8_BAR; PG8_MMA(1, 0, At, B0); PG8_MMA(1, 1, At, B1); PG8_BAR; PG8_SCHED;
        }
        if constexpr (ALIGN_EPI) { if (wr == 0) PG8_BAR; }
        E(acc, cur, wr, wc, fr, fq);
        if (!has_next) break;
#pragma unroll
        for (int a = 0; a < 2; ++a)
#pragma unroll
            for (int b = 0; b < 2; ++b)
#pragma unroll
                for (int m = 0; m < 4; ++m)
#pragma unroll
                    for (int n = 0; n < 2; ++n) acc[a][b][m][n] = (f32x4){0.f, 0.f, 0.f, 0.f};
        cur = nxt; cB = nB; ++ui;
        if constexpr (ALIGN_EPI) { if (wr == 1) PG8_BAR; }
    }
    PG8_WAIT_V(0);
    if constexpr (!ALIGN_EPI) { if (wr == 0) PG8_BAR; }
    PG8_BAR;
}
}

#define XB_TMO      128
#define XB_XCNT(j)  (256  + 64 * (j))
#define XB_XSUB(j)  (1280 + 64 * (j))
#define XB_XGEN(j)  (2304 + 64 * (j))
#define XB_TOP      3328
#define XB_TOPGEN   3392
#define XCD_BAR_WORDS 3456
#define XB_SPIN_CAP (1u << 18)
__device__ __forceinline__ unsigned xb_ld(unsigned* p)              { return __hip_atomic_load(p, __ATOMIC_RELAXED, __HIP_MEMORY_SCOPE_AGENT); }
__device__ __forceinline__ unsigned xb_add(unsigned* p, unsigned v) { return __hip_atomic_fetch_add(p, v, __ATOMIC_RELAXED, __HIP_MEMORY_SCOPE_AGENT); }
__device__ __forceinline__ unsigned xb_xcc_id() { return (unsigned)__builtin_amdgcn_s_getreg((3 << 11) | 20) & 0xFu; }
#define XB_SPIN(cond, bar) do { unsigned _sp = 0; while (cond) { __builtin_amdgcn_s_sleep(1); \
    if ((++_sp & 255u) == 0u) { if (xb_ld(&(bar)[XB_TMO])) break; if (_sp > XB_SPIN_CAP) { atomicAdd(&(bar)[XB_TMO], 1u); break; } } } } while (0)
struct XcdBarrier { unsigned* bar; unsigned x; volatile LAS unsigned* st; };
__device__ __forceinline__ XcdBarrier xcd_barrier_post(unsigned* bar, volatile LAS unsigned* st) {
    XcdBarrier b; b.bar = bar; b.x = xb_xcc_id(); b.st = st;
    if (threadIdx.x == 0) (void)xb_add(&bar[XB_XCNT(b.x)], 1u);
    return b;
}
__device__ __forceinline__ void xcd_barrier_complete(unsigned* bar, unsigned x, unsigned& nloc, unsigned& nx) {
    const unsigned G = gridDim.x * gridDim.y * gridDim.z;
    unsigned sum, cnt, mine, sp = 0u;
    for (;;) {
        sum = 0u; cnt = 0u; mine = 0u;
#pragma unroll
        for (unsigned j = 0; j < 16; ++j) { const unsigned c = xb_ld(&bar[XB_XCNT(j)]); sum += c; cnt += (c > 0u) ? 1u : 0u; mine = (j == x) ? c : mine; }
        if (sum == G) break;
        __builtin_amdgcn_s_sleep(1);
        if ((++sp & 255u) == 0u) { if (xb_ld(&bar[XB_TMO])) break; if (sp > XB_SPIN_CAP) { atomicAdd(&bar[XB_TMO], 1u); break; } }
    }
    nloc = mine > 0u ? mine : 1u; nx = cnt > 0u ? cnt : 1u;
}
__device__ __forceinline__ void xcd_barrier(const XcdBarrier& b, const int tid) {
    asm volatile("s_waitcnt vmcnt(0)" ::: "memory");
    __syncthreads();
    if (tid == 0) {
        unsigned* bar = b.bar; const unsigned bx_ = xb_xcc_id();
        __builtin_amdgcn_s_waitcnt(0);
        unsigned nloc = b.st[0], nx = b.st[1];
        if (nloc == 0u) { xcd_barrier_complete(bar, bx_, nloc, nx); b.st[0] = nloc; b.st[1] = nx; }
        const unsigned old = xb_add(&bar[XB_XSUB(bx_)], 1u);
        const unsigned gen = old / nloc;
        if (old + 1u == (gen + 1u) * nloc) {
            __builtin_amdgcn_fence(__ATOMIC_RELEASE, "agent");
            asm volatile("s_waitcnt vmcnt(0)" ::: "memory");
            const unsigned og = xb_add(&bar[XB_TOP], 1u);
            const unsigned tg = og / nx;
            if (og + 1u == (tg + 1u) * nx) xb_add(&bar[XB_TOPGEN], 1u);
            else XB_SPIN(xb_ld(&bar[XB_TOPGEN]) == tg, bar);
            __builtin_amdgcn_fence(__ATOMIC_ACQUIRE, "agent");
            xb_add(&bar[XB_XGEN(bx_)], 1u);
            asm volatile("s_waitcnt vmcnt(0)" ::: "memory");
        } else {
            XB_SPIN(xb_ld(&bar[XB_XGEN(bx_)]) == gen, bar);
            __builtin_amdgcn_fence(__ATOMIC_ACQUIRE, "agent");
            asm volatile("s_waitcnt vmcnt(0)" ::: "memory");
        }
    }
    __syncthreads();
}

__device__ __forceinline__ const void* launder_ptr(const void* p) {
    unsigned lo = (unsigned)(uintptr_t)p, hi = (unsigned)((uintptr_t)p >> 32);
    asm volatile("" : "+v"(lo), "+v"(hi));
    lo = __builtin_amdgcn_readfirstlane(lo); hi = __builtin_amdgcn_readfirstlane(hi);
    return (const void*)(((uintptr_t)hi << 32) | (uintptr_t)lo);
}
struct Args { const float* in[26]; float* out; unsigned char* ws; };

__device__ __forceinline__ const void* karg_ptr(int idx) {
    const unsigned long long ka = (unsigned long long)__builtin_amdgcn_kernarg_segment_ptr();
    unsigned long long v; asm volatile("s_load_dwordx2 %0, %1, %2\n\ts_waitcnt lgkmcnt(0)" : "=s"(v) : "s"(ka), "s"(idx * 8) : "memory");
    return (const void*)(GAS const void*)(uintptr_t)v;
}
struct Frame {
    LAS unsigned char* lds; char* shm;
    int tid, lane, wave, vcu, G;
    float* out; unsigned char* ws; int wave_s;
    __device__ __forceinline__ const float* inp(int i) const { return (const float*)karg_ptr(i); }
};
__device__ __forceinline__ void frame_refresh(Frame& F) {
    asm volatile("" ::: "memory");
    int t_; asm volatile("v_mbcnt_lo_u32_b32 %0, -1, 0\n\tv_mbcnt_hi_u32_b32 %0, -1, %0" : "=v"(t_)); t_ |= (F.wave_s << 6);
    F.tid = t_; F.lane = t_ & 63; F.wave = __builtin_amdgcn_readfirstlane(t_ >> 6);
    F.out = (float*)karg_ptr(26); F.ws = (unsigned char*)karg_ptr(27);
}
#define F_X 0
#define F_C 1
#define F_WMOD 2
#define F_BMOD 3
#define F_NMIX 4
#define F_NFFN 5
#define F_WIN 6
#define F_WOUT 7
#define F_OGAIN 8
#define F_SINKS 9
#define F_CONVW 10
#define F_CONVB 11
#define F_LWA 12
#define F_LBA 13
#define F_LWX 14
#define F_LBX 15
#define F_LAM 16
#define F_FOXB 17
#define F_WRG 18
#define F_BRG 19
#define F_WRE 20
#define F_BRE 21
#define F_WGATE 22
#define F_WUP 23
#define F_WDOWN 24
#define F_NFIN 25

struct EpiProj {
    static constexpr bool PERM = true;
    bf16_t* O; unsigned* km;
    __device__ __forceinline__ void operator()(const f32x4 (&acc)[2][2][4][2], const pg8::GUnit& u, int wr, int wc, int fr, int fq) const {
        const int row0 = u.e0 * 256 + wr * 64 + fr, pn = u.e1;
        const float sc = (pn == 0 || pn == 1 || pn == 5) ? C2 : 1.f;
        const int col0 = pn * 256 + wc * 32 + 8 * fq;
#pragma unroll
        for (int ai = 0; ai < 2; ++ai)
#pragma unroll
            for (int m = 0; m < 4; ++m) { bf16_t* rowp = O + (size_t)(row0 + ai * 128 + m * 16) * NPROJ + col0;
#pragma unroll
                for (int bj = 0; bj < 2; ++bj) { const f32x4 v0 = acc[ai][bj][m][0] * sc, v1 = acc[ai][bj][m][1] * sc;
                    u32x4 w; w.x = cvtpk(v0[0], v0[1]); w.y = cvtpk(v0[2], v0[3]); w.z = cvtpk(v1[0], v1[1]); w.w = cvtpk(v1[2], v1[3]);
                    *(u32x4*)(rowp + bj * 128) = w; } }
        if (pn == 6) {
            const int b = u.e0 >> 5;
#pragma unroll
            for (int bj = 0; bj < 2; ++bj) { float mx = 0.f;
#pragma unroll
                for (int ai = 0; ai < 2; ++ai)
#pragma unroll
                    for (int m = 0; m < 4; ++m) { const f32x4 v0 = acc[ai][bj][m][0], v1 = acc[ai][bj][m][1];
                        mx = __builtin_fmaxf(mx, (v0[0] * v0[0] + v0[1] * v0[1]) + (v0[2] * v0[2] + v0[3] * v0[3]) + (v1[0] * v1[0] + v1[1] * v1[1]) + (v1[2] * v1[2] + v1[3] * v1[3])); }
                mx = __builtin_fmaxf(mx, shx<1>(mx)); mx = __builtin_fmaxf(mx, shx<2>(mx)); mx = __builtin_fmaxf(mx, shx<4>(mx)); mx = __builtin_fmaxf(mx, shx<8>(mx));
                if (fr == 0) atomicMax(km + ((b * 4 + 2 * bj + (wc >> 1)) * 8 + 4 * (wc & 1) + fq), __float_as_uint(mx)); }
        }
    }
};
struct EpiP {
    static constexpr bool PERM = true;
    bf16_t* P;
    __device__ __forceinline__ void operator()(const f32x4 (&acc)[2][2][4][2], const pg8::GUnit& u, int wr, int wc, int fr, int fq) const {
        const int row0 = u.e0 * 256 + wr * 64 + fr, col0 = u.e1 * 256 + wc * 32 + 8 * fq;
#pragma unroll
        for (int ai = 0; ai < 2; ++ai)
#pragma unroll
            for (int m = 0; m < 4; ++m) { bf16_t* rowp = P + (size_t)(row0 + ai * 128 + m * 16) * D + col0;
#pragma unroll
                for (int bj = 0; bj < 2; ++bj) { const f32x4 v0 = acc[ai][bj][m][0], v1 = acc[ai][bj][m][1];
                    u32x4 w; w.x = cvtpk(v0[0], v0[1]); w.y = cvtpk(v0[2], v0[3]); w.z = cvtpk(v1[0], v1[1]); w.w = cvtpk(v1[2], v1[3]);
                    *(u32x4*)(rowp + bj * 128) = w; } }
    }
};
struct EpiUp {
    static constexpr bool PERM = true;
    bf16_t* HID; const LEntry* list; const unsigned* cnt;
    __device__ __forceinline__ void operator()(const f32x4 (&acc)[2][2][4][2], const pg8::GUnit& u, int wr, int wc, int fr, int fq) const {
        const int pn = u.e1, slot = pn >> 1, pnl = pn & 1, cls = u.e2;
        const unsigned n = __hip_atomic_load(cnt + 64 * cls, __ATOMIC_RELAXED, __HIP_MEMORY_SCOPE_AGENT);
        const int colh = 256 * slot + 128 * pnl + wc * 32 + 8 * fq;
        float wrow[8];
#pragma unroll
        for (int k = 0; k < 8; ++k) { const int r = (k >> 2) * 128 + wr * 64 + (k & 3) * 16 + fr; const unsigned pos = (unsigned)(u.e3 + r);
            const LEntry* e = list + (size_t)cls * LCAP + (pos < n ? pos : 0u); const float w = slot ? e->w1 : e->w0; wrow[k] = pos < n ? w : 0.f; }
#pragma unroll
        for (int ai = 0; ai < 2; ++ai)
#pragma unroll
            for (int m = 0; m < 4; ++m) { const int r = ai * 128 + wr * 64 + m * 16 + fr; const float w = wrow[ai * 4 + m];
                float h[8];
#pragma unroll
                for (int nn = 0; nn < 2; ++nn)
#pragma unroll
                    for (int i = 0; i < 4; ++i) { const float g = acc[ai][0][m][nn][i], up = acc[ai][1][m][nn][i]; h[nn * 4 + i] = g * sigmoidf_(g) * up * w; }
                u32x4 o; o.x = cvtpk(h[0], h[1]); o.y = cvtpk(h[2], h[3]); o.z = cvtpk(h[4], h[5]); o.w = cvtpk(h[6], h[7]);
                *(u32x4*)(HID + (size_t)(u.e0 * 256 + r) * 512 + colh) = o; }
    }
};
struct EpiDown {
    static constexpr bool PERM = true;
    bf16_t* M; const LEntry* list; const unsigned* cnt;
    __device__ __forceinline__ void operator()(const f32x4 (&acc)[2][2][4][2], const pg8::GUnit& u, int wr, int wc, int fr, int fq) const {
        const int cls = u.e2, col0 = u.e1 * 256 + wc * 32 + 8 * fq;
        const unsigned n = __hip_atomic_load(cnt + 64 * cls, __ATOMIC_RELAXED, __HIP_MEMORY_SCOPE_AGENT);
        int tok[8];
#pragma unroll
        for (int k = 0; k < 8; ++k) { const int r = (k >> 2) * 128 + wr * 64 + (k & 3) * 16 + fr; const unsigned pos = (unsigned)(u.e3 + r);
            const int t = list[(size_t)cls * LCAP + (pos < n ? pos : 0u)].tok; tok[k] = pos < n ? t : -1; }
#pragma unroll
        for (int k = 0; k < 8; ++k) { const int ai = k >> 2, m = k & 3;
            if (tok[k] >= 0) { bf16_t* rowp = M + (size_t)tok[k] * D + col0;
#pragma unroll
                for (int bj = 0; bj < 2; ++bj) { const f32x4 v0 = acc[ai][bj][m][0], v1 = acc[ai][bj][m][1];
                    u32x4 w; w.x = cvtpk(v0[0], v0[1]); w.y = cvtpk(v0[2], v0[3]); w.z = cvtpk(v1[0], v1[1]); w.w = cvtpk(v1[2], v1[3]);
                    *(u32x4*)(rowp + bj * 128) = w; } } }
    }
};

__device__ __forceinline__ void pair_of(int p, int& lo, int& hi) { lo = p < 3 ? 0 : (p < 5 ? 1 : 2); hi = p < 3 ? p + 1 : (p < 5 ? p - 1 : 3); }
struct MoeUpOrder {
    int nunits, G, c; const LAS int* tt; const char* WGU; const LEntry* list; const unsigned* cnt;
    __device__ __forceinline__ bool next(int i, pg8::GUnit& u) const {
        const long L = (long)i * G + c; if (L >= (long)nunits * UPREP) return false;
        const int wgid = pg8::xcd_remap((int)(L % nunits), nunits); const int tile = wgid >> 2, pn = wgid & 3; const int e = tt[tile];
        const int cls = e & 255; u.e0 = tile; u.e1 = pn; u.e2 = cls; u.e3 = e >> 8; u.a0 = 0;
        int lo, hi; pair_of(cls % 6, lo, hi); const int ex = (cls / 6) * 4 + ((pn >> 1) ? hi : lo);
        u.bb = WGU + ((size_t)ex * 512 + (size_t)(pn & 1) * 256) * 2048; return true;
    }
    __device__ __forceinline__ unsigned arow(const pg8::GUnit& u, int r) const {
        const unsigned n = __hip_atomic_load(cnt + 64 * u.e2, __ATOMIC_RELAXED, __HIP_MEMORY_SCOPE_AGENT); const unsigned pos = (unsigned)(u.e3 + r);
        return (unsigned)list[(size_t)u.e2 * LCAP + (pos < n ? pos : 0u)].tok;
    }
};
struct MoeDownOrder {
    int nunits, G, c; const LAS int* tt; const char* WDP;
    __device__ __forceinline__ bool next(int i, pg8::GUnit& u) const {
        const long L = (long)i * G + c; if (L >= nunits) return false;
        const int wgid = pg8::xcd_remap((int)L, nunits); const int tile = wgid >> 2, pn = wgid & 3; const int e = tt[tile];
        const int cls = e & 255; u.e0 = tile; u.e1 = pn; u.e2 = cls; u.e3 = e >> 8; u.a0 = tile * 256;
        u.bb = WDP + ((size_t)cls * 1024 + (size_t)pn * 256) * 1024; return true;
    }
    __device__ __forceinline__ unsigned arow(const pg8::GUnit& u, int r) const { return (unsigned)(u.a0 + r); }
};

namespace att {
constexpr int DM = NPROJ;
constexpr int SLOTB = 8192;
constexpr int LDS_K = 0, LDS_V = 3 * SLOTB, LDS_WS = 6 * SLOTB, LDS_OST = LDS_WS + 2048, LDS_BIAS = LDS_OST + 8 * 4096, LDS_BLK = LDS_BIAS + 32768, LDS_MM = LDS_BLK + 256  , LDS_QM = LDS_MM + 96  , LDS_END = LDS_QM + 32;
static_assert(LDS_END <= RING_BYTES, "attention LDS");
typedef LAS const char* lds_cptr;
__device__ __forceinline__ int crow(int r, int hi) { return (r & 3) + 8 * (r >> 2) + 4 * hi; }
__device__ __forceinline__ void glds16(const void* gsrc, unsigned lds_dst) { unsigned keep;
    asm volatile("s_mov_b32 %0, m0\n\ts_mov_b32 m0, %2\n\ts_nop 0\n\tglobal_load_lds_dwordx4 %1, off\n\ts_mov_b32 m0, %0" : "=&s"(keep) : "v"(gsrc), "s"(lds_dst) : "memory"); }
__device__ __forceinline__ float max3f(float a, float b, float c) { return __builtin_fmaxf(__builtin_fmaxf(a, b), c); }
#define ATT_WAIT_BAR(N) asm volatile("s_waitcnt vmcnt(" #N ") lgkmcnt(0)\n\ts_barrier" ::: "memory")
typedef short v4i16_t __attribute__((ext_vector_type(4)));
__device__ __forceinline__ s16x4 vtr(lds_cptr p) { return __builtin_bit_cast(s16x4, __builtin_amdgcn_ds_read_tr16_b64_v4i16((LAS v4i16_t*)p)); }
__device__ __forceinline__ float rowmax(const f32x16& p0, const f32x16& p1) {
    float a = max3f(p0[0], p0[1], p1[0]), b = max3f(p0[2], p0[3], p1[1]); a = max3f(a, p1[2], p1[3]);
#pragma unroll
    for (int r = 4; r < 16; r += 4) { a = max3f(a, p0[r], p0[r + 1]); b = max3f(b, p0[r + 2], p0[r + 3]); a = max3f(a, p1[r], p1[r + 1]); b = max3f(b, p1[r + 2], p1[r + 3]); }
    const float m = __builtin_fmaxf(a, b);
    auto rr = __builtin_amdgcn_permlane32_swap(__float_as_uint(m), __float_as_uint(m), false, false);
    return __builtin_fmaxf(__uint_as_float(rr[0]), __uint_as_float(rr[1]));
}
__device__ __forceinline__ void pv(f32x16* o, int vb, bf16x8 pa0, bf16x8 pa1, bf16x8 pa2, bf16x8 pa3) {
#pragma unroll
    for (int d0 = 0; d0 < 2; ++d0) { s16x4 lo[4], hi[4];
#pragma unroll
        for (int ks = 0; ks < 4; ++ks) {
            asm volatile("ds_read_b64_tr_b16 %0,%1 offset:%c2" : "=&v"(lo[ks]) : "v"(vb), "i"(d0 * 4096 + ks * 1024) : "memory");
            asm volatile("ds_read_b64_tr_b16 %0,%1 offset:%c2" : "=&v"(hi[ks]) : "v"(vb), "i"(d0 * 4096 + ks * 1024 + 512) : "memory"); }
        asm volatile("s_waitcnt lgkmcnt(0)" ::: "memory"); __builtin_amdgcn_sched_barrier(0);
#define ATT_PK(k) (bf16x8){lo[k][0], lo[k][1], lo[k][2], lo[k][3], hi[k][0], hi[k][1], hi[k][2], hi[k][3]}
        o[d0] = __builtin_amdgcn_mfma_f32_32x32x16_bf16(pa0, ATT_PK(0), o[d0], 0, 0, 0);
        o[d0] = __builtin_amdgcn_mfma_f32_32x32x16_bf16(pa1, ATT_PK(1), o[d0], 0, 0, 0);
        o[d0] = __builtin_amdgcn_mfma_f32_32x32x16_bf16(pa2, ATT_PK(2), o[d0], 0, 0, 0);
        o[d0] = __builtin_amdgcn_mfma_f32_32x32x16_bf16(pa3, ATT_PK(3), o[d0], 0, 0, 0);
#undef ATT_PK
    }
}
template <int MODE>
__device__ __forceinline__ void attn_core(char* shm, const bf16_t* Qw, const bf16_t* Kh, const bf16_t* Vh, bf16_t* Ow, int q0, const int qw0, int t_lo, int t_hi, const int bias_off, float sinkl2, float slope2, const int tid, const float kn2 = 0.f) {
    const int lane = tid & 63, r32 = lane & 31, hi = lane >> 5; const int wid = __builtin_amdgcn_readfirstlane(tid >> 6);
    const unsigned lds0 = (unsigned)(uintptr_t)shm;
    float* wsf = (float*)(shm + LDS_WS) + wid * 64;
    const lds_cptr shm3 = (lds_cptr)shm;
    const bf16_t* ksrc = Kh + (long)lane * DM + wid * 8;
    const bf16_t* vsrc = Vh + (long)(16 * (wid & 3) + (lane >> 2)) * DM + (wid >> 2) * 32 + (lane & 3) * 8;
    const unsigned kdst = lds0 + LDS_K + wid * 1024, vdst = lds0 + LDS_V + wid * 1024;
#define ATT_DMA_K(t, slot) glds16(ksrc + (long)(t) * 64 * DM, (unsigned)__builtin_amdgcn_readfirstlane(kdst + (slot)))
#define ATT_DMA_V(t, slot) glds16(vsrc + (long)(t) * 64 * DM, (unsigned)__builtin_amdgcn_readfirstlane(vdst + (slot)))
    const int vb0 = (int)(lds0 + LDS_V) + ((lane >> 4) & 1) * 32 + (lane & 3) * 8 + (4 * hi + ((lane & 15) >> 2)) * 64;
    const int n = t_hi - t_lo + 1;
    const int w_hi = (qw0 + 31) >> 6;
    const int w_lo = (MODE == 1) ? ((qw0 - 127 > 0 ? qw0 - 127 : 0) >> 6) : t_lo;
    bf16x8 qr[4];
#pragma unroll
    for (int d0 = 0; d0 < 4; ++d0) qr[d0] = *reinterpret_cast<const bf16x8*>(&Qw[(long)r32 * DM + d0 * 16 + hi * 8]);
    ATT_DMA_K(t_hi, 0); ATT_DMA_V(t_hi, 0);
    if (n > 1) { ATT_DMA_K(t_hi - 1, SLOTB); ATT_DMA_V(t_hi - 1, SLOTB); }
    LAS float* mmp = (LAS float*)(shm3 + LDS_MM); LAS float* qmp = (LAS float*)(shm3 + LDS_QM);
    if (MODE == 0) {
        float qs = 0.f;
#pragma unroll
        for (int d0 = 0; d0 < 4; ++d0)
#pragma unroll
            for (int e = 0; e < 8; ++e) { const float v = bf2f((bf16_t)qr[d0][e]); qs += v * v; }
        { auto rr = __builtin_amdgcn_permlane32_swap(__float_as_uint(qs), __float_as_uint(qs), false, false); qs = __uint_as_float(rr[0]) + __uint_as_float(rr[1]); }
        qs = __builtin_fmaxf(qs, shx<1>(qs)); qs = __builtin_fmaxf(qs, shx<2>(qs)); qs = __builtin_fmaxf(qs, shx<4>(qs)); qs = __builtin_fmaxf(qs, shx<8>(qs)); qs = __builtin_fmaxf(qs, shx<16>(qs));
        if (lane == 0) { qmp[wid] = qs; mmp[wid] = -1e30f; mmp[8 + wid] = -1e30f; mmp[16 + wid] = -1e30f; }
    }
    float bqk = 0.f;
    float mhat = 0.f, l_reg = 0.f; f32x16 o[2]; o[0] = f32x16{}; o[1] = f32x16{}; bool first = true;
    float ex[32]; bool pend = false;
#pragma unroll
    for (int r = 0; r < 32; ++r) ex[r] = 0.f;
    const int q = qw0 + r32;
    const int grp = wid >> 2;
#define ATT_LBAR() asm volatile("s_waitcnt lgkmcnt(0)\n\ts_barrier" ::: "memory")
#define ATT_ISSUE(i2) do { if ((i2) < n) { const int sl_ = ((i2) % 3) * SLOTB; ATT_DMA_K(t_hi - (i2), sl_); ATT_DMA_V(t_hi - (i2), sl_); } } while (0)
    if (grp == 1) { if (n > 1) { ATT_WAIT_BAR(2); } else { ATT_WAIT_BAR(0); } }
#pragma unroll 1
    for (int ti = 0; ti < n; ++ti) {
        const int t = t_hi - ti, sl_cur = (ti % 3) * SLOTB;
        const bool need = (t >= w_lo && t <= w_hi);
        if (MODE == 0 && ti >= 2 && (ti & 3) == 2) {
            if (ti == 2) { const f32x4 qa = *(const LAS f32x4*)qmp, qb_ = *(const LAS f32x4*)(qmp + 4);
                const float qn2 = __builtin_fmaxf(__builtin_fmaxf(__builtin_fmaxf(qa[0], qa[1]), __builtin_fmaxf(qa[2], qa[3])), __builtin_fmaxf(__builtin_fmaxf(qb_[0], qb_[1]), __builtin_fmaxf(qb_[2], qb_[3])));
                bqk = __int_as_float(__builtin_amdgcn_readfirstlane(__float_as_int(sqrtf(qn2 * kn2) * 1.02f + 1.0f))); }
            const LAS float* mp = mmp + ((ti - 2) % 3) * 8; const f32x4 ma = *(const LAS f32x4*)mp, mb = *(const LAS f32x4*)(mp + 4);
            const float mm = __builtin_fminf(__builtin_fminf(__builtin_fminf(ma[0], ma[1]), __builtin_fminf(ma[2], ma[3])), __builtin_fminf(__builtin_fminf(mb[0], mb[1]), __builtin_fminf(mb[2], mb[3])));
            const float bmax = *((const LAS float*)(shm3 + LDS_BIAS) + (t - t_lo) * 64 + 63);
            if (__builtin_amdgcn_readfirstlane((int)(bqk + bmax < mm - 160.f))) break;
        }
        if (grp == 0) { if (ti + 1 < n) { ATT_WAIT_BAR(2); } else { ATT_WAIT_BAR(0); } }
        else { ATT_LBAR(); ATT_ISSUE(ti + 2); }
        f32x16 p0, p1;
        if (need) {
            { const LAS float* bp = (const LAS float*)(shm3 + LDS_BIAS) + bias_off + (t - t_lo) * 64 + 4 * hi;
#pragma unroll
              for (int jj = 0; jj < 4; ++jj) { const f32x4 a = *(const LAS f32x4*)(bp + 8 * jj), b = *(const LAS f32x4*)(bp + 32 + 8 * jj);
                  p0[4 * jj] = a[0] - mhat; p0[4 * jj + 1] = a[1] - mhat; p0[4 * jj + 2] = a[2] - mhat; p0[4 * jj + 3] = a[3] - mhat;
                  p1[4 * jj] = b[0] - mhat; p1[4 * jj + 1] = b[1] - mhat; p1[4 * jj + 2] = b[2] - mhat; p1[4 * jj + 3] = b[3] - mhat; } }
            { const lds_cptr kb = shm3 + LDS_K + sl_cur + hi * 1024 + r32 * 16;
              bf16x8 kf0[4], kf1[4];
#pragma unroll
              for (int d0 = 0; d0 < 4; ++d0) { kf0[d0] = *(const LAS bf16x8*)(kb + d0 * 2048); kf1[d0] = *(const LAS bf16x8*)(kb + d0 * 2048 + 512); }
              float sacc = 0.f;
#define ATT_QS4(B) do { sacc += ex[B]; sacc += ex[B + 1]; sacc += ex[B + 2]; sacc += ex[B + 3]; asm volatile("" : "+v"(sacc)); __builtin_amdgcn_sched_barrier(0); } while (0)
              p0 = __builtin_amdgcn_mfma_f32_32x32x16_bf16(kf0[0], qr[0], p0, 0, 0, 0); ATT_QS4(0);
              p1 = __builtin_amdgcn_mfma_f32_32x32x16_bf16(kf1[0], qr[0], p1, 0, 0, 0); ATT_QS4(4);
              p0 = __builtin_amdgcn_mfma_f32_32x32x16_bf16(kf0[1], qr[1], p0, 0, 0, 0); ATT_QS4(8);
              p1 = __builtin_amdgcn_mfma_f32_32x32x16_bf16(kf1[1], qr[1], p1, 0, 0, 0); ATT_QS4(12);
              p0 = __builtin_amdgcn_mfma_f32_32x32x16_bf16(kf0[2], qr[2], p0, 0, 0, 0); ATT_QS4(16);
              p1 = __builtin_amdgcn_mfma_f32_32x32x16_bf16(kf1[2], qr[2], p1, 0, 0, 0); ATT_QS4(20);
              p0 = __builtin_amdgcn_mfma_f32_32x32x16_bf16(kf0[3], qr[3], p0, 0, 0, 0); ATT_QS4(24);
              p1 = __builtin_amdgcn_mfma_f32_32x32x16_bf16(kf1[3], qr[3], p1, 0, 0, 0); ATT_QS4(28);
#undef ATT_QS4
              if (pend) { l_reg += sacc; pend = false; } }
            const float NEG = -__builtin_inff();
            if (MODE == 0) { if (t == w_hi) { const int kb_ = 64 * t + 4 * hi;
#pragma unroll
                for (int r = 0; r < 16; ++r) { const int kv = kb_ + (r & 3) + 8 * (r >> 2); if (kv > q) p0[r] = NEG; if (kv + 32 > q) p1[r] = NEG; } } }
            else { const int kb_ = 64 * t + 4 * hi;
#pragma unroll
                for (int r = 0; r < 16; ++r) { const int kv = kb_ + (r & 3) + 8 * (r >> 2); if ((unsigned)(q - kv) >= 128u) p0[r] = NEG; if ((unsigned)(q - kv - 32) >= 128u) p1[r] = NEG; } }
            const float rm = rowmax(p0, p1);
            if (first || __any(rm > 8.f)) {
                const float dl = first ? __builtin_fmaxf(rm, -1e30f) : __builtin_fmaxf(rm, 0.f); const float f = first ? 1.f : __builtin_amdgcn_exp2f(-dl);
                first = false; mhat += dl; l_reg *= f; if (hi == 0) wsf[r32] = f;
#pragma unroll
                for (int r = 0; r < 16; ++r) { p0[r] -= dl; p1[r] -= dl; }
                asm volatile("s_waitcnt lgkmcnt(0)" ::: "memory");
#pragma unroll
                for (int jj = 0; jj < 4; ++jj) { const f32x4 fv = *(const f32x4*)(wsf + 8 * jj + 4 * hi);
#pragma unroll
                    for (int i2 = 0; i2 < 4; ++i2) { o[0][4 * jj + i2] *= fv[i2]; o[1][4 * jj + i2] *= fv[i2]; } }
            }
            if (MODE == 0 && (ti & 3) == 0) {
                float mn = mhat; mn = __builtin_fminf(mn, shx<1>(mn)); mn = __builtin_fminf(mn, shx<2>(mn)); mn = __builtin_fminf(mn, shx<4>(mn)); mn = __builtin_fminf(mn, shx<8>(mn)); mn = __builtin_fminf(mn, shx<16>(mn));
                if (lane == 0) mmp[(ti % 3) * 8 + wid] = mn; }
        }
        if (grp == 0) { ATT_LBAR(); ATT_ISSUE(ti + 2); }
        else { if (ti + 1 < n) { if (ti + 2 < n) { ATT_WAIT_BAR(2); } else { ATT_WAIT_BAR(0); } } else { ATT_LBAR(); } }
        if (need) {
            const lds_cptr vp = shm3 + LDS_V + sl_cur + ((lane >> 4) & 1) * 32 + (lane & 3) * 8 + (4 * hi + ((lane & 15) >> 2)) * 64;
#define ATT_SB() __builtin_amdgcn_sched_barrier(0)
#define ATT_PIN(x) asm volatile("" : "+v"(x))
#define ATT_VRD(i) do { vlo[i] = vtr(vp + (((i) >> 2) * 4096 + ((i) & 3) * 1024)); vhi[i] = vtr(vp + (((i) >> 2) * 4096 + ((i) & 3) * 1024 + 512)); } while (0)
#define ATT_VF(i) (bf16x8){vlo[i][0], vlo[i][1], vlo[i][2], vlo[i][3], vhi[i][0], vhi[i][1], vhi[i][2], vhi[i][3]}
#define ATT_PIN4(B) asm volatile("" : "+v"(ex[B]), "+v"(ex[B + 1]), "+v"(ex[B + 2]), "+v"(ex[B + 3]))
#define ATT_EX4(P, PB, B) do { ex[B] = __builtin_amdgcn_exp2f(P[PB]); ex[B + 1] = __builtin_amdgcn_exp2f(P[PB + 1]); ex[B + 2] = __builtin_amdgcn_exp2f(P[PB + 2]); ex[B + 3] = __builtin_amdgcn_exp2f(P[PB + 3]); ATT_PIN4(B); } while (0)
#define ATT_PK4(B) (u32x4){cvtpk(ex[B], ex[B + 1]), cvtpk(ex[B + 2], ex[B + 3]), cvtpk(ex[B + 4], ex[B + 5]), cvtpk(ex[B + 6], ex[B + 7])}
#define ATT_SUM4(B) do { sacc += ex[B]; sacc += ex[B + 1]; sacc += ex[B + 2]; sacc += ex[B + 3]; ATT_PIN(sacc); } while (0)
            s16x4 vlo[8], vhi[8]; u32x4 pw0, pw1, pw2, pw3;
            ATT_VRD(0); ATT_VRD(4);
            ATT_EX4(p0, 0, 0); ATT_EX4(p0, 4, 4); pw0 = ATT_PK4(0); ATT_PIN(pw0); ATT_SB();
            o[0] = __builtin_amdgcn_mfma_f32_32x32x16_bf16(__builtin_bit_cast(bf16x8, pw0), ATT_VF(0), o[0], 0, 0, 0); ATT_VRD(1); ATT_EX4(p0, 8, 8); ATT_SB();
            o[1] = __builtin_amdgcn_mfma_f32_32x32x16_bf16(__builtin_bit_cast(bf16x8, pw0), ATT_VF(4), o[1], 0, 0, 0); ATT_VRD(5); ATT_EX4(p0, 12, 12); pw1 = ATT_PK4(8); ATT_PIN(pw1); ATT_SB();
            o[0] = __builtin_amdgcn_mfma_f32_32x32x16_bf16(__builtin_bit_cast(bf16x8, pw1), ATT_VF(1), o[0], 0, 0, 0); ATT_VRD(2); ATT_EX4(p1, 0, 16); ATT_SB();
            o[1] = __builtin_amdgcn_mfma_f32_32x32x16_bf16(__builtin_bit_cast(bf16x8, pw1), ATT_VF(5), o[1], 0, 0, 0); ATT_VRD(6); ATT_EX4(p1, 4, 20); pw2 = ATT_PK4(16); ATT_PIN(pw2); ATT_SB();
            o[0] = __builtin_amdgcn_mfma_f32_32x32x16_bf16(__builtin_bit_cast(bf16x8, pw2), ATT_VF(2), o[0], 0, 0, 0); ATT_VRD(3); ATT_EX4(p1, 8, 24); ATT_SB();
            o[1] = __builtin_amdgcn_mfma_f32_32x32x16_bf16(__builtin_bit_cast(bf16x8, pw2), ATT_VF(6), o[1], 0, 0, 0); ATT_VRD(7); ATT_EX4(p1, 12, 28); pw3 = ATT_PK4(24); ATT_PIN(pw3); ATT_SB();
            o[0] = __builtin_amdgcn_mfma_f32_32x32x16_bf16(__builtin_bit_cast(bf16x8, pw3), ATT_VF(3), o[0], 0, 0, 0); ATT_SB();
            o[1] = __builtin_amdgcn_mfma_f32_32x32x16_bf16(__builtin_bit_cast(bf16x8, pw3), ATT_VF(7), o[1], 0, 0, 0); ATT_SB();
            pend = true;
#undef ATT_SB
#undef ATT_PIN
#undef ATT_VRD
#undef ATT_VF
#undef ATT_EX4
#undef ATT_PK4
#undef ATT_SUM4
#undef ATT_PIN4
        }
    }
    if (pend) { float sacc = 0.f;
#pragma unroll
        for (int r = 0; r < 32; ++r) sacc += ex[r];
        l_reg += sacc; }
    if (grp == 0) { ATT_LBAR(); }
#undef ATT_LBAR
#undef ATT_ISSUE
    { auto rr = __builtin_amdgcn_permlane32_swap(__float_as_uint(l_reg), __float_as_uint(l_reg), false, false); l_reg = __uint_as_float(rr[0]) + __uint_as_float(rr[1]); }
    if (MODE == 1) l_reg += __builtin_amdgcn_exp2f(sinkl2 + slope2 * (float)(qw0 - q0 + r32) - mhat);
    if (hi == 0) wsf[32 + r32] = l_reg;
    asm volatile("s_waitcnt lgkmcnt(0)" ::: "memory");
    float rli[16];
#pragma unroll
    for (int r = 0; r < 16; ++r) rli[r] = __builtin_amdgcn_rcpf(wsf[32 + crow(r, hi)]);
    { bf16_t* stg = (bf16_t*)(shm + LDS_OST) + wid * 2048;
#pragma unroll
      for (int r = 0; r < 16; ++r) { const int orow = crow(r, hi);
#pragma unroll
          for (int d0 = 0; d0 < 2; ++d0) stg[orow * 64 + d0 * 32 + r32] = (bf16_t)(cvtpk(o[d0][r] * rli[r], 0.f) & 0xffffu); }
      asm volatile("s_waitcnt lgkmcnt(0)" ::: "memory");
#pragma unroll
      for (int i = 0; i < 4; ++i) { const int row = i * 8 + (lane >> 3), ch = lane & 7; const u32x4 v = *(const u32x4*)(stg + row * 64 + ch * 8); *(u32x4*)(Ow + (long)row * D + ch * 8) = v; } }
    asm volatile("s_waitcnt vmcnt(0) lgkmcnt(0)\n\ts_barrier" ::: "memory");
#undef ATT_DMA_K
#undef ATT_DMA_V
}
}

__device__ __forceinline__ void p0_tr_item(const float* W, int ld_src, int k0, int n0, bf16_t* d0, bf16_t* d1, bf16_t* d2, int ld_dst, LAS float* scr, int lane) {
    float tv[32];
#pragma unroll
    for (int i = 0; i < 32; ++i) { const int kk = 2 * i + (lane >> 5); tv[i] = W[(size_t)(k0 + kk) * ld_src + n0 + (lane & 31)]; }
#pragma unroll
    for (int i = 0; i < 32; ++i) { const int kk = 2 * i + (lane >> 5); scr[kk * 33 + (lane & 31)] = tv[i]; }
    LDS_WAIT(); asm volatile("" ::: "memory");
    const int c = lane & 7;
#pragma unroll
    for (int j = 0; j < 4; ++j) { const int n = (lane >> 3) + 8 * j; const LAS float* s = scr + (8 * c) * 33 + n;
        u32x4 o; o.x = cvtpk(s[0 * 33], s[1 * 33]); o.y = cvtpk(s[2 * 33], s[3 * 33]); o.z = cvtpk(s[4 * 33], s[5 * 33]); o.w = cvtpk(s[6 * 33], s[7 * 33]);
        *(u32x4*)(d0 + (size_t)n * ld_dst + 8 * c) = o;
        if (d1) *(u32x4*)(d1 + (size_t)n * ld_dst + 8 * c) = o;
        if (d2) *(u32x4*)(d2 + (size_t)n * ld_dst + 8 * c) = o; }
    LDS_WAIT(); asm volatile("" ::: "memory");
}
__device__ __forceinline__ int pair_idx(int lo, int hi) { return lo == 0 ? hi - 1 : (lo == 1 ? hi + 1 : 5); }

__device__ __forceinline__ void phase_p0(Frame& F) {
    __syncthreads();
    {
        LAS float* sc = (LAS float*)F.lds;
        LAS float* red = (LAS float*)(F.lds + 16384);
        float* MOD = (float*)(F.ws + WS_MOD);
        bool have = false;
        for (int task = F.vcu; task < 48; task += F.G) {
            if (!have) { for (int i = F.tid; i < 4096; i += 512) { const float v = F.inp(F_C)[i]; sc[i] = v * sigmoidf_(v); } __syncthreads(); have = true; }
            const int l = task / 24, j0 = (task % 24) * 256;
            const float* wp = F.inp(F_WMOD) + (size_t)l * 1024 * 6144 + j0 + 4 * F.lane;
            f32x4 a0 = {0, 0, 0, 0}, a1 = a0, a2 = a0, a3 = a0;
            const int kbeg = F.wave * 128;
#pragma unroll 8
            for (int k = kbeg; k < kbeg + 128; ++k) { const f32x4 wv = *(const f32x4*)(wp + (size_t)k * 6144);
                a0 += wv * sc[k]; a1 += wv * sc[1024 + k]; a2 += wv * sc[2048 + k]; a3 += wv * sc[3072 + k]; }
            *(LAS f32x4*)(red + (F.wave * 4 + 0) * 256 + 4 * F.lane) = a0; *(LAS f32x4*)(red + (F.wave * 4 + 1) * 256 + 4 * F.lane) = a1;
            *(LAS f32x4*)(red + (F.wave * 4 + 2) * 256 + 4 * F.lane) = a2; *(LAS f32x4*)(red + (F.wave * 4 + 3) * 256 + 4 * F.lane) = a3;
            __syncthreads();
            for (int o = F.tid; o < 1024; o += 512) { const int b = o >> 8, cidx = o & 255; float s = F.inp(F_BMOD)[l * 6144 + j0 + cidx];
#pragma unroll
                for (int w = 0; w < 8; ++w) s += red[(w * 4 + b) * 256 + cidx];
                MOD[(size_t)(l * 4 + b) * 6144 + j0 + cidx] = s; }
            __syncthreads();
        }
        __syncthreads();
    }
    LAS float* scr = (LAS float*)(F.lds + F.wave * 16384);
    const int gw = F.vcu * 8 + F.wave, NGW = F.G * 8;
    bf16_t* WIN = (bf16_t*)(F.ws + WS_WIN); bf16_t* WOUT = (bf16_t*)(F.ws + WS_WOUT); bf16_t* WGU = (bf16_t*)(F.ws + WS_WGU); bf16_t* WDP = (bf16_t*)(F.ws + WS_WDP);
    constexpr int I_IN = 2 * 16 * 64, I_OUT = 2 * 16 * 32, I_GU = 2 * 16 * 2 * 16 * 8, I_DN = 2 * 16 * 4 * 32;
    for (int it = gw; it < I_IN + I_OUT + I_GU + I_DN; it += NGW) {
        int r = it;
        if (r < I_IN) { const int l = r / 1024, kb = (r % 1024) / 64, nb = r % 64;
            p0_tr_item(F.inp(F_WIN) + (size_t)l * 1024 * IN_COLS, IN_COLS, 64 * kb, 32 * nb, WIN + ((size_t)l * 2048 + 32 * nb) * 1024 + 64 * kb, nullptr, nullptr, 1024, scr, F.lane); continue; }
        r -= I_IN;
        if (r < I_OUT) { const int l = r / 512, kb = (r % 512) / 32, nb = r % 32;
            p0_tr_item(F.inp(F_WOUT) + (size_t)l * 1024 * 1024, 1024, 64 * kb, 32 * nb, WOUT + ((size_t)l * 1024 + 32 * nb) * 1024 + 64 * kb, nullptr, nullptr, 1024, scr, F.lane); continue; }
        r -= I_OUT;
        if (r < I_GU) { const int le = r / 256, which = (r % 256) / 128, kb = (r % 128) / 8, nb = r % 8;
            const int j0 = 32 * nb, row = 256 * (j0 >> 7) + (j0 & 127) + which * 128;
            p0_tr_item((which ? F.inp(F_WUP) : F.inp(F_WGATE)) + (size_t)le * 1024 * 256, 256, 64 * kb, j0, WGU + ((size_t)le * 512 + row) * 1024 + 64 * kb, nullptr, nullptr, 1024, scr, F.lane); continue; }
        r -= I_GU;
        { const int le = r / 128, kb = (r % 128) / 32, nb = r % 32; const int l = le >> 4, e = le & 15, g = e >> 2, i = e & 3;
          bf16_t* dst[3]; int nd = 0;
#pragma unroll
          for (int j = 0; j < 4; ++j) { if (j == i) continue; const int lo = i < j ? i : j, hi = i < j ? j : i; const int cls = g * 6 + pair_idx(lo, hi); const int kofs = (i == lo) ? 0 : 256;
              dst[nd++] = WDP + ((size_t)(l * 24 + cls) * 1024 + 32 * nb) * 512 + kofs + 64 * kb; }
          p0_tr_item(F.inp(F_WDOWN) + (size_t)le * 256 * 1024, 1024, 64 * kb, 32 * nb, dst[0], dst[1], dst[2], 512, scr, F.lane); }
    }
}

template <bool PM>
__device__ __forceinline__ void phase_norm1(Frame& F, int l, const float* xin) {
    const bf16_t* Pb = (const bf16_t*)(F.ws + WS_P); const bf16_t* Mb = (const bf16_t*)(F.ws + WS_M); float* XA = (float*)(F.ws + WS_XA);
    LAS float* gpm = (LAS float*)(F.lds + 256);
    const float* MOD = (const float*)(F.ws + WS_MOD) + (size_t)l * 4 * 6144;
    bf16_t* H = (bf16_t*)(F.ws + WS_H); float* CUM = (float*)(F.ws + WS_CUM); float* CTOT = (float*)(F.ws + WS_CTOT);
    LAS float* wtot = (LAS float*)F.lds;
    for (int tile = F.vcu; tile < T / 128; tile += F.G) {
        const int b = tile >> 6, row0 = tile * 128;
        f32x4 g1[4], s1[4], wfc[16];
#pragma unroll
        for (int j = 0; j < 4; ++j) { const int col = 4 * F.lane + 256 * j;
            const f32x4 nm = *(const f32x4*)(F.inp(F_NMIX) + l * 1024 + col), scv = *(const f32x4*)(MOD + b * 6144 + 1024 + col);
            g1[j] = nm * (scv + 1.0f); s1[j] = *(const f32x4*)(MOD + b * 6144 + col);
#pragma unroll
            for (int i = 0; i < 4; ++i) wfc[j * 4 + i] = *(const f32x4*)(F.inp(F_WIN) + ((size_t)l * 1024 + col + i) * IN_COLS + 2048); }
        const f32x4 fb = *(const f32x4*)(F.inp(F_FOXB) + l * 4);
        if (PM) { const float* MODp = (const float*)(F.ws + WS_MOD) + (size_t)(l - 1) * 4 * 6144 + b * 6144;
            for (int i = F.tid; i < 1024; i += 512) { gpm[i] = MODp[2048 + i]; gpm[1024 + i] = MODp[5120 + i]; }
            __syncthreads(); }
        f32x4 run = {0.f, 0.f, 0.f, 0.f}, keep = {0.f, 0.f, 0.f, 0.f};
#pragma unroll 1
        for (int i = 0; i < 16; i += 2) {
            const int row = row0 + F.wave * 16 + i;
            const f32x4* xr0 = (const f32x4*)(xin + (size_t)row * D) + F.lane; const f32x4* xr1 = xr0 + D / 4;
            f32x4 v0[4], v1[4]; float ss0 = 0.f, ss1 = 0.f;
#pragma unroll
            for (int j = 0; j < 4; ++j) { v0[j] = xr0[64 * j]; v1[j] = xr1[64 * j]; }
            if (PM) {
                u32x2 p0[4], p1[4], m0[4], m1[4];
                const u32x2* pr0 = (const u32x2*)(Pb + (size_t)row * D) + F.lane; const u32x2* mr0 = (const u32x2*)(Mb + (size_t)row * D) + F.lane;
#pragma unroll
                for (int j = 0; j < 4; ++j) { p0[j] = pr0[64 * j]; p1[j] = pr0[64 * j + D / 4]; m0[j] = mr0[64 * j]; m1[j] = mr0[64 * j + D / 4]; }
                f32x4* xo0 = (f32x4*)(XA + (size_t)row * D) + F.lane; f32x4* xo1 = xo0 + D / 4;
#pragma unroll
                for (int j = 0; j < 4; ++j) { const f32x4 gm = *(const LAS f32x4*)(gpm + 4 * F.lane + 256 * j), gf = *(const LAS f32x4*)(gpm + 1024 + 4 * F.lane + 256 * j);
                    v0[j] = v0[j] + gm * bf4_to_f32(p0[j]) + gf * bf4_to_f32(m0[j]); v1[j] = v1[j] + gm * bf4_to_f32(p1[j]) + gf * bf4_to_f32(m1[j]);
                    xo0[64 * j] = v0[j]; xo1[64 * j] = v1[j]; }
            }
#pragma unroll
            for (int j = 0; j < 4; ++j) { ss0 += (v0[j].x * v0[j].x + v0[j].y * v0[j].y) + (v0[j].z * v0[j].z + v0[j].w * v0[j].w); ss1 += (v1[j].x * v1[j].x + v1[j].y * v1[j].y) + (v1[j].z * v1[j].z + v1[j].w * v1[j].w); }
            const float rstd0 = 1.0f / sqrtf(wave_sum(ss0) * (1.f / D) + EPS), rstd1 = 1.0f / sqrtf(wave_sum(ss1) * (1.f / D) + EPS);
            f32x4 fa0 = {0.f, 0.f, 0.f, 0.f}, fa1 = {0.f, 0.f, 0.f, 0.f};
            u32x2* o0 = (u32x2*)(H + (size_t)row * D) + F.lane; u32x2* o1 = o0 + D / 4;
#pragma unroll
            for (int j = 0; j < 4; ++j) { const f32x4 h0 = v0[j] * rstd0 * g1[j] + s1[j], h1 = v1[j] * rstd1 * g1[j] + s1[j];
                fa0 += wfc[j * 4 + 0] * h0.x + wfc[j * 4 + 1] * h0.y + wfc[j * 4 + 2] * h0.z + wfc[j * 4 + 3] * h0.w;
                fa1 += wfc[j * 4 + 0] * h1.x + wfc[j * 4 + 1] * h1.y + wfc[j * 4 + 2] * h1.z + wfc[j * 4 + 3] * h1.w;
                u32x2 w; w.x = cvtpk(h0.x, h0.y); w.y = cvtpk(h0.z, h0.w); o0[64 * j] = w; w.x = cvtpk(h1.x, h1.y); w.y = cvtpk(h1.z, h1.w); o1[64 * j] = w; }
            f32x4 lf0, lf1;
#pragma unroll
            for (int e = 0; e < 4; ++e) { const float z0 = wave_sum(fa0[e]) + fb[e], z1 = wave_sum(fa1[e]) + fb[e];
                lf0[e] = fminf(z0, 0.f) - __builtin_amdgcn_logf(1.f + fast_exp(-fabsf(z0))) * 0.6931471805599453f;
                lf1[e] = fminf(z1, 0.f) - __builtin_amdgcn_logf(1.f + fast_exp(-fabsf(z1))) * 0.6931471805599453f; }
            run += lf0; if (F.lane == i) keep = run;
            run += lf1; if (F.lane == i + 1) keep = run;
        }
        if (F.lane == 0) *(LAS f32x4*)(wtot + F.wave * 4) = run;
        __syncthreads();
        f32x4 pre = {0.f, 0.f, 0.f, 0.f}, tot = {0.f, 0.f, 0.f, 0.f};
#pragma unroll
        for (int w = 0; w < 8; ++w) { const f32x4 tv = *(const LAS f32x4*)(wtot + w * 4); if (w < F.wave) pre += tv; tot += tv; }
        if (F.lane < 16) { const int s = (row0 & (SEQ - 1)) + F.wave * 16 + F.lane; const f32x4 cv = keep + pre;
#pragma unroll
            for (int e = 0; e < 4; ++e) CUM[(size_t)(b * 4 + e) * SEQ + s] = cv[e]; }
        if (F.tid == 0) *(f32x4*)(CTOT + (size_t)(b * 64 + (tile & 63)) * 4) = tot;
        __syncthreads();
    }
}

__device__ __forceinline__ void lru_unit(Frame& F, int l, int b, int tt) {
    const bf16_t* PROJ = (const bf16_t*)(F.ws + WS_PROJ);
    float* HLOC = (float*)(F.ws + WS_H); float* PP = HLOC + (size_t)T * 256;
    float* LRUA = (float*)(F.ws + WS_LRUA); float* LRUH = (float*)(F.ws + WS_LRUH);
    LAS bf16_t* xcb = (LAS bf16_t*)F.lds;
    LAS float* gb_ = (LAS float*)(F.lds + 16384);
    const int c = F.tid & 255, sl = F.tid >> 8;
    const int blk = F.wave, kq = F.lane >> 4, nn = F.lane & 15;
    bf16x8 bfr[2][2];
    f32x4 cinit[2][2];
#pragma unroll
    for (int g = 0; g < 2; ++g)
#pragma unroll
        for (int hf = 0; hf < 2; ++hf) { const float* wp = (g ? F.inp(F_LWX) : F.inp(F_LWA)) + ((size_t)(l * 8 + blk) * 32 + 8 * kq) * 32 + 16 * hf + nn;
            u32x4 pk; pk.x = cvtpk(wp[0], wp[32]); pk.y = cvtpk(wp[64], wp[96]); pk.z = cvtpk(wp[128], wp[160]); pk.w = cvtpk(wp[192], wp[224]); bfr[g][hf] = __builtin_bit_cast(bf16x8, pk);
            const float bv = (g ? F.inp(F_LBX) : F.inp(F_LBA))[l * 256 + blk * 32 + 16 * hf + nn]; cinit[g][hf] = (f32x4){bv, bv, bv, bv}; }
    const float cw0 = F.inp(F_CONVW)[(l * 4 + 0) * 256 + c], cw1 = F.inp(F_CONVW)[(l * 4 + 1) * 256 + c], cw2 = F.inp(F_CONVW)[(l * 4 + 2) * 256 + c], cw3 = F.inp(F_CONVW)[(l * 4 + 3) * 256 + c];
    const float cb = F.inp(F_CONVB)[l * 256 + c];
    const float lam = F.inp(F_LAM)[l * 256 + c];
    const float sp = -8.0f * (fmaxf(-lam, 0.f) + log1pf(expf(-fabsf(lam))));
    const int s0 = tt * 128 + sl * 64;
    const bf16_t* xp = PROJ + ((size_t)b * SEQ + s0) * NPROJ + C_XB + c;
    float xm3 = s0 >= 3 ? bf2f(xp[-3 * (long)NPROJ]) : 0.f, xm2 = s0 >= 2 ? bf2f(xp[-2 * (long)NPROJ]) : 0.f, xm1 = s0 >= 1 ? bf2f(xp[-1 * (long)NPROJ]) : 0.f;
    float h = 0.f, P = 1.f;
    bf16_t xr[16];
#pragma unroll
    for (int i = 0; i < 16; ++i) xr[i] = xp[(long)i * NPROJ];
#pragma unroll 1
    for (int sub = 0; sub < 4; ++sub) {
        float xv[16];
#pragma unroll
        for (int i = 0; i < 16; ++i) { const float xc = bf2f(xr[i]); xv[i] = cb + cw0 * xm3 + cw1 * xm2 + cw2 * xm1 + cw3 * xc; xm3 = xm2; xm2 = xm1; xm1 = xc;
            xcb[(sl * 16 + i) * 256 + c] = (bf16_t)(cvtpk(xv[i], 0.f) & 0xffffu); }
        if (sub < 3) {
#pragma unroll
            for (int i = 0; i < 16; ++i) xr[i] = xp[(long)((sub + 1) * 16 + i) * NPROJ]; }
        __syncthreads();
#pragma unroll
        for (int s2 = 0; s2 < 2; ++s2) {
            const bf16x8 af = *(const LAS bf16x8*)(xcb + (s2 * 16 + nn) * 256 + blk * 32 + 8 * kq);
#pragma unroll
            for (int g = 0; g < 2; ++g)
#pragma unroll
                for (int hf = 0; hf < 2; ++hf) { const f32x4 r4 = __builtin_amdgcn_mfma_f32_16x16x32_bf16(af, bfr[g][hf], cinit[g][hf], 0, 0, 0);
                    LAS float* gp = gb_ + ((g * 2 + s2) * 16 + 4 * kq) * 256 + blk * 32 + 16 * hf + nn;
                    gp[0] = r4[0]; gp[256] = r4[1]; gp[512] = r4[2]; gp[768] = r4[3]; }
        }
        __syncthreads();
#pragma unroll
        for (int i = 0; i < 16; ++i) {
            const float ga = gb_[((0 * 2 + sl) * 16 + i) * 256 + c], gx = gb_[((1 * 2 + sl) * 16 + i) * 256 + c];
            const float r = sigmoidf_(ga), ig = sigmoidf_(gx);
            const float la = sp * r; const float a = fast_exp(la);
            const float mult = __builtin_amdgcn_sqrtf(__builtin_fmaxf(1.f - a * a, 0.f));
            const float u = mult * ig * xv[i];
            h = a * h + u; P *= a;
            const size_t off = ((size_t)b * SEQ + s0 + sub * 16 + i) * 256 + c;
            HLOC[off] = h; PP[off] = P;
        }
    }
    const size_t so = ((size_t)(b * 128 + tt * 2 + sl)) * 256 + c;
    LRUA[so] = P; LRUH[so] = h;
    __syncthreads();
}

__device__ __forceinline__ void fox_unit(Frame& F, int l, int b, int h, int qb) {
    const bf16_t* PROJ = (const bf16_t*)(F.ws + WS_PROJ); bf16_t* Y = (bf16_t*)(F.ws + WS_Y);
    const float* CUM = (const float*)(F.ws + WS_CUM) + (size_t)(b * 4 + h) * SEQ; const float* CTOT = (const float*)(F.ws + WS_CTOT);
    LAS float* bias = (LAS float*)(F.lds + att::LDS_BIAS); LAS float* blk = (LAS float*)(F.lds + att::LDS_BLK);
    const int q0 = qb * 256;
    const float vtot = CTOT[(size_t)(b * 64 + F.lane) * 4 + h];
    float cv[16];
#pragma unroll
    for (int k = 0; k < 16; ++k) { const int s = F.tid + 512 * k; cv[k] = (s < q0 + 256) ? CUM[s] : 0.f; }
    const float cq = CUM[q0 + 255];
    float kn2 = 0.f; { const unsigned* km = (const unsigned*)(F.ws + WS_CTL) + CW_KM + l * 128 + (b * 4 + h) * 8;
#pragma unroll
        for (int c = 0; c < 8; ++c) kn2 += __uint_as_float(__hip_atomic_load(km + c, __ATOMIC_RELAXED, __HIP_MEMORY_SCOPE_AGENT)); }
    if (F.wave == 0) { float s = vtot;
#pragma unroll
        for (int o = 1; o < 64; o <<= 1) { const float t = __int_as_float(__builtin_amdgcn_ds_bpermute(((F.lane - o) & 63) << 2, __float_as_int(s))); if (F.lane >= o) s += t; }
        blk[F.lane] = s - vtot; }
    __syncthreads();
    const float cref = cq + blk[(q0 + 255) >> 7];
#pragma unroll
    for (int k = 0; k < 16; ++k) { const int s = F.tid + 512 * k; if (s < q0 + 256) bias[s] = (cref - (cv[k] + blk[s >> 7])) * LOG2E; }
    __syncthreads();
    const size_t rowbase = (size_t)b * SEQ;
    att::attn_core<0>(F.shm, PROJ + (rowbase + q0 + F.wave * 32) * NPROJ + C_QC + h * 64, PROJ + rowbase * NPROJ + C_KC + h * 64, PROJ + rowbase * NPROJ + C_VC + h * 64,
                      Y + (rowbase + q0 + F.wave * 32) * D + 768 + h * 64, q0, q0 + F.wave * 32, 0, (q0 + 255) >> 6, 0, 0.f, 0.f, F.tid, kn2);
}
__device__ __forceinline__ void swa_unit(Frame& F, int l, int b, int kvh, int qb64) {
    const bf16_t* PROJ = (const bf16_t*)(F.ws + WS_PROJ); bf16_t* Y = (bf16_t*)(F.ws + WS_Y);
    LAS float* bias = (LAS float*)(F.lds + att::LDS_BIAS);
    const int q0 = qb64 * 64;
    const int t_lo = (q0 >= 128 ? q0 - 128 : 0) >> 6, t_hi = q0 >> 6, n = t_hi - t_lo + 1;
    for (int i = F.tid; i < 4 * 192; i += 512) { const int hh = i / 192, j = i - hh * 192; const float sl = exp2f(-(float)(kvh * 4 + hh + 1)) * LOG2E;
        if (j < n * 64) bias[i] = sl * (float)(64 * t_lo + j - q0); }
    __syncthreads();
    const int h = kvh * 4 + (F.wave >> 1), qw0 = q0 + 32 * (F.wave & 1);
    const float slope2 = exp2f(-(float)(h + 1)) * LOG2E;
    const size_t rowbase = (size_t)b * SEQ;
    att::attn_core<1>(F.shm, PROJ + (rowbase + qw0) * NPROJ + C_QA + h * 64, PROJ + rowbase * NPROJ + C_KA + kvh * 64, PROJ + rowbase * NPROJ + C_VA + kvh * 64,
                      Y + (rowbase + qw0) * D + h * 64, q0, qw0, t_lo, t_hi, (F.wave >> 1) * 192, F.inp(F_SINKS)[l * 8 + h] * LOG2E, slope2, F.tid);
}
__device__ __forceinline__ void phase_mixer(Frame& F, int l, int qsel) {
    unsigned* qhead = (unsigned*)(F.ws + WS_CTL) + CW_Q + qsel * 64;
    LAS unsigned* qslot = (LAS unsigned*)(F.lds + LDSCTL_OFF + 16);
#pragma unroll 1
    for (;;) {
        frame_refresh(F);
        if (F.tid == 0) qslot[0] = __hip_atomic_fetch_add(qhead, 1u, __ATOMIC_RELAXED, __HIP_MEMORY_SCOPE_AGENT);
        __syncthreads();
        const int u = __builtin_amdgcn_readfirstlane((int)qslot[0]);
        __syncthreads();
        if (u >= 512 + 256 + 1024) break;
        if (u < 512) { if (PH(11)) fox_unit(F, l, (u & 15) >> 2, u & 3, 31 - (u >> 4)); }
        else if (u < 768) { if (PH(10)) lru_unit(F, l, (u - 512) >> 6, (u - 512) & 63); }
        else { if (PH(12)) { const int v = u - 768; swa_unit(F, l, v >> 8, (v >> 7) & 1, v & 127); } }
    }
}

__device__ __forceinline__ void phase_ynorm(Frame& F, int l, bf16_t* YO) {
    const bf16_t* Y = (const bf16_t*)(F.ws + WS_Y); const bf16_t* PROJ = (const bf16_t*)(F.ws + WS_PROJ);
    const float* HLOC = (const float*)(F.ws + WS_H); const float* PP = HLOC + (size_t)T * 256;
    const float* LRUA = (const float*)(F.ws + WS_LRUA); const float* LRUH = (const float*)(F.ws + WS_LRUH);
    LAS float* cs = (LAS float*)F.lds;
    LAS float* carry = (LAS float*)(F.lds + 4096);
    const float* og = F.inp(F_OGAIN) + l * 1024;
    for (int tile = F.vcu; tile < T / 128; tile += F.G) {
        const int b = tile >> 6, tt = tile & 63, j0 = 2 * tt;
        { const int c = F.tid & 255, seg = F.tid >> 8; const int jb = seg ? j0 / 2 : 0, je = seg ? j0 : j0 / 2;
          float A = 1.f, Hh = 0.f;
          int j = jb;
          for (; j + 8 <= je; j += 8) {
              float aj[8], hj[8];
#pragma unroll
              for (int k = 0; k < 8; ++k) { const size_t so = (size_t)(b * 128 + j + k) * 256 + c; aj[k] = LRUA[so]; hj[k] = LRUH[so]; }
#pragma unroll
              for (int k = 0; k < 8; ++k) { Hh = aj[k] * Hh + hj[k]; A *= aj[k]; } }
          for (; j < je; ++j) { const size_t so = (size_t)(b * 128 + j) * 256 + c; const float aj = LRUA[so], hj = LRUH[so]; Hh = aj * Hh + hj; A *= aj; }
          cs[(seg * 2 + 0) * 256 + c] = A; cs[(seg * 2 + 1) * 256 + c] = Hh; }
        __syncthreads();
        if (F.tid < 256) { const int c = F.tid; const float c0 = cs[(2 + 0) * 256 + c] * cs[(0 + 1) * 256 + c] + cs[(2 + 1) * 256 + c];
            const size_t so = (size_t)(b * 128 + j0) * 256 + c; carry[c] = c0; carry[256 + c] = LRUA[so] * c0 + LRUH[so]; }
        __syncthreads();
#pragma unroll 1
        for (int i = 0; i < 16; i += 2) {
            u32x4 ya[2]; u32x2 yc[2], gb[2]; f32x4 hl[2], pp[2], cr[2];
#pragma unroll
            for (int k = 0; k < 2; ++k) { const int rl = F.wave * 16 + i + k; const size_t row = (size_t)tile * 128 + rl; const bf16_t* yr = Y + row * D;
                ya[k] = *(const u32x4*)(yr + 8 * F.lane); yc[k] = *(const u32x2*)(yr + 768 + 4 * F.lane);
                hl[k] = *(const f32x4*)(HLOC + row * 256 + 4 * F.lane); pp[k] = *(const f32x4*)(PP + row * 256 + 4 * F.lane);
                gb[k] = *(const u32x2*)(PROJ + row * NPROJ + C_GB + 4 * F.lane); cr[k] = *(const LAS f32x4*)(carry + (rl >> 6) * 256 + 4 * F.lane); }
#pragma unroll
            for (int k = 0; k < 2; ++k) { const int rl = F.wave * 16 + i + k; const size_t row = (size_t)tile * 128 + rl; bf16_t* yr = YO + row * D;
                float fa[8]; fa[0] = __uint_as_float(ya[k].x << 16); fa[1] = __uint_as_float(ya[k].x & 0xffff0000u); fa[2] = __uint_as_float(ya[k].y << 16); fa[3] = __uint_as_float(ya[k].y & 0xffff0000u);
                fa[4] = __uint_as_float(ya[k].z << 16); fa[5] = __uint_as_float(ya[k].z & 0xffff0000u); fa[6] = __uint_as_float(ya[k].w << 16); fa[7] = __uint_as_float(ya[k].w & 0xffff0000u);
                float sa = 0.f;
#pragma unroll
                for (int e = 0; e < 8; ++e) sa += fa[e] * fa[e];
                float fc[4]; fc[0] = __uint_as_float(yc[k].x << 16); fc[1] = __uint_as_float(yc[k].x & 0xffff0000u); fc[2] = __uint_as_float(yc[k].y << 16); fc[3] = __uint_as_float(yc[k].y & 0xffff0000u);
                const float sc_ = fc[0] * fc[0] + fc[1] * fc[1] + fc[2] * fc[2] + fc[3] * fc[3];
                float fb[4]; { const f32x4 hh = hl[k] + pp[k] * cr[k];
                    fb[0] = hh.x * gelu_tanh(__uint_as_float(gb[k].x << 16)); fb[1] = hh.y * gelu_tanh(__uint_as_float(gb[k].x & 0xffff0000u));
                    fb[2] = hh.z * gelu_tanh(__uint_as_float(gb[k].y << 16)); fb[3] = hh.w * gelu_tanh(__uint_as_float(gb[k].y & 0xffff0000u)); }
                const float sb = fb[0] * fb[0] + fb[1] * fb[1] + fb[2] * fb[2] + fb[3] * fb[3];
                const float ra = 1.0f / sqrtf(wave_sum(sa) * (1.f / 512.f) + EPS), rb = 1.0f / sqrtf(wave_sum(sb) * (1.f / 256.f) + EPS), rc = 1.0f / sqrtf(wave_sum(sc_) * (1.f / 256.f) + EPS);
                { const f32x4 g0 = *(const f32x4*)(og + 8 * F.lane), g1 = *(const f32x4*)(og + 8 * F.lane + 4);
                  u32x4 w; w.x = cvtpk(fa[0] * ra * g0.x, fa[1] * ra * g0.y); w.y = cvtpk(fa[2] * ra * g0.z, fa[3] * ra * g0.w); w.z = cvtpk(fa[4] * ra * g1.x, fa[5] * ra * g1.y); w.w = cvtpk(fa[6] * ra * g1.z, fa[7] * ra * g1.w);
                  *(u32x4*)(yr + 8 * F.lane) = w; }
                { const f32x4 g = *(const f32x4*)(og + 512 + 4 * F.lane); u32x2 w; w.x = cvtpk(fb[0] * rb * g.x, fb[1] * rb * g.y); w.y = cvtpk(fb[2] * rb * g.z, fb[3] * rb * g.w); *(u32x2*)(yr + 512 + 4 * F.lane) = w; }
                { const f32x4 g = *(const f32x4*)(og + 768 + 4 * F.lane); u32x2 w; w.x = cvtpk(fc[0] * rc * g.x, fc[1] * rc * g.y); w.y = cvtpk(fc[2] * rc * g.z, fc[3] * rc * g.w); *(u32x2*)(yr + 768 + 4 * F.lane) = w; }
            }
        }
        __syncthreads();
    }
}

template <int N, int MASK> __device__ __forceinline__ void tr_step(float (&v)[40], bool upper) {
#pragma unroll
    for (int i = 0; i < N / 2; ++i) { const float a = v[i], b = v[i + N / 2]; const float send = upper ? a : b, kp = upper ? b : a; float rcv;
        if constexpr (MASK == 32) { auto rr = __builtin_amdgcn_permlane32_swap(__float_as_uint(send), __float_as_uint(send), false, false); rcv = upper ? __uint_as_float(rr[0]) : __uint_as_float(rr[1]); }
        else rcv = shx<MASK>(send);
        v[i] = kp + rcv; }
}
__device__ __forceinline__ void phase_norm2_router(Frame& F, int l, const float* xa, unsigned* cnt) {
    const float* MOD = (const float*)(F.ws + WS_MOD) + (size_t)l * 4 * 6144;
    bf16_t* H = (bf16_t*)(F.ws + WS_H);
    LEntry* list = (LEntry*)(F.ws + WS_LIST);
    LAS float* wr = (LAS float*)F.lds;
    LAS float* gs = (LAS float*)(F.lds + 81920);
    LAS float* lg = (LAS float*)(F.lds + 90112);
    LAS int* tcls = (LAS int*)(F.lds + 92672);
    LAS float* tw = (LAS float*)(F.lds + 93184);
    LAS int* trank = (LAS int*)(F.lds + 94208);
    LAS unsigned* lcnt = (LAS unsigned*)(F.lds + 94720);
    LAS unsigned* lbase = (LAS unsigned*)(F.lds + 94848);
    const bf16_t* Pb = (const bf16_t*)(F.ws + WS_P); LAS float* gmv = (LAS float*)(F.lds + 98304);
    for (int i = F.tid; i < 1024 * 4; i += 512) { const int k = i >> 2, e = i & 3; wr[e * 1024 + k] = F.inp(F_WRG)[(size_t)l * 4096 + i]; }
    for (int i = F.tid; i < 1024 * 16; i += 512) { const int k = i >> 4, e = i & 15; wr[(4 + e) * 1024 + k] = F.inp(F_WRE)[(size_t)l * 16384 + i]; }
    int cur_b = -1;
    for (int tile = F.vcu; tile < T / 128; tile += F.G) {
        const int b = tile >> 6;
        __syncthreads();
        if (b != cur_b) { for (int i = F.tid; i < 1024; i += 512) { gs[i] = F.inp(F_NFFN)[l * 1024 + i] * (1.f + MOD[b * 6144 + 4096 + i]); gs[1024 + i] = MOD[b * 6144 + 3072 + i]; gmv[i] = MOD[b * 6144 + 2048 + i]; } cur_b = b; }
        if (F.tid < NCLS) lcnt[F.tid] = 0u;
        __syncthreads();
#pragma unroll 1
        for (int grp = 0; grp < 8; ++grp) {
            const size_t row0 = (size_t)tile * 128 + F.wave * 16 + grp * 2;
            f32x4 hv[2][4];
#pragma unroll
            for (int r = 0; r < 2; ++r) { const f32x4* xr = (const f32x4*)(xa + (row0 + r) * D) + F.lane;
#pragma unroll
                for (int j = 0; j < 4; ++j) hv[r][j] = xr[64 * j]; }
            { u32x2 pv_[2][4];
#pragma unroll
              for (int r = 0; r < 2; ++r) { const u32x2* pr = (const u32x2*)(Pb + (row0 + r) * D) + F.lane;
#pragma unroll
                  for (int j = 0; j < 4; ++j) pv_[r][j] = pr[64 * j]; }
#pragma unroll
              for (int j = 0; j < 4; ++j) { const f32x4 gm = *(const LAS f32x4*)(gmv + 4 * F.lane + 256 * j);
                  hv[0][j] = hv[0][j] + gm * bf4_to_f32(pv_[0][j]); hv[1][j] = hv[1][j] + gm * bf4_to_f32(pv_[1][j]); } }
#pragma unroll
            for (int r = 0; r < 2; ++r) { float ss = 0.f;
#pragma unroll
                for (int j = 0; j < 4; ++j) ss += (hv[r][j].x * hv[r][j].x + hv[r][j].y * hv[r][j].y) + (hv[r][j].z * hv[r][j].z + hv[r][j].w * hv[r][j].w);
                const float rstd = 1.0f / sqrtf(wave_sum(ss) * (1.f / D) + EPS);
                u32x2* o8 = (u32x2*)(H + (row0 + r) * D) + F.lane;
#pragma unroll
                for (int j = 0; j < 4; ++j) { const f32x4 g = *(const LAS f32x4*)(gs + 4 * F.lane + 256 * j), s = *(const LAS f32x4*)(gs + 1024 + 4 * F.lane + 256 * j);
                    hv[r][j] = hv[r][j] * rstd * g + s; u32x2 w; w.x = cvtpk(hv[r][j].x, hv[r][j].y); w.y = cvtpk(hv[r][j].z, hv[r][j].w); o8[64 * j] = w; } }
            float acc[40];
#pragma unroll
            for (int e = 0; e < 20; ++e) { float a0 = 0.f, a1 = 0.f;
#pragma unroll
                for (int j = 0; j < 4; ++j) { const f32x4 w = *(const LAS f32x4*)(wr + e * 1024 + 4 * F.lane + 256 * j);
                    a0 += hv[0][j].x * w.x + hv[0][j].y * w.y + hv[0][j].z * w.z + hv[0][j].w * w.w;
                    a1 += hv[1][j].x * w.x + hv[1][j].y * w.y + hv[1][j].z * w.z + hv[1][j].w * w.w; }
                acc[e] = a0; acc[20 + e] = a1; }
            tr_step<40, 32>(acc, (F.lane & 32) != 0); tr_step<20, 16>(acc, (F.lane & 16) != 0); tr_step<10, 8>(acc, (F.lane & 8) != 0);
#pragma unroll
            for (int i = 0; i < 5; ++i) { acc[i] += shx<4>(acc[i]); acc[i] += shx<2>(acc[i]); acc[i] += shx<1>(acc[i]); }
            if ((F.lane & 7) == 0) { const int v0 = 5 * (F.lane >> 3);
#pragma unroll
                for (int i = 0; i < 5; ++i) lg[F.wave * 40 + v0 + i] = acc[i]; }
            LDS_WAIT();
            if (F.lane < 2) {
                const LAS float* q = lg + F.wave * 40 + F.lane * 20;
                float gl[4];
#pragma unroll
                for (int j = 0; j < 4; ++j) gl[j] = q[j] + F.inp(F_BRG)[l * 4 + j];
                int gsel = 0; float gm = gl[0];
#pragma unroll
                for (int j = 1; j < 4; ++j) if (gl[j] > gm) { gm = gl[j]; gsel = j; }
                float den = 0.f;
#pragma unroll
                for (int j = 0; j < 4; ++j) den += expf(gl[j] - gm);
                const float gp = 1.0f / den;
                float el[4];
#pragma unroll
                for (int j = 0; j < 4; ++j) el[j] = q[4 + 4 * gsel + j] + F.inp(F_BRE)[l * 16 + gsel * 4 + j];
                int i1 = 0; float m1 = el[0];
#pragma unroll
                for (int j = 1; j < 4; ++j) if (el[j] > m1) { m1 = el[j]; i1 = j; }
                int i2 = -1; float m2 = -__builtin_inff();
#pragma unroll
                for (int j = 0; j < 4; ++j) if (j != i1 && el[j] > m2) { m2 = el[j]; i2 = j; }
                const float e2 = expf(m2 - m1); const float w1 = gp / (1.f + e2), w2 = gp * e2 / (1.f + e2);
                const int lo = i1 < i2 ? i1 : i2, hi = i1 < i2 ? i2 : i1;
                const int rl = F.wave * 16 + grp * 2 + F.lane;
                tcls[rl] = gsel * 6 + pair_idx(lo, hi); tw[rl * 2] = (i1 < i2) ? w1 : w2; tw[rl * 2 + 1] = (i1 < i2) ? w2 : w1;
            }
        }
        __syncthreads();
        if (F.tid < 128) trank[F.tid] = (int)atomicAdd((unsigned*)&lcnt[tcls[F.tid]], 1u);
        __syncthreads();
        if (F.tid < NCLS) lbase[F.tid] = lcnt[F.tid] ? __hip_atomic_fetch_add(cnt + 64 * F.tid, lcnt[F.tid], __ATOMIC_RELAXED, __HIP_MEMORY_SCOPE_AGENT) : 0u;
        __syncthreads();
        if (F.tid < 128) { const int cls = tcls[F.tid]; const unsigned pos = lbase[cls] + (unsigned)trank[F.tid];
            LEntry e; e.tok = tile * 128 + F.tid; e.w0 = tw[F.tid * 2]; e.w1 = tw[F.tid * 2 + 1]; e.pad = 0; list[(size_t)cls * LCAP + pos] = e; }
    }
    __syncthreads();
}

__device__ __forceinline__ int build_tile_table(Frame& F, int l) {
    unsigned* cnt = (unsigned*)(F.ws + WS_CTL) + CW_CNT + l * NCLS * 64;
    LAS int* tt = (LAS int*)(F.lds + TT_OFF); LAS int* ntl = (LAS int*)(F.lds + TT_OFF + 1024);
    __syncthreads();
    if (F.tid == 0) { int nt = 0;
        for (int c = 0; c < NCLS; ++c) { const unsigned n = __hip_atomic_load(cnt + 64 * c, __ATOMIC_RELAXED, __HIP_MEMORY_SCOPE_AGENT); const int k = (int)((n + 255u) >> 8);
            for (int j = 0; j < k; ++j) tt[nt++] = c | ((j * 256) << 8); }
        ntl[0] = nt; }
    __syncthreads();
    return ntl[0];
}

__device__ __forceinline__ void phase_final(Frame& F, const float* xa, int lp) {
    const bf16_t* Pb = (const bf16_t*)(F.ws + WS_P); const bf16_t* Mb = (const bf16_t*)(F.ws + WS_M); const float* MODp = (const float*)(F.ws + WS_MOD) + (size_t)lp * 4 * 6144;
    const int gw = F.vcu * 8 + F.wave;
    const int rbase = gw * 16; const float* gp = MODp + (rbase >> 13) * 6144;
    f32x4 g[4], gm[4], gf[4];
#pragma unroll
    for (int j = 0; j < 4; ++j) { const int col = 4 * F.lane + 256 * j; g[j] = *(const f32x4*)(F.inp(F_NFIN) + col); gm[j] = *(const f32x4*)(gp + 2048 + col); gf[j] = *(const f32x4*)(gp + 5120 + col); }
#pragma unroll 1
    for (int i = 0; i < 16; i += 2) {
        const int row = rbase + i;
        const f32x4* xr0 = (const f32x4*)(xa + (size_t)row * D) + F.lane; const f32x4* xr1 = xr0 + D / 4;
        const u32x2* pa = (const u32x2*)(Pb + (size_t)row * D) + F.lane; const u32x2* ma = (const u32x2*)(Mb + (size_t)row * D) + F.lane;
        f32x4 v0[4], v1[4]; u32x2 p0[4], p1[4], m0[4], m1[4]; float ss0 = 0.f, ss1 = 0.f;
#pragma unroll
        for (int j = 0; j < 4; ++j) { v0[j] = xr0[64 * j]; v1[j] = xr1[64 * j]; p0[j] = pa[64 * j]; p1[j] = pa[64 * j + D / 4]; m0[j] = ma[64 * j]; m1[j] = ma[64 * j + D / 4]; }
#pragma unroll
        for (int j = 0; j < 4; ++j) { v0[j] = v0[j] + gm[j] * bf4_to_f32(p0[j]) + gf[j] * bf4_to_f32(m0[j]); v1[j] = v1[j] + gm[j] * bf4_to_f32(p1[j]) + gf[j] * bf4_to_f32(m1[j]);
            ss0 += (v0[j].x * v0[j].x + v0[j].y * v0[j].y) + (v0[j].z * v0[j].z + v0[j].w * v0[j].w); ss1 += (v1[j].x * v1[j].x + v1[j].y * v1[j].y) + (v1[j].z * v1[j].z + v1[j].w * v1[j].w); }
        const float rstd0 = 1.0f / sqrtf(wave_sum(ss0) * (1.f / D) + EPS), rstd1 = 1.0f / sqrtf(wave_sum(ss1) * (1.f / D) + EPS);
        f32x4* o0 = (f32x4*)(F.out + (size_t)row * D) + F.lane; f32x4* o1 = o0 + D / 4;
#pragma unroll
        for (int j = 0; j < 4; ++j) { o0[64 * j] = v0[j] * rstd0 * g[j]; o1[64 * j] = v1[j] * rstd1 * g[j]; }
    }
}

__global__ void __launch_bounds__(512, 2) mk_fwd(const Args args) {
    extern __shared__ __attribute__((aligned(16))) unsigned char lds[];
    Frame F;
    F.lds = (LAS unsigned char*)lds; F.shm = (char*)lds;
    F.tid = threadIdx.x; F.lane = F.tid & 63; F.wave = __builtin_amdgcn_readfirstlane(F.tid >> 6);
    F.G = 256; { const int bx = blockIdx.x; __builtin_assume(bx >= 0 && bx < 256); F.vcu = (bx % 8) * 32 + bx / 8; }
    for (int u = F.tid; u < (LDS_BYTES - LDSCTL_OFF) / 4; u += 512) ((LAS unsigned*)(F.lds + LDSCTL_OFF))[u] = 0u;
    __syncthreads();
    F.wave_s = __builtin_amdgcn_readfirstlane((int)threadIdx.x >> 6);
#define REFRESH() frame_refresh(F)
    REFRESH();
    unsigned* ctl = (unsigned*)(F.ws + WS_CTL);
    XcdBarrier bar = xcd_barrier_post(ctl + CW_BAR, (volatile LAS unsigned*)(F.lds + MISC_OFF) + 8);

    for (int rep = 0; rep < DUP(0); ++rep) if (PH(0)) phase_p0(F);
    xcd_barrier(bar, F.tid);
    float* XA = (float*)(F.ws + WS_XA);
    for (int l = 0; l < DEPTH; ++l) {
        const float* xin = (l <= 1) ? F.inp(F_X) : XA;
        const float* xbase = (l == 0) ? F.inp(F_X) : XA;
        const float* MODl = (const float*)(F.ws + WS_MOD) + (size_t)l * 4 * 6144;
        REFRESH();
        for (int rep = 0; rep < DUP(1); ++rep) if (PH(1)) { if (l == 0) phase_norm1<false>(F, l, xin); else phase_norm1<true>(F, l, xin); }
        xcd_barrier(bar, F.tid);
        REFRESH();
        for (int rep = 0; rep < DUP(2); ++rep) if (PH(2)) { pg8::DenseOrder S; S.init(T, NPROJ, F.G, (int)blockIdx.x, F.ws + WS_WIN + (size_t)l * 2048 * 1024 * 2, 2048u, G1REP);
          EpiProj E{(bf16_t*)(F.ws + WS_PROJ), (unsigned*)(F.ws + WS_CTL) + CW_KM + l * 128};
          pg8::gemm_phase<EpiProj, pg8::DenseOrder, true>(F.tid, F.lds, (const char*)(F.ws + WS_H), 2048u, 2048u, 1024, S, E); }
        xcd_barrier(bar, F.tid);
        REFRESH();
        for (int rep = 0; rep < DUP(3); ++rep) if (PH(3)) { phase_mixer(F, l, l + 2 * rep); if (rep + 1 < DUP(3)) xcd_barrier(bar, F.tid); }
        xcd_barrier(bar, F.tid);
        REFRESH();
        for (int rep = 0; rep < DUP(4); ++rep) if (PH(4)) phase_ynorm(F, l, (rep + 1 < DUP(4)) ? (bf16_t*)F.out : (bf16_t*)(F.ws + WS_Y));
        xcd_barrier(bar, F.tid);
        REFRESH();
        for (int rep = 0; rep < DUP(5); ++rep) if (PH(5)) { pg8::DenseOrder S; S.init(T, D, F.G, (int)blockIdx.x, F.ws + WS_WOUT + (size_t)l * 1024 * 1024 * 2, 2048u, (l == 0) ? G2REP : 1);
          EpiP E{(bf16_t*)(F.ws + WS_P)};
          pg8::gemm_phase<EpiP, pg8::DenseOrder, true>(F.tid, F.lds, (const char*)(F.ws + WS_Y), 2048u, 2048u, 1024, S, E); }
        xcd_barrier(bar, F.tid);
        REFRESH();
        for (int rep = 0; rep < DUP(6); ++rep) if (PH(6)) phase_norm2_router(F, l, xbase, (unsigned*)(F.ws + WS_CTL) + ((rep + 1 < DUP(6)) ? 32768 + l * NCLS * 64 : CW_CNT + l * NCLS * 64));
        xcd_barrier(bar, F.tid);
        REFRESH();
        const int ntiles = build_tile_table(F, l);
        const LEntry* list = (const LEntry*)(F.ws + WS_LIST); const unsigned* cnt = (const unsigned*)(F.ws + WS_CTL) + CW_CNT + l * NCLS * 64;
        for (int rep = 0; rep < DUP(7); ++rep) if (PH(7)) { MoeUpOrder S{ntiles * 4, F.G, (int)blockIdx.x, (const LAS int*)(F.lds + TT_OFF), (const char*)(F.ws + WS_WGU + (size_t)l * 16 * 512 * 1024 * 2), list, cnt};
          EpiUp E{(bf16_t*)(F.ws + WS_PROJ), list, cnt};
          pg8::gemm_phase<EpiUp, MoeUpOrder, true>(F.tid, F.lds, (const char*)(F.ws + WS_H), 2048u, 2048u, 1024, S, E); }
        xcd_barrier(bar, F.tid);
        REFRESH();
        for (int rep = 0; rep < DUP(8); ++rep) if (PH(8)) { MoeDownOrder S{ntiles * 4, F.G, (int)blockIdx.x, (const LAS int*)(F.lds + TT_OFF), (const char*)(F.ws + WS_WDP + (size_t)l * 24 * 1024 * 512 * 2)};
          EpiDown E{(bf16_t*)(F.ws + WS_M), list, cnt};
          pg8::gemm_phase<EpiDown, MoeDownOrder, true>(F.tid, F.lds, (const char*)(F.ws + WS_PROJ), 1024u, 1024u, 512, S, E); }
        xcd_barrier(bar, F.tid);
    }
        REFRESH();
    for (int rep = 0; rep < DUP(9); ++rep) if (PH(9)) phase_final(F, (DEPTH == 1) ? F.inp(F_X) : XA, DEPTH - 1);
}

extern "C" void kernel_launch(void* const* d_in, const int* in_sizes, int n_in, void* d_out, int out_size, void* d_ws, size_t ws_size, hipStream_t stream) {
    static int grid = 0;
    if (grid == 0) {
        if (n_in != 26 || in_sizes[0] != T * D || out_size != T * D || ws_size < WS_END) { fprintf(stderr, "kernel_launch: unexpected shapes (n_in %d, in0 %d, out %d, ws %zu)\n", n_in, n_in > 0 ? in_sizes[0] : -1, out_size, ws_size); grid = -1; return; }
        int dev = 0, cus = 0, per_cu = 0;
        if (hipGetDevice(&dev) != hipSuccess || hipDeviceGetAttribute(&cus, hipDeviceAttributeMultiprocessorCount, dev) != hipSuccess) { grid = -1; return; }
        if (hipFuncSetAttribute((const void*)mk_fwd, hipFuncAttributeMaxDynamicSharedMemorySize, LDS_BYTES) != hipSuccess) { fprintf(stderr, "kernel_launch: hipFuncSetAttribute failed\n"); grid = -1; return; }
        if (hipOccupancyMaxActiveBlocksPerMultiprocessor(&per_cu, (const void*)mk_fwd, 512, LDS_BYTES) != hipSuccess || per_cu < 1) fprintf(stderr, "kernel_launch: occupancy query reports %d\n", per_cu);
        (void)hipGetLastError();
        if (cus != 256) fprintf(stderr, "kernel_launch: built for 256 CUs, device reports %d\n", cus);
        grid = 256;
    }
    if (grid < 0) return;
    (void)hipMemsetAsync((char*)d_ws + WS_CTL, 0, CTL_ZERO_BYTES, stream);
    Args a{};
    for (int i = 0; i < 26; ++i) a.in[i] = (const float*)d_in[i];
    a.out = (float*)d_out; a.ws = (unsigned char*)d_ws;
    hipLaunchKernelGGL(mk_fwd, dim3(grid), dim3(512), LDS_BYTES, stream, a);
}
```

```cpp
#include <hip/hip_runtime.h>
#include <hip/hip_bf16.h>
#include <cstdio>
#include <cstdint>

#define GAS __attribute__((address_space(1)))
#define LAS __attribute__((address_space(3)))
typedef unsigned short bf16_t;
typedef short bf16x8 __attribute__((ext_vector_type(8)));
typedef short s16x4 __attribute__((ext_vector_type(4)));
typedef float f32x2 __attribute__((ext_vector_type(2)));
typedef float f32x4 __attribute__((ext_vector_type(4)));
typedef float f32x16 __attribute__((ext_vector_type(16)));
typedef unsigned u32x2 __attribute__((ext_vector_type(2)));
typedef unsigned u32x4 __attribute__((ext_vector_type(4)));
typedef __bf16 bf16x2_t __attribute__((ext_vector_type(2)));

#ifndef DUP_MASK
#define DUP_MASK 0x0u
#endif
#define DUP(n) (1 + (int)((DUP_MASK >> (n)) & 1u))
#ifndef G2REP
#define G2REP 1
#endif
#ifndef G1REP
#define G1REP 1
#endif
#ifndef UPREP
#define UPREP 1
#endif
#ifndef PH_MASK
#define PH_MASK 0xFFFFFFFFu
#endif
#define PH(n) ((PH_MASK >> (n)) & 1u)
constexpr int D = 1024, NB = 4, SEQ = 8192, T = NB * SEQ, DEPTH = 2;
constexpr int IN_COLS = 2052, NPROJ = 2048;
constexpr int C_QA = 0, C_KA = 512, C_VA = 640, C_XB = 768, C_GB = 1024, C_QC = 1280, C_KC = 1536, C_VC = 1792;
constexpr int NCLS = 24, LCAP = 32768;
constexpr float EPS = 1e-6f;
constexpr float LOG2E = 1.4426950408889634f;
constexpr float C2 = 0.125f * 1.4426950408889634f;

constexpr size_t MiB = 1u << 20;
constexpr size_t WS_CTL = 0, CTL_ZERO_BYTES = 1 * MiB;
constexpr size_t WS_MOD = 1 * MiB;
constexpr size_t WS_CUM = WS_MOD + 256 * 1024;
constexpr size_t WS_CTOT = WS_CUM + 512 * 1024;
constexpr size_t WS_LRUA = 2 * MiB;
constexpr size_t WS_LRUH = WS_LRUA + 512 * 1024;
constexpr size_t WS_LIST = 4 * MiB;
constexpr size_t WS_WIN = 16 * MiB;
constexpr size_t WS_WOUT = 24 * MiB;
constexpr size_t WS_WGU = 28 * MiB;
constexpr size_t WS_WDP = 60 * MiB;
constexpr size_t WS_XA = 108 * MiB;
constexpr size_t WS_H = 236 * MiB;
constexpr size_t WS_PROJ = 300 * MiB;
constexpr size_t WS_Y = 428 * MiB;
constexpr size_t WS_P = WS_PROJ + 64 * MiB;
constexpr size_t WS_M = WS_Y;
constexpr size_t WS_END = 492 * MiB;
constexpr int CW_BAR = 4096;
constexpr int CW_KM = 20480;
constexpr int CW_Q = 21504;
constexpr int CW_CNT = 16384;

struct LEntry { int tok; float w0, w1; int pad; };

constexpr int RING_BYTES = 131072;
constexpr int LDSCTL_OFF = RING_BYTES;
constexpr int MISC_OFF = LDSCTL_OFF + 320;
constexpr int TT_OFF = LDSCTL_OFF + 1024;
constexpr int LDS_BYTES = 147456;

__device__ __forceinline__ unsigned cvtpk(float lo, float hi) { f32x2 v = {lo, hi}; bf16x2_t b = __builtin_convertvector(v, bf16x2_t); return __builtin_bit_cast(unsigned, b); }
__device__ __forceinline__ float bf2f(bf16_t v) { return __builtin_bit_cast(float, (unsigned)v << 16); }
__device__ __forceinline__ f32x4 bf4_to_f32(u32x2 v) { return (f32x4){__uint_as_float(v.x << 16), __uint_as_float(v.x & 0xffff0000u), __uint_as_float(v.y << 16), __uint_as_float(v.y & 0xffff0000u)}; }
template <int M> __device__ __forceinline__ float shx(float v) {
    return __int_as_float(__builtin_amdgcn_ds_swizzle(__float_as_int(v), (M << 10) | 0x1f));
}
__device__ __forceinline__ float wave_sum(float v) {
    v += shx<1>(v); v += shx<2>(v); v += shx<4>(v); v += shx<8>(v); v += shx<16>(v);
    auto rr = __builtin_amdgcn_permlane32_swap(__float_as_uint(v), __float_as_uint(v), false, false);
    return __uint_as_float(rr[0]) + __uint_as_float(rr[1]);
}
__device__ __forceinline__ float fast_exp(float x) { return __builtin_amdgcn_exp2f(x * LOG2E); }
__device__ __forceinline__ float sigmoidf_(float x) { return __builtin_amdgcn_rcpf(1.f + fast_exp(-x)); }
__device__ __forceinline__ float gelu_tanh(float x) {
    const float u = 0.7978845608028654f * (x + 0.044715f * x * x * x);
    const float e = fast_exp(2.f * u);
    const float th = 1.f - 2.f * __builtin_amdgcn_rcpf(e + 1.f);
    return 0.5f * x * (1.f + th);
}
#define LDS_WAIT() asm volatile("s_waitcnt lgkmcnt(0)" ::: "memory")
#define VM_WAIT() asm volatile("s_waitcnt vmcnt(0)" ::: "memory")

namespace pg8 {
constexpr int BM = 256, BK = 64, HALF = 128, HTB = HALF * BK * 2, STAGE_BYTES = 8 * HTB, NXCD = 8, WGM = 8;
__host__ __device__ __forceinline__ int lds_byte(int r, int c) { const int st = (r >> 4) * 2 + (c >> 5), rr = r & 15, cc = c & 31, ob = rr * 64 + cc * 2; return st * 1024 + (ob ^ (((ob >> 9) & 1) << 5)); }
__host__ __device__ __forceinline__ void stage_rc(int b, int& R, int& C) { const int st = b / 1024, sb = b % 1024, swz = sb ^ (((sb >> 9) & 1) << 5); R = (st >> 1) * 16 + swz / 64; C = (st & 1) * 32 + (swz % 64) / 2; }
__host__ __device__ __forceinline__ int perm32(int rho) { const int n = rho >> 4, i = rho & 15; return 8 * (i >> 2) + 4 * n + (i & 3); }

struct GUnit { int a0; const char* bb; int e0, e1, e2, e3; };

__device__ __forceinline__ int xcd_remap(int L, int nwg) {
    const int q = nwg / NXCD, r = nwg % NXCD, xcd = L % NXCD, off = L / NXCD;
    return (xcd < r ? xcd * (q + 1) : r * (q + 1) + (xcd - r) * q) + off;
}

struct DenseOrder {
    int nM, nN, nwg, G, c, rep; const char* Bt; unsigned pitchB;
    __device__ __forceinline__ void init(int M, int N, int G_, int c_, const void* Bt_, unsigned pitchB_, int rep_ = 1) { nM = M / BM; nN = N / BM; nwg = nM * nN; G = G_; c = c_; Bt = (const char*)Bt_; pitchB = pitchB_; rep = rep_; }
    __device__ __forceinline__ bool next(int i, GUnit& u) const {
        const long L = (long)i * G + c; if (L >= (long)nwg * rep) return false;
        const int wgid = xcd_remap((int)(L % nwg), nwg);
        const int nig = WGM * nN, gid = wgid / nig, fm = gid * WGM, gsz = (nM - fm) < WGM ? (nM - fm) : WGM;
        const int pm = fm + ((wgid % nig) % gsz), pn = (wgid % nig) / gsz;
        u.a0 = pm * BM; u.bb = Bt + (size_t)pn * BM * pitchB; u.e0 = pm; u.e1 = pn; u.e2 = 0; u.e3 = 0; return true;
    }
    __device__ __forceinline__ unsigned arow(const GUnit& u, int r) const { return (unsigned)(u.a0 + r); }
};

#define PG8_SA(b, h) (((b) * 2 + (h)) * HTB)
#define PG8_SB(b, h) ((4 + (b) * 2 + (h)) * HTB)
#define PG8_STG(bufoff, gptr, v0, v1) do { \
        __builtin_amdgcn_global_load_lds((const unsigned*)((const char*)(gptr) + (v0)), (LAS unsigned*)(lds + (bufoff) + ldsw), 16, 0, 0); \
        __builtin_amdgcn_global_load_lds((const unsigned*)((const char*)(gptr) + (v1)), (LAS unsigned*)(lds + (bufoff) + ldsw + 8192), 16, 0, 0); } while (0)
#define PG8_STGA(bufoff, kb, vo) PG8_STG(bufoff, Abase + (kb), (vo)[0], (vo)[1])
#define PG8_STGB(bufoff, bp) PG8_STG(bufoff, bp, voffB[0], voffB[1])
#define PG8_LDA(dst, b, h) do { _Pragma("unroll") for (int m = 0; m < 4; ++m) _Pragma("unroll") for (int k = 0; k < 2; ++k) dst[m][k] = *(const LAS bf16x8*)(lds + PG8_SA(b, h) + aoff + m * 2048 + k * 1024); } while (0)
#define PG8_LDB(dst, b, h) do { _Pragma("unroll") for (int n = 0; n < 2; ++n) _Pragma("unroll") for (int k = 0; k < 2; ++k) dst[n][k] = *(const LAS bf16x8*)(lds + PG8_SB(b, h) + boff + n * 2048 + k * 1024); } while (0)
#define PG8_MMA(ai, bj, At, Bt) do { __builtin_amdgcn_s_setprio(1); _Pragma("unroll") for (int m = 0; m < 4; ++m) _Pragma("unroll") for (int n = 0; n < 2; ++n) _Pragma("unroll") for (int k = 0; k < 2; ++k) \
        acc[ai][bj][m][n] = __builtin_amdgcn_mfma_f32_16x16x32_bf16(Bt[n][k], At[m][k], acc[ai][bj][m][n], 0, 0, 0); __builtin_amdgcn_s_setprio(0); } while (0)
#define PG8_WAIT_V(n) asm volatile("s_waitcnt vmcnt(" #n ")" ::: "memory")
#define PG8_WAIT_L(n) asm volatile("s_waitcnt lgkmcnt(" #n ")" ::: "memory")
#define PG8_BAR __builtin_amdgcn_s_barrier()
#define PG8_SCHED __builtin_amdgcn_sched_barrier(0)

template <class Epi, class Sched, bool ALIGN_EPI>
__device__ __forceinline__ void gemm_phase(const int tid, LAS unsigned char* lds, const char* Abase, unsigned pitchA, unsigned pitchB, int K, const Sched& S, const Epi& E) {
    const int wid = __builtin_amdgcn_readfirstlane(tid >> 6), lane = tid & 63, wr = wid >> 2, wc = wid & 3, fr = lane & 15, fq = lane >> 4;
    const int nt = K / BK;
    int RA[2]; unsigned cA2[2], voffB[2];
#pragma unroll
    for (int i = 0; i < 2; ++i) { int R, C; stage_rc(tid * 16 + i * 8192, R, C); const int Rb = Epi::PERM ? ((R & ~31) + perm32(R & 31)) : R;
        RA[i] = R; cA2[i] = (unsigned)C * 2u; voffB[i] = (unsigned)Rb * pitchB + (unsigned)C * 2u; }
    const unsigned hstepB = (unsigned)HALF * pitchB;
    const unsigned ldsw = (unsigned)wid * 1024u;
    const int aoff = lds_byte(wr * 64 + fr, fq * 8), boff = lds_byte(wc * 32 + fr, fq * 8);
    GUnit cur, nxt; int ui = 0;
    if (!S.next(0, cur)) return;
    f32x4 acc[2][2][4][2];
#pragma unroll
    for (int a = 0; a < 2; ++a)
#pragma unroll
        for (int b = 0; b < 2; ++b)
#pragma unroll
            for (int m = 0; m < 4; ++m)
#pragma unroll
                for (int n = 0; n < 2; ++n) acc[a][b][m][n] = (f32x4){0.f, 0.f, 0.f, 0.f};
    bf16x8 At[4][2], B0[2][2], B1[2][2];
    unsigned voA[2][2];
#pragma unroll
    for (int h = 0; h < 2; ++h)
#pragma unroll
        for (int i = 0; i < 2; ++i) voA[h][i] = S.arow(cur, h * HALF + RA[i]) * pitchA + cA2[i];
    const char* cB = cur.bb;
    const unsigned kstep = BK * 2;
    PG8_STGB(PG8_SB(0, 0), cB); PG8_STGB(PG8_SB(0, 1), cB + hstepB); PG8_STGA(PG8_SA(0, 0), 0, voA[0]); PG8_STGA(PG8_SA(0, 1), 0, voA[1]);
    if (wr == 1) PG8_BAR;
    PG8_WAIT_V(2); PG8_BAR;
    PG8_STGB(PG8_SB(1, 0), cB + kstep); PG8_STGA(PG8_SA(1, 0), kstep, voA[0]); PG8_STGB(PG8_SB(1, 1), cB + hstepB + kstep);
    PG8_WAIT_V(6); PG8_BAR;
    for (;;) {
        const bool has_next = S.next(ui + 1, nxt);
        const char* nB = has_next ? nxt.bb : cB;
        for (int t = 0; t < nt; t += 2) {
            const bool last = (t == nt - 2);
            const unsigned kb1 = (unsigned)(t + 1) * kstep;
            const unsigned kb2 = last ? 0u : (unsigned)(t + 2) * kstep, kb3 = kb2 + kstep;
            const char* b2 = last ? nB : cB + (size_t)(t + 2) * kstep; const char* b3 = b2 + kstep;
            PG8_LDB(B0, 0, 0); PG8_LDB(B1, 0, 1); PG8_SCHED; PG8_LDA(At, 0, 0); PG8_STGA(PG8_SA(1, 1), kb1, voA[1]);
            if (last && has_next) {
#pragma unroll
                for (int h = 0; h < 2; ++h)
#pragma unroll
                    for (int i = 0; i < 2; ++i) voA[h][i] = S.arow(nxt, h * HALF + RA[i]) * pitchA + cA2[i]; }
            PG8_WAIT_V(8); PG8_WAIT_L(0); PG8_BAR; PG8_MMA(0, 0, At, B0); PG8_MMA(0, 1, At, B1); PG8_BAR; PG8_SCHED;
            PG8_LDA(At, 0, 1); PG8_STGB(PG8_SB(0, 0), b2); PG8_STGB(PG8_SB(0, 1), b2 + hstepB); PG8_STGA(PG8_SA(0, 0), kb2, voA[0]);
            PG8_WAIT_V(8); PG8_WAIT_L(0); PG8_BAR; PG8_MMA(1, 0, At, B0); PG8_MMA(1, 1, At, B1); PG8_BAR; PG8_SCHED;
            PG8_LDB(B0, 1, 0); PG8_LDB(B1, 1, 1); PG8_SCHED; PG8_LDA(At, 1, 0); PG8_STGA(PG8_SA(0, 1), kb2, voA[1]);
            PG8_WAIT_V(8); PG8_WAIT_L(0); PG8_BAR; PG8_MMA(0, 0, At, B0); PG8_MMA(0, 1, At, B1); PG8_BAR; PG8_SCHED;
            PG8_LDA(At, 1, 1); PG8_STGB(PG8_SB(1, 0), b3); PG8_STGB(PG8_SB(1, 1), b3 + hstepB); PG8_STGA(PG8_SA(1, 0), kb3, voA[0]);
            PG8_WAIT_V(8); PG8_WAIT_L(0); PG8_BAR; PG8_MMA(1, 0, At, B0); PG8_MMA(1, 1, At, B1); PG8_BAR; PG8_SCHED;
        }
        if constexpr (ALIGN_EPI) { if (wr == 0) PG8_BAR; }
        E(acc, cur, wr, wc, fr, fq);
        if (!has_next) break;
#pragma unroll
        for (int a = 0; a < 2; ++a)
#pragma unroll
            for (int b = 0; b < 2; ++b)
#pragma unroll
                for (int m = 0; m < 4; ++m)
#pragma unroll
                    for (int n = 0; n < 2; ++n) acc[a][b][m][n] = (f32x4){0.f, 0.f, 0.f, 0.f};
        cur = nxt; cB = nB; ++ui;
        if constexpr (ALIGN_EPI) { if (wr == 1) PG8_BAR; }
    }
    PG8_WAIT_V(0);
    if constexpr (!ALIGN_EPI) { if (wr == 0) PG8_BAR; }
    PG8_BAR;
}
}

#define XB_TMO      128
#define XB_XCNT(j)  (256  + 64 * (j))
#define XB_XSUB(j)  (1280 + 64 * (j))
#define XB_XGEN(j)  (2304 + 64 * (j))
#define XB_TOP      3328
#define XB_TOPGEN   3392
#define XCD_BAR_WORDS 3456
#define XB_SPIN_CAP (1u << 18)
__device__ __forceinline__ unsigned xb_ld(unsigned* p)              { return __hip_atomic_load(p, __ATOMIC_RELAXED, __HIP_MEMORY_SCOPE_AGENT); }
__device__ __forceinline__ unsigned xb_add(unsigned* p, unsigned v) { return __hip_atomic_fetch_add(p, v, __ATOMIC_RELAXED, __HIP_MEMORY_SCOPE_AGENT); }
__device__ __forceinline__ unsigned xb_xcc_id() { return (unsigned)__builtin_amdgcn_s_getreg((3 << 11) | 20) & 0xFu; }
#define XB_SPIN(cond, bar) do { unsigned _sp = 0; while (cond) { __builtin_amdgcn_s_sleep(1); \
    if ((++_sp & 255u) == 0u) { if (xb_ld(&(bar)[XB_TMO])) break; if (_sp > XB_SPIN_CAP) { atomicAdd(&(bar)[XB_TMO], 1u); break; } } } } while (0)
struct XcdBarrier { unsigned* bar; unsigned x; volatile LAS unsigned* st; };
__device__ __forceinline__ XcdBarrier xcd_barrier_post(unsigned* bar, volatile LAS unsigned* st) {
    XcdBarrier b; b.bar = bar; b.x = xb_xcc_id(); b.st = st;
    if (threadIdx.x == 0) (void)xb_add(&bar[XB_XCNT(b.x)], 1u);
    return b;
}
__device__ __forceinline__ void xcd_barrier_complete(unsigned* bar, unsigned x, unsigned& nloc, unsigned& nx) {
    const unsigned G = gridDim.x * gridDim.y * gridDim.z;
    unsigned sum, cnt, mine, sp = 0u;
    for (;;) {
        sum = 0u; cnt = 0u; mine = 0u;
#pragma unroll
        for (unsigned j = 0; j < 16; ++j) { const unsigned c = xb_ld(&bar[XB_XCNT(j)]); sum += c; cnt += (c > 0u) ? 1u : 0u; mine = (j == x) ? c : mine; }
        if (sum == G) break;
        __builtin_amdgcn_s_sleep(1);
        if ((++sp & 255u) == 0u) { if (xb_ld(&bar[XB_TMO])) break; if (sp > XB_SPIN_CAP) { atomicAdd(&bar[XB_TMO], 1u); break; } }
    }
    nloc = mine > 0u ? mine : 1u; nx = cnt > 0u ? cnt : 1u;
}
__device__ __forceinline__ void xcd_barrier(const XcdBarrier& b, const int tid) {
    asm volatile("s_waitcnt vmcnt(0)" ::: "memory");
    __syncthreads();
    if (tid == 0) {
        unsigned* bar = b.bar; const unsigned bx_ = xb_xcc_id();
        __builtin_amdgcn_s_waitcnt(0);
        unsigned nloc = b.st[0], nx = b.st[1];
        if (nloc == 0u) { xcd_barrier_complete(bar, bx_, nloc, nx); b.st[0] = nloc; b.st[1] = nx; }
        const unsigned old = xb_add(&bar[XB_XSUB(bx_)], 1u);
        const unsigned gen = old / nloc;
        if (old + 1u == (gen + 1u) * nloc) {
            __builtin_amdgcn_fence(__ATOMIC_RELEASE, "agent");
            asm volatile("s_waitcnt vmcnt(0)" ::: "memory");
            const unsigned og = xb_add(&bar[XB_TOP], 1u);
            const unsigned tg = og / nx;
            if (og + 1u == (tg + 1u) * nx) xb_add(&bar[XB_TOPGEN], 1u);
            else XB_SPIN(xb_ld(&bar[XB_TOPGEN]) == tg, bar);
            __builtin_amdgcn_fence(__ATOMIC_ACQUIRE, "agent");
            xb_add(&bar[XB_XGEN(bx_)], 1u);
            asm volatile("s_waitcnt vmcnt(0)" ::: "memory");
        } else {
            XB_SPIN(xb_ld(&bar[XB_XGEN(bx_)]) == gen, bar);
            __builtin_amdgcn_fence(__ATOMIC_ACQUIRE, "agent");
            asm volatile("s_waitcnt vmcnt(0)" ::: "memory");
        }
    }
    __syncthreads();
}

__device__ __forceinline__ const void* launder_ptr(const void* p) {
    unsigned lo = (unsigned)(uintptr_t)p, hi = (unsigned)((uintptr_t)p >> 32);
    asm volatile("" : "+v"(lo), "+v"(hi));
    lo = __builtin_amdgcn_readfirstlane(lo); hi = __builtin_amdgcn_readfirstlane(hi);
    return (const void*)(((uintptr_t)hi << 32) | (uintptr_t)lo);
}
struct Args { const float* in[26]; float* out; unsigned char* ws; };

__device__ __forceinline__ const void* karg_ptr(int idx) {
    const unsigned long long ka = (unsigned long long)__builtin_amdgcn_kernarg_segment_ptr();
    unsigned long long v; asm volatile("s_load_dwordx2 %0, %1, %2\n\ts_waitcnt lgkmcnt(0)" : "=s"(v) : "s"(ka), "s"(idx * 8) : "memory");
    return (const void*)(GAS const void*)(uintptr_t)v;
}
struct Frame {
    LAS unsigned char* lds; char* shm;
    int tid, lane, wave, vcu, G;
    float* out; unsigned char* ws; int wave_s;
    __device__ __forceinline__ const float* inp(int i) const { return (const float*)karg_ptr(i); }
};
__device__ __forceinline__ void frame_refresh(Frame& F) {
    asm volatile("" ::: "memory");
    int t_; asm volatile("v_mbcnt_lo_u32_b32 %0, -1, 0\n\tv_mbcnt_hi_u32_b32 %0, -1, %0" : "=v"(t_)); t_ |= (F.wave_s << 6);
    F.tid = t_; F.lane = t_ & 63; F.wave = __builtin_amdgcn_readfirstlane(t_ >> 6);
    F.out = (float*)karg_ptr(26); F.ws = (unsigned char*)karg_ptr(27);
}
#define F_X 0
#define F_C 1
#define F_WMOD 2
#define F_BMOD 3
#define F_NMIX 4
#define F_NFFN 5
#define F_WIN 6
#define F_WOUT 7
#define F_OGAIN 8
#define F_SINKS 9
#define F_CONVW 10
#define F_CONVB 11
#define F_LWA 12
#define F_LBA 13
#define F_LWX 14
#define F_LBX 15
#define F_LAM 16
#define F_FOXB 17
#define F_WRG 18
#define F_BRG 19
#define F_WRE 20
#define F_BRE 21
#define F_WGATE 22
#define F_WUP 23
#define F_WDOWN 24
#define F_NFIN 25

struct EpiProj {
    static constexpr bool PERM = true;
    bf16_t* O; unsigned* km;
    __device__ __forceinline__ void operator()(const f32x4 (&acc)[2][2][4][2], const pg8::GUnit& u, int wr, int wc, int fr, int fq) const {
        const int row0 = u.e0 * 256 + wr * 64 + fr, pn = u.e1;
        const float sc = (pn == 0 || pn == 1 || pn == 5) ? C2 : 1.f;
        const int col0 = pn * 256 + wc * 32 + 8 * fq;
#pragma unroll
        for (int ai = 0; ai < 2; ++ai)
#pragma unroll
            for (int m = 0; m < 4; ++m) { bf16_t* rowp = O + (size_t)(row0 + ai * 128 + m * 16) * NPROJ + col0;
#pragma unroll
                for (int bj = 0; bj < 2; ++bj) { const f32x4 v0 = acc[ai][bj][m][0] * sc, v1 = acc[ai][bj][m][1] * sc;
                    u32x4 w; w.x = cvtpk(v0[0], v0[1]); w.y = cvtpk(v0[2], v0[3]); w.z = cvtpk(v1[0], v1[1]); w.w = cvtpk(v1[2], v1[3]);
                    *(u32x4*)(rowp + bj * 128) = w; } }
        if (pn == 6) {
            const int b = u.e0 >> 5;
#pragma unroll
            for (int bj = 0; bj < 2; ++bj) { float mx = 0.f;
#pragma unroll
                for (int ai = 0; ai < 2; ++ai)
#pragma unroll
                    for (int m = 0; m < 4; ++m) { const f32x4 v0 = acc[ai][bj][m][0], v1 = acc[ai][bj][m][1];
                        mx = __builtin_fmaxf(mx, (v0[0] * v0[0] + v0[1] * v0[1]) + (v0[2] * v0[2] + v0[3] * v0[3]) + (v1[0] * v1[0] + v1[1] * v1[1]) + (v1[2] * v1[2] + v1[3] * v1[3])); }
                mx = __builtin_fmaxf(mx, shx<1>(mx)); mx = __builtin_fmaxf(mx, shx<2>(mx)); mx = __builtin_fmaxf(mx, shx<4>(mx)); mx = __builtin_fmaxf(mx, shx<8>(mx));
                if (fr == 0) atomicMax(km + ((b * 4 + 2 * bj + (wc >> 1)) * 8 + 4 * (wc & 1) + fq), __float_as_uint(mx)); }
        }
    }
};
struct EpiP {
    static constexpr bool PERM = true;
    bf16_t* P;
    __device__ __forceinline__ void operator()(const f32x4 (&acc)[2][2][4][2], const pg8::GUnit& u, int wr, int wc, int fr, int fq) const {
        const int row0 = u.e0 * 256 + wr * 64 + fr, col0 = u.e1 * 256 + wc * 32 + 8 * fq;
#pragma unroll
        for (int ai = 0; ai < 2; ++ai)
#pragma unroll
            for (int m = 0; m < 4; ++m) { bf16_t* rowp = P + (size_t)(row0 + ai * 128 + m * 16) * D + col0;
#pragma unroll
                for (int bj = 0; bj < 2; ++bj) { const f32x4 v0 = acc[ai][bj][m][0], v1 = acc[ai][bj][m][1];
                    u32x4 w; w.x = cvtpk(v0[0], v0[1]); w.y = cvtpk(v0[2], v0[3]); w.z = cvtpk(v1[0], v1[1]); w.w = cvtpk(v1[2], v1[3]);
                    *(u32x4*)(rowp + bj * 128) = w; } }
    }
};
struct EpiUp {
    static constexpr bool PERM = true;
    bf16_t* HID; const LEntry* list; const unsigned* cnt;
    __device__ __forceinline__ void operator()(const f32x4 (&acc)[2][2][4][2], const pg8::GUnit& u, int wr, int wc, int fr, int fq) const {
        const int pn = u.e1, slot = pn >> 1, pnl = pn & 1, cls = u.e2;
        const unsigned n = __hip_atomic_load(cnt + 64 * cls, __ATOMIC_RELAXED, __HIP_MEMORY_SCOPE_AGENT);
        const int colh = 256 * slot + 128 * pnl + wc * 32 + 8 * fq;
        float wrow[8];
#pragma unroll
        for (int k = 0; k < 8; ++k) { const int r = (k >> 2) * 128 + wr * 64 + (k & 3) * 16 + fr; const unsigned pos = (unsigned)(u.e3 + r);
            const LEntry* e = list + (size_t)cls * LCAP + (pos < n ? pos : 0u); const float w = slot ? e->w1 : e->w0; wrow[k] = pos < n ? w : 0.f; }
#pragma unroll
        for (int ai = 0; ai < 2; ++ai)
#pragma unroll
            for (int m = 0; m < 4; ++m) { const int r = ai * 128 + wr * 64 + m * 16 + fr; const float w = wrow[ai * 4 + m];
                float h[8];
#pragma unroll
                for (int nn = 0; nn < 2; ++nn)
#pragma unroll
                    for (int i = 0; i < 4; ++i) { const float g = acc[ai][0][m][nn][i], up = acc[ai][1][m][nn][i]; h[nn * 4 + i] = g * sigmoidf_(g) * up * w; }
                u32x4 o; o.x = cvtpk(h[0], h[1]); o.y = cvtpk(h[2], h[3]); o.z = cvtpk(h[4], h[5]); o.w = cvtpk(h[6], h[7]);
                *(u32x4*)(HID + (size_t)(u.e0 * 256 + r) * 512 + colh) = o; }
    }
};
struct EpiDown {
    static constexpr bool PERM = true;
    bf16_t* M; const LEntry* list; const unsigned* cnt;
    __device__ __forceinline__ void operator()(const f32x4 (&acc)[2][2][4][2], const pg8::GUnit& u, int wr, int wc, int fr, int fq) const {
        const int cls = u.e2, col0 = u.e1 * 256 + wc * 32 + 8 * fq;
        const unsigned n = __hip_atomic_load(cnt + 64 * cls, __ATOMIC_RELAXED, __HIP_MEMORY_SCOPE_AGENT);
        int tok[8];
#pragma unroll
        for (int k = 0; k < 8; ++k) { const int r = (k >> 2) * 128 + wr * 64 + (k & 3) * 16 + fr; const unsigned pos = (unsigned)(u.e3 + r);
            const int t = list[(size_t)cls * LCAP + (pos < n ? pos : 0u)].tok; tok[k] = pos < n ? t : -1; }
#pragma unroll
        for (int k = 0; k < 8; ++k) { const int ai = k >> 2, m = k & 3;
            if (tok[k] >= 0) { bf16_t* rowp = M + (size_t)tok[k] * D + col0;
#pragma unroll
                for (int bj = 0; bj < 2; ++bj) { const f32x4 v0 = acc[ai][bj][m][0], v1 = acc[ai][bj][m][1];
                    u32x4 w; w.x = cvtpk(v0[0], v0[1]); w.y = cvtpk(v0[2], v0[3]); w.z = cvtpk(v1[0], v1[1]); w.w = cvtpk(v1[2], v1[3]);
                    *(u32x4*)(rowp + bj * 128) = w; } } }
    }
};

__device__ __forceinline__ void pair_of(int p, int& lo, int& hi) { lo = p < 3 ? 0 : (p < 5 ? 1 : 2); hi = p < 3 ? p + 1 : (p < 5 ? p - 1 : 3); }
struct MoeUpOrder {
    int nunits, G, c; const LAS int* tt; const char* WGU; const LEntry* list; const unsigned* cnt;
    __device__ __forceinline__ bool next(int i, pg8::GUnit& u) const {
        const long L = (long)i * G + c; if (L >= (long)nunits * UPREP) return false;
        const int wgid = pg8::xcd_remap((int)(L % nunits), nunits); const int tile = wgid >> 2, pn = wgid & 3; const int e = tt[tile];
        const int cls = e & 255; u.e0 = tile; u.e1 = pn; u.e2 = cls; u.e3 = e >> 8; u.a0 = 0;
        int lo, hi; pair_of(cls % 6, lo, hi); const int ex = (cls / 6) * 4 + ((pn >> 1) ? hi : lo);
        u.bb = WGU + ((size_t)ex * 512 + (size_t)(pn & 1) * 256) * 2048; return true;
    }
    __device__ __forceinline__ unsigned arow(const pg8::GUnit& u, int r) const {
        const unsigned n = __hip_atomic_load(cnt + 64 * u.e2, __ATOMIC_RELAXED, __HIP_MEMORY_SCOPE_AGENT); const unsigned pos = (unsigned)(u.e3 + r);
        return (unsigned)list[(size_t)u.e2 * LCAP + (pos < n ? pos : 0u)].tok;
    }
};
struct MoeDownOrder {
    int nunits, G, c; const LAS int* tt; const char* WDP;
    __device__ __forceinline__ bool next(int i, pg8::GUnit& u) const {
        const long L = (long)i * G + c; if (L >= nunits) return false;
        const int wgid = pg8::xcd_remap((int)L, nunits); const int tile = wgid >> 2, pn = wgid & 3; const int e = tt[tile];
        const int cls = e & 255; u.e0 = tile; u.e1 = pn; u.e2 = cls; u.e3 = e >> 8; u.a0 = tile * 256;
        u.bb = WDP + ((size_t)cls * 1024 + (size_t)pn * 256) * 1024; return true;
    }
    __device__ __forceinline__ unsigned arow(const pg8::GUnit& u, int r) const { return (unsigned)(u.a0 + r); }
};

namespace att {
constexpr int DM = NPROJ;
constexpr int SLOTB = 8192;
constexpr int LDS_K = 0, LDS_V = 3 * SLOTB, LDS_WS = 6 * SLOTB, LDS_OST = LDS_WS + 2048, LDS_BIAS = LDS_OST + 8 * 4096, LDS_BLK = LDS_BIAS + 32768, LDS_MM = LDS_BLK + 256  , LDS_QM = LDS_MM + 96  , LDS_END = LDS_QM + 32;
static_assert(LDS_END <= RING_BYTES, "attention LDS");
typedef LAS const char* lds_cptr;
__device__ __forceinline__ int crow(int r, int hi) { return (r & 3) + 8 * (r >> 2) + 4 * hi; }
__device__ __forceinline__ void glds16(const void* gsrc, unsigned lds_dst) { unsigned keep;
    asm volatile("s_mov_b32 %0, m0\n\ts_mov_b32 m0, %2\n\ts_nop 0\n\tglobal_load_lds_dwordx4 %1, off\n\ts_mov_b32 m0, %0" : "=&s"(keep) : "v"(gsrc), "s"(lds_dst) : "memory"); }
__device__ __forceinline__ float max3f(float a, float b, float c) { return __builtin_fmaxf(__builtin_fmaxf(a, b), c); }
#define ATT_WAIT_BAR(N) asm volatile("s_waitcnt vmcnt(" #N ") lgkmcnt(0)\n\ts_barrier" ::: "memory")
typedef short v4i16_t __attribute__((ext_vector_type(4)));
__device__ __forceinline__ s16x4 vtr(lds_cptr p) { return __builtin_bit_cast(s16x4, __builtin_amdgcn_ds_read_tr16_b64_v4i16((LAS v4i16_t*)p)); }
__device__ __forceinline__ float rowmax(const f32x16& p0, const f32x16& p1) {
    float a = max3f(p0[0], p0[1], p1[0]), b = max3f(p0[2], p0[3], p1[1]); a = max3f(a, p1[2], p1[3]);
#pragma unroll
    for (int r = 4; r < 16; r += 4) { a = max3f(a, p0[r], p0[r + 1]); b = max3f(b, p0[r + 2], p0[r + 3]); a = max3f(a, p1[r], p1[r + 1]); b = max3f(b, p1[r + 2], p1[r + 3]); }
    const float m = __builtin_fmaxf(a, b);
    auto rr = __builtin_amdgcn_permlane32_swap(__float_as_uint(m), __float_as_uint(m), false, false);
    return __builtin_fmaxf(__uint_as_float(rr[0]), __uint_as_float(rr[1]));
}
__device__ __forceinline__ void pv(f32x16* o, int vb, bf16x8 pa0, bf16x8 pa1, bf16x8 pa2, bf16x8 pa3) {
#pragma unroll
    for (int d0 = 0; d0 < 2; ++d0) { s16x4 lo[4], hi[4];
#pragma unroll
        for (int ks = 0; ks < 4; ++ks) {
            asm volatile("ds_read_b64_tr_b16 %0,%1 offset:%c2" : "=&v"(lo[ks]) : "v"(vb), "i"(d0 * 4096 + ks * 1024) : "memory");
            asm volatile("ds_read_b64_tr_b16 %0,%1 offset:%c2" : "=&v"(hi[ks]) : "v"(vb), "i"(d0 * 4096 + ks * 1024 + 512) : "memory"); }
        asm volatile("s_waitcnt lgkmcnt(0)" ::: "memory"); __builtin_amdgcn_sched_barrier(0);
#define ATT_PK(k) (bf16x8){lo[k][0], lo[k][1], lo[k][2], lo[k][3], hi[k][0], hi[k][1], hi[k][2], hi[k][3]}
        o[d0] = __builtin_amdgcn_mfma_f32_32x32x16_bf16(pa0, ATT_PK(0), o[d0], 0, 0, 0);
        o[d0] = __builtin_amdgcn_mfma_f32_32x32x16_bf16(pa1, ATT_PK(1), o[d0], 0, 0, 0);
        o[d0] = __builtin_amdgcn_mfma_f32_32x32x16_bf16(pa2, ATT_PK(2), o[d0], 0, 0, 0);
        o[d0] = __builtin_amdgcn_mfma_f32_32x32x16_bf16(pa3, ATT_PK(3), o[d0], 0, 0, 0);
#undef ATT_PK
    }
}
template <int MODE>
__device__ __forceinline__ void attn_core(char* shm, const bf16_t* Qw, const bf16_t* Kh, const bf16_t* Vh, bf16_t* Ow, int q0, const int qw0, int t_lo, int t_hi, const int bias_off, float sinkl2, float slope2, const int tid, const float kn2 = 0.f) {
    const int lane = tid & 63, r32 = lane & 31, hi = lane >> 5; const int wid = __builtin_amdgcn_readfirstlane(tid >> 6);
    const unsigned lds0 = (unsigned)(uintptr_t)shm;
    float* wsf = (float*)(shm + LDS_WS) + wid * 64;
    const lds_cptr shm3 = (lds_cptr)shm;
    const bf16_t* ksrc = Kh + (long)lane * DM + wid * 8;
    const bf16_t* vsrc = Vh + (long)(16 * (wid & 3) + (lane >> 2)) * DM + (wid >> 2) * 32 + (lane & 3) * 8;
    const unsigned kdst = lds0 + LDS_K + wid * 1024, vdst = lds0 + LDS_V + wid * 1024;
#define ATT_DMA_K(t, slot) glds16(ksrc + (long)(t) * 64 * DM, (unsigned)__builtin_amdgcn_readfirstlane(kdst + (slot)))
#define ATT_DMA_V(t, slot) glds16(vsrc + (long)(t) * 64 * DM, (unsigned)__builtin_amdgcn_readfirstlane(vdst + (slot)))
    const int vb0 = (int)(lds0 + LDS_V) + ((lane >> 4) & 1) * 32 + (lane & 3) * 8 + (4 * hi + ((lane & 15) >> 2)) * 64;
    const int n = t_hi - t_lo + 1;
    const int w_hi = (qw0 + 31) >> 6;
    const int w_lo = (MODE == 1) ? ((qw0 - 127 > 0 ? qw0 - 127 : 0) >> 6) : t_lo;
    bf16x8 qr[4];
#pragma unroll
    for (int d0 = 0; d0 < 4; ++d0) qr[d0] = *reinterpret_cast<const bf16x8*>(&Qw[(long)r32 * DM + d0 * 16 + hi * 8]);
    ATT_DMA_K(t_hi, 0); ATT_DMA_V(t_hi, 0);
    if (n > 1) { ATT_DMA_K(t_hi - 1, SLOTB); ATT_DMA_V(t_hi - 1, SLOTB); }
    LAS float* mmp = (LAS float*)(shm3 + LDS_MM); LAS float* qmp = (LAS float*)(shm3 + LDS_QM);
    if (MODE == 0) {
        float qs = 0.f;
#pragma unroll
        for (int d0 = 0; d0 < 4; ++d0)
#pragma unroll
            for (int e = 0; e < 8; ++e) { const float v = bf2f((bf16_t)qr[d0][e]); qs += v * v; }
        { auto rr = __builtin_amdgcn_permlane32_swap(__float_as_uint(qs), __float_as_uint(qs), false, false); qs = __uint_as_float(rr[0]) + __uint_as_float(rr[1]); }
        qs = __builtin_fmaxf(qs, shx<1>(qs)); qs = __builtin_fmaxf(qs, shx<2>(qs)); qs = __builtin_fmaxf(qs, shx<4>(qs)); qs = __builtin_fmaxf(qs, shx<8>(qs)); qs = __builtin_fmaxf(qs, shx<16>(qs));
        if (lane == 0) { qmp[wid] = qs; mmp[wid] = -1e30f; mmp[8 + wid] = -1e30f; mmp[16 + wid] = -1e30f; }
    }
    float bqk = 0.f;
    float mhat = 0.f, l_reg = 0.f; f32x16 o[2]; o[0] = f32x16{}; o[1] = f32x16{}; bool first = true;
    float ex[32]; bool pend = false;
#pragma unroll
    for (int r = 0; r < 32; ++r) ex[r] = 0.f;
    const int q = qw0 + r32;
    const int grp = wid >> 2;
#define ATT_LBAR() asm volatile("s_waitcnt lgkmcnt(0)\n\ts_barrier" ::: "memory")
#define ATT_ISSUE(i2) do { if ((i2) < n) { const int sl_ = ((i2) % 3) * SLOTB; ATT_DMA_K(t_hi - (i2), sl_); ATT_DMA_V(t_hi - (i2), sl_); } } while (0)
    if (grp == 1) { if (n > 1) { ATT_WAIT_BAR(2); } else { ATT_WAIT_BAR(0); } }
#pragma unroll 1
    for (int ti = 0; ti < n; ++ti) {
        const int t = t_hi - ti, sl_cur = (ti % 3) * SLOTB;
        const bool need = (t >= w_lo && t <= w_hi);
        if (MODE == 0 && ti >= 2 && (ti & 3) == 2) {
            if (ti == 2) { const f32x4 qa = *(const LAS f32x4*)qmp, qb_ = *(const LAS f32x4*)(qmp + 4);
                const float qn2 = __builtin_fmaxf(__builtin_fmaxf(__builtin_fmaxf(qa[0], qa[1]), __builtin_fmaxf(qa[2], qa[3])), __builtin_fmaxf(__builtin_fmaxf(qb_[0], qb_[1]), __builtin_fmaxf(qb_[2], qb_[3])));
                bqk = __int_as_float(__builtin_amdgcn_readfirstlane(__float_as_int(sqrtf(qn2 * kn2) * 1.02f + 1.0f))); }
            const LAS float* mp = mmp + ((ti - 2) % 3) * 8; const f32x4 ma = *(const LAS f32x4*)mp, mb = *(const LAS f32x4*)(mp + 4);
            const float mm = __builtin_fminf(__builtin_fminf(__builtin_fminf(ma[0], ma[1]), __builtin_fminf(ma[2], ma[3])), __builtin_fminf(__builtin_fminf(mb[0], mb[1]), __builtin_fminf(mb[2], mb[3])));
            const float bmax = *((const LAS float*)(shm3 + LDS_BIAS) + (t - t_lo) * 64 + 63);
            if (__builtin_amdgcn_readfirstlane((int)(bqk + bmax < mm - 160.f))) break;
        }
        if (grp == 0) { if (ti + 1 < n) { ATT_WAIT_BAR(2); } else { ATT_WAIT_BAR(0); } }
        else { ATT_LBAR(); ATT_ISSUE(ti + 2); }
        f32x16 p0, p1;
        if (need) {
            { const LAS float* bp = (const LAS float*)(shm3 + LDS_BIAS) + bias_off + (t - t_lo) * 64 + 4 * hi;
#pragma unroll
              for (int jj = 0; jj < 4; ++jj) { const f32x4 a = *(const LAS f32x4*)(bp + 8 * jj), b = *(const LAS f32x4*)(bp + 32 + 8 * jj);
                  p0[4 * jj] = a[0] - mhat; p0[4 * jj + 1] = a[1] - mhat; p0[4 * jj + 2] = a[2] - mhat; p0[4 * jj + 3] = a[3] - mhat;
                  p1[4 * jj] = b[0] - mhat; p1[4 * jj + 1] = b[1] - mhat; p1[4 * jj + 2] = b[2] - mhat; p1[4 * jj + 3] = b[3] - mhat; } }
            { const lds_cptr kb = shm3 + LDS_K + sl_cur + hi * 1024 + r32 * 16;
              bf16x8 kf0[4], kf1[4];
#pragma unroll
              for (int d0 = 0; d0 < 4; ++d0) { kf0[d0] = *(const LAS bf16x8*)(kb + d0 * 2048); kf1[d0] = *(const LAS bf16x8*)(kb + d0 * 2048 + 512); }
              float sacc = 0.f;
#define ATT_QS4(B) do { sacc += ex[B]; sacc += ex[B + 1]; sacc += ex[B + 2]; sacc += ex[B + 3]; asm volatile("" : "+v"(sacc)); __builtin_amdgcn_sched_barrier(0); } while (0)
              p0 = __builtin_amdgcn_mfma_f32_32x32x16_bf16(kf0[0], qr[0], p0, 0, 0, 0); ATT_QS4(0);
              p1 = __builtin_amdgcn_mfma_f32_32x32x16_bf16(kf1[0], qr[0], p1, 0, 0, 0); ATT_QS4(4);
              p0 = __builtin_amdgcn_mfma_f32_32x32x16_bf16(kf0[1], qr[1], p0, 0, 0, 0); ATT_QS4(8);
              p1 = __builtin_amdgcn_mfma_f32_32x32x16_bf16(kf1[1], qr[1], p1, 0, 0, 0); ATT_QS4(12);
              p0 = __builtin_amdgcn_mfma_f32_32x32x16_bf16(kf0[2], qr[2], p0, 0, 0, 0); ATT_QS4(16);
              p1 = __builtin_amdgcn_mfma_f32_32x32x16_bf16(kf1[2], qr[2], p1, 0, 0, 0); ATT_QS4(20);
              p0 = __builtin_amdgcn_mfma_f32_32x32x16_bf16(kf0[3], qr[3], p0, 0, 0, 0); ATT_QS4(24);
              p1 = __builtin_amdgcn_mfma_f32_32x32x16_bf16(kf1[3], qr[3], p1, 0, 0, 0); ATT_QS4(28);
#undef ATT_QS4
              if (pend) { l_reg += sacc; pend = false; } }
            const float NEG = -__builtin_inff();
            if (MODE == 0) { if (t == w_hi) { const int kb_ = 64 * t + 4 * hi;
#pragma unroll
                for (int r = 0; r < 16; ++r) { const int kv = kb_ + (r & 3) + 8 * (r >> 2); if (kv > q) p0[r] = NEG; if (kv + 32 > q) p1[r] = NEG; } } }
            else { const int kb_ = 64 * t + 4 * hi;
#pragma unroll
                for (int r = 0; r < 16; ++r) { const int kv = kb_ + (r & 3) + 8 * (r >> 2); if ((unsigned)(q - kv) >= 128u) p0[r] = NEG; if ((unsigned)(q - kv - 32) >= 128u) p1[r] = NEG; } }
            const float rm = rowmax(p0, p1);
            if (first || __any(rm > 8.f)) {
                const float dl = first ? __builtin_fmaxf(rm, -1e30f) : __builtin_fmaxf(rm, 0.f); const float f = first ? 1.f : __builtin_amdgcn_exp2f(-dl);
                first = false; mhat += dl; l_reg *= f; if (hi == 0) wsf[r32] = f;
#pragma unroll
                for (int r = 0; r < 16; ++r) { p0[r] -= dl; p1[r] -= dl; }
                asm volatile("s_waitcnt lgkmcnt(0)" ::: "memory");
#pragma unroll
                for (int jj = 0; jj < 4; ++jj) { const f32x4 fv = *(const f32x4*)(wsf + 8 * jj + 4 * hi);
#pragma unroll
                    for (int i2 = 0; i2 < 4; ++i2) { o[0][4 * jj + i2] *= fv[i2]; o[1][4 * jj + i2] *= fv[i2]; } }
            }
            if (MODE == 0 && (ti & 3) == 0) {
                float mn = mhat; mn = __builtin_fminf(mn, shx<1>(mn)); mn = __builtin_fminf(mn, shx<2>(mn)); mn = __builtin_fminf(mn, shx<4>(mn)); mn = __builtin_fminf(mn, shx<8>(mn)); mn = __builtin_fminf(mn, shx<16>(mn));
                if (lane == 0) mmp[(ti % 3) * 8 + wid] = mn; }
        }
        if (grp == 0) { ATT_LBAR(); ATT_ISSUE(ti + 2); }
        else { if (ti + 1 < n) { if (ti + 2 < n) { ATT_WAIT_BAR(2); } else { ATT_WAIT_BAR(0); } } else { ATT_LBAR(); } }
        if (need) {
            const lds_cptr vp = shm3 + LDS_V + sl_cur + ((lane >> 4) & 1) * 32 + (lane & 3) * 8 + (4 * hi + ((lane & 15) >> 2)) * 64;
#define ATT_SB() __builtin_amdgcn_sched_barrier(0)
#define ATT_PIN(x) asm volatile("" : "+v"(x))
#define ATT_VRD(i) do { vlo[i] = vtr(vp + (((i) >> 2) * 4096 + ((i) & 3) * 1024)); vhi[i] = vtr(vp + (((i) >> 2) * 4096 + ((i) & 3) * 1024 + 512)); } while (0)
#define ATT_VF(i) (bf16x8){vlo[i][0], vlo[i][1], vlo[i][2], vlo[i][3], vhi[i][0], vhi[i][1], vhi[i][2], vhi[i][3]}
#define ATT_PIN4(B) asm volatile("" : "+v"(ex[B]), "+v"(ex[B + 1]), "+v"(ex[B + 2]), "+v"(ex[B + 3]))
#define ATT_EX4(P, PB, B) do { ex[B] = __builtin_amdgcn_exp2f(P[PB]); ex[B + 1] = __builtin_amdgcn_exp2f(P[PB + 1]); ex[B + 2] = __builtin_amdgcn_exp2f(P[PB + 2]); ex[B + 3] = __builtin_amdgcn_exp2f(P[PB + 3]); ATT_PIN4(B); } while (0)
#define ATT_PK4(B) (u32x4){cvtpk(ex[B], ex[B + 1]), cvtpk(ex[B + 2], ex[B + 3]), cvtpk(ex[B + 4], ex[B + 5]), cvtpk(ex[B + 6], ex[B + 7])}
#define ATT_SUM4(B) do { sacc += ex[B]; sacc += ex[B + 1]; sacc += ex[B + 2]; sacc += ex[B + 3]; ATT_PIN(sacc); } while (0)
            s16x4 vlo[8], vhi[8]; u32x4 pw0, pw1, pw2, pw3;
            ATT_VRD(0); ATT_VRD(4);
            ATT_EX4(p0, 0, 0); ATT_EX4(p0, 4, 4); pw0 = ATT_PK4(0); ATT_PIN(pw0); ATT_SB();
            o[0] = __builtin_amdgcn_mfma_f32_32x32x16_bf16(__builtin_bit_cast(bf16x8, pw0), ATT_VF(0), o[0], 0, 0, 0); ATT_VRD(1); ATT_EX4(p0, 8, 8); ATT_SB();
            o[1] = __builtin_amdgcn_mfma_f32_32x32x16_bf16(__builtin_bit_cast(bf16x8, pw0), ATT_VF(4), o[1], 0, 0, 0); ATT_VRD(5); ATT_EX4(p0, 12, 12); pw1 = ATT_PK4(8); ATT_PIN(pw1); ATT_SB();
            o[0] = __builtin_amdgcn_mfma_f32_32x32x16_bf16(__builtin_bit_cast(bf16x8, pw1), ATT_VF(1), o[0], 0, 0, 0); ATT_VRD(2); ATT_EX4(p1, 0, 16); ATT_SB();
            o[1] = __builtin_amdgcn_mfma_f32_32x32x16_bf16(__builtin_bit_cast(bf16x8, pw1), ATT_VF(5), o[1], 0, 0, 0); ATT_VRD(6); ATT_EX4(p1, 4, 20); pw2 = ATT_PK4(16); ATT_PIN(pw2); ATT_SB();
            o[0] = __builtin_amdgcn_mfma_f32_32x32x16_bf16(__builtin_bit_cast(bf16x8, pw2), ATT_VF(2), o[0], 0, 0, 0); ATT_VRD(3); ATT_EX4(p1, 8, 24); ATT_SB();
            o[1] = __builtin_amdgcn_mfma_f32_32x32x16_bf16(__builtin_bit_cast(bf16x8, pw2), ATT_VF(6), o[1], 0, 0, 0); ATT_VRD(7); ATT_EX4(p1, 12, 28); pw3 = ATT_PK4(24); ATT_PIN(pw3); ATT_SB();
            o[0] = __builtin_amdgcn_mfma_f32_32x32x16_bf16(__builtin_bit_cast(bf16x8, pw3), ATT_VF(3), o[0], 0, 0, 0); ATT_SB();
            o[1] = __builtin_amdgcn_mfma_f32_32x32x16_bf16(__builtin_bit_cast(bf16x8, pw3), ATT_VF(7), o[1], 0, 0, 0); ATT_SB();
            pend = true;
#undef ATT_SB
#undef ATT_PIN
#undef ATT_VRD
#undef ATT_VF
#undef ATT_EX4
#undef ATT_PK4
#undef ATT_SUM4
#undef ATT_PIN4
        }
    }
    if (pend) { float sacc = 0.f;
#pragma unroll
        for (int r = 0; r < 32; ++r) sacc += ex[r];
        l_reg += sacc; }
    if (grp == 0) { ATT_LBAR(); }
#undef ATT_LBAR
#undef ATT_ISSUE
    { auto rr = __builtin_amdgcn_permlane32_swap(__float_as_uint(l_reg), __float_as_uint(l_reg), false, false); l_reg = __uint_as_float(rr[0]) + __uint_as_float(rr[1]); }
    if (MODE == 1) l_reg += __builtin_amdgcn_exp2f(sinkl2 + slope2 * (float)(qw0 - q0 + r32) - mhat);
    if (hi == 0) wsf[32 + r32] = l_reg;
    asm volatile("s_waitcnt lgkmcnt(0)" ::: "memory");
    float rli[16];
#pragma unroll
    for (int r = 0; r < 16; ++r) rli[r] = __builtin_amdgcn_rcpf(wsf[32 + crow(r, hi)]);
    { bf16_t* stg = (bf16_t*)(shm + LDS_OST) + wid * 2048;
#pragma unroll
      for (int r = 0; r < 16; ++r) { const int orow = crow(r, hi);
#pragma unroll
          for (int d0 = 0; d0 < 2; ++d0) stg[orow * 64 + d0 * 32 + r32] = (bf16_t)(cvtpk(o[d0][r] * rli[r], 0.f) & 0xffffu); }
      asm volatile("s_waitcnt lgkmcnt(0)" ::: "memory");
#pragma unroll
      for (int i = 0; i < 4; ++i) { const int row = i * 8 + (lane >> 3), ch = lane & 7; const u32x4 v = *(const u32x4*)(stg + row * 64 + ch * 8); *(u32x4*)(Ow + (long)row * D + ch * 8) = v; } }
    asm volatile("s_waitcnt vmcnt(0) lgkmcnt(0)\n\ts_barrier" ::: "memory");
#undef ATT_DMA_K
#undef ATT_DMA_V
}

__device__ __forceinline__ void fox_core(char* shm, const bf16_t* Qw, const bf16_t* Kh, const bf16_t* Vh, bf16_t* Ow, const int n  , const int tid, const float kn2) {
    const int lane = tid & 63, r32 = lane & 31, hi = lane >> 5; const int wid = __builtin_amdgcn_readfirstlane(tid >> 6);
    const unsigned lds0 = (unsigned)(uintptr_t)shm;
    float* wsf = (float*)(shm + LDS_WS) + wid * 64;
    const lds_cptr shm3 = (lds_cptr)shm;
    const int t_hi = n - 1;
#define FX_TILE(j) ((j) < 4 ? (t_hi - 3 + (j)) : (t_hi - (j)))
    const bf16_t* ksrc = Kh + (long)lane * DM + wid * 8;
    const bf16_t* vsrc = Vh + (long)(16 * (wid & 3) + (lane >> 2)) * DM + (wid >> 2) * 32 + (lane & 3) * 8;
    const unsigned kdst = lds0 + LDS_K + wid * 1024, vdst = lds0 + LDS_V + wid * 1024;
#define FX_DMA_K(j, slot) do { const long t_ = FX_TILE(j); glds16(ksrc + t_ * 64 * DM, (unsigned)__builtin_amdgcn_readfirstlane(kdst + (slot))); } while (0)
#define FX_DMA_V(j, slot) do { const long t_ = FX_TILE(j); glds16(vsrc + t_ * 64 * DM, (unsigned)__builtin_amdgcn_readfirstlane(vdst + (slot))); } while (0)
#define FX_WAIT(N) asm volatile("s_waitcnt vmcnt(" #N ") lgkmcnt(0)\n\ts_barrier" ::: "memory")
#define FX_SB() __builtin_amdgcn_sched_barrier(0)
    const lds_cptr kp0 = shm3 + LDS_K + hi * 1024 + r32 * 16;
    const lds_cptr vp0 = shm3 + LDS_V + ((lane >> 4) & 1) * 32 + (lane & 3) * 8 + (4 * hi + ((lane & 15) >> 2)) * 64;
    const int vb0 = (int)(lds0 + LDS_V) + ((lane >> 4) & 1) * 32 + (lane & 3) * 8 + (4 * hi + ((lane & 15) >> 2)) * 64;
    const LAS float* biasl = (const LAS float*)(shm3 + LDS_BIAS) + 4 * hi;
    FX_DMA_K(0, 0); FX_DMA_V(0, 0); FX_DMA_K(1, SLOTB);
    bf16x8 qr[4];
#pragma unroll
    for (int d0 = 0; d0 < 4; ++d0) qr[d0] = *reinterpret_cast<const bf16x8*>(&Qw[(long)r32 * DM + d0 * 16 + hi * 8]);
    LAS float* mmp = (LAS float*)(shm3 + LDS_MM); LAS float* qmp = (LAS float*)(shm3 + LDS_QM);
    { float qs = 0.f;
#pragma unroll
      for (int d0 = 0; d0 < 4; ++d0)
#pragma unroll
          for (int e = 0; e < 8; ++e) { const float v = bf2f((bf16_t)qr[d0][e]); qs += v * v; }
      { auto rr = __builtin_amdgcn_permlane32_swap(__float_as_uint(qs), __float_as_uint(qs), false, false); qs = __uint_as_float(rr[0]) + __uint_as_float(rr[1]); }
      qs = __builtin_fmaxf(qs, shx<1>(qs)); qs = __builtin_fmaxf(qs, shx<2>(qs)); qs = __builtin_fmaxf(qs, shx<4>(qs)); qs = __builtin_fmaxf(qs, shx<8>(qs)); qs = __builtin_fmaxf(qs, shx<16>(qs));
      if (lane == 0) { qmp[wid] = qs; mmp[wid] = -1e30f; mmp[8 + wid] = -1e30f; mmp[16 + wid] = -1e30f; } }
    float mhat = 0.f, l_reg = 0.f; f32x16 o[2]; o[0] = f32x16{}; o[1] = f32x16{};
    const int qrel = wid * 32 + r32;
    bool resc = false; float bqk = 0.f;
    f32x16 pA0, pA1, pB0, pB1;
    bf16x8 kf[8];
    int sl_prev = 0, sl_cur = 0, sl_next = SLOTB;
#define FX_ROT() do { sl_prev = sl_cur; sl_cur = sl_next; sl_next = (sl_next == 2 * SLOTB) ? 0 : sl_next + SLOTB; } while (0)
#define FX_CMASK(P0, P1, j) do { const int kb_ = 64 * (j) + 4 * hi; const float NEG_ = -__builtin_inff(); \
        _Pragma("unroll") for (int r = 0; r < 16; ++r) { const int kv = kb_ + (r & 3) + 8 * (r >> 2); if (kv > qrel) P0[r] = NEG_; if (kv + 32 > qrel) P1[r] = NEG_; } } while (0)
#define FX_KLOAD2(jj, sl) do { kf[2 * (jj)] = *(const LAS bf16x8*)(kp0 + (sl) + (jj) * 2048); kf[2 * (jj) + 1] = *(const LAS bf16x8*)(kp0 + (sl) + (jj) * 2048 + 512); } while (0)
#define FX_MF(a, b, c) __builtin_amdgcn_mfma_f32_32x32x16_bf16(a, b, c, 0, 0, 0)
#define FX_BLD(g, tl) (*(const LAS f32x4*)(biasl + 64 * (tl) + ((g) & 3) * 8 + ((g) >> 2) * 32))
#define FX_BSET(P0, P1, g, v) do { if ((g) < 4) { P0[4 * (g)] = v[0] - mhat; P0[4 * (g) + 1] = v[1] - mhat; P0[4 * (g) + 2] = v[2] - mhat; P0[4 * (g) + 3] = v[3] - mhat; } \
        else { P1[4 * ((g) - 4)] = v[0] - mhat; P1[4 * ((g) - 4) + 1] = v[1] - mhat; P1[4 * ((g) - 4) + 2] = v[2] - mhat; P1[4 * ((g) - 4) + 3] = v[3] - mhat; } } while (0)
    FX_DMA_K(2, 2 * SLOTB);
    { const int t0 = FX_TILE(0);
#pragma unroll
      for (int g = 0; g < 8; ++g) { const f32x4 bv = FX_BLD(g, t0); FX_BSET(pA0, pA1, g, bv); } }
    FX_WAIT(3);
    FX_KLOAD2(0, 0); FX_KLOAD2(1, 0); FX_KLOAD2(2, 0); FX_KLOAD2(3, 0);
    pA0 = FX_MF(kf[0], qr[0], pA0); pA1 = FX_MF(kf[1], qr[0], pA1); pA0 = FX_MF(kf[2], qr[1], pA0); pA1 = FX_MF(kf[3], qr[1], pA1);
    pA0 = FX_MF(kf[4], qr[2], pA0); pA1 = FX_MF(kf[5], qr[2], pA1); pA0 = FX_MF(kf[6], qr[3], pA0); pA1 = FX_MF(kf[7], qr[3], pA1);
    FX_CMASK(pA0, pA1, 0);
    { const float rm = rowmax(pA0, pA1); const float dl = __builtin_fmaxf(rm, -1e30f); mhat += dl;
#pragma unroll
      for (int r = 0; r < 16; ++r) { pA0[r] = __builtin_amdgcn_exp2f(pA0[r] - dl); pA1[r] = __builtin_amdgcn_exp2f(pA1[r] - dl); } }
    { const int t1 = FX_TILE(1);
#pragma unroll
      for (int g = 0; g < 8; ++g) { const f32x4 bv = FX_BLD(g, t1); FX_BSET(pB0, pB1, g, bv); } }
    FX_WAIT(0);
    FX_DMA_K(3, 0); FX_DMA_V(1, SLOTB);
    FX_ROT();
    FX_KLOAD2(0, sl_cur); FX_KLOAD2(1, sl_cur); FX_KLOAD2(2, sl_cur); FX_KLOAD2(3, sl_cur);
    FX_WAIT(2);
    s16x4 vlo[8], vhi[8]; u32x4 pw0, pw1, pw2, pw3; f32x4 bt;
#define FX_PKW(P, B) cvtpk(P[B], P[B + 1])
#define FX_PAF(k) __builtin_bit_cast(bf16x8, pw##k)
#define FX_VFR(i) (bf16x8){vlo[i][0], vlo[i][1], vlo[i][2], vlo[i][3], vhi[i][0], vhi[i][1], vhi[i][2], vhi[i][3]}
#define FX_PIN(x) asm volatile("" : "+v"(x))
#define FX_VRD(i) do { vlo[i] = vtr(vp_ + (((i) >> 2) * 4096 + ((i) & 3) * 1024)); vhi[i] = vtr(vp_ + (((i) >> 2) * 4096 + ((i) & 3) * 1024 + 512)); } while (0)
#define FX_GAPA(MFS, A0, A1, A2, A3, W0, W1, PW) do { MFS; sacc += A0; sacc += A1; sacc += A2; sacc += A3; FX_PIN(sacc); W0; W1; FX_PIN(PW); FX_SB(); } while (0)
#define FX_GAPB(MFS, X, B, GL, N0, N1, g, tl) do { MFS; X[B] = __builtin_amdgcn_exp2f(X[B]); X[B + 1] = __builtin_amdgcn_exp2f(X[B + 1]); X[B + 2] = __builtin_amdgcn_exp2f(X[B + 2]); X[B + 3] = __builtin_amdgcn_exp2f(X[B + 3]); FX_PIN(X); \
        if (GL) { if ((g) > 0) { FX_BSET(N0, N1, (g) - 1, bt); } bt = FX_BLD(g, tl); } FX_SB(); } while (0)
#define FX_STEP(C0, C1, P0, P1, j, MASKED, GK, GV, GL) do { FX_SB(); \
    const lds_cptr vp_ = vp0 + sl_prev; const int tn_ = FX_TILE((j) + 1); \
    FX_VRD(0); FX_SB(); float sacc = (P0[0] + P0[1]); \
    FX_GAPA(C0 = FX_MF(kf[0], qr[0], C0), P0[2], P0[3], P0[4], P0[5],     pw0[0] = FX_PKW(P0, 0),  pw0[1] = FX_PKW(P0, 2),  pw0); \
    FX_VRD(4); FX_SB(); FX_GAPA(C1 = FX_MF(kf[1], qr[0], C1), P0[6], P0[7], P0[8], P0[9],     pw0[2] = FX_PKW(P0, 4),  pw0[3] = FX_PKW(P0, 6),  pw0); \
    FX_VRD(1); FX_SB(); FX_GAPA(C0 = FX_MF(kf[2], qr[1], C0),   P0[10], P0[11], P0[12], P0[13], pw1[0] = FX_PKW(P0, 8),  pw1[1] = FX_PKW(P0, 10), pw1); \
    FX_VRD(5); FX_SB(); FX_GAPA(C1 = FX_MF(kf[3], qr[1], C1),   P0[14], P0[15], P1[0], P1[1],   pw1[2] = FX_PKW(P0, 12), pw1[3] = FX_PKW(P0, 14), pw1); \
    FX_VRD(2); FX_SB(); FX_GAPA(C0 = FX_MF(kf[4], qr[2], C0),   P1[2], P1[3], P1[4], P1[5],     pw2[0] = FX_PKW(P1, 0),  pw2[1] = FX_PKW(P1, 2),  pw2); \
    FX_VRD(6); FX_SB(); FX_GAPA(C1 = FX_MF(kf[5], qr[2], C1),   P1[6], P1[7], P1[8], P1[9],     pw2[2] = FX_PKW(P1, 4),  pw2[3] = FX_PKW(P1, 6),  pw2); \
    FX_VRD(3); FX_SB(); FX_GAPA(C0 = FX_MF(kf[6], qr[3], C0),   P1[10], P1[11], P1[12], P1[13], pw3[0] = FX_PKW(P1, 8),  pw3[1] = FX_PKW(P1, 10), pw3); \
    FX_VRD(7); FX_SB(); FX_GAPA(C1 = FX_MF(kf[7], qr[3], C1),   P1[14], P1[15], 0.f, 0.f,       pw3[2] = FX_PKW(P1, 12), pw3[3] = FX_PKW(P1, 14), pw3); \
    l_reg += sacc; \
    if (GK) { FX_DMA_K((j) + 3, sl_cur); } if (GV) { FX_DMA_V((j) + 1, sl_next); } \
    if (MASKED) { FX_CMASK(C0, C1, j); } \
    { const float rm = rowmax(C0, C1); resc = false; \
      if (__builtin_expect(__any(rm > 8.f), 0)) { const float dl = __builtin_fmaxf(rm, 0.f); mhat += dl; \
        _Pragma("unroll") for (int r = 0; r < 16; ++r) { C0[r] -= dl; C1[r] -= dl; } \
        const float f = __builtin_amdgcn_exp2f(-dl); l_reg *= f; if (hi == 0) wsf[r32] = f; resc = true; } \
      if (((j) & 3) == 0) { float mn = mhat; mn = __builtin_fminf(mn, shx<1>(mn)); mn = __builtin_fminf(mn, shx<2>(mn)); mn = __builtin_fminf(mn, shx<4>(mn)); mn = __builtin_fminf(mn, shx<8>(mn)); mn = __builtin_fminf(mn, shx<16>(mn)); \
        if (lane == 0) mmp[((j) % 3) * 8 + wid] = mn; } } \
    FX_SB(); \
    FX_GAPB(o[0] = FX_MF(FX_PAF(0), FX_VFR(0), o[0]), C0, 0, GL, P0, P1, 0, tn_); \
    FX_GAPB(o[1] = FX_MF(FX_PAF(0), FX_VFR(4), o[1]), C0, 4, GL, P0, P1, 1, tn_); \
    if (GL) { FX_KLOAD2(0, sl_next); FX_SB(); } FX_GAPB(o[0] = FX_MF(FX_PAF(1), FX_VFR(1), o[0]), C0, 8, GL, P0, P1, 2, tn_); \
    if (GL) { FX_KLOAD2(1, sl_next); FX_SB(); } FX_GAPB(o[1] = FX_MF(FX_PAF(1), FX_VFR(5), o[1]), C0, 12, GL, P0, P1, 3, tn_); \
    if (GL) { FX_KLOAD2(2, sl_next); FX_SB(); } FX_GAPB(o[0] = FX_MF(FX_PAF(2), FX_VFR(2), o[0]), C1, 0, GL, P0, P1, 4, tn_); \
    if (GL) { FX_KLOAD2(3, sl_next); FX_SB(); } FX_GAPB(o[1] = FX_MF(FX_PAF(2), FX_VFR(6), o[1]), C1, 4, GL, P0, P1, 5, tn_); \
    FX_GAPB(o[0] = FX_MF(FX_PAF(3), FX_VFR(3), o[0]), C1, 8, GL, P0, P1, 6, tn_); \
    FX_GAPB(o[1] = FX_MF(FX_PAF(3), FX_VFR(7), o[1]), C1, 12, GL, P0, P1, 7, tn_); \
    if (GL) { FX_BSET(P0, P1, 7, bt); } \
    } while (0)
#define FX_CLOSEW(W) do { W; \
        if (resc) { asm volatile("s_waitcnt lgkmcnt(0)" ::: "memory"); \
            _Pragma("unroll") for (int d_ = 0; d_ < 2; ++d_) _Pragma("unroll") for (int r = 0; r < 16; ++r) o[d_][r] *= wsf[crow(r, hi)]; } \
        FX_ROT(); } while (0)
#define FX_CLOSE(j) do { if ((j) + 3 < n) { FX_CLOSEW(FX_WAIT(2)); } else if ((j) + 2 < n) { FX_CLOSEW(FX_WAIT(1)); } else { FX_CLOSEW(FX_WAIT(0)); } } while (0)
#define FX_EXIT_TEST(j) ({ bool stop_ = false; if ((((j) & 3) == 2) && (j) >= 6) { \
        if ((j) == 6) { const f32x4 qa_ = *(const LAS f32x4*)qmp, qb_ = *(const LAS f32x4*)(qmp + 4); \
            const float qn2 = __builtin_fmaxf(__builtin_fmaxf(__builtin_fmaxf(qa_[0], qa_[1]), __builtin_fmaxf(qa_[2], qa_[3])), __builtin_fmaxf(__builtin_fmaxf(qb_[0], qb_[1]), __builtin_fmaxf(qb_[2], qb_[3]))); \
            bqk = __int_as_float(__builtin_amdgcn_readfirstlane(__float_as_int(sqrtf(qn2 * kn2) * 1.02f + 1.0f))); } \
        const LAS float* mp_ = mmp + (((j) - 2) % 3) * 8; const f32x4 ma_ = *(const LAS f32x4*)mp_, mb_ = *(const LAS f32x4*)(mp_ + 4); \
        const float mm_ = __builtin_fminf(__builtin_fminf(__builtin_fminf(ma_[0], ma_[1]), __builtin_fminf(ma_[2], ma_[3])), __builtin_fminf(__builtin_fminf(mb_[0], mb_[1]), __builtin_fminf(mb_[2], mb_[3]))); \
        const float bmax_ = *((const LAS float*)(shm3 + LDS_BIAS) + FX_TILE(j) * 64 + 63); \
        stop_ = __builtin_amdgcn_readfirstlane((int)(bqk + bmax_ < mm_ - 160.f)) != 0; } stop_; })
    FX_STEP(pB0, pB1, pA0, pA1, 1, true, (4 < n), true, true); FX_CLOSE(1);
    FX_STEP(pA0, pA1, pB0, pB1, 2, true, (5 < n), true, true); FX_CLOSE(2);
    FX_STEP(pB0, pB1, pA0, pA1, 3, true, (6 < n), (4 < n), (4 < n)); FX_CLOSE(3);
    int j = 4, nrun = n;
#pragma unroll 1
    for (; j + 4 < nrun; j += 2) {
        FX_STEP(pA0, pA1, pB0, pB1, j, false, true, true, true); FX_CLOSEW(FX_WAIT(2));
        FX_STEP(pB0, pB1, pA0, pA1, j + 1, false, true, true, true); FX_CLOSEW(FX_WAIT(2));
        if (FX_EXIT_TEST(j + 2)) nrun = j + 2;
    }
#pragma unroll 1
    for (; j < nrun; j += 2) {
        FX_STEP(pA0, pA1, pB0, pB1, j, false, (j + 3 < n), (j + 1 < n), (j + 1 < n)); FX_CLOSE(j);
        FX_STEP(pB0, pB1, pA0, pA1, j + 1, false, (j + 4 < n), (j + 2 < n), (j + 2 < n)); FX_CLOSE(j + 1);
    }
    asm volatile("s_waitcnt vmcnt(0)" ::: "memory");
    { float sacc = 0.f;
#pragma unroll
      for (int r = 0; r < 16; ++r) sacc += pB0[r] + pB1[r];
      l_reg += sacc;
      pw0 = (u32x4){FX_PKW(pB0, 0), FX_PKW(pB0, 2), FX_PKW(pB0, 4), FX_PKW(pB0, 6)}; pw1 = (u32x4){FX_PKW(pB0, 8), FX_PKW(pB0, 10), FX_PKW(pB0, 12), FX_PKW(pB0, 14)};
      pw2 = (u32x4){FX_PKW(pB1, 0), FX_PKW(pB1, 2), FX_PKW(pB1, 4), FX_PKW(pB1, 6)}; pw3 = (u32x4){FX_PKW(pB1, 8), FX_PKW(pB1, 10), FX_PKW(pB1, 12), FX_PKW(pB1, 14)};
      FX_SB(); pv(o, vb0 + sl_prev, FX_PAF(0), FX_PAF(1), FX_PAF(2), FX_PAF(3)); }
    { auto rr = __builtin_amdgcn_permlane32_swap(__float_as_uint(l_reg), __float_as_uint(l_reg), false, false); l_reg = __uint_as_float(rr[0]) + __uint_as_float(rr[1]); }
    if (hi == 0) wsf[32 + r32] = l_reg;
    asm volatile("s_waitcnt lgkmcnt(0)" ::: "memory");
    float rli[16];
#pragma unroll
    for (int r = 0; r < 16; ++r) rli[r] = __builtin_amdgcn_rcpf(wsf[32 + crow(r, hi)]);
    { bf16_t* stg = (bf16_t*)(shm + LDS_OST) + wid * 2048;
#pragma unroll
      for (int r = 0; r < 16; ++r) { const int orow = crow(r, hi);
#pragma unroll
          for (int d0 = 0; d0 < 2; ++d0) stg[orow * 64 + d0 * 32 + r32] = (bf16_t)(cvtpk(o[d0][r] * rli[r], 0.f) & 0xffffu); }
      asm volatile("s_waitcnt lgkmcnt(0)" ::: "memory");
#pragma unroll
      for (int i = 0; i < 4; ++i) { const int row = i * 8 + (lane >> 3), ch = lane & 7; const u32x4 v = *(const u32x4*)(stg + row * 64 + ch * 8); *(u32x4*)(Ow + (long)row * D + ch * 8) = v; } }
    asm volatile("s_waitcnt lgkmcnt(0)\n\ts_barrier" ::: "memory");
#undef FX_TILE
#undef FX_DMA_K
#undef FX_DMA_V
#undef FX_WAIT
#undef FX_SB
#undef FX_ROT
#undef FX_CMASK
#undef FX_KLOAD2
#undef FX_MF
#undef FX_BLD
#undef FX_BSET
#undef FX_PKW
#undef FX_PAF
#undef FX_VFR
#undef FX_PIN
#undef FX_VRD
#undef FX_GAPA
#undef FX_GAPB
#undef FX_STEP
#undef FX_CLOSEW
#undef FX_CLOSE
#undef FX_EXIT_TEST
}
}

__device__ __forceinline__ void p0_tr_item(const float* W, int ld_src, int k0, int n0, bf16_t* d0, bf16_t* d1, bf16_t* d2, int ld_dst, LAS float* scr, int lane) {
    float tv[32];
#pragma unroll
    for (int i = 0; i < 32; ++i) { const int kk = 2 * i + (lane >> 5); tv[i] = W[(size_t)(k0 + kk) * ld_src + n0 + (lane & 31)]; }
#pragma unroll
    for (int i = 0; i < 32; ++i) { const int kk = 2 * i + (lane >> 5); scr[kk * 33 + (lane & 31)] = tv[i]; }
    LDS_WAIT(); asm volatile("" ::: "memory");
    const int c = lane & 7;
#pragma unroll
    for (int j = 0; j < 4; ++j) { const int n = (lane >> 3) + 8 * j; const LAS float* s = scr + (8 * c) * 33 + n;
        u32x4 o; o.x = cvtpk(s[0 * 33], s[1 * 33]); o.y = cvtpk(s[2 * 33], s[3 * 33]); o.z = cvtpk(s[4 * 33], s[5 * 33]); o.w = cvtpk(s[6 * 33], s[7 * 33]);
        *(u32x4*)(d0 + (size_t)n * ld_dst + 8 * c) = o;
        if (d1) *(u32x4*)(d1 + (size_t)n * ld_dst + 8 * c) = o;
        if (d2) *(u32x4*)(d2 + (size_t)n * ld_dst + 8 * c) = o; }
    LDS_WAIT(); asm volatile("" ::: "memory");
}
__device__ __forceinline__ int pair_idx(int lo, int hi) { return lo == 0 ? hi - 1 : (lo == 1 ? hi + 1 : 5); }

__device__ __forceinline__ void phase_p0(Frame& F) {
    __syncthreads();
    {
        LAS float* sc = (LAS float*)F.lds;
        LAS float* red = (LAS float*)(F.lds + 16384);
        float* MOD = (float*)(F.ws + WS_MOD);
        bool have = false;
        for (int task = F.vcu; task < 48; task += F.G) {
            if (!have) { for (int i = F.tid; i < 4096; i += 512) { const float v = F.inp(F_C)[i]; sc[i] = v * sigmoidf_(v); } __syncthreads(); have = true; }
            const int l = task / 24, j0 = (task % 24) * 256;
            const float* wp = F.inp(F_WMOD) + (size_t)l * 1024 * 6144 + j0 + 4 * F.lane;
            f32x4 a0 = {0, 0, 0, 0}, a1 = a0, a2 = a0, a3 = a0;
            const int kbeg = F.wave * 128;
#pragma unroll 8
            for (int k = kbeg; k < kbeg + 128; ++k) { const f32x4 wv = *(const f32x4*)(wp + (size_t)k * 6144);
                a0 += wv * sc[k]; a1 += wv * sc[1024 + k]; a2 += wv * sc[2048 + k]; a3 += wv * sc[3072 + k]; }
            *(LAS f32x4*)(red + (F.wave * 4 + 0) * 256 + 4 * F.lane) = a0; *(LAS f32x4*)(red + (F.wave * 4 + 1) * 256 + 4 * F.lane) = a1;
            *(LAS f32x4*)(red + (F.wave * 4 + 2) * 256 + 4 * F.lane) = a2; *(LAS f32x4*)(red + (F.wave * 4 + 3) * 256 + 4 * F.lane) = a3;
            __syncthreads();
            for (int o = F.tid; o < 1024; o += 512) { const int b = o >> 8, cidx = o & 255; float s = F.inp(F_BMOD)[l * 6144 + j0 + cidx];
#pragma unroll
                for (int w = 0; w < 8; ++w) s += red[(w * 4 + b) * 256 + cidx];
                MOD[(size_t)(l * 4 + b) * 6144 + j0 + cidx] = s; }
            __syncthreads();
        }
        __syncthreads();
    }
    LAS float* scr = (LAS float*)(F.lds + F.wave * 16384);
    const int gw = F.vcu * 8 + F.wave, NGW = F.G * 8;
    bf16_t* WIN = (bf16_t*)(F.ws + WS_WIN); bf16_t* WOUT = (bf16_t*)(F.ws + WS_WOUT); bf16_t* WGU = (bf16_t*)(F.ws + WS_WGU); bf16_t* WDP = (bf16_t*)(F.ws + WS_WDP);
    constexpr int I_IN = 2 * 16 * 64, I_OUT = 2 * 16 * 32, I_GU = 2 * 16 * 2 * 16 * 8, I_DN = 2 * 16 * 4 * 32;
    for (int it = gw; it < I_IN + I_OUT + I_GU + I_DN; it += NGW) {
        int r = it;
        if (r < I_IN) { const int l = r / 1024, kb = (r % 1024) / 64, nb = r % 64;
            p0_tr_item(F.inp(F_WIN) + (size_t)l * 1024 * IN_COLS, IN_COLS, 64 * kb, 32 * nb, WIN + ((size_t)l * 2048 + 32 * nb) * 1024 + 64 * kb, nullptr, nullptr, 1024, scr, F.lane); continue; }
        r -= I_IN;
        if (r < I_OUT) { const int l = r / 512, kb = (r % 512) / 32, nb = r % 32;
            p0_tr_item(F.inp(F_WOUT) + (size_t)l * 1024 * 1024, 1024, 64 * kb, 32 * nb, WOUT + ((size_t)l * 1024 + 32 * nb) * 1024 + 64 * kb, nullptr, nullptr, 1024, scr, F.lane); continue; }
        r -= I_OUT;
        if (r < I_GU) { const int le = r / 256, which = (r % 256) / 128, kb = (r % 128) / 8, nb = r % 8;
            const int j0 = 32 * nb, row = 256 * (j0 >> 7) + (j0 & 127) + which * 128;
            p0_tr_item((which ? F.inp(F_WUP) : F.inp(F_WGATE)) + (size_t)le * 1024 * 256, 256, 64 * kb, j0, WGU + ((size_t)le * 512 + row) * 1024 + 64 * kb, nullptr, nullptr, 1024, scr, F.lane); continue; }
        r -= I_GU;
        { const int le = r / 128, kb = (r % 128) / 32, nb = r % 32; const int l = le >> 4, e = le & 15, g = e >> 2, i = e & 3;
          bf16_t* dst[3]; int nd = 0;
#pragma unroll
          for (int j = 0; j < 4; ++j) { if (j == i) continue; const int lo = i < j ? i : j, hi = i < j ? j : i; const int cls = g * 6 + pair_idx(lo, hi); const int kofs = (i == lo) ? 0 : 256;
              dst[nd++] = WDP + ((size_t)(l * 24 + cls) * 1024 + 32 * nb) * 512 + kofs + 64 * kb; }
          p0_tr_item(F.inp(F_WDOWN) + (size_t)le * 256 * 1024, 1024, 64 * kb, 32 * nb, dst[0], dst[1], dst[2], 512, scr, F.lane); }
    }
}

template <bool PM>
__device__ __forceinline__ void phase_norm1(Frame& F, int l, const float* xin) {
    const bf16_t* Pb = (const bf16_t*)(F.ws + WS_P); const bf16_t* Mb = (const bf16_t*)(F.ws + WS_M); float* XA = (float*)(F.ws + WS_XA);
    LAS float* gpm = (LAS float*)(F.lds + 256);
    const float* MOD = (const float*)(F.ws + WS_MOD) + (size_t)l * 4 * 6144;
    bf16_t* H = (bf16_t*)(F.ws + WS_H); float* CUM = (float*)(F.ws + WS_CUM); float* CTOT = (float*)(F.ws + WS_CTOT);
    LAS float* wtot = (LAS float*)F.lds;
    for (int tile = F.vcu; tile < T / 128; tile += F.G) {
        const int b = tile >> 6, row0 = tile * 128;
        f32x4 g1[4], s1[4], wfc[16];
#pragma unroll
        for (int j = 0; j < 4; ++j) { const int col = 4 * F.lane + 256 * j;
            const f32x4 nm = *(const f32x4*)(F.inp(F_NMIX) + l * 1024 + col), scv = *(const f32x4*)(MOD + b * 6144 + 1024 + col);
            g1[j] = nm * (scv + 1.0f); s1[j] = *(const f32x4*)(MOD + b * 6144 + col);
#pragma unroll
            for (int i = 0; i < 4; ++i) wfc[j * 4 + i] = *(const f32x4*)(F.inp(F_WIN) + ((size_t)l * 1024 + col + i) * IN_COLS + 2048); }
        const f32x4 fb = *(const f32x4*)(F.inp(F_FOXB) + l * 4);
        if (PM) { const float* MODp = (const float*)(F.ws + WS_MOD) + (size_t)(l - 1) * 4 * 6144 + b * 6144;
            for (int i = F.tid; i < 1024; i += 512) { gpm[i] = MODp[2048 + i]; gpm[1024 + i] = MODp[5120 + i]; }
            __syncthreads(); }
        f32x4 run = {0.f, 0.f, 0.f, 0.f}, keep = {0.f, 0.f, 0.f, 0.f};
#pragma unroll 1
        for (int i = 0; i < 16; i += 2) {
            const int row = row0 + F.wave * 16 + i;
            const f32x4* xr0 = (const f32x4*)(xin + (size_t)row * D) + F.lane; const f32x4* xr1 = xr0 + D / 4;
            f32x4 v0[4], v1[4]; float ss0 = 0.f, ss1 = 0.f;
#pragma unroll
            for (int j = 0; j < 4; ++j) { v0[j] = xr0[64 * j]; v1[j] = xr1[64 * j]; }
            if (PM) {
                u32x2 p0[4], p1[4], m0[4], m1[4];
                const u32x2* pr0 = (const u32x2*)(Pb + (size_t)row * D) + F.lane; const u32x2* mr0 = (const u32x2*)(Mb + (size_t)row * D) + F.lane;
#pragma unroll
                for (int j = 0; j < 4; ++j) { p0[j] = pr0[64 * j]; p1[j] = pr0[64 * j + D / 4]; m0[j] = mr0[64 * j]; m1[j] = mr0[64 * j + D / 4]; }
                f32x4* xo0 = (f32x4*)(XA + (size_t)row * D) + F.lane; f32x4* xo1 = xo0 + D / 4;
#pragma unroll
                for (int j = 0; j < 4; ++j) { const f32x4 gm = *(const LAS f32x4*)(gpm + 4 * F.lane + 256 * j), gf = *(const LAS f32x4*)(gpm + 1024 + 4 * F.lane + 256 * j);
                    v0[j] = v0[j] + gm * bf4_to_f32(p0[j]) + gf * bf4_to_f32(m0[j]); v1[j] = v1[j] + gm * bf4_to_f32(p1[j]) + gf * bf4_to_f32(m1[j]);
                    xo0[64 * j] = v0[j]; xo1[64 * j] = v1[j]; }
            }
#pragma unroll
            for (int j = 0; j < 4; ++j) { ss0 += (v0[j].x * v0[j].x + v0[j].y * v0[j].y) + (v0[j].z * v0[j].z + v0[j].w * v0[j].w); ss1 += (v1[j].x * v1[j].x + v1[j].y * v1[j].y) + (v1[j].z * v1[j].z + v1[j].w * v1[j].w); }
            const float rstd0 = 1.0f / sqrtf(wave_sum(ss0) * (1.f / D) + EPS), rstd1 = 1.0f / sqrtf(wave_sum(ss1) * (1.f / D) + EPS);
            f32x4 fa0 = {0.f, 0.f, 0.f, 0.f}, fa1 = {0.f, 0.f, 0.f, 0.f};
            u32x2* o0 = (u32x2*)(H + (size_t)row * D) + F.lane; u32x2* o1 = o0 + D / 4;
#pragma unroll
            for (int j = 0; j < 4; ++j) { const f32x4 h0 = v0[j] * rstd0 * g1[j] + s1[j], h1 = v1[j] * rstd1 * g1[j] + s1[j];
                fa0 += wfc[j * 4 + 0] * h0.x + wfc[j * 4 + 1] * h0.y + wfc[j * 4 + 2] * h0.z + wfc[j * 4 + 3] * h0.w;
                fa1 += wfc[j * 4 + 0] * h1.x + wfc[j * 4 + 1] * h1.y + wfc[j * 4 + 2] * h1.z + wfc[j * 4 + 3] * h1.w;
                u32x2 w; w.x = cvtpk(h0.x, h0.y); w.y = cvtpk(h0.z, h0.w); o0[64 * j] = w; w.x = cvtpk(h1.x, h1.y); w.y = cvtpk(h1.z, h1.w); o1[64 * j] = w; }
            f32x4 lf0, lf1;
#pragma unroll
            for (int e = 0; e < 4; ++e) { const float z0 = wave_sum(fa0[e]) + fb[e], z1 = wave_sum(fa1[e]) + fb[e];
                lf0[e] = fminf(z0, 0.f) - __builtin_amdgcn_logf(1.f + fast_exp(-fabsf(z0))) * 0.6931471805599453f;
                lf1[e] = fminf(z1, 0.f) - __builtin_amdgcn_logf(1.f + fast_exp(-fabsf(z1))) * 0.6931471805599453f; }
            run += lf0; if (F.lane == i) keep = run;
            run += lf1; if (F.lane == i + 1) keep = run;
        }
        if (F.lane == 0) *(LAS f32x4*)(wtot + F.wave * 4) = run;
        __syncthreads();
        f32x4 pre = {0.f, 0.f, 0.f, 0.f}, tot = {0.f, 0.f, 0.f, 0.f};
#pragma unroll
        for (int w = 0; w < 8; ++w) { const f32x4 tv = *(const LAS f32x4*)(wtot + w * 4); if (w < F.wave) pre += tv; tot += tv; }
        if (F.lane < 16) { const int s = (row0 & (SEQ - 1)) + F.wave * 16 + F.lane; const f32x4 cv = keep + pre;
#pragma unroll
            for (int e = 0; e < 4; ++e) CUM[(size_t)(b * 4 + e) * SEQ + s] = cv[e]; }
        if (F.tid == 0) *(f32x4*)(CTOT + (size_t)(b * 64 + (tile & 63)) * 4) = tot;
        __syncthreads();
    }
}

__device__ __forceinline__ void lru_unit(Frame& F, int l, int b, int tt) {
    const bf16_t* PROJ = (const bf16_t*)(F.ws + WS_PROJ);
    float* HLOC = (float*)(F.ws + WS_H); float* PP = HLOC + (size_t)T * 256;
    float* LRUA = (float*)(F.ws + WS_LRUA); float* LRUH = (float*)(F.ws + WS_LRUH);
    LAS bf16_t* xcb = (LAS bf16_t*)F.lds;
    LAS float* gb_ = (LAS float*)(F.lds + 16384);
    const int c = F.tid & 255, sl = F.tid >> 8;
    const int blk = F.wave, kq = F.lane >> 4, nn = F.lane & 15;
    bf16x8 bfr[2][2];
    f32x4 cinit[2][2];
#pragma unroll
    for (int g = 0; g < 2; ++g)
#pragma unroll
        for (int hf = 0; hf < 2; ++hf) { const float* wp = (g ? F.inp(F_LWX) : F.inp(F_LWA)) + ((size_t)(l * 8 + blk) * 32 + 8 * kq) * 32 + 16 * hf + nn;
            u32x4 pk; pk.x = cvtpk(wp[0], wp[32]); pk.y = cvtpk(wp[64], wp[96]); pk.z = cvtpk(wp[128], wp[160]); pk.w = cvtpk(wp[192], wp[224]); bfr[g][hf] = __builtin_bit_cast(bf16x8, pk);
            const float bv = (g ? F.inp(F_LBX) : F.inp(F_LBA))[l * 256 + blk * 32 + 16 * hf + nn]; cinit[g][hf] = (f32x4){bv, bv, bv, bv}; }
    const float cw0 = F.inp(F_CONVW)[(l * 4 + 0) * 256 + c], cw1 = F.inp(F_CONVW)[(l * 4 + 1) * 256 + c], cw2 = F.inp(F_CONVW)[(l * 4 + 2) * 256 + c], cw3 = F.inp(F_CONVW)[(l * 4 + 3) * 256 + c];
    const float cb = F.inp(F_CONVB)[l * 256 + c];
    const float lam = F.inp(F_LAM)[l * 256 + c];
    const float sp = -8.0f * (fmaxf(-lam, 0.f) + log1pf(expf(-fabsf(lam))));
    const int s0 = tt * 128 + sl * 64;
    const bf16_t* xp = PROJ + ((size_t)b * SEQ + s0) * NPROJ + C_XB + c;
    float xm3 = s0 >= 3 ? bf2f(xp[-3 * (long)NPROJ]) : 0.f, xm2 = s0 >= 2 ? bf2f(xp[-2 * (long)NPROJ]) : 0.f, xm1 = s0 >= 1 ? bf2f(xp[-1 * (long)NPROJ]) : 0.f;
    float h = 0.f, P = 1.f;
    bf16_t xr[16];
#pragma unroll
    for (int i = 0; i < 16; ++i) xr[i] = xp[(long)i * NPROJ];
#pragma unroll 1
    for (int sub = 0; sub < 4; ++sub) {
        float xv[16];
#pragma unroll
        for (int i = 0; i < 16; ++i) { const float xc = bf2f(xr[i]); xv[i] = cb + cw0 * xm3 + cw1 * xm2 + cw2 * xm1 + cw3 * xc; xm3 = xm2; xm2 = xm1; xm1 = xc;
            xcb[(sl * 16 + i) * 256 + c] = (bf16_t)(cvtpk(xv[i], 0.f) & 0xffffu); }
        if (sub < 3) {
#pragma unroll
            for (int i = 0; i < 16; ++i) xr[i] = xp[(long)((sub + 1) * 16 + i) * NPROJ]; }
        __syncthreads();
#pragma unroll
        for (int s2 = 0; s2 < 2; ++s2) {
            const bf16x8 af = *(const LAS bf16x8*)(xcb + (s2 * 16 + nn) * 256 + blk * 32 + 8 * kq);
#pragma unroll
            for (int g = 0; g < 2; ++g)
#pragma unroll
                for (int hf = 0; hf < 2; ++hf) { const f32x4 r4 = __builtin_amdgcn_mfma_f32_16x16x32_bf16(af, bfr[g][hf], cinit[g][hf], 0, 0, 0);
                    LAS float* gp = gb_ + ((g * 2 + s2) * 16 + 4 * kq) * 256 + blk * 32 + 16 * hf + nn;
                    gp[0] = r4[0]; gp[256] = r4[1]; gp[512] = r4[2]; gp[768] = r4[3]; }
        }
        __syncthreads();
#pragma unroll
        for (int i = 0; i < 16; ++i) {
            const float ga = gb_[((0 * 2 + sl) * 16 + i) * 256 + c], gx = gb_[((1 * 2 + sl) * 16 + i) * 256 + c];
            const float r = sigmoidf_(ga), ig = sigmoidf_(gx);
            const float la = sp * r; const float a = fast_exp(la);
            const float mult = __builtin_amdgcn_sqrtf(__builtin_fmaxf(1.f - a * a, 0.f));
            const float u = mult * ig * xv[i];
            h = a * h + u; P *= a;
            const size_t off = ((size_t)b * SEQ + s0 + sub * 16 + i) * 256 + c;
            HLOC[off] = h; PP[off] = P;
        }
    }
    const size_t so = ((size_t)(b * 128 + tt * 2 + sl)) * 256 + c;
    LRUA[so] = P; LRUH[so] = h;
    __syncthreads();
}

__device__ __forceinline__ void fox_unit(Frame& F, int l, int b, int h, int qb) {
    const bf16_t* PROJ = (const bf16_t*)(F.ws + WS_PROJ); bf16_t* Y = (bf16_t*)(F.ws + WS_Y);
    const float* CUM = (const float*)(F.ws + WS_CUM) + (size_t)(b * 4 + h) * SEQ; const float* CTOT = (const float*)(F.ws + WS_CTOT);
    LAS float* bias = (LAS float*)(F.lds + att::LDS_BIAS); LAS float* blk = (LAS float*)(F.lds + att::LDS_BLK);
    const int q0 = qb * 256;
    const float vtot = CTOT[(size_t)(b * 64 + F.lane) * 4 + h];
    float cv[16];
#pragma unroll
    for (int k = 0; k < 16; ++k) { const int s = F.tid + 512 * k; cv[k] = (s < q0 + 256) ? CUM[s] : 0.f; }
    const float cq = CUM[q0 + 255];
    float kn2 = 0.f; { const unsigned* km = (const unsigned*)(F.ws + WS_CTL) + CW_KM + l * 128 + (b * 4 + h) * 8;
#pragma unroll
        for (int c = 0; c < 8; ++c) kn2 += __uint_as_float(__hip_atomic_load(km + c, __ATOMIC_RELAXED, __HIP_MEMORY_SCOPE_AGENT)); }
    if (F.wave == 0) { float s = vtot;
#pragma unroll
        for (int o = 1; o < 64; o <<= 1) { const float t = __int_as_float(__builtin_amdgcn_ds_bpermute(((F.lane - o) & 63) << 2, __float_as_int(s))); if (F.lane >= o) s += t; }
        blk[F.lane] = s - vtot; }
    __syncthreads();
    const float cref = cq + blk[(q0 + 255) >> 7];
#pragma unroll
    for (int k = 0; k < 16; ++k) { const int s = F.tid + 512 * k; if (s < q0 + 256) bias[s] = (cref - (cv[k] + blk[s >> 7])) * LOG2E; }
    __syncthreads();
    const size_t rowbase = (size_t)b * SEQ;
    att::fox_core(F.shm, PROJ + (rowbase + q0 + F.wave * 32) * NPROJ + C_QC + h * 64, PROJ + rowbase * NPROJ + C_KC + h * 64, PROJ + rowbase * NPROJ + C_VC + h * 64,
                  Y + (rowbase + q0 + F.wave * 32) * D + 768 + h * 64, 4 * (qb + 1), F.tid, kn2);
}
__device__ __forceinline__ void swa_unit(Frame& F, int l, int b, int kvh, int qb64) {
    const bf16_t* PROJ = (const bf16_t*)(F.ws + WS_PROJ); bf16_t* Y = (bf16_t*)(F.ws + WS_Y);
    LAS float* bias = (LAS float*)(F.lds + att::LDS_BIAS);
    const int q0 = qb64 * 64;
    const int t_lo = (q0 >= 128 ? q0 - 128 : 0) >> 6, t_hi = q0 >> 6, n = t_hi - t_lo + 1;
    for (int i = F.tid; i < 4 * 192; i += 512) { const int hh = i / 192, j = i - hh * 192; const float sl = exp2f(-(float)(kvh * 4 + hh + 1)) * LOG2E;
        if (j < n * 64) bias[i] = sl * (float)(64 * t_lo + j - q0); }
    __syncthreads();
    const int h = kvh * 4 + (F.wave >> 1), qw0 = q0 + 32 * (F.wave & 1);
    const float slope2 = exp2f(-(float)(h + 1)) * LOG2E;
    const size_t rowbase = (size_t)b * SEQ;
    att::attn_core<1>(F.shm, PROJ + (rowbase + qw0) * NPROJ + C_QA + h * 64, PROJ + rowbase * NPROJ + C_KA + kvh * 64, PROJ + rowbase * NPROJ + C_VA + kvh * 64,
                      Y + (rowbase + qw0) * D + h * 64, q0, qw0, t_lo, t_hi, (F.wave >> 1) * 192, F.inp(F_SINKS)[l * 8 + h] * LOG2E, slope2, F.tid);
}
__device__ __forceinline__ void phase_mixer(Frame& F, int l, int qsel) {
    unsigned* qhead = (unsigned*)(F.ws + WS_CTL) + CW_Q + qsel * 64;
    LAS unsigned* qslot = (LAS unsigned*)(F.lds + LDSCTL_OFF + 16);
#pragma unroll 1
    for (;;) {
        frame_refresh(F);
        if (F.tid == 0) qslot[0] = __hip_atomic_fetch_add(qhead, 1u, __ATOMIC_RELAXED, __HIP_MEMORY_SCOPE_AGENT);
        __syncthreads();
        const int u = __builtin_amdgcn_readfirstlane((int)qslot[0]);
        __syncthreads();
        if (u >= 512 + 256 + 1024) break;
        if (u < 512) { if (PH(11)) fox_unit(F, l, (u & 15) >> 2, u & 3, 31 - (u >> 4)); }
        else if (u < 768) { if (PH(10)) lru_unit(F, l, (u - 512) >> 6, (u - 512) & 63); }
        else { if (PH(12)) { const int v = u - 768; swa_unit(F, l, v >> 8, (v >> 7) & 1, v & 127); } }
    }
}

__device__ __forceinline__ void phase_ynorm(Frame& F, int l, bf16_t* YO) {
    const bf16_t* Y = (const bf16_t*)(F.ws + WS_Y); const bf16_t* PROJ = (const bf16_t*)(F.ws + WS_PROJ);
    const float* HLOC = (const float*)(F.ws + WS_H); const float* PP = HLOC + (size_t)T * 256;
    const float* LRUA = (const float*)(F.ws + WS_LRUA); const float* LRUH = (const float*)(F.ws + WS_LRUH);
    LAS float* cs = (LAS float*)F.lds;
    LAS float* carry = (LAS float*)(F.lds + 4096);
    const float* og = F.inp(F_OGAIN) + l * 1024;
    for (int tile = F.vcu; tile < T / 128; tile += F.G) {
        const int b = tile >> 6, tt = tile & 63, j0 = 2 * tt;
        { const int c = F.tid & 255, seg = F.tid >> 8; const int jb = seg ? j0 / 2 : 0, je = seg ? j0 : j0 / 2;
          float A = 1.f, Hh = 0.f;
          int j = jb;
          for (; j + 8 <= je; j += 8) {
              float aj[8], hj[8];
#pragma unroll
              for (int k = 0; k < 8; ++k) { const size_t so = (size_t)(b * 128 + j + k) * 256 + c; aj[k] = LRUA[so]; hj[k] = LRUH[so]; }
#pragma unroll
              for (int k = 0; k < 8; ++k) { Hh = aj[k] * Hh + hj[k]; A *= aj[k]; } }
          for (; j < je; ++j) { const size_t so = (size_t)(b * 128 + j) * 256 + c; const float aj = LRUA[so], hj = LRUH[so]; Hh = aj * Hh + hj; A *= aj; }
          cs[(seg * 2 + 0) * 256 + c] = A; cs[(seg * 2 + 1) * 256 + c] = Hh; }
        __syncthreads();
        if (F.tid < 256) { const int c = F.tid; const float c0 = cs[(2 + 0) * 256 + c] * cs[(0 + 1) * 256 + c] + cs[(2 + 1) * 256 + c];
            const size_t so = (size_t)(b * 128 + j0) * 256 + c; carry[c] = c0; carry[256 + c] = LRUA[so] * c0 + LRUH[so]; }
        __syncthreads();
#pragma unroll 1
        for (int i = 0; i < 16; i += 2) {
            u32x4 ya[2]; u32x2 yc[2], gb[2]; f32x4 hl[2], pp[2], cr[2];
#pragma unroll
            for (int k = 0; k < 2; ++k) { const int rl = F.wave * 16 + i + k; const size_t row = (size_t)tile * 128 + rl; const bf16_t* yr = Y + row * D;
                ya[k] = *(const u32x4*)(yr + 8 * F.lane); yc[k] = *(const u32x2*)(yr + 768 + 4 * F.lane);
                hl[k] = *(const f32x4*)(HLOC + row * 256 + 4 * F.lane); pp[k] = *(const f32x4*)(PP + row * 256 + 4 * F.lane);
                gb[k] = *(const u32x2*)(PROJ + row * NPROJ + C_GB + 4 * F.lane); cr[k] = *(const LAS f32x4*)(carry + (rl >> 6) * 256 + 4 * F.lane); }
#pragma unroll
            for (int k = 0; k < 2; ++k) { const int rl = F.wave * 16 + i + k; const size_t row = (size_t)tile * 128 + rl; bf16_t* yr = YO + row * D;
                float fa[8]; fa[0] = __uint_as_float(ya[k].x << 16); fa[1] = __uint_as_float(ya[k].x & 0xffff0000u); fa[2] = __uint_as_float(ya[k].y << 16); fa[3] = __uint_as_float(ya[k].y & 0xffff0000u);
                fa[4] = __uint_as_float(ya[k].z << 16); fa[5] = __uint_as_float(ya[k].z & 0xffff0000u); fa[6] = __uint_as_float(ya[k].w << 16); fa[7] = __uint_as_float(ya[k].w & 0xffff0000u);
                float sa = 0.f;
#pragma unroll
                for (int e = 0; e < 8; ++e) sa += fa[e] * fa[e];
                float fc[4]; fc[0] = __uint_as_float(yc[k].x << 16); fc[1] = __uint_as_float(yc[k].x & 0xffff0000u); fc[2] = __uint_as_float(yc[k].y << 16); fc[3] = __uint_as_float(yc[k].y & 0xffff0000u);
                const float sc_ = fc[0] * fc[0] + fc[1] * fc[1] + fc[2] * fc[2] + fc[3] * fc[3];
                float fb[4]; { const f32x4 hh = hl[k] + pp[k] * cr[k];
                    fb[0] = hh.x * gelu_tanh(__uint_as_float(gb[k].x << 16)); fb[1] = hh.y * gelu_tanh(__uint_as_float(gb[k].x & 0xffff0000u));
                    fb[2] = hh.z * gelu_tanh(__uint_as_float(gb[k].y << 16)); fb[3] = hh.w * gelu_tanh(__uint_as_float(gb[k].y & 0xffff0000u)); }
                const float sb = fb[0] * fb[0] + fb[1] * fb[1] + fb[2] * fb[2] + fb[3] * fb[3];
                const float ra = 1.0f / sqrtf(wave_sum(sa) * (1.f / 512.f) + EPS), rb = 1.0f / sqrtf(wave_sum(sb) * (1.f / 256.f) + EPS), rc = 1.0f / sqrtf(wave_sum(sc_) * (1.f / 256.f) + EPS);
                { const f32x4 g0 = *(const f32x4*)(og + 8 * F.lane), g1 = *(const f32x4*)(og + 8 * F.lane + 4);
                  u32x4 w; w.x = cvtpk(fa[0] * ra * g0.x, fa[1] * ra * g0.y); w.y = cvtpk(fa[2] * ra * g0.z, fa[3] * ra * g0.w); w.z = cvtpk(fa[4] * ra * g1.x, fa[5] * ra * g1.y); w.w = cvtpk(fa[6] * ra * g1.z, fa[7] * ra * g1.w);
                  *(u32x4*)(yr + 8 * F.lane) = w; }
                { const f32x4 g = *(const f32x4*)(og + 512 + 4 * F.lane); u32x2 w; w.x = cvtpk(fb[0] * rb * g.x, fb[1] * rb * g.y); w.y = cvtpk(fb[2] * rb * g.z, fb[3] * rb * g.w); *(u32x2*)(yr + 512 + 4 * F.lane) = w; }
                { const f32x4 g = *(const f32x4*)(og + 768 + 4 * F.lane); u32x2 w; w.x = cvtpk(fc[0] * rc * g.x, fc[1] * rc * g.y); w.y = cvtpk(fc[2] * rc * g.z, fc[3] * rc * g.w); *(u32x2*)(yr + 768 + 4 * F.lane) = w; }
            }
        }
        __syncthreads();
    }
}

template <int N, int MASK> __device__ __forceinline__ void tr_step(float (&v)[40], bool upper) {
#pragma unroll
    for (int i = 0; i < N / 2; ++i) { const float a = v[i], b = v[i + N / 2]; const float send = upper ? a : b, kp = upper ? b : a; float rcv;
        if constexpr (MASK == 32) { auto rr = __builtin_amdgcn_permlane32_swap(__float_as_uint(send), __float_as_uint(send), false, false); rcv = upper ? __uint_as_float(rr[0]) : __uint_as_float(rr[1]); }
        else rcv = shx<MASK>(send);
        v[i] = kp + rcv; }
}
__device__ __forceinline__ void phase_norm2_router(Frame& F, int l, const float* xa, unsigned* cnt) {
    const float* MOD = (const float*)(F.ws + WS_MOD) + (size_t)l * 4 * 6144;
    bf16_t* H = (bf16_t*)(F.ws + WS_H);
    LEntry* list = (LEntry*)(F.ws + WS_LIST);
    LAS float* wr = (LAS float*)F.lds;
    LAS float* gs = (LAS float*)(F.lds + 81920);
    LAS float* lg = (LAS float*)(F.lds + 90112);
    LAS int* tcls = (LAS int*)(F.lds + 92672);
    LAS float* tw = (LAS float*)(F.lds + 93184);
    LAS int* trank = (LAS int*)(F.lds + 94208);
    LAS unsigned* lcnt = (LAS unsigned*)(F.lds + 94720);
    LAS unsigned* lbase = (LAS unsigned*)(F.lds + 94848);
    const bf16_t* Pb = (const bf16_t*)(F.ws + WS_P); LAS float* gmv = (LAS float*)(F.lds + 98304);
    for (int i = F.tid; i < 1024 * 4; i += 512) { const int k = i >> 2, e = i & 3; wr[e * 1024 + k] = F.inp(F_WRG)[(size_t)l * 4096 + i]; }
    for (int i = F.tid; i < 1024 * 16; i += 512) { const int k = i >> 4, e = i & 15; wr[(4 + e) * 1024 + k] = F.inp(F_WRE)[(size_t)l * 16384 + i]; }
    int cur_b = -1;
    for (int tile = F.vcu; tile < T / 128; tile += F.G) {
        const int b = tile >> 6;
        __syncthreads();
        if (b != cur_b) { for (int i = F.tid; i < 1024; i += 512) { gs[i] = F.inp(F_NFFN)[l * 1024 + i] * (1.f + MOD[b * 6144 + 4096 + i]); gs[1024 + i] = MOD[b * 6144 + 3072 + i]; gmv[i] = MOD[b * 6144 + 2048 + i]; } cur_b = b; }
        if (F.tid < NCLS) lcnt[F.tid] = 0u;
        __syncthreads();
#pragma unroll 1
        for (int grp = 0; grp < 8; ++grp) {
            const size_t row0 = (size_t)tile * 128 + F.wave * 16 + grp * 2;
            f32x4 hv[2][4];
#pragma unroll
            for (int r = 0; r < 2; ++r) { const f32x4* xr = (const f32x4*)(xa + (row0 + r) * D) + F.lane;
#pragma unroll
                for (int j = 0; j < 4; ++j) hv[r][j] = xr[64 * j]; }
            { u32x2 pv_[2][4];
#pragma unroll
              for (int r = 0; r < 2; ++r) { const u32x2* pr = (const u32x2*)(Pb + (row0 + r) * D) + F.lane;
#pragma unroll
                  for (int j = 0; j < 4; ++j) pv_[r][j] = pr[64 * j]; }
#pragma unroll
              for (int j = 0; j < 4; ++j) { const f32x4 gm = *(const LAS f32x4*)(gmv + 4 * F.lane + 256 * j);
                  hv[0][j] = hv[0][j] + gm * bf4_to_f32(pv_[0][j]); hv[1][j] = hv[1][j] + gm * bf4_to_f32(pv_[1][j]); } }
#pragma unroll
            for (int r = 0; r < 2; ++r) { float ss = 0.f;
#pragma unroll
                for (int j = 0; j < 4; ++j) ss += (hv[r][j].x * hv[r][j].x + hv[r][j].y * hv[r][j].y) + (hv[r][j].z * hv[r][j].z + hv[r][j].w * hv[r][j].w);
                const float rstd = 1.0f / sqrtf(wave_sum(ss) * (1.f / D) + EPS);
                u32x2* o8 = (u32x2*)(H + (row0 + r) * D) + F.lane;
#pragma unroll
                for (int j = 0; j < 4; ++j) { const f32x4 g = *(const LAS f32x4*)(gs + 4 * F.lane + 256 * j), s = *(const LAS f32x4*)(gs + 1024 + 4 * F.lane + 256 * j);
                    hv[r][j] = hv[r][j] * rstd * g + s; u32x2 w; w.x = cvtpk(hv[r][j].x, hv[r][j].y); w.y = cvtpk(hv[r][j].z, hv[r][j].w); o8[64 * j] = w; } }
            float acc[40];
#pragma unroll
            for (int e = 0; e < 20; ++e) { float a0 = 0.f, a1 = 0.f;
#pragma unroll
                for (int j = 0; j < 4; ++j) { const f32x4 w = *(const LAS f32x4*)(wr + e * 1024 + 4 * F.lane + 256 * j);
                    a0 += hv[0][j].x * w.x + hv[0][j].y * w.y + hv[0][j].z * w.z + hv[0][j].w * w.w;
                    a1 += hv[1][j].x * w.x + hv[1][j].y * w.y + hv[1][j].z * w.z + hv[1][j].w * w.w; }
                acc[e] = a0; acc[20 + e] = a1; }
            tr_step<40, 32>(acc, (F.lane & 32) != 0); tr_step<20, 16>(acc, (F.lane & 16) != 0); tr_step<10, 8>(acc, (F.lane & 8) != 0);
#pragma unroll
            for (int i = 0; i < 5; ++i) { acc[i] += shx<4>(acc[i]); acc[i] += shx<2>(acc[i]); acc[i] += shx<1>(acc[i]); }
            if ((F.lane & 7) == 0) { const int v0 = 5 * (F.lane >> 3);
#pragma unroll
                for (int i = 0; i < 5; ++i) lg[F.wave * 40 + v0 + i] = acc[i]; }
            LDS_WAIT();
            if (F.lane < 2) {
                const LAS float* q = lg + F.wave * 40 + F.lane * 20;
                float gl[4];
#pragma unroll
                for (int j = 0; j < 4; ++j) gl[j] = q[j] + F.inp(F_BRG)[l * 4 + j];
                int gsel = 0; float gm = gl[0];
#pragma unroll
                for (int j = 1; j < 4; ++j) if (gl[j] > gm) { gm = gl[j]; gsel = j; }
                float den = 0.f;
#pragma unroll
                for (int j = 0; j < 4; ++j) den += expf(gl[j] - gm);
                const float gp = 1.0f / den;
                float el[4];
#pragma unroll
                for (int j = 0; j < 4; ++j) el[j] = q[4 + 4 * gsel + j] + F.inp(F_BRE)[l * 16 + gsel * 4 + j];
                int i1 = 0; float m1 = el[0];
#pragma unroll
                for (int j = 1; j < 4; ++j) if (el[j] > m1) { m1 = el[j]; i1 = j; }
                int i2 = -1; float m2 = -__builtin_inff();
#pragma unroll
                for (int j = 0; j < 4; ++j) if (j != i1 && el[j] > m2) { m2 = el[j]; i2 = j; }
                const float e2 = expf(m2 - m1); const float w1 = gp / (1.f + e2), w2 = gp * e2 / (1.f + e2);
                const int lo = i1 < i2 ? i1 : i2, hi = i1 < i2 ? i2 : i1;
                const int rl = F.wave * 16 + grp * 2 + F.lane;
                tcls[rl] = gsel * 6 + pair_idx(lo, hi); tw[rl * 2] = (i1 < i2) ? w1 : w2; tw[rl * 2 + 1] = (i1 < i2) ? w2 : w1;
            }
        }
        __syncthreads();
        if (F.tid < 128) trank[F.tid] = (int)atomicAdd((unsigned*)&lcnt[tcls[F.tid]], 1u);
        __syncthreads();
        if (F.tid < NCLS) lbase[F.tid] = lcnt[F.tid] ? __hip_atomic_fetch_add(cnt + 64 * F.tid, lcnt[F.tid], __ATOMIC_RELAXED, __HIP_MEMORY_SCOPE_AGENT) : 0u;
        __syncthreads();
        if (F.tid < 128) { const int cls = tcls[F.tid]; const unsigned pos = lbase[cls] + (unsigned)trank[F.tid];
            LEntry e; e.tok = tile * 128 + F.tid; e.w0 = tw[F.tid * 2]; e.w1 = tw[F.tid * 2 + 1]; e.pad = 0; list[(size_t)cls * LCAP + pos] = e; }
    }
    __syncthreads();
}

__device__ __forceinline__ int build_tile_table(Frame& F, int l) {
    unsigned* cnt = (unsigned*)(F.ws + WS_CTL) + CW_CNT + l * NCLS * 64;
    LAS int* tt = (LAS int*)(F.lds + TT_OFF); LAS int* ntl = (LAS int*)(F.lds + TT_OFF + 1024);
    __syncthreads();
    if (F.tid == 0) { int nt = 0;
        for (int c = 0; c < NCLS; ++c) { const unsigned n = __hip_atomic_load(cnt + 64 * c, __ATOMIC_RELAXED, __HIP_MEMORY_SCOPE_AGENT); const int k = (int)((n + 255u) >> 8);
            for (int j = 0; j < k; ++j) tt[nt++] = c | ((j * 256) << 8); }
        ntl[0] = nt; }
    __syncthreads();
    return ntl[0];
}

__device__ __forceinline__ void phase_final(Frame& F, const float* xa, int lp) {
    const bf16_t* Pb = (const bf16_t*)(F.ws + WS_P); const bf16_t* Mb = (const bf16_t*)(F.ws + WS_M); const float* MODp = (const float*)(F.ws + WS_MOD) + (size_t)lp * 4 * 6144;
    const int gw = F.vcu * 8 + F.wave;
    const int rbase = gw * 16; const float* gp = MODp + (rbase >> 13) * 6144;
    f32x4 g[4], gm[4], gf[4];
#pragma unroll
    for (int j = 0; j < 4; ++j) { const int col = 4 * F.lane + 256 * j; g[j] = *(const f32x4*)(F.inp(F_NFIN) + col); gm[j] = *(const f32x4*)(gp + 2048 + col); gf[j] = *(const f32x4*)(gp + 5120 + col); }
#pragma unroll 1
    for (int i = 0; i < 16; i += 2) {
        const int row = rbase + i;
        const f32x4* xr0 = (const f32x4*)(xa + (size_t)row * D) + F.lane; const f32x4* xr1 = xr0 + D / 4;
        const u32x2* pa = (const u32x2*)(Pb + (size_t)row * D) + F.lane; const u32x2* ma = (const u32x2*)(Mb + (size_t)row * D) + F.lane;
        f32x4 v0[4], v1[4]; u32x2 p0[4], p1[4], m0[4], m1[4]; float ss0 = 0.f, ss1 = 0.f;
#pragma unroll
        for (int j = 0; j < 4; ++j) { v0[j] = xr0[64 * j]; v1[j] = xr1[64 * j]; p0[j] = pa[64 * j]; p1[j] = pa[64 * j + D / 4]; m0[j] = ma[64 * j]; m1[j] = ma[64 * j + D / 4]; }
#pragma unroll
        for (int j = 0; j < 4; ++j) { v0[j] = v0[j] + gm[j] * bf4_to_f32(p0[j]) + gf[j] * bf4_to_f32(m0[j]); v1[j] = v1[j] + gm[j] * bf4_to_f32(p1[j]) + gf[j] * bf4_to_f32(m1[j]);
            ss0 += (v0[j].x * v0[j].x + v0[j].y * v0[j].y) + (v0[j].z * v0[j].z + v0[j].w * v0[j].w); ss1 += (v1[j].x * v1[j].x + v1[j].y * v1[j].y) + (v1[j].z * v1[j].z + v1[j].w * v1[j].w); }
        const float rstd0 = 1.0f / sqrtf(wave_sum(ss0) * (1.f / D) + EPS), rstd1 = 1.0f / sqrtf(wave_sum(ss1) * (1.f / D) + EPS);
        f32x4* o0 = (f32x4*)(F.out + (size_t)row * D) + F.lane; f32x4* o1 = o0 + D / 4;
#pragma unroll
        for (int j = 0; j < 4; ++j) { o0[64 * j] = v0[j] * rstd0 * g[j]; o1[64 * j] = v1[j] * rstd1 * g[j]; }
    }
}

__global__ void __launch_bounds__(512, 2) mk_fwd(const Args args) {
    extern __shared__ __attribute__((aligned(16))) unsigned char lds[];
    Frame F;
    F.lds = (LAS unsigned char*)lds; F.shm = (char*)lds;
    F.tid = threadIdx.x; F.lane = F.tid & 63; F.wave = __builtin_amdgcn_readfirstlane(F.tid >> 6);
    F.G = 256; { const int bx = blockIdx.x; __builtin_assume(bx >= 0 && bx < 256); F.vcu = (bx % 8) * 32 + bx / 8; }
    for (int u = F.tid; u < (LDS_BYTES - LDSCTL_OFF) / 4; u += 512) ((LAS unsigned*)(F.lds + LDSCTL_OFF))[u] = 0u;
    __syncthreads();
    F.wave_s = __builtin_amdgcn_readfirstlane((int)threadIdx.x >> 6);
#define REFRESH() frame_refresh(F)
    REFRESH();
    unsigned* ctl = (unsigned*)(F.ws + WS_CTL);
    XcdBarrier bar = xcd_barrier_post(ctl + CW_BAR, (volatile LAS unsigned*)(F.lds + MISC_OFF) + 8);

    for (int rep = 0; rep < DUP(0); ++rep) if (PH(0)) phase_p0(F);
    xcd_barrier(bar, F.tid);
    float* XA = (float*)(F.ws + WS_XA);
    for (int l = 0; l < DEPTH; ++l) {
        const float* xin = (l <= 1) ? F.inp(F_X) : XA;
        const float* xbase = (l == 0) ? F.inp(F_X) : XA;
        const float* MODl = (const float*)(F.ws + WS_MOD) + (size_t)l * 4 * 6144;
        REFRESH();
        for (int rep = 0; rep < DUP(1); ++rep) if (PH(1)) { if (l == 0) phase_norm1<false>(F, l, xin); else phase_norm1<true>(F, l, xin); }
        xcd_barrier(bar, F.tid);
        REFRESH();
        for (int rep = 0; rep < DUP(2); ++rep) if (PH(2)) { pg8::DenseOrder S; S.init(T, NPROJ, F.G, (int)blockIdx.x, F.ws + WS_WIN + (size_t)l * 2048 * 1024 * 2, 2048u, G1REP);
          EpiProj E{(bf16_t*)(F.ws + WS_PROJ), (unsigned*)(F.ws + WS_CTL) + CW_KM + l * 128};
          pg8::gemm_phase<EpiProj, pg8::DenseOrder, true>(F.tid, F.lds, (const char*)(F.ws + WS_H), 2048u, 2048u, 1024, S, E); }
        xcd_barrier(bar, F.tid);
        REFRESH();
        for (int rep = 0; rep < DUP(3); ++rep) if (PH(3)) { phase_mixer(F, l, l + 2 * rep); if (rep + 1 < DUP(3)) xcd_barrier(bar, F.tid); }
        xcd_barrier(bar, F.tid);
        REFRESH();
        for (int rep = 0; rep < DUP(4); ++rep) if (PH(4)) phase_ynorm(F, l, (rep + 1 < DUP(4)) ? (bf16_t*)F.out : (bf16_t*)(F.ws + WS_Y));
        xcd_barrier(bar, F.tid);
        REFRESH();
        for (int rep = 0; rep < DUP(5); ++rep) if (PH(5)) { pg8::DenseOrder S; S.init(T, D, F.G, (int)blockIdx.x, F.ws + WS_WOUT + (size_t)l * 1024 * 1024 * 2, 2048u, (l == 0) ? G2REP : 1);
          EpiP E{(bf16_t*)(F.ws + WS_P)};
          pg8::gemm_phase<EpiP, pg8::DenseOrder, true>(F.tid, F.lds, (const char*)(F.ws + WS_Y), 2048u, 2048u, 1024, S, E); }
        xcd_barrier(bar, F.tid);
        REFRESH();
        for (int rep = 0; rep < DUP(6); ++rep) if (PH(6)) phase_norm2_router(F, l, xbase, (unsigned*)(F.ws + WS_CTL) + ((rep + 1 < DUP(6)) ? 32768 + l * NCLS * 64 : CW_CNT + l * NCLS * 64));
        xcd_barrier(bar, F.tid);
        REFRESH();
        const int ntiles = build_tile_table(F, l);
        const LEntry* list = (const LEntry*)(F.ws + WS_LIST); const unsigned* cnt = (const unsigned*)(F.ws + WS_CTL) + CW_CNT + l * NCLS * 64;
        for (int rep = 0; rep < DUP(7); ++rep) if (PH(7)) { MoeUpOrder S{ntiles * 4, F.G, (int)blockIdx.x, (const LAS int*)(F.lds + TT_OFF), (const char*)(F.ws + WS_WGU + (size_t)l * 16 * 512 * 1024 * 2), list, cnt};
          EpiUp E{(bf16_t*)(F.ws + WS_PROJ), list, cnt};
          pg8::gemm_phase<EpiUp, MoeUpOrder, true>(F.tid, F.lds, (const char*)(F.ws + WS_H), 2048u, 2048u, 1024, S, E); }
        xcd_barrier(bar, F.tid);
        REFRESH();
        for (int rep = 0; rep < DUP(8); ++rep) if (PH(8)) { MoeDownOrder S{ntiles * 4, F.G, (int)blockIdx.x, (const LAS int*)(F.lds + TT_OFF), (const char*)(F.ws + WS_WDP + (size_t)l * 24 * 1024 * 512 * 2)};
          EpiDown E{(bf16_t*)(F.ws + WS_M), list, cnt};
          pg8::gemm_phase<EpiDown, MoeDownOrder, true>(F.tid, F.lds, (const char*)(F.ws + WS_PROJ), 1024u, 1024u, 512, S, E); }
        xcd_barrier(bar, F.tid);
    }
        REFRESH();
    for (int rep = 0; rep < DUP(9); ++rep) if (PH(9)) phase_final(F, (DEPTH == 1) ? F.inp(F_X) : XA, DEPTH - 1);
}

extern "C" void kernel_launch(void* const* d_in, const int* in_sizes, int n_in, void* d_out, int out_size, void* d_ws, size_t ws_size, hipStream_t stream) {
    static int grid = 0;
    if (grid == 0) {
        if (n_in != 26 || in_sizes[0] != T * D || out_size != T * D || ws_size < WS_END) { fprintf(stderr, "kernel_launch: unexpected shapes (n_in %d, in0 %d, out %d, ws %zu)\n", n_in, n_in > 0 ? in_sizes[0] : -1, out_size, ws_size); grid = -1; return; }
        int dev = 0, cus = 0, per_cu = 0;
        if (hipGetDevice(&dev) != hipSuccess || hipDeviceGetAttribute(&cus, hipDeviceAttributeMultiprocessorCount, dev) != hipSuccess) { grid = -1; return; }
        if (hipFuncSetAttribute((const void*)mk_fwd, hipFuncAttributeMaxDynamicSharedMemorySize, LDS_BYTES) != hipSuccess) { fprintf(stderr, "kernel_launch: hipFuncSetAttribute failed\n"); grid = -1; return; }
        if (hipOccupancyMaxActiveBlocksPerMultiprocessor(&per_cu, (const void*)mk_fwd, 512, LDS_BYTES) != hipSuccess || per_cu < 1) fprintf(stderr, "kernel_launch: occupancy query reports %d\n", per_cu);
        (void)hipGetLastError();
        if (cus != 256) fprintf(stderr, "kernel_launch: built for 256 CUs, device reports %d\n", cus);
        grid = 256;
    }
    if (grid < 0) return;
    (void)hipMemsetAsync((char*)d_ws + WS_CTL, 0, CTL_ZERO_BYTES, stream);
    Args a{};
    for (int i = 0; i < 26; ++i) a.in[i] = (const float*)d_in[i];
    a.out = (float*)d_out; a.ws = (unsigned char*)d_ws;
    hipLaunchKernelGGL(mk_fwd, dim3(grid), dim3(512), LDS_BYTES, stream, a);
}
```

```cpp
#include <hip/hip_runtime.h>
#include <hip/hip_bf16.h>
#include <cstdio>
#include <cstdint>

#define GAS __attribute__((address_space(1)))
#define LAS __attribute__((address_space(3)))
typedef unsigned short bf16_t;
typedef short bf16x8 __attribute__((ext_vector_type(8)));
typedef short s16x4 __attribute__((ext_vector_type(4)));
typedef float f32x2 __attribute__((ext_vector_type(2)));
typedef float f32x4 __attribute__((ext_vector_type(4)));
typedef float f32x16 __attribute__((ext_vector_type(16)));
typedef unsigned u32x2 __attribute__((ext_vector_type(2)));
typedef unsigned u32x4 __attribute__((ext_vector_type(4)));
typedef __bf16 bf16x2_t __attribute__((ext_vector_type(2)));

#ifndef DUP_MASK
#define DUP_MASK 0x0u
#endif
#define DUP(n) (1 + (int)((DUP_MASK >> (n)) & 1u))
#ifndef G2REP
#define G2REP 1
#endif
#ifndef G1REP
#define G1REP 1
#endif
#ifndef UPREP
#define UPREP 1
#endif
#ifndef PH_MASK
#define PH_MASK 0xFFFFFFFFu
#endif
#define PH(n) ((PH_MASK >> (n)) & 1u)
constexpr int D = 1024, NB = 4, SEQ = 8192, T = NB * SEQ, DEPTH = 2;
constexpr int IN_COLS = 2052, NPROJ = 2048;
constexpr int C_QA = 0, C_KA = 512, C_VA = 640, C_XB = 768, C_GB = 1024, C_QC = 1280, C_KC = 1536, C_VC = 1792;
constexpr int NCLS = 24, LCAP = 32768;
constexpr float EPS = 1e-6f;
constexpr float LOG2E = 1.4426950408889634f;
constexpr float C2 = 0.125f * 1.4426950408889634f;

constexpr size_t MiB = 1u << 20;
constexpr size_t WS_CTL = 0, CTL_ZERO_BYTES = 1 * MiB;
constexpr size_t WS_MOD = 1 * MiB;
constexpr size_t WS_CUM = WS_MOD + 256 * 1024;
constexpr size_t WS_CTOT = WS_CUM + 512 * 1024;
constexpr size_t WS_LRUA = 2 * MiB;
constexpr size_t WS_LRUH = WS_LRUA + 512 * 1024;
constexpr size_t WS_LIST = 4 * MiB;
constexpr size_t WS_WIN = 16 * MiB;
constexpr size_t WS_WOUT = 24 * MiB;
constexpr size_t WS_WGU = 28 * MiB;
constexpr size_t WS_WDP = 60 * MiB;
constexpr size_t WS_XA = 108 * MiB;
constexpr size_t WS_H = 236 * MiB;
constexpr size_t WS_PROJ = 300 * MiB;
constexpr size_t WS_Y = 428 * MiB;
constexpr size_t WS_P = WS_PROJ + 64 * MiB;
constexpr size_t WS_M = WS_Y;
constexpr size_t WS_END = 492 * MiB;
constexpr int CW_BAR = 4096;
constexpr int CW_KM = 20480;
constexpr int CW_Q = 21504;
constexpr int CW_CNT = 16384;

struct LEntry { int tok; float w0, w1; int pad; };

constexpr int RING_BYTES = 131072;
constexpr int LDSCTL_OFF = RING_BYTES;
constexpr int MISC_OFF = LDSCTL_OFF + 320;
constexpr int TT_OFF = LDSCTL_OFF + 1024;
constexpr int LDS_BYTES = 147456;

__device__ __forceinline__ unsigned cvtpk(float lo, float hi) { f32x2 v = {lo, hi}; bf16x2_t b = __builtin_convertvector(v, bf16x2_t); return __builtin_bit_cast(unsigned, b); }
__device__ __forceinline__ float bf2f(bf16_t v) { return __builtin_bit_cast(float, (unsigned)v << 16); }
__device__ __forceinline__ f32x4 bf4_to_f32(u32x2 v) { return (f32x4){__uint_as_float(v.x << 16), __uint_as_float(v.x & 0xffff0000u), __uint_as_float(v.y << 16), __uint_as_float(v.y & 0xffff0000u)}; }
template <int M> __device__ __forceinline__ float shx(float v) {
    return __int_as_float(__builtin_amdgcn_ds_swizzle(__float_as_int(v), (M << 10) | 0x1f));
}
__device__ __forceinline__ float wave_sum(float v) {
    v += shx<1>(v); v += shx<2>(v); v += shx<4>(v); v += shx<8>(v); v += shx<16>(v);
    auto rr = __builtin_amdgcn_permlane32_swap(__float_as_uint(v), __float_as_uint(v), false, false);
    return __uint_as_float(rr[0]) + __uint_as_float(rr[1]);
}
__device__ __forceinline__ float fast_exp(float x) { return __builtin_amdgcn_exp2f(x * LOG2E); }
__device__ __forceinline__ float sigmoidf_(float x) { return __builtin_amdgcn_rcpf(1.f + fast_exp(-x)); }
__device__ __forceinline__ float gelu_tanh(float x) {
    const float u = 0.7978845608028654f * (x + 0.044715f * x * x * x);
    const float e = fast_exp(2.f * u);
    const float th = 1.f - 2.f * __builtin_amdgcn_rcpf(e + 1.f);
    return 0.5f * x * (1.f + th);
}
#define LDS_WAIT() asm volatile("s_waitcnt lgkmcnt(0)" ::: "memory")
#define VM_WAIT() asm volatile("s_waitcnt vmcnt(0)" ::: "memory")

namespace pg8 {
constexpr int BM = 256, BK = 64, HALF = 128, HTB = HALF * BK * 2, STAGE_BYTES = 8 * HTB, NXCD = 8, WGM = 8;
__host__ __device__ __forceinline__ int lds_byte(int r, int c) { const int st = (r >> 4) * 2 + (c >> 5), rr = r & 15, cc = c & 31, ob = rr * 64 + cc * 2; return st * 1024 + (ob ^ (((ob >> 9) & 1) << 5)); }
__host__ __device__ __forceinline__ void stage_rc(int b, int& R, int& C) { const int st = b / 1024, sb = b % 1024, swz = sb ^ (((sb >> 9) & 1) << 5); R = (st >> 1) * 16 + swz / 64; C = (st & 1) * 32 + (swz % 64) / 2; }
__host__ __device__ __forceinline__ int perm32(int rho) { const int n = rho >> 4, i = rho & 15; return 8 * (i >> 2) + 4 * n + (i & 3); }

struct GUnit { int a0; const char* bb; int e0, e1, e2, e3; };

__device__ __forceinline__ int xcd_remap(int L, int nwg) {
    const int q = nwg / NXCD, r = nwg % NXCD, xcd = L % NXCD, off = L / NXCD;
    return (xcd < r ? xcd * (q + 1) : r * (q + 1) + (xcd - r) * q) + off;
}

struct DenseOrder {
    int nM, nN, nwg, G, c, rep; const char* Bt; unsigned pitchB;
    __device__ __forceinline__ void init(int M, int N, int G_, int c_, const void* Bt_, unsigned pitchB_, int rep_ = 1) { nM = M / BM; nN = N / BM; nwg = nM * nN; G = G_; c = c_; Bt = (const char*)Bt_; pitchB = pitchB_; rep = rep_; }
    __device__ __forceinline__ bool next(int i, GUnit& u) const {
        const long L = (long)i * G + c; if (L >= (long)nwg * rep) return false;
        const int wgid = xcd_remap((int)(L % nwg), nwg);
        const int nig = WGM * nN, gid = wgid / nig, fm = gid * WGM, gsz = (nM - fm) < WGM ? (nM - fm) : WGM;
        const int pm = fm + ((wgid % nig) % gsz), pn = (wgid % nig) / gsz;
        u.a0 = pm * BM; u.bb = Bt + (size_t)pn * BM * pitchB; u.e0 = pm; u.e1 = pn; u.e2 = 0; u.e3 = 0; return true;
    }
    __device__ __forceinline__ unsigned arow(const GUnit& u, int r) const { return (unsigned)(u.a0 + r); }
};

#define PG8_SA(b, h) (((b) * 2 + (h)) * HTB)
#define PG8_SB(b, h) ((4 + (b) * 2 + (h)) * HTB)
#define PG8_STG(bufoff, gptr, v0, v1) do { \
        __builtin_amdgcn_global_load_lds((const unsigned*)((const char*)(gptr) + (v0)), (LAS unsigned*)(lds + (bufoff) + ldsw), 16, 0, 0); \
        __builtin_amdgcn_global_load_lds((const unsigned*)((const char*)(gptr) + (v1)), (LAS unsigned*)(lds + (bufoff) + ldsw + 8192), 16, 0, 0); } while (0)
#define PG8_STGA(bufoff, kb, vo) PG8_STG(bufoff, Abase + (kb), (vo)[0], (vo)[1])
#define PG8_STGB(bufoff, bp) PG8_STG(bufoff, bp, voffB[0], voffB[1])
#define PG8_LDA(dst, b, h) do { _Pragma("unroll") for (int m = 0; m < 4; ++m) _Pragma("unroll") for (int k = 0; k < 2; ++k) dst[m][k] = *(const LAS bf16x8*)(lds + PG8_SA(b, h) + aoff + m * 2048 + k * 1024); } while (0)
#define PG8_LDB(dst, b, h) do { _Pragma("unroll") for (int n = 0; n < 2; ++n) _Pragma("unroll") for (int k = 0; k < 2; ++k) dst[n][k] = *(const LAS bf16x8*)(lds + PG8_SB(b, h) + boff + n * 2048 + k * 1024); } while (0)
#define PG8_MMA(ai, bj, At, Bt) do { __builtin_amdgcn_s_setprio(1); _Pragma("unroll") for (int m = 0; m < 4; ++m) _Pragma("unroll") for (int n = 0; n < 2; ++n) _Pragma("unroll") for (int k = 0; k < 2; ++k) \
        acc[ai][bj][m][n] = __builtin_amdgcn_mfma_f32_16x16x32_bf16(Bt[n][k], At[m][k], acc[ai][bj][m][n], 0, 0, 0); __builtin_amdgcn_s_setprio(0); } while (0)
#define PG8_WAIT_V(n) asm volatile("s_waitcnt vmcnt(" #n ")" ::: "memory")
#define PG8_WAIT_L(n) asm volatile("s_waitcnt lgkmcnt(" #n ")" ::: "memory")
#define PG8_BAR __builtin_amdgcn_s_barrier()
#define PG8_SCHED __builtin_amdgcn_sched_barrier(0)

template <class Epi, class Sched, bool ALIGN_EPI>
__device__ __forceinline__ void gemm_phase(const int tid, LAS unsigned char* lds, const char* Abase, unsigned pitchA, unsigned pitchB, int K, const Sched& S, const Epi& E) {
    const int wid = __builtin_amdgcn_readfirstlane(tid >> 6), lane = tid & 63, wr = wid >> 2, wc = wid & 3, fr = lane & 15, fq = lane >> 4;
    const int nt = K / BK;
    int RA[2]; unsigned cA2[2], voffB[2];
#pragma unroll
    for (int i = 0; i < 2; ++i) { int R, C; stage_rc(tid * 16 + i * 8192, R, C); const int Rb = Epi::PERM ? ((R & ~31) + perm32(R & 31)) : R;
        RA[i] = R; cA2[i] = (unsigned)C * 2u; voffB[i] = (unsigned)Rb * pitchB + (unsigned)C * 2u; }
    const unsigned hstepB = (unsigned)HALF * pitchB;
    const unsigned ldsw = (unsigned)wid * 1024u;
    const int aoff = lds_byte(wr * 64 + fr, fq * 8), boff = lds_byte(wc * 32 + fr, fq * 8);
    GUnit cur, nxt; int ui = 0;
    if (!S.next(0, cur)) return;
    f32x4 acc[2][2][4][2];
#pragma unroll
    for (int a = 0; a < 2; ++a)
#pragma unroll
        for (int b = 0; b < 2; ++b)
#pragma unroll
            for (int m = 0; m < 4; ++m)
#pragma unroll
                for (int n = 0; n < 2; ++n) acc[a][b][m][n] = (f32x4){0.f, 0.f, 0.f, 0.f};
    bf16x8 At[4][2], B0[2][2], B1[2][2];
    unsigned voA[2][2];
#pragma unroll
    for (int h = 0; h < 2; ++h)
#pragma unroll
        for (int i = 0; i < 2; ++i) voA[h][i] = S.arow(cur, h * HALF + RA[i]) * pitchA + cA2[i];
    const char* cB = cur.bb;
    const unsigned kstep = BK * 2;
    PG8_STGB(PG8_SB(0, 0), cB); PG8_STGB(PG8_SB(0, 1), cB + hstepB); PG8_STGA(PG8_SA(0, 0), 0, voA[0]); PG8_STGA(PG8_SA(0, 1), 0, voA[1]);
    if (wr == 1) PG8_BAR;
    PG8_WAIT_V(2); PG8_BAR;
    PG8_STGB(PG8_SB(1, 0), cB + kstep); PG8_STGA(PG8_SA(1, 0), kstep, voA[0]); PG8_STGB(PG8_SB(1, 1), cB + hstepB + kstep);
    PG8_WAIT_V(6); PG8_BAR;
    for (;;) {
        const bool has_next = S.next(ui + 1, nxt);
        const char* nB = has_next ? nxt.bb : cB;
        for (int t = 0; t < nt; t += 2) {
            const bool last = (t == nt - 2);
            const unsigned kb1 = (unsigned)(t + 1) * kstep;
            const unsigned kb2 = last ? 0u : (unsigned)(t + 2) * kstep, kb3 = kb2 + kstep;
            const char* b2 = last ? nB : cB + (size_t)(t + 2) * kstep; const char* b3 = b2 + kstep;
            PG8_LDB(B0, 0, 0); PG8_LDB(B1, 0, 1); PG8_SCHED; PG8_LDA(At, 0, 0); PG8_STGA(PG8_SA(1, 1), kb1, voA[1]);
            if (last && has_next) {
#pragma unroll
                for (int h = 0; h < 2; ++h)
#pragma unroll
                    for (int i = 0; i < 2; ++i) voA[h][i] = S.arow(nxt, h * HALF + RA[i]) * pitchA + cA2[i]; }
            PG8_WAIT_V(8); PG8_WAIT_L(0); PG8_BAR; PG8_MMA(0, 0, At, B0); PG8_MMA(0, 1, At, B1); PG8_BAR; PG8_SCHED;
            PG8_LDA(At, 0, 1); PG8_STGB(PG8_SB(0, 0), b2); PG8_STGB(PG8_SB(0, 1), b2 + hstepB); PG8_STGA(PG8_SA(0, 0), kb2, voA[0]);
            PG8_WAIT_V(8); PG8_WAIT_L(0); PG8_BAR; PG8_MMA(1, 0, At, B0); PG8_MMA(1, 1, At, B1); PG8_BAR; PG8_SCHED;
            PG8_LDB(B0, 1, 0); PG8_LDB(B1, 1, 1); PG8_SCHED; PG8_LDA(At, 1, 0); PG8_STGA(PG8_SA(0, 1), kb2, voA[1]);
            PG8_WAIT_V(8); PG8_WAIT_L(0); PG8_BAR; PG8_MMA(0, 0, At, B0); PG8_MMA(0, 1, At, B1); PG8_BAR; PG8_SCHED;
            PG8_LDA(At, 1, 1); PG8_STGB(PG8_SB(1, 0), b3); PG8_STGB(PG8_SB(1, 1), b3 + hstepB); PG8_STGA(PG8_SA(1, 0), kb3, voA[0]);
            PG8_WAIT_V(8); PG8_WAIT_L(0); PG8_BAR; PG8_MMA(1, 0, At, B0); PG8_MMA(1, 1, At, B1); PG8_BAR; PG8_SCHED;
        }
        if constexpr (ALIGN_EPI) { if (wr == 0) PG8_BAR; }
        E(acc, cur, wr, wc, fr, fq);
        if (!has_next) break;
#pragma unroll
        for (int a = 0; a < 2; ++a)
#pragma unroll
            for (int b = 0; b < 2; ++b)
#pragma unroll
                for (int m = 0; m < 4; ++m)
#pragma unroll
                    for (int n = 0; n < 2; ++n) acc[a][b][m][n] = (f32x4){0.f, 0.f, 0.f, 0.f};
        cur = nxt; cB = nB; ++ui;
        if constexpr (ALIGN_EPI) { if (wr == 1) PG8_BAR; }
    }
    PG8_WAIT_V(0);
    if constexpr (!ALIGN_EPI) { if (wr == 0) PG8_BAR; }
    PG8_BAR;
}
}

#define XB_TMO      128
#define XB_XCNT(j)  (256  + 64 * (j))
#define XB_XSUB(j)  (1280 + 64 * (j))
#define XB_XGEN(j)  (2304 + 64 * (j))
#define XB_TOP      3328
#define XB_TOPGEN   3392
#define XCD_BAR_WORDS 3456
#define XB_SPIN_CAP (1u << 18)
__device__ __forceinline__ unsigned xb_ld(unsigned* p)              { return __hip_atomic_load(p, __ATOMIC_RELAXED, __HIP_MEMORY_SCOPE_AGENT); }
__device__ __forceinline__ unsigned xb_add(unsigned* p, unsigned v) { return __hip_atomic_fetch_add(p, v, __ATOMIC_RELAXED, __HIP_MEMORY_SCOPE_AGENT); }
__device__ __forceinline__ unsigned xb_xcc_id() { return (unsigned)__builtin_amdgcn_s_getreg((3 << 11) | 20) & 0xFu; }
#define XB_SPIN(cond, bar) do { unsigned _sp = 0; while (cond) { __builtin_amdgcn_s_sleep(1); \
    if ((++_sp & 255u) == 0u) { if (xb_ld(&(bar)[XB_TMO])) break; if (_sp > XB_SPIN_CAP) { atomicAdd(&(bar)[XB_TMO], 1u); break; } } } } while (0)
struct XcdBarrier { unsigned* bar; unsigned x; volatile LAS unsigned* st; };
__device__ __forceinline__ XcdBarrier xcd_barrier_post(unsigned* bar, volatile LAS unsigned* st) {
    XcdBarrier b; b.bar = bar; b.x = xb_xcc_id(); b.st = st;
    if (threadIdx.x == 0) (void)xb_add(&bar[XB_XCNT(b.x)], 1u);
    return b;
}
__device__ __forceinline__ void xcd_barrier_complete(unsigned* bar, unsigned x, unsigned& nloc, unsigned& nx) {
    const unsigned G = gridDim.x * gridDim.y * gridDim.z;
    unsigned sum, cnt, mine, sp = 0u;
    for (;;) {
        sum = 0u; cnt = 0u; mine = 0u;
#pragma unroll
        for (unsigned j = 0; j < 16; ++j) { const unsigned c = xb_ld(&bar[XB_XCNT(j)]); sum += c; cnt += (c > 0u) ? 1u : 0u; mine = (j == x) ? c : mine; }
        if (sum == G) break;
        __builtin_amdgcn_s_sleep(1);
        if ((++sp & 255u) == 0u) { if (xb_ld(&bar[XB_TMO])) break; if (sp > XB_SPIN_CAP) { atomicAdd(&bar[XB_TMO], 1u); break; } }
    }
    nloc = mine > 0u ? mine : 1u; nx = cnt > 0u ? cnt : 1u;
}
__device__ __forceinline__ void xcd_barrier(const XcdBarrier& b, const int tid) {
    asm volatile("s_waitcnt vmcnt(0)" ::: "memory");
    __syncthreads();
    if (tid == 0) {
        unsigned* bar = b.bar; const unsigned bx_ = xb_xcc_id();
        __builtin_amdgcn_s_waitcnt(0);
        unsigned nloc = b.st[0], nx = b.st[1];
        if (nloc == 0u) { xcd_barrier_complete(bar, bx_, nloc, nx); b.st[0] = nloc; b.st[1] = nx; }
        const unsigned old = xb_add(&bar[XB_XSUB(bx_)], 1u);
        const unsigned gen = old / nloc;
        if (old + 1u == (gen + 1u) * nloc) {
            __builtin_amdgcn_fence(__ATOMIC_RELEASE, "agent");
            asm volatile("s_waitcnt vmcnt(0)" ::: "memory");
            const unsigned og = xb_add(&bar[XB_TOP], 1u);
            const unsigned tg = og / nx;
            if (og + 1u == (tg + 1u) * nx) xb_add(&bar[XB_TOPGEN], 1u);
            else XB_SPIN(xb_ld(&bar[XB_TOPGEN]) == tg, bar);
            __builtin_amdgcn_fence(__ATOMIC_ACQUIRE, "agent");
            xb_add(&bar[XB_XGEN(bx_)], 1u);
            asm volatile("s_waitcnt vmcnt(0)" ::: "memory");
        } else {
            XB_SPIN(xb_ld(&bar[XB_XGEN(bx_)]) == gen, bar);
            __builtin_amdgcn_fence(__ATOMIC_ACQUIRE, "agent");
            asm volatile("s_waitcnt vmcnt(0)" ::: "memory");
        }
    }
    __syncthreads();
}

__device__ __forceinline__ const void* launder_ptr(const void* p) {
    unsigned lo = (unsigned)(uintptr_t)p, hi = (unsigned)((uintptr_t)p >> 32);
    asm volatile("" : "+v"(lo), "+v"(hi));
    lo = __builtin_amdgcn_readfirstlane(lo); hi = __builtin_amdgcn_readfirstlane(hi);
    return (const void*)(((uintptr_t)hi << 32) | (uintptr_t)lo);
}
struct Args { const float* in[26]; float* out; unsigned char* ws; };

__device__ __forceinline__ const void* karg_ptr(int idx) {
    const unsigned long long ka = (unsigned long long)__builtin_amdgcn_kernarg_segment_ptr();
    unsigned long long v; asm volatile("s_load_dwordx2 %0, %1, %2\n\ts_waitcnt lgkmcnt(0)" : "=s"(v) : "s"(ka), "s"(idx * 8) : "memory");
    return (const void*)(GAS const void*)(uintptr_t)v;
}
struct Frame {
    LAS unsigned char* lds; char* shm;
    int tid, lane, wave, vcu, G;
    float* out; unsigned char* ws; int wave_s;
    __device__ __forceinline__ const float* inp(int i) const { return (const float*)karg_ptr(i); }
};
__device__ __forceinline__ void frame_refresh(Frame& F) {
    asm volatile("" ::: "memory");
    int t_; asm volatile("v_mbcnt_lo_u32_b32 %0, -1, 0\n\tv_mbcnt_hi_u32_b32 %0, -1, %0" : "=v"(t_)); t_ |= (F.wave_s << 6);
    F.tid = t_; F.lane = t_ & 63; F.wave = __builtin_amdgcn_readfirstlane(t_ >> 6);
    F.out = (float*)karg_ptr(26); F.ws = (unsigned char*)karg_ptr(27);
}
#define F_X 0
#define F_C 1
#define F_WMOD 2
#define F_BMOD 3
#define F_NMIX 4
#define F_NFFN 5
#define F_WIN 6
#define F_WOUT 7
#define F_OGAIN 8
#define F_SINKS 9
#define F_CONVW 10
#define F_CONVB 11
#define F_LWA 12
#define F_LBA 13
#define F_LWX 14
#define F_LBX 15
#define F_LAM 16
#define F_FOXB 17
#define F_WRG 18
#define F_BRG 19
#define F_WRE 20
#define F_BRE 21
#define F_WGATE 22
#define F_WUP 23
#define F_WDOWN 24
#define F_NFIN 25

struct EpiProj {
    static constexpr bool PERM = true;
    bf16_t* O; unsigned* km;
    __device__ __forceinline__ void operator()(const f32x4 (&acc)[2][2][4][2], const pg8::GUnit& u, int wr, int wc, int fr, int fq) const {
        const int row0 = u.e0 * 256 + wr * 64 + fr, pn = u.e1;
        const float sc = (pn == 0 || pn == 1 || pn == 5) ? C2 : 1.f;
        const int col0 = pn * 256 + wc * 32 + 8 * fq;
#pragma unroll
        for (int ai = 0; ai < 2; ++ai)
#pragma unroll
            for (int m = 0; m < 4; ++m) { bf16_t* rowp = O + (size_t)(row0 + ai * 128 + m * 16) * NPROJ + col0;
#pragma unroll
                for (int bj = 0; bj < 2; ++bj) { const f32x4 v0 = acc[ai][bj][m][0] * sc, v1 = acc[ai][bj][m][1] * sc;
                    u32x4 w; w.x = cvtpk(v0[0], v0[1]); w.y = cvtpk(v0[2], v0[3]); w.z = cvtpk(v1[0], v1[1]); w.w = cvtpk(v1[2], v1[3]);
                    *(u32x4*)(rowp + bj * 128) = w; } }
        if (pn == 6) {
            const int b = u.e0 >> 5;
#pragma unroll
            for (int bj = 0; bj < 2; ++bj) { float mx = 0.f;
#pragma unroll
                for (int ai = 0; ai < 2; ++ai)
#pragma unroll
                    for (int m = 0; m < 4; ++m) { const f32x4 v0 = acc[ai][bj][m][0], v1 = acc[ai][bj][m][1];
                        mx = __builtin_fmaxf(mx, (v0[0] * v0[0] + v0[1] * v0[1]) + (v0[2] * v0[2] + v0[3] * v0[3]) + (v1[0] * v1[0] + v1[1] * v1[1]) + (v1[2] * v1[2] + v1[3] * v1[3])); }
                mx = __builtin_fmaxf(mx, shx<1>(mx)); mx = __builtin_fmaxf(mx, shx<2>(mx)); mx = __builtin_fmaxf(mx, shx<4>(mx)); mx = __builtin_fmaxf(mx, shx<8>(mx));
                if (fr == 0) atomicMax(km + ((b * 4 + 2 * bj + (wc >> 1)) * 8 + 4 * (wc & 1) + fq), __float_as_uint(mx)); }
        }
    }
};
struct EpiP {
    static constexpr bool PERM = true;
    bf16_t* P;
    __device__ __forceinline__ void operator()(const f32x4 (&acc)[2][2][4][2], const pg8::GUnit& u, int wr, int wc, int fr, int fq) const {
        const int row0 = u.e0 * 256 + wr * 64 + fr, col0 = u.e1 * 256 + wc * 32 + 8 * fq;
#pragma unroll
        for (int ai = 0; ai < 2; ++ai)
#pragma unroll
            for (int m = 0; m < 4; ++m) { bf16_t* rowp = P + (size_t)(row0 + ai * 128 + m * 16) * D + col0;
#pragma unroll
                for (int bj = 0; bj < 2; ++bj) { const f32x4 v0 = acc[ai][bj][m][0], v1 = acc[ai][bj][m][1];
                    u32x4 w; w.x = cvtpk(v0[0], v0[1]); w.y = cvtpk(v0[2], v0[3]); w.z = cvtpk(v1[0], v1[1]); w.w = cvtpk(v1[2], v1[3]);
                    *(u32x4*)(rowp + bj * 128) = w; } }
    }
};
struct EpiUp {
    static constexpr bool PERM = true;
    bf16_t* HID; const LEntry* list; const unsigned* cnt;
    __device__ __forceinline__ void operator()(const f32x4 (&acc)[2][2][4][2], const pg8::GUnit& u, int wr, int wc, int fr, int fq) const {
        const int pn = u.e1, slot = pn >> 1, pnl = pn & 1, cls = u.e2;
        const unsigned n = __hip_atomic_load(cnt + 64 * cls, __ATOMIC_RELAXED, __HIP_MEMORY_SCOPE_AGENT);
        const int colh = 256 * slot + 128 * pnl + wc * 32 + 8 * fq;
        float wrow[8];
#pragma unroll
        for (int k = 0; k < 8; ++k) { const int r = (k >> 2) * 128 + wr * 64 + (k & 3) * 16 + fr; const unsigned pos = (unsigned)(u.e3 + r);
            const LEntry* e = list + (size_t)cls * LCAP + (pos < n ? pos : 0u); const float w = slot ? e->w1 : e->w0; wrow[k] = pos < n ? w : 0.f; }
#pragma unroll
        for (int ai = 0; ai < 2; ++ai)
#pragma unroll
            for (int m = 0; m < 4; ++m) { const int r = ai * 128 + wr * 64 + m * 16 + fr; const float w = wrow[ai * 4 + m];
                float h[8];
#pragma unroll
                for (int nn = 0; nn < 2; ++nn)
#pragma unroll
                    for (int i = 0; i < 4; ++i) { const float g = acc[ai][0][m][nn][i], up = acc[ai][1][m][nn][i]; h[nn * 4 + i] = g * sigmoidf_(g) * up * w; }
                u32x4 o; o.x = cvtpk(h[0], h[1]); o.y = cvtpk(h[2], h[3]); o.z = cvtpk(h[4], h[5]); o.w = cvtpk(h[6], h[7]);
                *(u32x4*)(HID + (size_t)(u.e0 * 256 + r) * 512 + colh) = o; }
    }
};
struct EpiDown {
    static constexpr bool PERM = true;
    bf16_t* M; const LEntry* list; const unsigned* cnt;
    __device__ __forceinline__ void operator()(const f32x4 (&acc)[2][2][4][2], const pg8::GUnit& u, int wr, int wc, int fr, int fq) const {
        const int cls = u.e2, col0 = u.e1 * 256 + wc * 32 + 8 * fq;
        const unsigned n = __hip_atomic_load(cnt + 64 * cls, __ATOMIC_RELAXED, __HIP_MEMORY_SCOPE_AGENT);
        int tok[8];
#pragma unroll
        for (int k = 0; k < 8; ++k) { const int r = (k >> 2) * 128 + wr * 64 + (k & 3) * 16 + fr; const unsigned pos = (unsigned)(u.e3 + r);
            const int t = list[(size_t)cls * LCAP + (pos < n ? pos : 0u)].tok; tok[k] = pos < n ? t : -1; }
#pragma unroll
        for (int k = 0; k < 8; ++k) { const int ai = k >> 2, m = k & 3;
            if (tok[k] >= 0) { bf16_t* rowp = M + (size_t)tok[k] * D + col0;
#pragma unroll
                for (int bj = 0; bj < 2; ++bj) { const f32x4 v0 = acc[ai][bj][m][0], v1 = acc[ai][bj][m][1];
                    u32x4 w; w.x = cvtpk(v0[0], v0[1]); w.y = cvtpk(v0[2], v0[3]); w.z = cvtpk(v1[0], v1[1]); w.w = cvtpk(v1[2], v1[3]);
                    *(u32x4*)(rowp + bj * 128) = w; } } }
    }
};

__device__ __forceinline__ void pair_of(int p, int& lo, int& hi) { lo = p < 3 ? 0 : (p < 5 ? 1 : 2); hi = p < 3 ? p + 1 : (p < 5 ? p - 1 : 3); }
struct MoeUpOrder {
    int nunits, G, c; const LAS int* tt; const char* WGU; const LEntry* list; const unsigned* cnt;
    __device__ __forceinline__ bool next(int i, pg8::GUnit& u) const {
        const long L = (long)i * G + c; if (L >= (long)nunits * UPREP) return false;
        const int wgid = pg8::xcd_remap((int)(L % nunits), nunits); const int tile = wgid >> 2, pn = wgid & 3; const int e = tt[tile];
        const int cls = e & 255; u.e0 = tile; u.e1 = pn; u.e2 = cls; u.e3 = e >> 8; u.a0 = 0;
        int lo, hi; pair_of(cls % 6, lo, hi); const int ex = (cls / 6) * 4 + ((pn >> 1) ? hi : lo);
        u.bb = WGU + ((size_t)ex * 512 + (size_t)(pn & 1) * 256) * 2048; return true;
    }
    __device__ __forceinline__ unsigned arow(const pg8::GUnit& u, int r) const {
        const unsigned n = __hip_atomic_load(cnt + 64 * u.e2, __ATOMIC_RELAXED, __HIP_MEMORY_SCOPE_AGENT); const unsigned pos = (unsigned)(u.e3 + r);
        return (unsigned)list[(size_t)u.e2 * LCAP + (pos < n ? pos : 0u)].tok;
    }
};
struct MoeDownOrder {
    int nunits, G, c; const LAS int* tt; const char* WDP;
    __device__ __forceinline__ bool next(int i, pg8::GUnit& u) const {
        const long L = (long)i * G + c; if (L >= nunits) return false;
        const int wgid = pg8::xcd_remap((int)L, nunits); const int tile = wgid >> 2, pn = wgid & 3; const int e = tt[tile];
        const int cls = e & 255; u.e0 = tile; u.e1 = pn; u.e2 = cls; u.e3 = e >> 8; u.a0 = tile * 256;
        u.bb = WDP + ((size_t)cls * 1024 + (size_t)pn * 256) * 1024; return true;
    }
    __device__ __forceinline__ unsigned arow(const pg8::GUnit& u, int r) const { return (unsigned)(u.a0 + r); }
};

namespace att {
constexpr int DM = NPROJ;
constexpr int SLOTB = 8192;
constexpr int LDS_K = 0, LDS_V = 3 * SLOTB, LDS_WS = 6 * SLOTB, LDS_OST = LDS_WS + 2048, LDS_BIAS = LDS_OST + 8 * 4096, LDS_BLK = LDS_BIAS + 32768, LDS_MM = LDS_BLK + 256  , LDS_QM = LDS_MM + 96  , LDS_END = LDS_QM + 32;
static_assert(LDS_END <= RING_BYTES, "attention LDS");
typedef LAS const char* lds_cptr;
__device__ __forceinline__ int crow(int r, int hi) { return (r & 3) + 8 * (r >> 2) + 4 * hi; }
__device__ __forceinline__ void glds16(const void* gsrc, unsigned lds_dst) { unsigned keep;
    asm volatile("s_mov_b32 %0, m0\n\ts_mov_b32 m0, %2\n\ts_nop 0\n\tglobal_load_lds_dwordx4 %1, off\n\ts_mov_b32 m0, %0" : "=&s"(keep) : "v"(gsrc), "s"(lds_dst) : "memory"); }
__device__ __forceinline__ float max3f(float a, float b, float c) { return __builtin_fmaxf(__builtin_fmaxf(a, b), c); }
#define ATT_WAIT_BAR(N) asm volatile("s_waitcnt vmcnt(" #N ") lgkmcnt(0)\n\ts_barrier" ::: "memory")
typedef short v4i16_t __attribute__((ext_vector_type(4)));
__device__ __forceinline__ s16x4 vtr(lds_cptr p) { return __builtin_bit_cast(s16x4, __builtin_amdgcn_ds_read_tr16_b64_v4i16((LAS v4i16_t*)p)); }
__device__ __forceinline__ float rowmax(const f32x16& p0, const f32x16& p1) {
    float a = max3f(p0[0], p0[1], p1[0]), b = max3f(p0[2], p0[3], p1[1]); a = max3f(a, p1[2], p1[3]);
#pragma unroll
    for (int r = 4; r < 16; r += 4) { a = max3f(a, p0[r], p0[r + 1]); b = max3f(b, p0[r + 2], p0[r + 3]); a = max3f(a, p1[r], p1[r + 1]); b = max3f(b, p1[r + 2], p1[r + 3]); }
    const float m = __builtin_fmaxf(a, b);
    auto rr = __builtin_amdgcn_permlane32_swap(__float_as_uint(m), __float_as_uint(m), false, false);
    return __builtin_fmaxf(__uint_as_float(rr[0]), __uint_as_float(rr[1]));
}
__device__ __forceinline__ void pv(f32x16* o, int vb, bf16x8 pa0, bf16x8 pa1, bf16x8 pa2, bf16x8 pa3) {
#pragma unroll
    for (int d0 = 0; d0 < 2; ++d0) { s16x4 lo[4], hi[4];
#pragma unroll
        for (int ks = 0; ks < 4; ++ks) {
            asm volatile("ds_read_b64_tr_b16 %0,%1 offset:%c2" : "=&v"(lo[ks]) : "v"(vb), "i"(d0 * 4096 + ks * 1024) : "memory");
            asm volatile("ds_read_b64_tr_b16 %0,%1 offset:%c2" : "=&v"(hi[ks]) : "v"(vb), "i"(d0 * 4096 + ks * 1024 + 512) : "memory"); }
        asm volatile("s_waitcnt lgkmcnt(0)" ::: "memory"); __builtin_amdgcn_sched_barrier(0);
#define ATT_PK(k) (bf16x8){lo[k][0], lo[k][1], lo[k][2], lo[k][3], hi[k][0], hi[k][1], hi[k][2], hi[k][3]}
        o[d0] = __builtin_amdgcn_mfma_f32_32x32x16_bf16(pa0, ATT_PK(0), o[d0], 0, 0, 0);
        o[d0] = __builtin_amdgcn_mfma_f32_32x32x16_bf16(pa1, ATT_PK(1), o[d0], 0, 0, 0);
        o[d0] = __builtin_amdgcn_mfma_f32_32x32x16_bf16(pa2, ATT_PK(2), o[d0], 0, 0, 0);
        o[d0] = __builtin_amdgcn_mfma_f32_32x32x16_bf16(pa3, ATT_PK(3), o[d0], 0, 0, 0);
#undef ATT_PK
    }
}
template <int MODE>
__device__ __forceinline__ void attn_core(char* shm, const bf16_t* Qw, const bf16_t* Kh, const bf16_t* Vh, bf16_t* Ow, int q0, const int qw0, int t_lo, int t_hi, const int bias_off, float sinkl2, float slope2, const int tid, const float kn2 = 0.f) {
    const int lane = tid & 63, r32 = lane & 31, hi = lane >> 5; const int wid = __builtin_amdgcn_readfirstlane(tid >> 6);
    const unsigned lds0 = (unsigned)(uintptr_t)shm;
    float* wsf = (float*)(shm + LDS_WS) + wid * 64;
    const lds_cptr shm3 = (lds_cptr)shm;
    const bf16_t* ksrc = Kh + (long)lane * DM + wid * 8;
    const bf16_t* vsrc = Vh + (long)(16 * (wid & 3) + (lane >> 2)) * DM + (wid >> 2) * 32 + (lane & 3) * 8;
    const unsigned kdst = lds0 + LDS_K + wid * 1024, vdst = lds0 + LDS_V + wid * 1024;
#define ATT_DMA_K(t, slot) glds16(ksrc + (long)(t) * 64 * DM, (unsigned)__builtin_amdgcn_readfirstlane(kdst + (slot)))
#define ATT_DMA_V(t, slot) glds16(vsrc + (long)(t) * 64 * DM, (unsigned)__builtin_amdgcn_readfirstlane(vdst + (slot)))
    const int vb0 = (int)(lds0 + LDS_V) + ((lane >> 4) & 1) * 32 + (lane & 3) * 8 + (4 * hi + ((lane & 15) >> 2)) * 64;
    const int n = t_hi - t_lo + 1;
    const int w_hi = (qw0 + 31) >> 6;
    const int w_lo = (MODE == 1) ? ((qw0 - 127 > 0 ? qw0 - 127 : 0) >> 6) : t_lo;
    bf16x8 qr[4];
#pragma unroll
    for (int d0 = 0; d0 < 4; ++d0) qr[d0] = *reinterpret_cast<const bf16x8*>(&Qw[(long)r32 * DM + d0 * 16 + hi * 8]);
    ATT_DMA_K(t_hi, 0); ATT_DMA_V(t_hi, 0);
    if (n > 1) { ATT_DMA_K(t_hi - 1, SLOTB); ATT_DMA_V(t_hi - 1, SLOTB); }
    LAS float* mmp = (LAS float*)(shm3 + LDS_MM); LAS float* qmp = (LAS float*)(shm3 + LDS_QM);
    if (MODE == 0) {
        float qs = 0.f;
#pragma unroll
        for (int d0 = 0; d0 < 4; ++d0)
#pragma unroll
            for (int e = 0; e < 8; ++e) { const float v = bf2f((bf16_t)qr[d0][e]); qs += v * v; }
        { auto rr = __builtin_amdgcn_permlane32_swap(__float_as_uint(qs), __float_as_uint(qs), false, false); qs = __uint_as_float(rr[0]) + __uint_as_float(rr[1]); }
        qs = __builtin_fmaxf(qs, shx<1>(qs)); qs = __builtin_fmaxf(qs, shx<2>(qs)); qs = __builtin_fmaxf(qs, shx<4>(qs)); qs = __builtin_fmaxf(qs, shx<8>(qs)); qs = __builtin_fmaxf(qs, shx<16>(qs));
        if (lane == 0) { qmp[wid] = qs; mmp[wid] = -1e30f; mmp[8 + wid] = -1e30f; mmp[16 + wid] = -1e30f; }
    }
    float bqk = 0.f;
    float mhat = 0.f, l_reg = 0.f; f32x16 o[2]; o[0] = f32x16{}; o[1] = f32x16{}; bool first = true;
    float ex[32]; bool pend = false;
#pragma unroll
    for (int r = 0; r < 32; ++r) ex[r] = 0.f;
    const int q = qw0 + r32;
    const int grp = wid >> 2;
#define ATT_LBAR() asm volatile("s_waitcnt lgkmcnt(0)\n\ts_barrier" ::: "memory")
#define ATT_ISSUE(i2) do { if ((i2) < n) { const int sl_ = ((i2) % 3) * SLOTB; ATT_DMA_K(t_hi - (i2), sl_); ATT_DMA_V(t_hi - (i2), sl_); } } while (0)
    if (grp == 1) { if (n > 1) { ATT_WAIT_BAR(2); } else { ATT_WAIT_BAR(0); } }
#pragma unroll 1
    for (int ti = 0; ti < n; ++ti) {
        const int t = t_hi - ti, sl_cur = (ti % 3) * SLOTB;
        const bool need = (t >= w_lo && t <= w_hi);
        if (MODE == 0 && ti >= 2 && (ti & 3) == 2) {
            if (ti == 2) { const f32x4 qa = *(const LAS f32x4*)qmp, qb_ = *(const LAS f32x4*)(qmp + 4);
                const float qn2 = __builtin_fmaxf(__builtin_fmaxf(__builtin_fmaxf(qa[0], qa[1]), __builtin_fmaxf(qa[2], qa[3])), __builtin_fmaxf(__builtin_fmaxf(qb_[0], qb_[1]), __builtin_fmaxf(qb_[2], qb_[3])));
                bqk = __int_as_float(__builtin_amdgcn_readfirstlane(__float_as_int(sqrtf(qn2 * kn2) * 1.02f + 1.0f))); }
            const LAS float* mp = mmp + ((ti - 2) % 3) * 8; const f32x4 ma = *(const LAS f32x4*)mp, mb = *(const LAS f32x4*)(mp + 4);
            const float mm = __builtin_fminf(__builtin_fminf(__builtin_fminf(ma[0], ma[1]), __builtin_fminf(ma[2], ma[3])), __builtin_fminf(__builtin_fminf(mb[0], mb[1]), __builtin_fminf(mb[2], mb[3])));
            const float bmax = *((const LAS float*)(shm3 + LDS_BIAS) + (t - t_lo) * 64 + 63);
            if (__builtin_amdgcn_readfirstlane((int)(bqk + bmax < mm - 160.f))) break;
        }
        if (grp == 0) { if (ti + 1 < n) { ATT_WAIT_BAR(2); } else { ATT_WAIT_BAR(0); } }
        else { ATT_LBAR(); ATT_ISSUE(ti + 2); }
        f32x16 p0, p1;
        if (need) {
            { const LAS float* bp = (const LAS float*)(shm3 + LDS_BIAS) + bias_off + (t - t_lo) * 64 + 4 * hi;
#pragma unroll
              for (int jj = 0; jj < 4; ++jj) { const f32x4 a = *(const LAS f32x4*)(bp + 8 * jj), b = *(const LAS f32x4*)(bp + 32 + 8 * jj);
                  p0[4 * jj] = a[0] - mhat; p0[4 * jj + 1] = a[1] - mhat; p0[4 * jj + 2] = a[2] - mhat; p0[4 * jj + 3] = a[3] - mhat;
                  p1[4 * jj] = b[0] - mhat; p1[4 * jj + 1] = b[1] - mhat; p1[4 * jj + 2] = b[2] - mhat; p1[4 * jj + 3] = b[3] - mhat; } }
            { const lds_cptr kb = shm3 + LDS_K + sl_cur + hi * 1024 + r32 * 16;
              bf16x8 kf0[4], kf1[4];
#pragma unroll
              for (int d0 = 0; d0 < 4; ++d0) { kf0[d0] = *(const LAS bf16x8*)(kb + d0 * 2048); kf1[d0] = *(const LAS bf16x8*)(kb + d0 * 2048 + 512); }
              float sacc = 0.f;
#define ATT_QS4(B) do { sacc += ex[B]; sacc += ex[B + 1]; sacc += ex[B + 2]; sacc += ex[B + 3]; asm volatile("" : "+v"(sacc)); __builtin_amdgcn_sched_barrier(0); } while (0)
              p0 = __builtin_amdgcn_mfma_f32_32x32x16_bf16(kf0[0], qr[0], p0, 0, 0, 0); ATT_QS4(0);
              p1 = __builtin_amdgcn_mfma_f32_32x32x16_bf16(kf1[0], qr[0], p1, 0, 0, 0); ATT_QS4(4);
              p0 = __builtin_amdgcn_mfma_f32_32x32x16_bf16(kf0[1], qr[1], p0, 0, 0, 0); ATT_QS4(8);
              p1 = __builtin_amdgcn_mfma_f32_32x32x16_bf16(kf1[1], qr[1], p1, 0, 0, 0); ATT_QS4(12);
              p0 = __builtin_amdgcn_mfma_f32_32x32x16_bf16(kf0[2], qr[2], p0, 0, 0, 0); ATT_QS4(16);
              p1 = __builtin_amdgcn_mfma_f32_32x32x16_bf16(kf1[2], qr[2], p1, 0, 0, 0); ATT_QS4(20);
              p0 = __builtin_amdgcn_mfma_f32_32x32x16_bf16(kf0[3], qr[3], p0, 0, 0, 0); ATT_QS4(24);
              p1 = __builtin_amdgcn_mfma_f32_32x32x16_bf16(kf1[3], qr[3], p1, 0, 0, 0); ATT_QS4(28);
#undef ATT_QS4
              if (pend) { l_reg += sacc; pend = false; } }
            const float NEG = -__builtin_inff();
            if (MODE == 0) { if (t == w_hi) { const int kb_ = 64 * t + 4 * hi;
#pragma unroll
                for (int r = 0; r < 16; ++r) { const int kv = kb_ + (r & 3) + 8 * (r >> 2); if (kv > q) p0[r] = NEG; if (kv + 32 > q) p1[r] = NEG; } } }
            else { const int kb_ = 64 * t + 4 * hi;
#pragma unroll
                for (int r = 0; r < 16; ++r) { const int kv = kb_ + (r & 3) + 8 * (r >> 2); if ((unsigned)(q - kv) >= 128u) p0[r] = NEG; if ((unsigned)(q - kv - 32) >= 128u) p1[r] = NEG; } }
            const float rm = rowmax(p0, p1);
            if (first || __any(rm > 8.f)) {
                const float dl = first ? __builtin_fmaxf(rm, -1e30f) : __builtin_fmaxf(rm, 0.f); const float f = first ? 1.f : __builtin_amdgcn_exp2f(-dl);
                first = false; mhat += dl; l_reg *= f; if (hi == 0) wsf[r32] = f;
#pragma unroll
                for (int r = 0; r < 16; ++r) { p0[r] -= dl; p1[r] -= dl; }
                asm volatile("s_waitcnt lgkmcnt(0)" ::: "memory");
#pragma unroll
                for (int jj = 0; jj < 4; ++jj) { const f32x4 fv = *(const f32x4*)(wsf + 8 * jj + 4 * hi);
#pragma unroll
                    for (int i2 = 0; i2 < 4; ++i2) { o[0][4 * jj + i2] *= fv[i2]; o[1][4 * jj + i2] *= fv[i2]; } }
            }
            if (MODE == 0 && (ti & 3) == 0) {
                float mn = mhat; mn = __builtin_fminf(mn, shx<1>(mn)); mn = __builtin_fminf(mn, shx<2>(mn)); mn = __builtin_fminf(mn, shx<4>(mn)); mn = __builtin_fminf(mn, shx<8>(mn)); mn = __builtin_fminf(mn, shx<16>(mn));
                if (lane == 0) mmp[(ti % 3) * 8 + wid] = mn; }
        }
        if (grp == 0) { ATT_LBAR(); ATT_ISSUE(ti + 2); }
        else { if (ti + 1 < n) { if (ti + 2 < n) { ATT_WAIT_BAR(2); } else { ATT_WAIT_BAR(0); } } else { ATT_LBAR(); } }
        if (need) {
            const lds_cptr vp = shm3 + LDS_V + sl_cur + ((lane >> 4) & 1) * 32 + (lane & 3) * 8 + (4 * hi + ((lane & 15) >> 2)) * 64;
#define ATT_SB() __builtin_amdgcn_sched_barrier(0)
#define ATT_PIN(x) asm volatile("" : "+v"(x))
#define ATT_VRD(i) do { vlo[i] = vtr(vp + (((i) >> 2) * 4096 + ((i) & 3) * 1024)); vhi[i] = vtr(vp + (((i) >> 2) * 4096 + ((i) & 3) * 1024 + 512)); } while (0)
#define ATT_VF(i) (bf16x8){vlo[i][0], vlo[i][1], vlo[i][2], vlo[i][3], vhi[i][0], vhi[i][1], vhi[i][2], vhi[i][3]}
#define ATT_PIN4(B) asm volatile("" : "+v"(ex[B]), "+v"(ex[B + 1]), "+v"(ex[B + 2]), "+v"(ex[B + 3]))
#define ATT_EX4(P, PB, B) do { ex[B] = __builtin_amdgcn_exp2f(P[PB]); ex[B + 1] = __builtin_amdgcn_exp2f(P[PB + 1]); ex[B + 2] = __builtin_amdgcn_exp2f(P[PB + 2]); ex[B + 3] = __builtin_amdgcn_exp2f(P[PB + 3]); ATT_PIN4(B); } while (0)
#define ATT_PK4(B) (u32x4){cvtpk(ex[B], ex[B + 1]), cvtpk(ex[B + 2], ex[B + 3]), cvtpk(ex[B + 4], ex[B + 5]), cvtpk(ex[B + 6], ex[B + 7])}
#define ATT_SUM4(B) do { sacc += ex[B]; sacc += ex[B + 1]; sacc += ex[B + 2]; sacc += ex[B + 3]; ATT_PIN(sacc); } while (0)
            s16x4 vlo[8], vhi[8]; u32x4 pw0, pw1, pw2, pw3;
            ATT_VRD(0); ATT_VRD(4);
            ATT_EX4(p0, 0, 0); ATT_EX4(p0, 4, 4); pw0 = ATT_PK4(0); ATT_PIN(pw0); ATT_SB();
            o[0] = __builtin_amdgcn_mfma_f32_32x32x16_bf16(__builtin_bit_cast(bf16x8, pw0), ATT_VF(0), o[0], 0, 0, 0); ATT_VRD(1); ATT_EX4(p0, 8, 8); ATT_SB();
            o[1] = __builtin_amdgcn_mfma_f32_32x32x16_bf16(__builtin_bit_cast(bf16x8, pw0), ATT_VF(4), o[1], 0, 0, 0); ATT_VRD(5); ATT_EX4(p0, 12, 12); pw1 = ATT_PK4(8); ATT_PIN(pw1); ATT_SB();
            o[0] = __builtin_amdgcn_mfma_f32_32x32x16_bf16(__builtin_bit_cast(bf16x8, pw1), ATT_VF(1), o[0], 0, 0, 0); ATT_VRD(2); ATT_EX4(p1, 0, 16); ATT_SB();
            o[1] = __builtin_amdgcn_mfma_f32_32x32x16_bf16(__builtin_bit_cast(bf16x8, pw1), ATT_VF(5), o[1], 0, 0, 0); ATT_VRD(6); ATT_EX4(p1, 4, 20); pw2 = ATT_PK4(16); ATT_PIN(pw2); ATT_SB();
            o[0] = __builtin_amdgcn_mfma_f32_32x32x16_bf16(__builtin_bit_cast(bf16x8, pw2), ATT_VF(2), o[0], 0, 0, 0); ATT_VRD(3); ATT_EX4(p1, 8, 24); ATT_SB();
            o[1] = __builtin_amdgcn_mfma_f32_32x32x16_bf16(__builtin_bit_cast(bf16x8, pw2), ATT_VF(6), o[1], 0, 0, 0); ATT_VRD(7); ATT_EX4(p1, 12, 28); pw3 = ATT_PK4(24); ATT_PIN(pw3); ATT_SB();
            o[0] = __builtin_amdgcn_mfma_f32_32x32x16_bf16(__builtin_bit_cast(bf16x8, pw3), ATT_VF(3), o[0], 0, 0, 0); ATT_SB();
            o[1] = __builtin_amdgcn_mfma_f32_32x32x16_bf16(__builtin_bit_cast(bf16x8, pw3), ATT_VF(7), o[1], 0, 0, 0); ATT_SB();
            pend = true;
#undef ATT_SB
#undef ATT_PIN
#undef ATT_VRD
#undef ATT_VF
#undef ATT_EX4
#undef ATT_PK4
#undef ATT_SUM4
#undef ATT_PIN4
        }
    }
    if (pend) { float sacc = 0.f;
#pragma unroll
        for (int r = 0; r < 32; ++r) sacc += ex[r];
        l_reg += sacc; }
    if (grp == 0) { ATT_LBAR(); }
#undef ATT_LBAR
#undef ATT_ISSUE
    { auto rr = __builtin_amdgcn_permlane32_swap(__float_as_uint(l_reg), __float_as_uint(l_reg), false, false); l_reg = __uint_as_float(rr[0]) + __uint_as_float(rr[1]); }
    if (MODE == 1) l_reg += __builtin_amdgcn_exp2f(sinkl2 + slope2 * (float)(qw0 - q0 + r32) - mhat);
    if (hi == 0) wsf[32 + r32] = l_reg;
    asm volatile("s_waitcnt lgkmcnt(0)" ::: "memory");
    float rli[16];
#pragma unroll
    for (int r = 0; r < 16; ++r) rli[r] = __builtin_amdgcn_rcpf(wsf[32 + crow(r, hi)]);
    { bf16_t* stg = (bf16_t*)(shm + LDS_OST) + wid * 2048;
#pragma unroll
      for (int r = 0; r < 16; ++r) { const int orow = crow(r, hi);
#pragma unroll
          for (int d0 = 0; d0 < 2; ++d0) stg[orow * 64 + d0 * 32 + r32] = (bf16_t)(cvtpk(o[d0][r] * rli[r], 0.f) & 0xffffu); }
      asm volatile("s_waitcnt lgkmcnt(0)" ::: "memory");
#pragma unroll
      for (int i = 0; i < 4; ++i) { const int row = i * 8 + (lane >> 3), ch = lane & 7; const u32x4 v = *(const u32x4*)(stg + row * 64 + ch * 8); *(u32x4*)(Ow + (long)row * D + ch * 8) = v; } }
    asm volatile("s_waitcnt vmcnt(0) lgkmcnt(0)\n\ts_barrier" ::: "memory");
#undef ATT_DMA_K
#undef ATT_DMA_V
}

__device__ __forceinline__ void fox_core(char* shm, const bf16_t* Qw, const bf16_t* Kh, const bf16_t* Vh, bf16_t* Ow, const int n  , const int tid, const float kn2) {
    const int lane = tid & 63, r32 = lane & 31, hi = lane >> 5; const int wid = __builtin_amdgcn_readfirstlane(tid >> 6);
    const unsigned lds0 = (unsigned)(uintptr_t)shm;
    float* wsf = (float*)(shm + LDS_WS) + wid * 64;
    const lds_cptr shm3 = (lds_cptr)shm;
    const int t_hi = n - 1;
#define FX_TILE(j) ((j) < 4 ? (t_hi - 3 + (j)) : (t_hi - (j)))
    const bf16_t* ksrc = Kh + (long)lane * DM + wid * 8;
    const bf16_t* vsrc = Vh + (long)(16 * (wid & 3) + (lane >> 2)) * DM + (wid >> 2) * 32 + (lane & 3) * 8;
    const unsigned kdst = lds0 + LDS_K + wid * 1024, vdst = lds0 + LDS_V + wid * 1024;
#define FX_DMA_K(j, slot) do { const long t_ = FX_TILE(j); glds16(ksrc + t_ * 64 * DM, (unsigned)__builtin_amdgcn_readfirstlane(kdst + (slot))); } while (0)
#define FX_DMA_V(j, slot) do { const long t_ = FX_TILE(j); glds16(vsrc + t_ * 64 * DM, (unsigned)__builtin_amdgcn_readfirstlane(vdst + (slot))); } while (0)
#define FX_WAIT(N) asm volatile("s_waitcnt vmcnt(" #N ") lgkmcnt(0)\n\ts_barrier" ::: "memory")
#define FX_SB() __builtin_amdgcn_sched_barrier(0)
    const lds_cptr kp0 = shm3 + LDS_K + hi * 1024 + r32 * 16;
    const lds_cptr vp0 = shm3 + LDS_V + ((lane >> 4) & 1) * 32 + (lane & 3) * 8 + (4 * hi + ((lane & 15) >> 2)) * 64;
    const int vb0 = (int)(lds0 + LDS_V) + ((lane >> 4) & 1) * 32 + (lane & 3) * 8 + (4 * hi + ((lane & 15) >> 2)) * 64;
    const LAS float* biasl = (const LAS float*)(shm3 + LDS_BIAS) + 4 * hi;
    FX_DMA_K(0, 0); FX_DMA_V(0, 0); FX_DMA_K(1, SLOTB);
    bf16x8 qr[4];
#pragma unroll
    for (int d0 = 0; d0 < 4; ++d0) qr[d0] = *reinterpret_cast<const bf16x8*>(&Qw[(long)r32 * DM + d0 * 16 + hi * 8]);
    LAS float* mmp = (LAS float*)(shm3 + LDS_MM); LAS float* qmp = (LAS float*)(shm3 + LDS_QM);
    { float qs = 0.f;
#pragma unroll
      for (int d0 = 0; d0 < 4; ++d0)
#pragma unroll
          for (int e = 0; e < 8; ++e) { const float v = bf2f((bf16_t)qr[d0][e]); qs += v * v; }
      { auto rr = __builtin_amdgcn_permlane32_swap(__float_as_uint(qs), __float_as_uint(qs), false, false); qs = __uint_as_float(rr[0]) + __uint_as_float(rr[1]); }
      qs = __builtin_fmaxf(qs, shx<1>(qs)); qs = __builtin_fmaxf(qs, shx<2>(qs)); qs = __builtin_fmaxf(qs, shx<4>(qs)); qs = __builtin_fmaxf(qs, shx<8>(qs)); qs = __builtin_fmaxf(qs, shx<16>(qs));
      if (lane == 0) { qmp[wid] = qs; mmp[wid] = -1e30f; mmp[8 + wid] = -1e30f; mmp[16 + wid] = -1e30f; } }
    float mhat = 0.f, l_reg = 0.f; f32x16 o[2]; o[0] = f32x16{}; o[1] = f32x16{};
    const int qrel = wid * 32 + r32;
    bool resc = false; float bqk = 0.f;
    f32x16 pA0, pA1, pB0, pB1;
    bf16x8 kf[8];
    int sl_prev = 0, sl_cur = 0, sl_next = SLOTB;
#define FX_ROT() do { sl_prev = sl_cur; sl_cur = sl_next; sl_next = (sl_next == 2 * SLOTB) ? 0 : sl_next + SLOTB; } while (0)
#define FX_CMASK(P0, P1, j) do { const int kb_ = 64 * (j) + 4 * hi; const float NEG_ = -__builtin_inff(); \
        _Pragma("unroll") for (int r = 0; r < 16; ++r) { const int kv = kb_ + (r & 3) + 8 * (r >> 2); if (kv > qrel) P0[r] = NEG_; if (kv + 32 > qrel) P1[r] = NEG_; } } while (0)
#define FX_KLOAD2(jj, sl) do { kf[2 * (jj)] = *(const LAS bf16x8*)(kp0 + (sl) + (jj) * 2048); kf[2 * (jj) + 1] = *(const LAS bf16x8*)(kp0 + (sl) + (jj) * 2048 + 512); } while (0)
#define FX_MF(a, b, c) __builtin_amdgcn_mfma_f32_32x32x16_bf16(a, b, c, 0, 0, 0)
#define FX_BLD(g, tl) (*(const LAS f32x4*)(biasl + 64 * (tl) + ((g) & 3) * 8 + ((g) >> 2) * 32))
#define FX_BSET(P0, P1, g, v) do { if ((g) < 4) { P0[4 * (g)] = v[0] - mhat; P0[4 * (g) + 1] = v[1] - mhat; P0[4 * (g) + 2] = v[2] - mhat; P0[4 * (g) + 3] = v[3] - mhat; } \
        else { P1[4 * ((g) - 4)] = v[0] - mhat; P1[4 * ((g) - 4) + 1] = v[1] - mhat; P1[4 * ((g) - 4) + 2] = v[2] - mhat; P1[4 * ((g) - 4) + 3] = v[3] - mhat; } } while (0)
    FX_DMA_K(2, 2 * SLOTB);
    { const int t0 = FX_TILE(0);
#pragma unroll
      for (int g = 0; g < 8; ++g) { const f32x4 bv = FX_BLD(g, t0); FX_BSET(pA0, pA1, g, bv); } }
    FX_WAIT(3);
    FX_KLOAD2(0, 0); FX_KLOAD2(1, 0); FX_KLOAD2(2, 0); FX_KLOAD2(3, 0);
    pA0 = FX_MF(kf[0], qr[0], pA0); pA1 = FX_MF(kf[1], qr[0], pA1); pA0 = FX_MF(kf[2], qr[1], pA0); pA1 = FX_MF(kf[3], qr[1], pA1);
    pA0 = FX_MF(kf[4], qr[2], pA0); pA1 = FX_MF(kf[5], qr[2], pA1); pA0 = FX_MF(kf[6], qr[3], pA0); pA1 = FX_MF(kf[7], qr[3], pA1);
    FX_CMASK(pA0, pA1, 0);
    { const float rm = rowmax(pA0, pA1); const float dl = __builtin_fmaxf(rm, -1e30f); mhat += dl;
#pragma unroll
      for (int r = 0; r < 16; ++r) { pA0[r] = __builtin_amdgcn_exp2f(pA0[r] - dl); pA1[r] = __builtin_amdgcn_exp2f(pA1[r] - dl); } }
    { const int t1 = FX_TILE(1);
#pragma unroll
      for (int g = 0; g < 8; ++g) { const f32x4 bv = FX_BLD(g, t1); FX_BSET(pB0, pB1, g, bv); } }
    FX_WAIT(0);
    FX_DMA_K(3, 0); FX_DMA_V(1, SLOTB);
    FX_ROT();
    FX_KLOAD2(0, sl_cur); FX_KLOAD2(1, sl_cur); FX_KLOAD2(2, sl_cur); FX_KLOAD2(3, sl_cur);
    FX_WAIT(2);
    s16x4 vlo[8], vhi[8]; u32x4 pw0, pw1, pw2, pw3; f32x4 bt;
#define FX_PKW(P, B) cvtpk(P[B], P[B + 1])
#define FX_PAF(k) __builtin_bit_cast(bf16x8, pw##k)
#define FX_VFR(i) (bf16x8){vlo[i][0], vlo[i][1], vlo[i][2], vlo[i][3], vhi[i][0], vhi[i][1], vhi[i][2], vhi[i][3]}
#define FX_PIN(x) asm volatile("" : "+v"(x))
#define FX_VRD(i) do { vlo[i] = vtr(vp_ + (((i) >> 2) * 4096 + ((i) & 3) * 1024)); vhi[i] = vtr(vp_ + (((i) >> 2) * 4096 + ((i) & 3) * 1024 + 512)); } while (0)
#define FX_GAPA(MFS, A0, A1, A2, A3, W0, W1, PW) do { MFS; sacc += A0; sacc += A1; sacc += A2; sacc += A3; FX_PIN(sacc); W0; W1; FX_PIN(PW); FX_SB(); } while (0)
#define FX_GAPB(MFS, X, B, GL, N0, N1, g, tl) do { MFS; X[B] = __builtin_amdgcn_exp2f(X[B]); X[B + 1] = __builtin_amdgcn_exp2f(X[B + 1]); X[B + 2] = __builtin_amdgcn_exp2f(X[B + 2]); X[B + 3] = __builtin_amdgcn_exp2f(X[B + 3]); FX_PIN(X); \
        if (GL) { if ((g) > 0) { FX_BSET(N0, N1, (g) - 1, bt); } bt = FX_BLD(g, tl); } FX_SB(); } while (0)
#define FX_STEP(C0, C1, P0, P1, j, MASKED, GK, GV, GL) do { FX_SB(); \
    const lds_cptr vp_ = vp0 + sl_prev; const int tn_ = FX_TILE((j) + 1); \
    FX_VRD(0); FX_SB(); float sacc = (P0[0] + P0[1]); \
    FX_GAPA(C0 = FX_MF(kf[0], qr[0], C0), P0[2], P0[3], P0[4], P0[5],     pw0[0] = FX_PKW(P0, 0),  pw0[1] = FX_PKW(P0, 2),  pw0); \
    FX_VRD(4); FX_SB(); FX_GAPA(C1 = FX_MF(kf[1], qr[0], C1), P0[6], P0[7], P0[8], P0[9],     pw0[2] = FX_PKW(P0, 4),  pw0[3] = FX_PKW(P0, 6),  pw0); \
    FX_VRD(1); FX_SB(); FX_GAPA(C0 = FX_MF(kf[2], qr[1], C0),   P0[10], P0[11], P0[12], P0[13], pw1[0] = FX_PKW(P0, 8),  pw1[1] = FX_PKW(P0, 10), pw1); \
    FX_VRD(5); FX_SB(); FX_GAPA(C1 = FX_MF(kf[3], qr[1], C1),   P0[14], P0[15], P1[0], P1[1],   pw1[2] = FX_PKW(P0, 12), pw1[3] = FX_PKW(P0, 14), pw1); \
    FX_VRD(2); FX_SB(); FX_GAPA(C0 = FX_MF(kf[4], qr[2], C0),   P1[2], P1[3], P1[4], P1[5],     pw2[0] = FX_PKW(P1, 0),  pw2[1] = FX_PKW(P1, 2),  pw2); \
    FX_VRD(6); FX_SB(); FX_GAPA(C1 = FX_MF(kf[5], qr[2], C1),   P1[6], P1[7], P1[8], P1[9],     pw2[2] = FX_PKW(P1, 4),  pw2[3] = FX_PKW(P1, 6),  pw2); \
    FX_VRD(3); FX_SB(); FX_GAPA(C0 = FX_MF(kf[6], qr[3], C0),   P1[10], P1[11], P1[12], P1[13], pw3[0] = FX_PKW(P1, 8),  pw3[1] = FX_PKW(P1, 10), pw3); \
    FX_VRD(7); FX_SB(); FX_GAPA(C1 = FX_MF(kf[7], qr[3], C1),   P1[14], P1[15], 0.f, 0.f,       pw3[2] = FX_PKW(P1, 12), pw3[3] = FX_PKW(P1, 14), pw3); \
    l_reg += sacc; \
    if (GK) { FX_DMA_K((j) + 3, sl_cur); } if (GV) { FX_DMA_V((j) + 1, sl_next); } \
    if (MASKED) { FX_CMASK(C0, C1, j); } \
    { const float rm = rowmax(C0, C1); resc = false; \
      if (__builtin_expect(__any(rm > 8.f), 0)) { const float dl = __builtin_fmaxf(rm, 0.f); mhat += dl; \
        _Pragma("unroll") for (int r = 0; r < 16; ++r) { C0[r] -= dl; C1[r] -= dl; } \
        const float f = __builtin_amdgcn_exp2f(-dl); l_reg *= f; if (hi == 0) wsf[r32] = f; resc = true; } \
      if (((j) & 3) == 0) { float mn = mhat; mn = __builtin_fminf(mn, shx<1>(mn)); mn = __builtin_fminf(mn, shx<2>(mn)); mn = __builtin_fminf(mn, shx<4>(mn)); mn = __builtin_fminf(mn, shx<8>(mn)); mn = __builtin_fminf(mn, shx<16>(mn)); \
        if (lane == 0) mmp[((j) % 3) * 8 + wid] = mn; } } \
    FX_SB(); \
    FX_GAPB(o[0] = FX_MF(FX_PAF(0), FX_VFR(0), o[0]), C0, 0, GL, P0, P1, 0, tn_); \
    FX_GAPB(o[1] = FX_MF(FX_PAF(0), FX_VFR(4), o[1]), C0, 4, GL, P0, P1, 1, tn_); \
    if (GL) { FX_KLOAD2(0, sl_next); FX_SB(); } FX_GAPB(o[0] = FX_MF(FX_PAF(1), FX_VFR(1), o[0]), C0, 8, GL, P0, P1, 2, tn_); \
    if (GL) { FX_KLOAD2(1, sl_next); FX_SB(); } FX_GAPB(o[1] = FX_MF(FX_PAF(1), FX_VFR(5), o[1]), C0, 12, GL, P0, P1, 3, tn_); \
    if (GL) { FX_KLOAD2(2, sl_next); FX_SB(); } FX_GAPB(o[0] = FX_MF(FX_PAF(2), FX_VFR(2), o[0]), C1, 0, GL, P0, P1, 4, tn_); \
    if (GL) { FX_KLOAD2(3, sl_next); FX_SB(); } FX_GAPB(o[1] = FX_MF(FX_PAF(2), FX_VFR(6), o[1]), C1, 4, GL, P0, P1, 5, tn_); \
    FX_GAPB(o[0] = FX_MF(FX_PAF(3), FX_VFR(3), o[0]), C1, 8, GL, P0, P1, 6, tn_); \
    FX_GAPB(o[1] = FX_MF(FX_PAF(3), FX_VFR(7), o[1]), C1, 12, GL, P0, P1, 7, tn_); \
    if (GL) { FX_BSET(P0, P1, 7, bt); } \
    } while (0)
#define FX_CLOSEW(W) do { W; \
        if (resc) { asm volatile("s_waitcnt lgkmcnt(0)" ::: "memory"); \
            _Pragma("unroll") for (int d_ = 0; d_ < 2; ++d_) _Pragma("unroll") for (int r = 0; r < 16; ++r) o[d_][r] *= wsf[crow(r, hi)]; } \
        FX_ROT(); } while (0)
#define FX_CLOSE(j) do { if ((j) + 3 < n) { FX_CLOSEW(FX_WAIT(2)); } else if ((j) + 2 < n) { FX_CLOSEW(FX_WAIT(1)); } else { FX_CLOSEW(FX_WAIT(0)); } } while (0)
#define FX_EXIT_TEST(j) ({ bool stop_ = false; if ((((j) & 3) == 2) && (j) >= 6) { \
        if ((j) == 6) { const f32x4 qa_ = *(const LAS f32x4*)qmp, qb_ = *(const LAS f32x4*)(qmp + 4); \
            const float qn2 = __builtin_fmaxf(__builtin_fmaxf(__builtin_fmaxf(qa_[0], qa_[1]), __builtin_fmaxf(qa_[2], qa_[3])), __builtin_fmaxf(__builtin_fmaxf(qb_[0], qb_[1]), __builtin_fmaxf(qb_[2], qb_[3]))); \
            bqk = __int_as_float(__builtin_amdgcn_readfirstlane(__float_as_int(sqrtf(qn2 * kn2) * 1.02f + 1.0f))); } \
        const LAS float* mp_ = mmp + (((j) - 2) % 3) * 8; const f32x4 ma_ = *(const LAS f32x4*)mp_, mb_ = *(const LAS f32x4*)(mp_ + 4); \
        const float mm_ = __builtin_fminf(__builtin_fminf(__builtin_fminf(ma_[0], ma_[1]), __builtin_fminf(ma_[2], ma_[3])), __builtin_fminf(__builtin_fminf(mb_[0], mb_[1]), __builtin_fminf(mb_[2], mb_[3]))); \
        const float bmax_ = *((const LAS float*)(shm3 + LDS_BIAS) + FX_TILE(j) * 64 + 63); \
        stop_ = __builtin_amdgcn_readfirstlane((int)(bqk + bmax_ < mm_ - 160.f)) != 0; } stop_; })
    FX_STEP(pB0, pB1, pA0, pA1, 1, true, (4 < n), true, true); FX_CLOSE(1);
    FX_STEP(pA0, pA1, pB0, pB1, 2, true, (5 < n), true, true); FX_CLOSE(2);
    FX_STEP(pB0, pB1, pA0, pA1, 3, true, (6 < n), (4 < n), (4 < n)); FX_CLOSE(3);
    int j = 4, nrun = n;
#pragma unroll 1
    for (; j + 4 < nrun; j += 2) {
        FX_STEP(pA0, pA1, pB0, pB1, j, false, true, true, true); FX_CLOSEW(FX_WAIT(2));
        FX_STEP(pB0, pB1, pA0, pA1, j + 1, false, true, true, true); FX_CLOSEW(FX_WAIT(2));
        if (FX_EXIT_TEST(j + 2)) nrun = j + 2;
    }
#pragma unroll 1
    for (; j < nrun; j += 2) {
        FX_STEP(pA0, pA1, pB0, pB1, j, false, (j + 3 < n), (j + 1 < n), (j + 1 < n)); FX_CLOSE(j);
        FX_STEP(pB0, pB1, pA0, pA1, j + 1, false, (j + 4 < n), (j + 2 < n), (j + 2 < n)); FX_CLOSE(j + 1);
    }
    asm volatile("s_waitcnt vmcnt(0)" ::: "memory");
    { float sacc = 0.f;
#pragma unroll
      for (int r = 0; r < 16; ++r) sacc += pB0[r] + pB1[r];
      l_reg += sacc;
      pw0 = (u32x4){FX_PKW(pB0, 0), FX_PKW(pB0, 2), FX_PKW(pB0, 4), FX_PKW(pB0, 6)}; pw1 = (u32x4){FX_PKW(pB0, 8), FX_PKW(pB0, 10), FX_PKW(pB0, 12), FX_PKW(pB0, 14)};
      pw2 = (u32x4){FX_PKW(pB1, 0), FX_PKW(pB1, 2), FX_PKW(pB1, 4), FX_PKW(pB1, 6)}; pw3 = (u32x4){FX_PKW(pB1, 8), FX_PKW(pB1, 10), FX_PKW(pB1, 12), FX_PKW(pB1, 14)};
      FX_SB(); pv(o, vb0 + sl_prev, FX_PAF(0), FX_PAF(1), FX_PAF(2), FX_PAF(3)); }
    { auto rr = __builtin_amdgcn_permlane32_swap(__float_as_uint(l_reg), __float_as_uint(l_reg), false, false); l_reg = __uint_as_float(rr[0]) + __uint_as_float(rr[1]); }
    if (hi == 0) wsf[32 + r32] = l_reg;
    asm volatile("s_waitcnt lgkmcnt(0)" ::: "memory");
    float rli[16];
#pragma unroll
    for (int r = 0; r < 16; ++r) rli[r] = __builtin_amdgcn_rcpf(wsf[32 + crow(r, hi)]);
    { bf16_t* stg = (bf16_t*)(shm + LDS_OST) + wid * 2048;
#pragma unroll
      for (int r = 0; r < 16; ++r) { const int orow = crow(r, hi);
#pragma unroll
          for (int d0 = 0; d0 < 2; ++d0) stg[orow * 64 + d0 * 32 + r32] = (bf16_t)(cvtpk(o[d0][r] * rli[r], 0.f) & 0xffffu); }
      asm volatile("s_waitcnt lgkmcnt(0)" ::: "memory");
#pragma unroll
      for (int i = 0; i < 4; ++i) { const int row = i * 8 + (lane >> 3), ch = lane & 7; const u32x4 v = *(const u32x4*)(stg + row * 64 + ch * 8); *(u32x4*)(Ow + (long)row * D + ch * 8) = v; } }
    asm volatile("s_waitcnt lgkmcnt(0)\n\ts_barrier" ::: "memory");
#undef FX_TILE
#undef FX_DMA_K
#undef FX_DMA_V
#undef FX_WAIT
#undef FX_SB
#undef FX_ROT
#undef FX_CMASK
#undef FX_KLOAD2
#undef FX_MF
#undef FX_BLD
#undef FX_BSET
#undef FX_PKW
#undef FX_PAF
#undef FX_VFR
#undef FX_PIN
#undef FX_VRD
#undef FX_GAPA
#undef FX_GAPB
#undef FX_STEP
#undef FX_CLOSEW
#undef FX_CLOSE
#undef FX_EXIT_TEST
}
}

__device__ __forceinline__ void p0_tr_item(const float* W, int ld_src, int k0, int n0, bf16_t* d0, bf16_t* d1, bf16_t* d2, int ld_dst, LAS float* scr, int lane) {
    float tv[32];
#pragma unroll
    for (int i = 0; i < 32; ++i) { const int kk = 2 * i + (lane >> 5); tv[i] = W[(size_t)(k0 + kk) * ld_src + n0 + (lane & 31)]; }
#pragma unroll
    for (int i = 0; i < 32; ++i) { const int kk = 2 * i + (lane >> 5); scr[kk * 33 + (lane & 31)] = tv[i]; }
    LDS_WAIT(); asm volatile("" ::: "memory");
    const int c = lane & 7;
#pragma unroll
    for (int j = 0; j < 4; ++j) { const int n = (lane >> 3) + 8 * j; const LAS float* s = scr + (8 * c) * 33 + n;
        u32x4 o; o.x = cvtpk(s[0 * 33], s[1 * 33]); o.y = cvtpk(s[2 * 33], s[3 * 33]); o.z = cvtpk(s[4 * 33], s[5 * 33]); o.w = cvtpk(s[6 * 33], s[7 * 33]);
        *(u32x4*)(d0 + (size_t)n * ld_dst + 8 * c) = o;
        if (d1) *(u32x4*)(d1 + (size_t)n * ld_dst + 8 * c) = o;
        if (d2) *(u32x4*)(d2 + (size_t)n * ld_dst + 8 * c) = o; }
    LDS_WAIT(); asm volatile("" ::: "memory");
}
__device__ __forceinline__ int pair_idx(int lo, int hi) { return lo == 0 ? hi - 1 : (lo == 1 ? hi + 1 : 5); }

__device__ __forceinline__ void phase_p0(Frame& F) {
    __syncthreads();
    {
        LAS float* sc = (LAS float*)F.lds;
        LAS float* red = (LAS float*)(F.lds + 16384);
        float* MOD = (float*)(F.ws + WS_MOD);
        bool have = false;
        for (int task = F.vcu; task < 48; task += F.G) {
            if (!have) { for (int i = F.tid; i < 4096; i += 512) { const float v = F.inp(F_C)[i]; sc[i] = v * sigmoidf_(v); } __syncthreads(); have = true; }
            const int l = task / 24, j0 = (task % 24) * 256;
            const float* wp = F.inp(F_WMOD) + (size_t)l * 1024 * 6144 + j0 + 4 * F.lane;
            f32x4 a0 = {0, 0, 0, 0}, a1 = a0, a2 = a0, a3 = a0;
            const int kbeg = F.wave * 128;
#pragma unroll 8
            for (int k = kbeg; k < kbeg + 128; ++k) { const f32x4 wv = *(const f32x4*)(wp + (size_t)k * 6144);
                a0 += wv * sc[k]; a1 += wv * sc[1024 + k]; a2 += wv * sc[2048 + k]; a3 += wv * sc[3072 + k]; }
            *(LAS f32x4*)(red + (F.wave * 4 + 0) * 256 + 4 * F.lane) = a0; *(LAS f32x4*)(red + (F.wave * 4 + 1) * 256 + 4 * F.lane) = a1;
            *(LAS f32x4*)(red + (F.wave * 4 + 2) * 256 + 4 * F.lane) = a2; *(LAS f32x4*)(red + (F.wave * 4 + 3) * 256 + 4 * F.lane) = a3;
            __syncthreads();
            for (int o = F.tid; o < 1024; o += 512) { const int b = o >> 8, cidx = o & 255; float s = F.inp(F_BMOD)[l * 6144 + j0 + cidx];
#pragma unroll
                for (int w = 0; w < 8; ++w) s += red[(w * 4 + b) * 256 + cidx];
                MOD[(size_t)(l * 4 + b) * 6144 + j0 + cidx] = s; }
            __syncthreads();
        }
        __syncthreads();
    }
    LAS float* scr = (LAS float*)(F.lds + F.wave * 16384);
    const int gw = F.vcu * 8 + F.wave, NGW = F.G * 8;
    bf16_t* WIN = (bf16_t*)(F.ws + WS_WIN); bf16_t* WOUT = (bf16_t*)(F.ws + WS_WOUT); bf16_t* WGU = (bf16_t*)(F.ws + WS_WGU); bf16_t* WDP = (bf16_t*)(F.ws + WS_WDP);
    constexpr int I_IN = 2 * 16 * 64, I_OUT = 2 * 16 * 32, I_GU = 2 * 16 * 2 * 16 * 8, I_DN = 2 * 16 * 4 * 32;
    for (int it = gw; it < I_IN + I_OUT + I_GU + I_DN; it += NGW) {
        int r = it;
        if (r < I_IN) { const int l = r / 1024, kb = (r % 1024) / 64, nb = r % 64;
            p0_tr_item(F.inp(F_WIN) + (size_t)l * 1024 * IN_COLS, IN_COLS, 64 * kb, 32 * nb, WIN + ((size_t)l * 2048 + 32 * nb) * 1024 + 64 * kb, nullptr, nullptr, 1024, scr, F.lane); continue; }
        r -= I_IN;
        if (r < I_OUT) { const int l = r / 512, kb = (r % 512) / 32, nb = r % 32;
            p0_tr_item(F.inp(F_WOUT) + (size_t)l * 1024 * 1024, 1024, 64 * kb, 32 * nb, WOUT + ((size_t)l * 1024 + 32 * nb) * 1024 + 64 * kb, nullptr, nullptr, 1024, scr, F.lane); continue; }
        r -= I_OUT;
        if (r < I_GU) { const int le = r / 256, which = (r % 256) / 128, kb = (r % 128) / 8, nb = r % 8;
            const int j0 = 32 * nb, row = 256 * (j0 >> 7) + (j0 & 127) + which * 128;
            p0_tr_item((which ? F.inp(F_WUP) : F.inp(F_WGATE)) + (size_t)le * 1024 * 256, 256, 64 * kb, j0, WGU + ((size_t)le * 512 + row) * 1024 + 64 * kb, nullptr, nullptr, 1024, scr, F.lane); continue; }
        r -= I_GU;
        { const int le = r / 128, kb = (r % 128) / 32, nb = r % 32; const int l = le >> 4, e = le & 15, g = e >> 2, i = e & 3;
          bf16_t* dst[3]; int nd = 0;
#pragma unroll
          for (int j = 0; j < 4; ++j) { if (j == i) continue; const int lo = i < j ? i : j, hi = i < j ? j : i; const int cls = g * 6 + pair_idx(lo, hi); const int kofs = (i == lo) ? 0 : 256;
              dst[nd++] = WDP + ((size_t)(l * 24 + cls) * 1024 + 32 * nb) * 512 + kofs + 64 * kb; }
          p0_tr_item(F.inp(F_WDOWN) + (size_t)le * 256 * 1024, 1024, 64 * kb, 32 * nb, dst[0], dst[1], dst[2], 512, scr, F.lane); }
    }
}

template <bool PM>
__device__ __forceinline__ void phase_norm1(Frame& F, int l, const float* xin) {
    const bf16_t* Pb = (const bf16_t*)(F.ws + WS_P); const bf16_t* Mb = (const bf16_t*)(F.ws + WS_M); float* XA = (float*)(F.ws + WS_XA);
    LAS float* gpm = (LAS float*)(F.lds + 256);
    const float* MOD = (const float*)(F.ws + WS_MOD) + (size_t)l * 4 * 6144;
    bf16_t* H = (bf16_t*)(F.ws + WS_H); float* CUM = (float*)(F.ws + WS_CUM); float* CTOT = (float*)(F.ws + WS_CTOT);
    LAS float* wtot = (LAS float*)F.lds;
    for (int tile = F.vcu; tile < T / 128; tile += F.G) {
        const int b = tile >> 6, row0 = tile * 128;
        f32x4 g1[4], s1[4], wfc[16];
#pragma unroll
        for (int j = 0; j < 4; ++j) { const int col = 4 * F.lane + 256 * j;
            const f32x4 nm = *(const f32x4*)(F.inp(F_NMIX) + l * 1024 + col), scv = *(const f32x4*)(MOD + b * 6144 + 1024 + col);
            g1[j] = nm * (scv + 1.0f); s1[j] = *(const f32x4*)(MOD + b * 6144 + col);
#pragma unroll
            for (int i = 0; i < 4; ++i) wfc[j * 4 + i] = *(const f32x4*)(F.inp(F_WIN) + ((size_t)l * 1024 + col + i) * IN_COLS + 2048); }
        const f32x4 fb = *(const f32x4*)(F.inp(F_FOXB) + l * 4);
        if (PM) { const float* MODp = (const float*)(F.ws + WS_MOD) + (size_t)(l - 1) * 4 * 6144 + b * 6144;
            for (int i = F.tid; i < 1024; i += 512) { gpm[i] = MODp[2048 + i]; gpm[1024 + i] = MODp[5120 + i]; }
            __syncthreads(); }
        f32x4 run = {0.f, 0.f, 0.f, 0.f}, keep = {0.f, 0.f, 0.f, 0.f};
#pragma unroll 1
        for (int i = 0; i < 16; i += 2) {
            const int row = row0 + F.wave * 16 + i;
            const f32x4* xr0 = (const f32x4*)(xin + (size_t)row * D) + F.lane; const f32x4* xr1 = xr0 + D / 4;
            f32x4 v0[4], v1[4]; float ss0 = 0.f, ss1 = 0.f;
#pragma unroll
            for (int j = 0; j < 4; ++j) { v0[j] = xr0[64 * j]; v1[j] = xr1[64 * j]; }
            if (PM) {
                u32x2 p0[4], p1[4], m0[4], m1[4];
                const u32x2* pr0 = (const u32x2*)(Pb + (size_t)row * D) + F.lane; const u32x2* mr0 = (const u32x2*)(Mb + (size_t)row * D) + F.lane;
#pragma unroll
                for (int j = 0; j < 4; ++j) { p0[j] = pr0[64 * j]; p1[j] = pr0[64 * j + D / 4]; m0[j] = mr0[64 * j]; m1[j] = mr0[64 * j + D / 4]; }
                f32x4* xo0 = (f32x4*)(XA + (size_t)row * D) + F.lane; f32x4* xo1 = xo0 + D / 4;
#pragma unroll
                for (int j = 0; j < 4; ++j) { const f32x4 gm = *(const LAS f32x4*)(gpm + 4 * F.lane + 256 * j), gf = *(const LAS f32x4*)(gpm + 1024 + 4 * F.lane + 256 * j);
                    v0[j] = v0[j] + gm * bf4_to_f32(p0[j]) + gf * bf4_to_f32(m0[j]); v1[j] = v1[j] + gm * bf4_to_f32(p1[j]) + gf * bf4_to_f32(m1[j]);
                    xo0[64 * j] = v0[j]; xo1[64 * j] = v1[j]; }
            }
#pragma unroll
            for (int j = 0; j < 4; ++j) { ss0 += (v0[j].x * v0[j].x + v0[j].y * v0[j].y) + (v0[j].z * v0[j].z + v0[j].w * v0[j].w); ss1 += (v1[j].x * v1[j].x + v1[j].y * v1[j].y) + (v1[j].z * v1[j].z + v1[j].w * v1[j].w); }
            const float rstd0 = 1.0f / sqrtf(wave_sum(ss0) * (1.f / D) + EPS), rstd1 = 1.0f / sqrtf(wave_sum(ss1) * (1.f / D) + EPS);
            f32x4 fa0 = {0.f, 0.f, 0.f, 0.f}, fa1 = {0.f, 0.f, 0.f, 0.f};
            u32x2* o0 = (u32x2*)(H + (size_t)row * D) + F.lane; u32x2* o1 = o0 + D / 4;
#pragma unroll
            for (int j = 0; j < 4; ++j) { const f32x4 h0 = v0[j] * rstd0 * g1[j] + s1[j], h1 = v1[j] * rstd1 * g1[j] + s1[j];
                fa0 += wfc[j * 4 + 0] * h0.x + wfc[j * 4 + 1] * h0.y + wfc[j * 4 + 2] * h0.z + wfc[j * 4 + 3] * h0.w;
                fa1 += wfc[j * 4 + 0] * h1.x + wfc[j * 4 + 1] * h1.y + wfc[j * 4 + 2] * h1.z + wfc[j * 4 + 3] * h1.w;
                u32x2 w; w.x = cvtpk(h0.x, h0.y); w.y = cvtpk(h0.z, h0.w); o0[64 * j] = w; w.x = cvtpk(h1.x, h1.y); w.y = cvtpk(h1.z, h1.w); o1[64 * j] = w; }
            f32x4 lf0, lf1;
#pragma unroll
            for (int e = 0; e < 4; ++e) { const float z0 = wave_sum(fa0[e]) + fb[e], z1 = wave_sum(fa1[e]) + fb[e];
                lf0[e] = fminf(z0, 0.f) - __builtin_amdgcn_logf(1.f + fast_exp(-fabsf(z0))) * 0.6931471805599453f;
                lf1[e] = fminf(z1, 0.f) - __builtin_amdgcn_logf(1.f + fast_exp(-fabsf(z1))) * 0.6931471805599453f; }
            run += lf0; if (F.lane == i) keep = run;
            run += lf1; if (F.lane == i + 1) keep = run;
        }
        if (F.lane == 0) *(LAS f32x4*)(wtot + F.wave * 4) = run;
        __syncthreads();
        f32x4 pre = {0.f, 0.f, 0.f, 0.f}, tot = {0.f, 0.f, 0.f, 0.f};
#pragma unroll
        for (int w = 0; w < 8; ++w) { const f32x4 tv = *(const LAS f32x4*)(wtot + w * 4); if (w < F.wave) pre += tv; tot += tv; }
        if (F.lane < 16) { const int s = (row0 & (SEQ - 1)) + F.wave * 16 + F.lane; const f32x4 cv = keep + pre;
#pragma unroll
            for (int e = 0; e < 4; ++e) CUM[(size_t)(b * 4 + e) * SEQ + s] = cv[e]; }
        if (F.tid == 0) *(f32x4*)(CTOT + (size_t)(b * 64 + (tile & 63)) * 4) = tot;
        __syncthreads();
    }
}

__device__ __forceinline__ void lru_unit(Frame& F, int l, int b, int tt) {
    const bf16_t* PROJ = (const bf16_t*)(F.ws + WS_PROJ);
    float* HLOC = (float*)(F.ws + WS_H); float* PP = HLOC + (size_t)T * 256;
    float* LRUA = (float*)(F.ws + WS_LRUA); float* LRUH = (float*)(F.ws + WS_LRUH);
    LAS bf16_t* xcb = (LAS bf16_t*)F.lds;
    LAS float* gb_ = (LAS float*)(F.lds + 16384);
    const int c = F.tid & 255, sl = F.tid >> 8;
    const int blk = F.wave, kq = F.lane >> 4, nn = F.lane & 15;
    bf16x8 bfr[2][2];
    f32x4 cinit[2][2];
#pragma unroll
    for (int g = 0; g < 2; ++g)
#pragma unroll
        for (int hf = 0; hf < 2; ++hf) { const float* wp = (g ? F.inp(F_LWX) : F.inp(F_LWA)) + ((size_t)(l * 8 + blk) * 32 + 8 * kq) * 32 + 16 * hf + nn;
            u32x4 pk; pk.x = cvtpk(wp[0], wp[32]); pk.y = cvtpk(wp[64], wp[96]); pk.z = cvtpk(wp[128], wp[160]); pk.w = cvtpk(wp[192], wp[224]); bfr[g][hf] = __builtin_bit_cast(bf16x8, pk);
            const float bv = (g ? F.inp(F_LBX) : F.inp(F_LBA))[l * 256 + blk * 32 + 16 * hf + nn]; cinit[g][hf] = (f32x4){bv, bv, bv, bv}; }
    const float cw0 = F.inp(F_CONVW)[(l * 4 + 0) * 256 + c], cw1 = F.inp(F_CONVW)[(l * 4 + 1) * 256 + c], cw2 = F.inp(F_CONVW)[(l * 4 + 2) * 256 + c], cw3 = F.inp(F_CONVW)[(l * 4 + 3) * 256 + c];
    const float cb = F.inp(F_CONVB)[l * 256 + c];
    const float lam = F.inp(F_LAM)[l * 256 + c];
    const float sp = -8.0f * (fmaxf(-lam, 0.f) + log1pf(expf(-fabsf(lam))));
    const int s0 = tt * 128 + sl * 64;
    const bf16_t* xp = PROJ + ((size_t)b * SEQ + s0) * NPROJ + C_XB + c;
    float xm3 = s0 >= 3 ? bf2f(xp[-3 * (long)NPROJ]) : 0.f, xm2 = s0 >= 2 ? bf2f(xp[-2 * (long)NPROJ]) : 0.f, xm1 = s0 >= 1 ? bf2f(xp[-1 * (long)NPROJ]) : 0.f;
    float h = 0.f, P = 1.f;
    bf16_t xr[16];
#pragma unroll
    for (int i = 0; i < 16; ++i) xr[i] = xp[(long)i * NPROJ];
#pragma unroll 1
    for (int sub = 0; sub < 4; ++sub) {
        float xv[16];
#pragma unroll
        for (int i = 0; i < 16; ++i) { const float xc = bf2f(xr[i]); xv[i] = cb + cw0 * xm3 + cw1 * xm2 + cw2 * xm1 + cw3 * xc; xm3 = xm2; xm2 = xm1; xm1 = xc;
            xcb[(sl * 16 + i) * 256 + c] = (bf16_t)(cvtpk(xv[i], 0.f) & 0xffffu); }
        if (sub < 3) {
#pragma unroll
            for (int i = 0; i < 16; ++i) xr[i] = xp[(long)((sub + 1) * 16 + i) * NPROJ]; }
        __syncthreads();
#pragma unroll
        for (int s2 = 0; s2 < 2; ++s2) {
            const bf16x8 af = *(const LAS bf16x8*)(xcb + (s2 * 16 + nn) * 256 + blk * 32 + 8 * kq);
#pragma unroll
            for (int g = 0; g < 2; ++g)
#pragma unroll
                for (int hf = 0; hf < 2; ++hf) { const f32x4 r4 = __builtin_amdgcn_mfma_f32_16x16x32_bf16(af, bfr[g][hf], cinit[g][hf], 0, 0, 0);
                    LAS float* gp = gb_ + ((g * 2 + s2) * 16 + 4 * kq) * 256 + blk * 32 + 16 * hf + nn;
                    gp[0] = r4[0]; gp[256] = r4[1]; gp[512] = r4[2]; gp[768] = r4[3]; }
        }
        __syncthreads();
#pragma unroll
        for (int i = 0; i < 16; ++i) {
            const float ga = gb_[((0 * 2 + sl) * 16 + i) * 256 + c], gx = gb_[((1 * 2 + sl) * 16 + i) * 256 + c];
            const float r = sigmoidf_(ga), ig = sigmoidf_(gx);
            const float la = sp * r; const float a = fast_exp(la);
            const float mult = __builtin_amdgcn_sqrtf(__builtin_fmaxf(1.f - a * a, 0.f));
            const float u = mult * ig * xv[i];
            h = a * h + u; P *= a;
            const size_t off = ((size_t)b * SEQ + s0 + sub * 16 + i) * 256 + c;
            HLOC[off] = h; PP[off] = P;
        }
    }
    const size_t so = ((size_t)(b * 128 + tt * 2 + sl)) * 256 + c;
    LRUA[so] = P; LRUH[so] = h;
    __syncthreads();
}

__device__ __forceinline__ void fox_unit(Frame& F, int l, int b, int h, int qb) {
    const bf16_t* PROJ = (const bf16_t*)(F.ws + WS_PROJ); bf16_t* Y = (bf16_t*)(F.ws + WS_Y);
    const float* CUM = (const float*)(F.ws + WS_CUM) + (size_t)(b * 4 + h) * SEQ; const float* CTOT = (const float*)(F.ws + WS_CTOT);
    LAS float* bias = (LAS float*)(F.lds + att::LDS_BIAS); LAS float* blk = (LAS float*)(F.lds + att::LDS_BLK);
    const int q0 = qb * 256;
    const float vtot = CTOT[(size_t)(b * 64 + F.lane) * 4 + h];
    float cv[16];
#pragma unroll
    for (int k = 0; k < 16; ++k) { const int s = F.tid + 512 * k; cv[k] = (s < q0 + 256) ? CUM[s] : 0.f; }
    const float cq = CUM[q0 + 255];
    float kn2 = 0.f; { const unsigned* km = (const unsigned*)(F.ws + WS_CTL) + CW_KM + l * 128 + (b * 4 + h) * 8;
#pragma unroll
        for (int c = 0; c < 8; ++c) kn2 += __uint_as_float(__hip_atomic_load(km + c, __ATOMIC_RELAXED, __HIP_MEMORY_SCOPE_AGENT)); }
    if (F.wave == 0) { float s = vtot;
#pragma unroll
        for (int o = 1; o < 64; o <<= 1) { const float t = __int_as_float(__builtin_amdgcn_ds_bpermute(((F.lane - o) & 63) << 2, __float_as_int(s))); if (F.lane >= o) s += t; }
        blk[F.lane] = s - vtot; }
    __syncthreads();
    const float cref = cq + blk[(q0 + 255) >> 7];
#pragma unroll
    for (int k = 0; k < 16; ++k) { const int s = F.tid + 512 * k; if (s < q0 + 256) bias[s] = (cref - (cv[k] + blk[s >> 7])) * LOG2E; }
    __syncthreads();
    const size_t rowbase = (size_t)b * SEQ;
    att::fox_core(F.shm, PROJ + (rowbase + q0 + F.wave * 32) * NPROJ + C_QC + h * 64, PROJ + rowbase * NPROJ + C_KC + h * 64, PROJ + rowbase * NPROJ + C_VC + h * 64,
                  Y + (rowbase + q0 + F.wave * 32) * D + 768 + h * 64, 4 * (qb + 1), F.tid, kn2);
}
__device__ __forceinline__ void swa_unit(Frame& F, int l, int b, int kvh, int qb64) {
    const bf16_t* PROJ = (const bf16_t*)(F.ws + WS_PROJ); bf16_t* Y = (bf16_t*)(F.ws + WS_Y);
    LAS float* bias = (LAS float*)(F.lds + att::LDS_BIAS);
    const int q0 = qb64 * 64;
    const int t_lo = (q0 >= 128 ? q0 - 128 : 0) >> 6, t_hi = q0 >> 6, n = t_hi - t_lo + 1;
    for (int i = F.tid; i < 4 * 192; i += 512) { const int hh = i / 192, j = i - hh * 192; const float sl = exp2f(-(float)(kvh * 4 + hh + 1)) * LOG2E;
        if (j < n * 64) bias[i] = sl * (float)(64 * t_lo + j - q0); }
    __syncthreads();
    const int h = kvh * 4 + (F.wave >> 1), qw0 = q0 + 32 * (F.wave & 1);
    const float slope2 = exp2f(-(float)(h + 1)) * LOG2E;
    const size_t rowbase = (size_t)b * SEQ;
    att::attn_core<1>(F.shm, PROJ + (rowbase + qw0) * NPROJ + C_QA + h * 64, PROJ + rowbase * NPROJ + C_KA + kvh * 64, PROJ + rowbase * NPROJ + C_VA + kvh * 64,
                      Y + (rowbase + qw0) * D + h * 64, q0, qw0, t_lo, t_hi, (F.wave >> 1) * 192, F.inp(F_SINKS)[l * 8 + h] * LOG2E, slope2, F.tid);
}
__device__ __forceinline__ void phase_mixer(Frame& F, int l, int qsel) {
    unsigned* qhead = (unsigned*)(F.ws + WS_CTL) + CW_Q + qsel * 64;
    LAS unsigned* qslot = (LAS unsigned*)(F.lds + LDSCTL_OFF + 16);
#pragma unroll 1
    for (;;) {
        frame_refresh(F);
        if (F.tid == 0) qslot[0] = __hip_atomic_fetch_add(qhead, 1u, __ATOMIC_RELAXED, __HIP_MEMORY_SCOPE_AGENT);
        __syncthreads();
        const int u = __builtin_amdgcn_readfirstlane((int)qslot[0]);
        __syncthreads();
        if (u >= 512 + 256 + 1024) break;
        if (u < 512) { if (PH(11)) fox_unit(F, l, (u & 15) >> 2, u & 3, 31 - (u >> 4)); }
        else if (u < 768) { if (PH(10)) lru_unit(F, l, (u - 512) >> 6, (u - 512) & 63); }
        else { if (PH(12)) { const int v = u - 768; swa_unit(F, l, v >> 8, (v >> 7) & 1, v & 127); } }
    }
}

__device__ __forceinline__ void phase_ynorm(Frame& F, int l, bf16_t* YO) {
    const bf16_t* Y = (const bf16_t*)(F.ws + WS_Y); const bf16_t* PROJ = (const bf16_t*)(F.ws + WS_PROJ);
    const float* HLOC = (const float*)(F.ws + WS_H); const float* PP = HLOC + (size_t)T * 256;
    const float* LRUA = (const float*)(F.ws + WS_LRUA); const float* LRUH = (const float*)(F.ws + WS_LRUH);
    LAS float* cs = (LAS float*)F.lds;
    LAS float* carry = (LAS float*)(F.lds + 4096);
    const float* og = F.inp(F_OGAIN) + l * 1024;
    for (int tile = F.vcu; tile < T / 128; tile += F.G) {
        const int b = tile >> 6, tt = tile & 63, j0 = 2 * tt;
        { const int c = F.tid & 255, seg = F.tid >> 8; const int jb = seg ? j0 / 2 : 0, je = seg ? j0 : j0 / 2;
          float A = 1.f, Hh = 0.f;
          int j = jb;
          for (; j + 8 <= je; j += 8) {
              float aj[8], hj[8];
#pragma unroll
              for (int k = 0; k < 8; ++k) { const size_t so = (size_t)(b * 128 + j + k) * 256 + c; aj[k] = LRUA[so]; hj[k] = LRUH[so]; }
#pragma unroll
              for (int k = 0; k < 8; ++k) { Hh = aj[k] * Hh + hj[k]; A *= aj[k]; } }
          for (; j < je; ++j) { const size_t so = (size_t)(b * 128 + j) * 256 + c; const float aj = LRUA[so], hj = LRUH[so]; Hh = aj * Hh + hj; A *= aj; }
          cs[(seg * 2 + 0) * 256 + c] = A; cs[(seg * 2 + 1) * 256 + c] = Hh; }
        __syncthreads();
        if (F.tid < 256) { const int c = F.tid; const float c0 = cs[(2 + 0) * 256 + c] * cs[(0 + 1) * 256 + c] + cs[(2 + 1) * 256 + c];
            const size_t so = (size_t)(b * 128 + j0) * 256 + c; carry[c] = c0; carry[256 + c] = LRUA[so] * c0 + LRUH[so]; }
        __syncthreads();
#pragma unroll 1
        for (int i = 0; i < 16; i += 2) {
            u32x4 ya[2]; u32x2 yc[2], gb[2]; f32x4 hl[2], pp[2], cr[2];
#pragma unroll
            for (int k = 0; k < 2; ++k) { const int rl = F.wave * 16 + i + k; const size_t row = (size_t)tile * 128 + rl; const bf16_t* yr = Y + row * D;
                ya[k] = *(const u32x4*)(yr + 8 * F.lane); yc[k] = *(const u32x2*)(yr + 768 + 4 * F.lane);
                hl[k] = *(const f32x4*)(HLOC + row * 256 + 4 * F.lane); pp[k] = *(const f32x4*)(PP + row * 256 + 4 * F.lane);
                gb[k] = *(const u32x2*)(PROJ + row * NPROJ + C_GB + 4 * F.lane); cr[k] = *(const LAS f32x4*)(carry + (rl >> 6) * 256 + 4 * F.lane); }
#pragma unroll
            for (int k = 0; k < 2; ++k) { const int rl = F.wave * 16 + i + k; const size_t row = (size_t)tile * 128 + rl; bf16_t* yr = YO + row * D;
                float fa[8]; fa[0] = __uint_as_float(ya[k].x << 16); fa[1] = __uint_as_float(ya[k].x & 0xffff0000u); fa[2] = __uint_as_float(ya[k].y << 16); fa[3] = __uint_as_float(ya[k].y & 0xffff0000u);
                fa[4] = __uint_as_float(ya[k].z << 16); fa[5] = __uint_as_float(ya[k].z & 0xffff0000u); fa[6] = __uint_as_float(ya[k].w << 16); fa[7] = __uint_as_float(ya[k].w & 0xffff0000u);
                float sa = 0.f;
#pragma unroll
                for (int e = 0; e < 8; ++e) sa += fa[e] * fa[e];
                float fc[4]; fc[0] = __uint_as_float(yc[k].x << 16); fc[1] = __uint_as_float(yc[k].x & 0xffff0000u); fc[2] = __uint_as_float(yc[k].y << 16); fc[3] = __uint_as_float(yc[k].y & 0xffff0000u);
                const float sc_ = fc[0] * fc[0] + fc[1] * fc[1] + fc[2] * fc[2] + fc[3] * fc[3];
                float fb[4]; { const f32x4 hh = hl[k] + pp[k] * cr[k];
                    fb[0] = hh.x * gelu_tanh(__uint_as_float(gb[k].x << 16)); fb[1] = hh.y * gelu_tanh(__uint_as_float(gb[k].x & 0xffff0000u));
                    fb[2] = hh.z * gelu_tanh(__uint_as_float(gb[k].y << 16)); fb[3] = hh.w * gelu_tanh(__uint_as_float(gb[k].y & 0xffff0000u)); }
                const float sb = fb[0] * fb[0] + fb[1] * fb[1] + fb[2] * fb[2] + fb[3] * fb[3];
                const float ra = 1.0f / sqrtf(wave_sum(sa) * (1.f / 512.f) + EPS), rb = 1.0f / sqrtf(wave_sum(sb) * (1.f / 256.f) + EPS), rc = 1.0f / sqrtf(wave_sum(sc_) * (1.f / 256.f) + EPS);
                { const f32x4 g0 = *(const f32x4*)(og + 8 * F.lane), g1 = *(const f32x4*)(og + 8 * F.lane + 4);
                  u32x4 w; w.x = cvtpk(fa[0] * ra * g0.x, fa[1] * ra * g0.y); w.y = cvtpk(fa[2] * ra * g0.z, fa[3] * ra * g0.w); w.z = cvtpk(fa[4] * ra * g1.x, fa[5] * ra * g1.y); w.w = cvtpk(fa[6] * ra * g1.z, fa[7] * ra * g1.w);
                  *(u32x4*)(yr + 8 * F.lane) = w; }
                { const f32x4 g = *(const f32x4*)(og + 512 + 4 * F.lane); u32x2 w; w.x = cvtpk(fb[0] * rb * g.x, fb[1] * rb * g.y); w.y = cvtpk(fb[2] * rb * g.z, fb[3] * rb * g.w); *(u32x2*)(yr + 512 + 4 * F.lane) = w; }
                { const f32x4 g = *(const f32x4*)(og + 768 + 4 * F.lane); u32x2 w; w.x = cvtpk(fc[0] * rc * g.x, fc[1] * rc * g.y); w.y = cvtpk(fc[2] * rc * g.z, fc[3] * rc * g.w); *(u32x2*)(yr + 768 + 4 * F.lane) = w; }
            }
        }
        __syncthreads();
    }
}

template <int N, int MASK, int SZ> __device__ __forceinline__ void tr_step(float (&v)[SZ], bool upper) {
#pragma unroll
    for (int i = 0; i < N / 2; ++i) { const float a = v[i], b = v[i + N / 2]; const float send = upper ? a : b, kp = upper ? b : a; float rcv;
        if constexpr (MASK == 32) { auto rr = __builtin_amdgcn_permlane32_swap(__float_as_uint(send), __float_as_uint(send), false, false); rcv = upper ? __uint_as_float(rr[0]) : __uint_as_float(rr[1]); }
        else rcv = shx<MASK>(send);
        v[i] = kp + rcv; }
}
__device__ __forceinline__ void phase_norm2_router(Frame& F, int l, const float* xa, unsigned* cnt) {
    const float* MOD = (const float*)(F.ws + WS_MOD) + (size_t)l * 4 * 6144;
    bf16_t* H = (bf16_t*)(F.ws + WS_H);
    LEntry* list = (LEntry*)(F.ws + WS_LIST);
    LAS float* wr = (LAS float*)F.lds;
    LAS float* gs = (LAS float*)(F.lds + 81920);
    LAS float* lg = (LAS float*)(F.lds + 90112);
    LAS int* tcls = (LAS int*)(F.lds + 92672);
    LAS float* tw = (LAS float*)(F.lds + 93184);
    LAS int* trank = (LAS int*)(F.lds + 94208);
    LAS unsigned* lcnt = (LAS unsigned*)(F.lds + 94720);
    LAS unsigned* lbase = (LAS unsigned*)(F.lds + 94848);
    const bf16_t* Pb = (const bf16_t*)(F.ws + WS_P); LAS float* gmv = (LAS float*)(F.lds + 98304);
    for (int i = F.tid; i < 1024 * 4; i += 512) { const int k = i >> 2, e = i & 3; wr[e * 1024 + k] = F.inp(F_WRG)[(size_t)l * 4096 + i]; }
    for (int i = F.tid; i < 1024 * 16; i += 512) { const int k = i >> 4, e = i & 15; wr[(4 + e) * 1024 + k] = F.inp(F_WRE)[(size_t)l * 16384 + i]; }
    int cur_b = -1;
    for (int tile = F.vcu; tile < T / 128; tile += F.G) {
        const int b = tile >> 6;
        __syncthreads();
        if (b != cur_b) { for (int i = F.tid; i < 1024; i += 512) { gs[i] = F.inp(F_NFFN)[l * 1024 + i] * (1.f + MOD[b * 6144 + 4096 + i]); gs[1024 + i] = MOD[b * 6144 + 3072 + i]; gmv[i] = MOD[b * 6144 + 2048 + i]; } cur_b = b; }
        if (F.tid < NCLS) lcnt[F.tid] = 0u;
        __syncthreads();
        f32x4 xn[2][4]; u32x2 pn_[2][4];
#define N2_LOAD(g_) do { const size_t r0_ = (size_t)tile * 128 + F.wave * 16 + (g_) * 2; \
            _Pragma("unroll") for (int r = 0; r < 2; ++r) { \
                const f32x4* xr = (const f32x4*)(xa + (r0_ + r) * D) + F.lane; const u32x2* pr = (const u32x2*)(Pb + (r0_ + r) * D) + F.lane; \
                _Pragma("unroll") for (int j = 0; j < 4; ++j) { xn[r][j] = xr[64 * j]; pn_[r][j] = pr[64 * j]; } } } while (0)
        N2_LOAD(0);
#pragma unroll 1
        for (int grp = 0; grp < 8; ++grp) {
            const size_t row0 = (size_t)tile * 128 + F.wave * 16 + grp * 2;
            f32x4 hv[2][4];
#pragma unroll
            for (int j = 0; j < 4; ++j) { const f32x4 gm = *(const LAS f32x4*)(gmv + 4 * F.lane + 256 * j);
                hv[0][j] = xn[0][j] + gm * bf4_to_f32(pn_[0][j]); hv[1][j] = xn[1][j] + gm * bf4_to_f32(pn_[1][j]); }
            if (grp < 7) N2_LOAD(grp + 1);
#pragma unroll
            for (int r = 0; r < 2; ++r) { float ss = 0.f;
#pragma unroll
                for (int j = 0; j < 4; ++j) ss += (hv[r][j].x * hv[r][j].x + hv[r][j].y * hv[r][j].y) + (hv[r][j].z * hv[r][j].z + hv[r][j].w * hv[r][j].w);
                const float rstd = 1.0f / sqrtf(wave_sum(ss) * (1.f / D) + EPS);
                u32x2* o8 = (u32x2*)(H + (row0 + r) * D) + F.lane;
#pragma unroll
                for (int j = 0; j < 4; ++j) { const f32x4 g = *(const LAS f32x4*)(gs + 4 * F.lane + 256 * j), s = *(const LAS f32x4*)(gs + 1024 + 4 * F.lane + 256 * j);
                    hv[r][j] = hv[r][j] * rstd * g + s; u32x2 w; w.x = cvtpk(hv[r][j].x, hv[r][j].y); w.y = cvtpk(hv[r][j].z, hv[r][j].w); o8[64 * j] = w; } }
            float ga[8];
#pragma unroll
            for (int e = 0; e < 4; ++e) { float a0 = 0.f, a1 = 0.f;
#pragma unroll
                for (int j = 0; j < 4; ++j) { const f32x4 w = *(const LAS f32x4*)(wr + e * 1024 + 4 * F.lane + 256 * j);
                    a0 += hv[0][j].x * w.x + hv[0][j].y * w.y + hv[0][j].z * w.z + hv[0][j].w * w.w;
                    a1 += hv[1][j].x * w.x + hv[1][j].y * w.y + hv[1][j].z * w.z + hv[1][j].w * w.w; }
                ga[e] = a0; ga[4 + e] = a1; }
            tr_step<8, 32, 8>(ga, (F.lane & 32) != 0); tr_step<4, 16, 8>(ga, (F.lane & 16) != 0); tr_step<2, 8, 8>(ga, (F.lane & 8) != 0);
            ga[0] += shx<4>(ga[0]); ga[0] += shx<2>(ga[0]); ga[0] += shx<1>(ga[0]);
            int gsel[2]; float gp[2];
#pragma unroll
            for (int r = 0; r < 2; ++r) { float gl[4];
#pragma unroll
                for (int g = 0; g < 4; ++g) gl[g] = __int_as_float(__builtin_amdgcn_readlane(__float_as_int(ga[0]), 32 * r + 8 * g)) + F.inp(F_BRG)[l * 4 + g];
                int gs_ = 0; float gm = gl[0];
#pragma unroll
                for (int g = 1; g < 4; ++g) if (gl[g] > gm) { gm = gl[g]; gs_ = g; }
                float den = 0.f;
#pragma unroll
                for (int g = 0; g < 4; ++g) den += fast_exp(gl[g] - gm);
                gsel[r] = __builtin_amdgcn_readfirstlane(gs_); gp[r] = __builtin_amdgcn_rcpf(den); }
            float ea[8];
#pragma unroll
            for (int r = 0; r < 2; ++r) { const LAS float* we = wr + (4 + 4 * gsel[r]) * 1024 + 4 * F.lane;
#pragma unroll
                for (int e = 0; e < 4; ++e) { float a0 = 0.f;
#pragma unroll
                    for (int j = 0; j < 4; ++j) { const f32x4 w = *(const LAS f32x4*)(we + e * 1024 + 256 * j); a0 += hv[r][j].x * w.x + hv[r][j].y * w.y + hv[r][j].z * w.z + hv[r][j].w * w.w; }
                    ea[4 * r + e] = a0; } }
            tr_step<8, 32, 8>(ea, (F.lane & 32) != 0); tr_step<4, 16, 8>(ea, (F.lane & 16) != 0); tr_step<2, 8, 8>(ea, (F.lane & 8) != 0);
            ea[0] += shx<4>(ea[0]); ea[0] += shx<2>(ea[0]); ea[0] += shx<1>(ea[0]);
#pragma unroll
            for (int r = 0; r < 2; ++r) { float el[4];
#pragma unroll
                for (int e = 0; e < 4; ++e) el[e] = __int_as_float(__builtin_amdgcn_readlane(__float_as_int(ea[0]), 32 * r + 8 * e)) + F.inp(F_BRE)[l * 16 + gsel[r] * 4 + e];
                int i1 = 0; float m1 = el[0];
#pragma unroll
                for (int e = 1; e < 4; ++e) if (el[e] > m1) { m1 = el[e]; i1 = e; }
                int i2 = -1; float m2 = -__builtin_inff();
#pragma unroll
                for (int e = 0; e < 4; ++e) if (e != i1 && el[e] > m2) { m2 = el[e]; i2 = e; }
                const float e2 = fast_exp(m2 - m1); const float w1 = gp[r] * __builtin_amdgcn_rcpf(1.f + e2), w2 = w1 * e2;
                const int lo = i1 < i2 ? i1 : i2, hi = i1 < i2 ? i2 : i1;
                if (F.lane == 0) { const int rl = F.wave * 16 + grp * 2 + r;
                    tcls[rl] = gsel[r] * 6 + pair_idx(lo, hi); tw[rl * 2] = (i1 < i2) ? w1 : w2; tw[rl * 2 + 1] = (i1 < i2) ? w2 : w1; } }
        }
#undef N2_LOAD
        __syncthreads();
        if (F.tid < 128) trank[F.tid] = (int)atomicAdd((unsigned*)&lcnt[tcls[F.tid]], 1u);
        __syncthreads();
        if (F.tid < NCLS) lbase[F.tid] = lcnt[F.tid] ? __hip_atomic_fetch_add(cnt + 64 * F.tid, lcnt[F.tid], __ATOMIC_RELAXED, __HIP_MEMORY_SCOPE_AGENT) : 0u;
        __syncthreads();
        if (F.tid < 128) { const int cls = tcls[F.tid]; const unsigned pos = lbase[cls] + (unsigned)trank[F.tid];
            LEntry e; e.tok = tile * 128 + F.tid; e.w0 = tw[F.tid * 2]; e.w1 = tw[F.tid * 2 + 1]; e.pad = 0; list[(size_t)cls * LCAP + pos] = e; }
    }
    __syncthreads();
}

__device__ __forceinline__ int build_tile_table(Frame& F, int l) {
    unsigned* cnt = (unsigned*)(F.ws + WS_CTL) + CW_CNT + l * NCLS * 64;
    LAS int* tt = (LAS int*)(F.lds + TT_OFF); LAS int* ntl = (LAS int*)(F.lds + TT_OFF + 1024);
    __syncthreads();
    if (F.tid == 0) { int nt = 0;
        for (int c = 0; c < NCLS; ++c) { const unsigned n = __hip_atomic_load(cnt + 64 * c, __ATOMIC_RELAXED, __HIP_MEMORY_SCOPE_AGENT); const int k = (int)((n + 255u) >> 8);
            for (int j = 0; j < k; ++j) tt[nt++] = c | ((j * 256) << 8); }
        ntl[0] = nt; }
    __syncthreads();
    return ntl[0];
}

__device__ __forceinline__ void phase_final(Frame& F, const float* xa, int lp) {
    const bf16_t* Pb = (const bf16_t*)(F.ws + WS_P); const bf16_t* Mb = (const bf16_t*)(F.ws + WS_M); const float* MODp = (const float*)(F.ws + WS_MOD) + (size_t)lp * 4 * 6144;
    const int gw = F.vcu * 8 + F.wave;
    const int rbase = gw * 16; const float* gp = MODp + (rbase >> 13) * 6144;
    f32x4 g[4], gm[4], gf[4];
#pragma unroll
    for (int j = 0; j < 4; ++j) { const int col = 4 * F.lane + 256 * j; g[j] = *(const f32x4*)(F.inp(F_NFIN) + col); gm[j] = *(const f32x4*)(gp + 2048 + col); gf[j] = *(const f32x4*)(gp + 5120 + col); }
#pragma unroll 1
    for (int i = 0; i < 16; i += 2) {
        const int row = rbase + i;
        const f32x4* xr0 = (const f32x4*)(xa + (size_t)row * D) + F.lane; const f32x4* xr1 = xr0 + D / 4;
        const u32x2* pa = (const u32x2*)(Pb + (size_t)row * D) + F.lane; const u32x2* ma = (const u32x2*)(Mb + (size_t)row * D) + F.lane;
        f32x4 v0[4], v1[4]; u32x2 p0[4], p1[4], m0[4], m1[4]; float ss0 = 0.f, ss1 = 0.f;
#pragma unroll
        for (int j = 0; j < 4; ++j) { v0[j] = xr0[64 * j]; v1[j] = xr1[64 * j]; p0[j] = pa[64 * j]; p1[j] = pa[64 * j + D / 4]; m0[j] = ma[64 * j]; m1[j] = ma[64 * j + D / 4]; }
#pragma unroll
        for (int j = 0; j < 4; ++j) { v0[j] = v0[j] + gm[j] * bf4_to_f32(p0[j]) + gf[j] * bf4_to_f32(m0[j]); v1[j] = v1[j] + gm[j] * bf4_to_f32(p1[j]) + gf[j] * bf4_to_f32(m1[j]);
            ss0 += (v0[j].x * v0[j].x + v0[j].y * v0[j].y) + (v0[j].z * v0[j].z + v0[j].w * v0[j].w); ss1 += (v1[j].x * v1[j].x + v1[j].y * v1[j].y) + (v1[j].z * v1[j].z + v1[j].w * v1[j].w); }
        const float rstd0 = 1.0f / sqrtf(wave_sum(ss0) * (1.f / D) + EPS), rstd1 = 1.0f / sqrtf(wave_sum(ss1) * (1.f / D) + EPS);
        f32x4* o0 = (f32x4*)(F.out + (size_t)row * D) + F.lane; f32x4* o1 = o0 + D / 4;
#pragma unroll
        for (int j = 0; j < 4; ++j) { o0[64 * j] = v0[j] * rstd0 * g[j]; o1[64 * j] = v1[j] * rstd1 * g[j]; }
    }
}

__global__ void __launch_bounds__(512, 2) mk_fwd(const Args args) {
    extern __shared__ __attribute__((aligned(16))) unsigned char lds[];
    Frame F;
    F.lds = (LAS unsigned char*)lds; F.shm = (char*)lds;
    F.tid = threadIdx.x; F.lane = F.tid & 63; F.wave = __builtin_amdgcn_readfirstlane(F.tid >> 6);
    F.G = 256; { const int bx = blockIdx.x; __builtin_assume(bx >= 0 && bx < 256); F.vcu = (bx % 8) * 32 + bx / 8; }
    for (int u = F.tid; u < (LDS_BYTES - LDSCTL_OFF) / 4; u += 512) ((LAS unsigned*)(F.lds + LDSCTL_OFF))[u] = 0u;
    __syncthreads();
    F.wave_s = __builtin_amdgcn_readfirstlane((int)threadIdx.x >> 6);
#define REFRESH() frame_refresh(F)
    REFRESH();
    unsigned* ctl = (unsigned*)(F.ws + WS_CTL);
    XcdBarrier bar = xcd_barrier_post(ctl + CW_BAR, (volatile LAS unsigned*)(F.lds + MISC_OFF) + 8);

    for (int rep = 0; rep < DUP(0); ++rep) if (PH(0)) phase_p0(F);
    xcd_barrier(bar, F.tid);
    float* XA = (float*)(F.ws + WS_XA);
    for (int l = 0; l < DEPTH; ++l) {
        const float* xin = (l <= 1) ? F.inp(F_X) : XA;
        const float* xbase = (l == 0) ? F.inp(F_X) : XA;
        const float* MODl = (const float*)(F.ws + WS_MOD) + (size_t)l * 4 * 6144;
        REFRESH();
        for (int rep = 0; rep < DUP(1); ++rep) if (PH(1)) { if (l == 0) phase_norm1<false>(F, l, xin); else phase_norm1<true>(F, l, xin); }
        xcd_barrier(bar, F.tid);
        REFRESH();
        for (int rep = 0; rep < DUP(2); ++rep) if (PH(2)) { pg8::DenseOrder S; S.init(T, NPROJ, F.G, (int)blockIdx.x, F.ws + WS_WIN + (size_t)l * 2048 * 1024 * 2, 2048u, G1REP);
          EpiProj E{(bf16_t*)(F.ws + WS_PROJ), (unsigned*)(F.ws + WS_CTL) + CW_KM + l * 128};
          pg8::gemm_phase<EpiProj, pg8::DenseOrder, true>(F.tid, F.lds, (const char*)(F.ws + WS_H), 2048u, 2048u, 1024, S, E); }
        xcd_barrier(bar, F.tid);
        REFRESH();
        for (int rep = 0; rep < DUP(3); ++rep) if (PH(3)) { phase_mixer(F, l, l + 2 * rep); if (rep + 1 < DUP(3)) xcd_barrier(bar, F.tid); }
        xcd_barrier(bar, F.tid);
        REFRESH();
        for (int rep = 0; rep < DUP(4); ++rep) if (PH(4)) phase_ynorm(F, l, (rep + 1 < DUP(4)) ? (bf16_t*)F.out : (bf16_t*)(F.ws + WS_Y));
        xcd_barrier(bar, F.tid);
        REFRESH();
        for (int rep = 0; rep < DUP(5); ++rep) if (PH(5)) { pg8::DenseOrder S; S.init(T, D, F.G, (int)blockIdx.x, F.ws + WS_WOUT + (size_t)l * 1024 * 1024 * 2, 2048u, (l == 0) ? G2REP : 1);
          EpiP E{(bf16_t*)(F.ws + WS_P)};
          pg8::gemm_phase<EpiP, pg8::DenseOrder, true>(F.tid, F.lds, (const char*)(F.ws + WS_Y), 2048u, 2048u, 1024, S, E); }
        xcd_barrier(bar, F.tid);
        REFRESH();
        for (int rep = 0; rep < DUP(6); ++rep) if (PH(6)) phase_norm2_router(F, l, xbase, (unsigned*)(F.ws + WS_CTL) + ((rep + 1 < DUP(6)) ? 32768 + l * NCLS * 64 : CW_CNT + l * NCLS * 64));
        xcd_barrier(bar, F.tid);
        REFRESH();
        const int ntiles = build_tile_table(F, l);
        const LEntry* list = (const LEntry*)(F.ws + WS_LIST); const unsigned* cnt = (const unsigned*)(F.ws + WS_CTL) + CW_CNT + l * NCLS * 64;
        for (int rep = 0; rep < DUP(7); ++rep) if (PH(7)) { MoeUpOrder S{ntiles * 4, F.G, (int)blockIdx.x, (const LAS int*)(F.lds + TT_OFF), (const char*)(F.ws + WS_WGU + (size_t)l * 16 * 512 * 1024 * 2), list, cnt};
          EpiUp E{(bf16_t*)(F.ws + WS_PROJ), list, cnt};
          pg8::gemm_phase<EpiUp, MoeUpOrder, true>(F.tid, F.lds, (const char*)(F.ws + WS_H), 2048u, 2048u, 1024, S, E); }
        xcd_barrier(bar, F.tid);
        REFRESH();
        for (int rep = 0; rep < DUP(8); ++rep) if (PH(8)) { MoeDownOrder S{ntiles * 4, F.G, (int)blockIdx.x, (const LAS int*)(F.lds + TT_OFF), (const char*)(F.ws + WS_WDP + (size_t)l * 24 * 1024 * 512 * 2)};
          EpiDown E{(bf16_t*)(F.ws + WS_M), list, cnt};
          pg8::gemm_phase<EpiDown, MoeDownOrder, true>(F.tid, F.lds, (const char*)(F.ws + WS_PROJ), 1024u, 1024u, 512, S, E); }
        xcd_barrier(bar, F.tid);
    }
        REFRESH();
    for (int rep = 0; rep < DUP(9); ++rep) if (PH(9)) phase_final(F, (DEPTH == 1) ? F.inp(F_X) : XA, DEPTH - 1);
}

extern "C" void kernel_launch(void* const* d_in, const int* in_sizes, int n_in, void* d_out, int out_size, void* d_ws, size_t ws_size, hipStream_t stream) {
    static int grid = 0;
    if (grid == 0) {
        if (n_in != 26 || in_sizes[0] != T * D || out_size != T * D || ws_size < WS_END) { fprintf(stderr, "kernel_launch: unexpected shapes (n_in %d, in0 %d, out %d, ws %zu)\n", n_in, n_in > 0 ? in_sizes[0] : -1, out_size, ws_size); grid = -1; return; }
        int dev = 0, cus = 0, per_cu = 0;
        if (hipGetDevice(&dev) != hipSuccess || hipDeviceGetAttribute(&cus, hipDeviceAttributeMultiprocessorCount, dev) != hipSuccess) { grid = -1; return; }
        if (hipFuncSetAttribute((const void*)mk_fwd, hipFuncAttributeMaxDynamicSharedMemorySize, LDS_BYTES) != hipSuccess) { fprintf(stderr, "kernel_launch: hipFuncSetAttribute failed\n"); grid = -1; return; }
        if (hipOccupancyMaxActiveBlocksPerMultiprocessor(&per_cu, (const void*)mk_fwd, 512, LDS_BYTES) != hipSuccess || per_cu < 1) fprintf(stderr, "kernel_launch: occupancy query reports %d\n", per_cu);
        (void)hipGetLastError();
        if (cus != 256) fprintf(stderr, "kernel_launch: built for 256 CUs, device reports %d\n", cus);
        grid = 256;
    }
    if (grid < 0) return;
    (void)hipMemsetAsync((char*)d_ws + WS_CTL, 0, CTL_ZERO_BYTES, stream);
    Args a{};
    for (int i = 0; i < 26; ++i) a.in[i] = (const float*)d_in[i];
    a.out = (float*)d_out; a.ws = (unsigned char*)d_ws;
    hipLaunchKernelGGL(mk_fwd, dim3(grid), dim3(512), LDS_BYTES, stream, a);
}
```

```cpp
#include <hip/hip_runtime.h>
#include <hip/hip_bf16.h>
#include <cstdio>
#include <cstdint>

#define GAS __attribute__((address_space(1)))
#define LAS __attribute__((address_space(3)))
typedef unsigned short bf16_t;
typedef short bf16x8 __attribute__((ext_vector_type(8)));
typedef short s16x4 __attribute__((ext_vector_type(4)));
typedef float f32x2 __attribute__((ext_vector_type(2)));
typedef float f32x4 __attribute__((ext_vector_type(4)));
typedef float f32x16 __attribute__((ext_vector_type(16)));
typedef unsigned u32x2 __attribute__((ext_vector_type(2)));
typedef unsigned u32x4 __attribute__((ext_vector_type(4)));
typedef __bf16 bf16x2_t __attribute__((ext_vector_type(2)));

#ifndef DUP_MASK
#define DUP_MASK 0x0u
#endif
#define DUP(n) (1 + (int)((DUP_MASK >> (n)) & 1u))
#ifndef G2REP
#define G2REP 1
#endif
#ifndef G1REP
#define G1REP 1
#endif
#ifndef UPREP
#define UPREP 1
#endif
#ifndef PH_MASK
#define PH_MASK 0xFFFFFFFFu
#endif
#define PH(n) ((PH_MASK >> (n)) & 1u)
constexpr int D = 1024, NB = 4, SEQ = 8192, T = NB * SEQ, DEPTH = 2;
constexpr int IN_COLS = 2052, NPROJ = 2048;
constexpr int C_QA = 0, C_KA = 512, C_VA = 640, C_XB = 768, C_GB = 1024, C_QC = 1280, C_KC = 1536, C_VC = 1792;
constexpr int NCLS = 24, LCAP = 32768;
constexpr float EPS = 1e-6f;
constexpr float LOG2E = 1.4426950408889634f;
constexpr float C2 = 0.125f * 1.4426950408889634f;

constexpr size_t MiB = 1u << 20;
constexpr size_t WS_CTL = 0, CTL_ZERO_BYTES = 1 * MiB;
constexpr size_t WS_MOD = 1 * MiB;
constexpr size_t WS_CUM = WS_MOD + 256 * 1024;
constexpr size_t WS_CTOT = WS_CUM + 512 * 1024;
constexpr size_t WS_LRUA = 2 * MiB;
constexpr size_t WS_LRUH = WS_LRUA + 512 * 1024;
constexpr size_t WS_LIST = 4 * MiB;
constexpr size_t WS_WIN = 16 * MiB;
constexpr size_t WS_WOUT = 24 * MiB;
constexpr size_t WS_WGU = 28 * MiB;
constexpr size_t WS_WDP = 60 * MiB;
constexpr size_t WS_XA = 108 * MiB;
constexpr size_t WS_H = 236 * MiB;
constexpr size_t WS_PROJ = 300 * MiB;
constexpr size_t WS_Y = 428 * MiB;
constexpr size_t WS_P = WS_PROJ + 64 * MiB;
constexpr size_t WS_M = WS_Y;
constexpr size_t WS_END = 492 * MiB;
constexpr int CW_BAR = 4096;
constexpr int CW_KM = 20480;
constexpr int CW_Q = 21504;
constexpr int CW_CNT = 16384;

struct LEntry { int tok; float w0, w1; int pad; };

constexpr int RING_BYTES = 131072;
constexpr int LDSCTL_OFF = RING_BYTES;
constexpr int MISC_OFF = LDSCTL_OFF + 320;
constexpr int TT_OFF = LDSCTL_OFF + 1024;
constexpr int LDS_BYTES = 147456;

__device__ __forceinline__ unsigned cvtpk(float lo, float hi) { f32x2 v = {lo, hi}; bf16x2_t b = __builtin_convertvector(v, bf16x2_t); return __builtin_bit_cast(unsigned, b); }
__device__ __forceinline__ float bf2f(bf16_t v) { return __builtin_bit_cast(float, (unsigned)v << 16); }
__device__ __forceinline__ f32x4 bf4_to_f32(u32x2 v) { return (f32x4){__uint_as_float(v.x << 16), __uint_as_float(v.x & 0xffff0000u), __uint_as_float(v.y << 16), __uint_as_float(v.y & 0xffff0000u)}; }
template <int M> __device__ __forceinline__ float shx(float v) {
    return __int_as_float(__builtin_amdgcn_ds_swizzle(__float_as_int(v), (M << 10) | 0x1f));
}
__device__ __forceinline__ float wave_sum(float v) {
    v += shx<1>(v); v += shx<2>(v); v += shx<4>(v); v += shx<8>(v); v += shx<16>(v);
    auto rr = __builtin_amdgcn_permlane32_swap(__float_as_uint(v), __float_as_uint(v), false, false);
    return __uint_as_float(rr[0]) + __uint_as_float(rr[1]);
}
__device__ __forceinline__ float fast_exp(float x) { return __builtin_amdgcn_exp2f(x * LOG2E); }
__device__ __forceinline__ float sigmoidf_(float x) { return __builtin_amdgcn_rcpf(1.f + fast_exp(-x)); }
__device__ __forceinline__ float gelu_tanh(float x) {
    const float u = 0.7978845608028654f * (x + 0.044715f * x * x * x);
    const float e = fast_exp(2.f * u);
    const float th = 1.f - 2.f * __builtin_amdgcn_rcpf(e + 1.f);
    return 0.5f * x * (1.f + th);
}
#define LDS_WAIT() asm volatile("s_waitcnt lgkmcnt(0)" ::: "memory")
#define VM_WAIT() asm volatile("s_waitcnt vmcnt(0)" ::: "memory")

namespace pg8 {
constexpr int BM = 256, BK = 64, HALF = 128, HTB = HALF * BK * 2, STAGE_BYTES = 8 * HTB, NXCD = 8, WGM = 8;
__host__ __device__ __forceinline__ int lds_byte(int r, int c) { const int st = (r >> 4) * 2 + (c >> 5), rr = r & 15, cc = c & 31, ob = rr * 64 + cc * 2; return st * 1024 + (ob ^ (((ob >> 9) & 1) << 5)); }
__host__ __device__ __forceinline__ void stage_rc(int b, int& R, int& C) { const int st = b / 1024, sb = b % 1024, swz = sb ^ (((sb >> 9) & 1) << 5); R = (st >> 1) * 16 + swz / 64; C = (st & 1) * 32 + (swz % 64) / 2; }
__host__ __device__ __forceinline__ int perm32(int rho) { const int n = rho >> 4, i = rho & 15; return 8 * (i >> 2) + 4 * n + (i & 3); }

struct GUnit { int a0; const char* bb; int e0, e1, e2, e3; };

__device__ __forceinline__ int xcd_remap(int L, int nwg) {
    const int q = nwg / NXCD, r = nwg % NXCD, xcd = L % NXCD, off = L / NXCD;
    return (xcd < r ? xcd * (q + 1) : r * (q + 1) + (xcd - r) * q) + off;
}

struct DenseOrder {
    int nM, nN, nwg, G, c, rep; const char* Bt; unsigned pitchB;
    __device__ __forceinline__ void init(int M, int N, int G_, int c_, const void* Bt_, unsigned pitchB_, int rep_ = 1) { nM = M / BM; nN = N / BM; nwg = nM * nN; G = G_; c = c_; Bt = (const char*)Bt_; pitchB = pitchB_; rep = rep_; }
    __device__ __forceinline__ bool next(int i, GUnit& u) const {
        const long L = (long)i * G + c; if (L >= (long)nwg * rep) return false;
        const int wgid = xcd_remap((int)(L % nwg), nwg);
        const int nig = WGM * nN, gid = wgid / nig, fm = gid * WGM, gsz = (nM - fm) < WGM ? (nM - fm) : WGM;
        const int pm = fm + ((wgid % nig) % gsz), pn = (wgid % nig) / gsz;
        u.a0 = pm * BM; u.bb = Bt + (size_t)pn * BM * pitchB; u.e0 = pm; u.e1 = pn; u.e2 = 0; u.e3 = 0; return true;
    }
    __device__ __forceinline__ unsigned arow(const GUnit& u, int r) const { return (unsigned)(u.a0 + r); }
};

#define PG8_SA(b, h) (((b) * 2 + (h)) * HTB)
#define PG8_SB(b, h) ((4 + (b) * 2 + (h)) * HTB)
#define PG8_STG(bufoff, gptr, v0, v1) do { \
        __builtin_amdgcn_global_load_lds((const unsigned*)((const char*)(gptr) + (v0)), (LAS unsigned*)(lds + (bufoff) + ldsw), 16, 0, 0); \
        __builtin_amdgcn_global_load_lds((const unsigned*)((const char*)(gptr) + (v1)), (LAS unsigned*)(lds + (bufoff) + ldsw + 8192), 16, 0, 0); } while (0)
#define PG8_STGA(bufoff, kb, vo) PG8_STG(bufoff, Abase + (kb), (vo)[0], (vo)[1])
#define PG8_STGB(bufoff, bp) PG8_STG(bufoff, bp, voffB[0], voffB[1])
#define PG8_LDA(dst, b, h) do { _Pragma("unroll") for (int m = 0; m < 4; ++m) _Pragma("unroll") for (int k = 0; k < 2; ++k) dst[m][k] = *(const LAS bf16x8*)(lds + PG8_SA(b, h) + aoff + m * 2048 + k * 1024); } while (0)
#define PG8_LDB(dst, b, h) do { _Pragma("unroll") for (int n = 0; n < 2; ++n) _Pragma("unroll") for (int k = 0; k < 2; ++k) dst[n][k] = *(const LAS bf16x8*)(lds + PG8_SB(b, h) + boff + n * 2048 + k * 1024); } while (0)
#define PG8_MMA(ai, bj, At, Bt) do { __builtin_amdgcn_s_setprio(1); _Pragma("unroll") for (int m = 0; m < 4; ++m) _Pragma("unroll") for (int n = 0; n < 2; ++n) _Pragma("unroll") for (int k = 0; k < 2; ++k) \
        acc[ai][bj][m][n] = __builtin_amdgcn_mfma_f32_16x16x32_bf16(Bt[n][k], At[m][k], acc[ai][bj][m][n], 0, 0, 0); __builtin_amdgcn_s_setprio(0); } while (0)
#define PG8_WAIT_V(n) asm volatile("s_waitcnt vmcnt(" #n ")" ::: "memory")
#define PG8_WAIT_L(n) asm volatile("s_waitcnt lgkmcnt(" #n ")" ::: "memory")
#define PG8_BAR __builtin_amdgcn_s_barrier()
#define PG8_SCHED __builtin_amdgcn_sched_barrier(0)

template <class Epi, class Sched, bool ALIGN_EPI>
__device__ __forceinline__ void gemm_phase(const int tid, LAS unsigned char* lds, const char* Abase, unsigned pitchA, unsigned pitchB, int K, const Sched& S, const Epi& E) {
    const int wid = __builtin_amdgcn_readfirstlane(tid >> 6), lane = tid & 63, wr = wid >> 2, wc = wid & 3, fr = lane & 15, fq = lane >> 4;
    const int nt = K / BK;
    int RA[2]; unsigned cA2[2], voffB[2];
#pragma unroll
    for (int i = 0; i < 2; ++i) { int R, C; stage_rc(tid * 16 + i * 8192, R, C); const int Rb = Epi::PERM ? ((R & ~31) + perm32(R & 31)) : R;
        RA[i] = R; cA2[i] = (unsigned)C * 2u; voffB[i] = (unsigned)Rb * pitchB + (unsigned)C * 2u; }
    const unsigned hstepB = (unsigned)HALF * pitchB;
    const unsigned ldsw = (unsigned)wid * 1024u;
    const int aoff = lds_byte(wr * 64 + fr, fq * 8), boff = lds_byte(wc * 32 + fr, fq * 8);
    GUnit cur, nxt; int ui = 0;
    if (!S.next(0, cur)) return;
    f32x4 acc[2][2][4][2];
#pragma unroll
    for (int a = 0; a < 2; ++a)
#pragma unroll
        for (int b = 0; b < 2; ++b)
#pragma unroll
            for (int m = 0; m < 4; ++m)
#pragma unroll
                for (int n = 0; n < 2; ++n) acc[a][b][m][n] = (f32x4){0.f, 0.f, 0.f, 0.f};
    bf16x8 At[4][2], B0[2][2], B1[2][2];
    unsigned voA[2][2];
#pragma unroll
    for (int h = 0; h < 2; ++h)
#pragma unroll
        for (int i = 0; i < 2; ++i) voA[h][i] = S.arow(cur, h * HALF + RA[i]) * pitchA + cA2[i];
    const char* cB = cur.bb;
    const unsigned kstep = BK * 2;
    PG8_STGB(PG8_SB(0, 0), cB); PG8_STGB(PG8_SB(0, 1), cB + hstepB); PG8_STGA(PG8_SA(0, 0), 0, voA[0]); PG8_STGA(PG8_SA(0, 1), 0, voA[1]);
    if (wr == 1) PG8_BAR;
    PG8_WAIT_V(2); PG8_BAR;
    PG8_STGB(PG8_SB(1, 0), cB + kstep); PG8_STGA(PG8_SA(1, 0), kstep, voA[0]); PG8_STGB(PG8_SB(1, 1), cB + hstepB + kstep);
    PG8_WAIT_V(6); PG8_BAR;
    for (;;) {
        const bool has_next = S.next(ui + 1, nxt);
        const char* nB = has_next ? nxt.bb : cB;
        for (int t = 0; t < nt; t += 2) {
            const bool last = (t == nt - 2);
            const unsigned kb1 = (unsigned)(t + 1) * kstep;
            const unsigned kb2 = last ? 0u : (unsigned)(t + 2) * kstep, kb3 = kb2 + kstep;
            const char* b2 = last ? nB : cB + (size_t)(t + 2) * kstep; const char* b3 = b2 + kstep;
            PG8_LDB(B0, 0, 0); PG8_LDB(B1, 0, 1); PG8_SCHED; PG8_LDA(At, 0, 0); PG8_STGA(PG8_SA(1, 1), kb1, voA[1]);
            if (last && has_next) {
#pragma unroll
                for (int h = 0; h < 2; ++h)
#pragma unroll
                    for (int i = 0; i < 2; ++i) voA[h][i] = S.arow(nxt, h * HALF + RA[i]) * pitchA + cA2[i]; }
            PG8_WAIT_V(8); PG8_WAIT_L(0); PG8_BAR; PG8_MMA(0, 0, At, B0); PG8_MMA(0, 1, At, B1); PG8_BAR; PG8_SCHED;
            PG8_LDA(At, 0, 1); PG8_STGB(PG8_SB(0, 0), b2); PG8_STGB(PG8_SB(0, 1), b2 + hstepB); PG8_STGA(PG8_SA(0, 0), kb2, voA[0]);
            PG8_WAIT_V(8); PG8_WAIT_L(0); PG8_BAR; PG8_MMA(1, 0, At, B0); PG8_MMA(1, 1, At, B1); PG8_BAR; PG8_SCHED;
            PG8_LDB(B0, 1, 0); PG8_LDB(B1, 1, 1); PG8_SCHED; PG8_LDA(At, 1, 0); PG8_STGA(PG8_SA(0, 1), kb2, voA[1]);
            PG8_WAIT_V(8); PG8_WAIT_L(0); PG8_BAR; PG8_MMA(0, 0, At, B0); PG8_MMA(0, 1, At, B1); PG8_BAR; PG8_SCHED;
            PG8_LDA(At, 1, 1); PG8_STGB(PG8_SB(1, 0), b3); PG8_STGB(PG8_SB(1, 1), b3 + hstepB); PG8_STGA(PG8_SA(1, 0), kb3, voA[0]);
            PG8_WAIT_V(8); PG8_WAIT_L(0); PG8_BAR; PG8_MMA(1, 0, At, B0); PG8_MMA(1, 1, At, B1); PG8_BAR; PG8_SCHED;
        }
        if constexpr (ALIGN_EPI) { if (wr == 0) PG8_BAR; }
        E(acc, cur, wr, wc, fr, fq);
        if (!has_next) break;
#pragma unroll
        for (int a = 0; a < 2; ++a)
#pragma unroll
            for (int b = 0; b < 2; ++b)
#pragma unroll
                for (int m = 0; m < 4; ++m)
#pragma unroll
                    for (int n = 0; n < 2; ++n) acc[a][b][m][n] = (f32x4){0.f, 0.f, 0.f, 0.f};
        cur = nxt; cB = nB; ++ui;
        if constexpr (ALIGN_EPI) { if (wr == 1) PG8_BAR; }
    }
    PG8_WAIT_V(0);
    if constexpr (!ALIGN_EPI) { if (wr == 0) PG8_BAR; }
    PG8_BAR;
}
}

#define XB_TMO      128
#define XB_XCNT(j)  (256  + 64 * (j))
#define XB_XSUB(j)  (1280 + 64 * (j))
#define XB_XGEN(j)  (2304 + 64 * (j))
#define XB_TOP      3328
#define XB_TOPGEN   3392
#define XCD_BAR_WORDS 3456
#define XB_SPIN_CAP (1u << 18)
__device__ __forceinline__ unsigned xb_ld(unsigned* p)              { return __hip_atomic_load(p, __ATOMIC_RELAXED, __HIP_MEMORY_SCOPE_AGENT); }
__device__ __forceinline__ unsigned xb_add(unsigned* p, unsigned v) { return __hip_atomic_fetch_add(p, v, __ATOMIC_RELAXED, __HIP_MEMORY_SCOPE_AGENT); }
__device__ __forceinline__ unsigned xb_xcc_id() { return (unsigned)__builtin_amdgcn_s_getreg((3 << 11) | 20) & 0xFu; }
#define XB_SPIN(cond, bar) do { unsigned _sp = 0; while (cond) { __builtin_amdgcn_s_sleep(1); \
    if ((++_sp & 255u) == 0u) { if (xb_ld(&(bar)[XB_TMO])) break; if (_sp > XB_SPIN_CAP) { atomicAdd(&(bar)[XB_TMO], 1u); break; } } } } while (0)
struct XcdBarrier { unsigned* bar; unsigned x; volatile LAS unsigned* st; };
__device__ __forceinline__ XcdBarrier xcd_barrier_post(unsigned* bar, volatile LAS unsigned* st) {
    XcdBarrier b; b.bar = bar; b.x = xb_xcc_id(); b.st = st;
    if (threadIdx.x == 0) (void)xb_add(&bar[XB_XCNT(b.x)], 1u);
    return b;
}
__device__ __forceinline__ void xcd_barrier_complete(unsigned* bar, unsigned x, unsigned& nloc, unsigned& nx) {
    const unsigned G = gridDim.x * gridDim.y * gridDim.z;
    unsigned sum, cnt, mine, sp = 0u;
    for (;;) {
        sum = 0u; cnt = 0u; mine = 0u;
#pragma unroll
        for (unsigned j = 0; j < 16; ++j) { const unsigned c = xb_ld(&bar[XB_XCNT(j)]); sum += c; cnt += (c > 0u) ? 1u : 0u; mine = (j == x) ? c : mine; }
        if (sum == G) break;
        __builtin_amdgcn_s_sleep(1);
        if ((++sp & 255u) == 0u) { if (xb_ld(&bar[XB_TMO])) break; if (sp > XB_SPIN_CAP) { atomicAdd(&bar[XB_TMO], 1u); break; } }
    }
    nloc = mine > 0u ? mine : 1u; nx = cnt > 0u ? cnt : 1u;
}
__device__ __forceinline__ void xcd_barrier(const XcdBarrier& b, const int tid) {
    asm volatile("s_waitcnt vmcnt(0)" ::: "memory");
    __syncthreads();
    if (tid == 0) {
        unsigned* bar = b.bar; const unsigned bx_ = xb_xcc_id();
        __builtin_amdgcn_s_waitcnt(0);
        unsigned nloc = b.st[0], nx = b.st[1];
        if (nloc == 0u) { xcd_barrier_complete(bar, bx_, nloc, nx); b.st[0] = nloc; b.st[1] = nx; }
        const unsigned old = xb_add(&bar[XB_XSUB(bx_)], 1u);
        const unsigned gen = old / nloc;
        if (old + 1u == (gen + 1u) * nloc) {
            __builtin_amdgcn_fence(__ATOMIC_RELEASE, "agent");
            asm volatile("s_waitcnt vmcnt(0)" ::: "memory");
            const unsigned og = xb_add(&bar[XB_TOP], 1u);
            const unsigned tg = og / nx;
            if (og + 1u == (tg + 1u) * nx) xb_add(&bar[XB_TOPGEN], 1u);
            else XB_SPIN(xb_ld(&bar[XB_TOPGEN]) == tg, bar);
            __builtin_amdgcn_fence(__ATOMIC_ACQUIRE, "agent");
            xb_add(&bar[XB_XGEN(bx_)], 1u);
            asm volatile("s_waitcnt vmcnt(0)" ::: "memory");
        } else {
            XB_SPIN(xb_ld(&bar[XB_XGEN(bx_)]) == gen, bar);
            __builtin_amdgcn_fence(__ATOMIC_ACQUIRE, "agent");
            asm volatile("s_waitcnt vmcnt(0)" ::: "memory");
        }
    }
    __syncthreads();
}

__device__ __forceinline__ const void* launder_ptr(const void* p) {
    unsigned lo = (unsigned)(uintptr_t)p, hi = (unsigned)((uintptr_t)p >> 32);
    asm volatile("" : "+v"(lo), "+v"(hi));
    lo = __builtin_amdgcn_readfirstlane(lo); hi = __builtin_amdgcn_readfirstlane(hi);
    return (const void*)(((uintptr_t)hi << 32) | (uintptr_t)lo);
}
struct Args { const float* in[26]; float* out; unsigned char* ws; };

__device__ __forceinline__ const void* karg_ptr(int idx) {
    const unsigned long long ka = (unsigned long long)__builtin_amdgcn_kernarg_segment_ptr();
    unsigned long long v; asm volatile("s_load_dwordx2 %0, %1, %2\n\ts_waitcnt lgkmcnt(0)" : "=s"(v) : "s"(ka), "s"(idx * 8) : "memory");
    return (const void*)(GAS const void*)(uintptr_t)v;
}
struct Frame {
    LAS unsigned char* lds; char* shm;
    int tid, lane, wave, vcu, G;
    float* out; unsigned char* ws; int wave_s;
    __device__ __forceinline__ const float* inp(int i) const { return (const float*)karg_ptr(i); }
};
__device__ __forceinline__ void frame_refresh(Frame& F) {
    asm volatile("" ::: "memory");
    int t_; asm volatile("v_mbcnt_lo_u32_b32 %0, -1, 0\n\tv_mbcnt_hi_u32_b32 %0, -1, %0" : "=v"(t_)); t_ |= (F.wave_s << 6);
    F.tid = t_; F.lane = t_ & 63; F.wave = __builtin_amdgcn_readfirstlane(t_ >> 6);
    F.out = (float*)karg_ptr(26); F.ws = (unsigned char*)karg_ptr(27);
}
#define F_X 0
#define F_C 1
#define F_WMOD 2
#define F_BMOD 3
#define F_NMIX 4
#define F_NFFN 5
#define F_WIN 6
#define F_WOUT 7
#define F_OGAIN 8
#define F_SINKS 9
#define F_CONVW 10
#define F_CONVB 11
#define F_LWA 12
#define F_LBA 13
#define F_LWX 14
#define F_LBX 15
#define F_LAM 16
#define F_FOXB 17
#define F_WRG 18
#define F_BRG 19
#define F_WRE 20
#define F_BRE 21
#define F_WGATE 22
#define F_WUP 23
#define F_WDOWN 24
#define F_NFIN 25

struct EpiProj {
    static constexpr bool PERM = true;
    bf16_t* O; unsigned* km;
    __device__ __forceinline__ void operator()(const f32x4 (&acc)[2][2][4][2], const pg8::GUnit& u, int wr, int wc, int fr, int fq) const {
        const int row0 = u.e0 * 256 + wr * 64 + fr, pn = u.e1;
        const float sc = (pn == 0 || pn == 1 || pn == 5) ? C2 : 1.f;
        const int col0 = pn * 256 + wc * 32 + 8 * fq;
#pragma unroll
        for (int ai = 0; ai < 2; ++ai)
#pragma unroll
            for (int m = 0; m < 4; ++m) { bf16_t* rowp = O + (size_t)(row0 + ai * 128 + m * 16) * NPROJ + col0;
#pragma unroll
                for (int bj = 0; bj < 2; ++bj) { const f32x4 v0 = acc[ai][bj][m][0] * sc, v1 = acc[ai][bj][m][1] * sc;
                    u32x4 w; w.x = cvtpk(v0[0], v0[1]); w.y = cvtpk(v0[2], v0[3]); w.z = cvtpk(v1[0], v1[1]); w.w = cvtpk(v1[2], v1[3]);
                    *(u32x4*)(rowp + bj * 128) = w; } }
        if (pn == 6) {
            const int b = u.e0 >> 5;
#pragma unroll
            for (int bj = 0; bj < 2; ++bj) { float mx = 0.f;
#pragma unroll
                for (int ai = 0; ai < 2; ++ai)
#pragma unroll
                    for (int m = 0; m < 4; ++m) { const f32x4 v0 = acc[ai][bj][m][0], v1 = acc[ai][bj][m][1];
                        mx = __builtin_fmaxf(mx, (v0[0] * v0[0] + v0[1] * v0[1]) + (v0[2] * v0[2] + v0[3] * v0[3]) + (v1[0] * v1[0] + v1[1] * v1[1]) + (v1[2] * v1[2] + v1[3] * v1[3])); }
                mx = __builtin_fmaxf(mx, shx<1>(mx)); mx = __builtin_fmaxf(mx, shx<2>(mx)); mx = __builtin_fmaxf(mx, shx<4>(mx)); mx = __builtin_fmaxf(mx, shx<8>(mx));
                if (fr == 0) atomicMax(km + ((b * 4 + 2 * bj + (wc >> 1)) * 8 + 4 * (wc & 1) + fq), __float_as_uint(mx)); }
        }
    }
};
struct EpiP {
    static constexpr bool PERM = true;
    bf16_t* P;
    __device__ __forceinline__ void operator()(const f32x4 (&acc)[2][2][4][2], const pg8::GUnit& u, int wr, int wc, int fr, int fq) const {
        const int row0 = u.e0 * 256 + wr * 64 + fr, col0 = u.e1 * 256 + wc * 32 + 8 * fq;
#pragma unroll
        for (int ai = 0; ai < 2; ++ai)
#pragma unroll
            for (int m = 0; m < 4; ++m) { bf16_t* rowp = P + (size_t)(row0 + ai * 128 + m * 16) * D + col0;
#pragma unroll
                for (int bj = 0; bj < 2; ++bj) { const f32x4 v0 = acc[ai][bj][m][0], v1 = acc[ai][bj][m][1];
                    u32x4 w; w.x = cvtpk(v0[0], v0[1]); w.y = cvtpk(v0[2], v0[3]); w.z = cvtpk(v1[0], v1[1]); w.w = cvtpk(v1[2], v1[3]);
                    *(u32x4*)(rowp + bj * 128) = w; } }
    }
};
struct EpiUp {
    static constexpr bool PERM = true;
    bf16_t* HID; const LEntry* list; const unsigned* cnt;
    __device__ __forceinline__ void operator()(const f32x4 (&acc)[2][2][4][2], const pg8::GUnit& u, int wr, int wc, int fr, int fq) const {
        const int pn = u.e1, slot = pn >> 1, pnl = pn & 1, cls = u.e2;
        const unsigned n = __hip_atomic_load(cnt + 64 * cls, __ATOMIC_RELAXED, __HIP_MEMORY_SCOPE_AGENT);
        const int colh = 256 * slot + 128 * pnl + wc * 32 + 8 * fq;
        float wrow[8];
#pragma unroll
        for (int k = 0; k < 8; ++k) { const int r = (k >> 2) * 128 + wr * 64 + (k & 3) * 16 + fr; const unsigned pos = (unsigned)(u.e3 + r);
            const LEntry* e = list + (size_t)cls * LCAP + (pos < n ? pos : 0u); const float w = slot ? e->w1 : e->w0; wrow[k] = pos < n ? w : 0.f; }
#pragma unroll
        for (int ai = 0; ai < 2; ++ai)
#pragma unroll
            for (int m = 0; m < 4; ++m) { const int r = ai * 128 + wr * 64 + m * 16 + fr; const float w = wrow[ai * 4 + m];
                float h[8];
#pragma unroll
                for (int nn = 0; nn < 2; ++nn)
#pragma unroll
                    for (int i = 0; i < 4; ++i) { const float g = acc[ai][0][m][nn][i], up = acc[ai][1][m][nn][i]; h[nn * 4 + i] = g * sigmoidf_(g) * up * w; }
                u32x4 o; o.x = cvtpk(h[0], h[1]); o.y = cvtpk(h[2], h[3]); o.z = cvtpk(h[4], h[5]); o.w = cvtpk(h[6], h[7]);
                *(u32x4*)(HID + (size_t)(u.e0 * 256 + r) * 512 + colh) = o; }
    }
};
struct EpiDown {
    static constexpr bool PERM = true;
    bf16_t* M; const LEntry* list; const unsigned* cnt;
    __device__ __forceinline__ void operator()(const f32x4 (&acc)[2][2][4][2], const pg8::GUnit& u, int wr, int wc, int fr, int fq) const {
        const int cls = u.e2, col0 = u.e1 * 256 + wc * 32 + 8 * fq;
        const unsigned n = __hip_atomic_load(cnt + 64 * cls, __ATOMIC_RELAXED, __HIP_MEMORY_SCOPE_AGENT);
        int tok[8];
#pragma unroll
        for (int k = 0; k < 8; ++k) { const int r = (k >> 2) * 128 + wr * 64 + (k & 3) * 16 + fr; const unsigned pos = (unsigned)(u.e3 + r);
            const int t = list[(size_t)cls * LCAP + (pos < n ? pos : 0u)].tok; tok[k] = pos < n ? t : -1; }
#pragma unroll
        for (int k = 0; k < 8; ++k) { const int ai = k >> 2, m = k & 3;
            if (tok[k] >= 0) { bf16_t* rowp = M + (size_t)tok[k] * D + col0;
#pragma unroll
                for (int bj = 0; bj < 2; ++bj) { const f32x4 v0 = acc[ai][bj][m][0], v1 = acc[ai][bj][m][1];
                    u32x4 w; w.x = cvtpk(v0[0], v0[1]); w.y = cvtpk(v0[2], v0[3]); w.z = cvtpk(v1[0], v1[1]); w.w = cvtpk(v1[2], v1[3]);
                    *(u32x4*)(rowp + bj * 128) = w; } } }
    }
};

__device__ __forceinline__ void pair_of(int p, int& lo, int& hi) { lo = p < 3 ? 0 : (p < 5 ? 1 : 2); hi = p < 3 ? p + 1 : (p < 5 ? p - 1 : 3); }
struct MoeUpOrder {
    int nunits, G, c; const LAS int* tt; const char* WGU; const LEntry* list; const unsigned* cnt;
    __device__ __forceinline__ bool next(int i, pg8::GUnit& u) const {
        const long L = (long)i * G + c; if (L >= (long)nunits * UPREP) return false;
        const int wgid = pg8::xcd_remap((int)(L % nunits), nunits); const int tile = wgid >> 2, pn = wgid & 3; const int e = tt[tile];
        const int cls = e & 255; u.e0 = tile; u.e1 = pn; u.e2 = cls; u.e3 = e >> 8; u.a0 = 0;
        int lo, hi; pair_of(cls % 6, lo, hi); const int ex = (cls / 6) * 4 + ((pn >> 1) ? hi : lo);
        u.bb = WGU + ((size_t)ex * 512 + (size_t)(pn & 1) * 256) * 2048; return true;
    }
    __device__ __forceinline__ unsigned arow(const pg8::GUnit& u, int r) const {
        const unsigned n = __hip_atomic_load(cnt + 64 * u.e2, __ATOMIC_RELAXED, __HIP_MEMORY_SCOPE_AGENT); const unsigned pos = (unsigned)(u.e3 + r);
        return (unsigned)list[(size_t)u.e2 * LCAP + (pos < n ? pos : 0u)].tok;
    }
};
struct MoeDownOrder {
    int nunits, G, c; const LAS int* tt; const char* WDP;
    __device__ __forceinline__ bool next(int i, pg8::GUnit& u) const {
        const long L = (long)i * G + c; if (L >= nunits) return false;
        const int wgid = pg8::xcd_remap((int)L, nunits); const int tile = wgid >> 2, pn = wgid & 3; const int e = tt[tile];
        const int cls = e & 255; u.e0 = tile; u.e1 = pn; u.e2 = cls; u.e3 = e >> 8; u.a0 = tile * 256;
        u.bb = WDP + ((size_t)cls * 1024 + (size_t)pn * 256) * 1024; return true;
    }
    __device__ __forceinline__ unsigned arow(const pg8::GUnit& u, int r) const { return (unsigned)(u.a0 + r); }
};

namespace att {
constexpr int DM = NPROJ;
constexpr int SLOTB = 8192;
constexpr int LDS_K = 0, LDS_V = 3 * SLOTB, LDS_WS = 6 * SLOTB, LDS_OST = LDS_WS + 2048, LDS_BIAS = LDS_OST + 8 * 4096, LDS_BLK = LDS_BIAS + 32768, LDS_MM = LDS_BLK + 256  , LDS_QM = LDS_MM + 96  , LDS_END = LDS_QM + 32;
static_assert(LDS_END <= RING_BYTES, "attention LDS");
typedef LAS const char* lds_cptr;
__device__ __forceinline__ int crow(int r, int hi) { return (r & 3) + 8 * (r >> 2) + 4 * hi; }
__device__ __forceinline__ void glds16(const void* gsrc, unsigned lds_dst) { unsigned keep;
    asm volatile("s_mov_b32 %0, m0\n\ts_mov_b32 m0, %2\n\ts_nop 0\n\tglobal_load_lds_dwordx4 %1, off\n\ts_mov_b32 m0, %0" : "=&s"(keep) : "v"(gsrc), "s"(lds_dst) : "memory"); }
__device__ __forceinline__ float max3f(float a, float b, float c) { return __builtin_fmaxf(__builtin_fmaxf(a, b), c); }
#define ATT_WAIT_BAR(N) asm volatile("s_waitcnt vmcnt(" #N ") lgkmcnt(0)\n\ts_barrier" ::: "memory")
typedef short v4i16_t __attribute__((ext_vector_type(4)));
__device__ __forceinline__ s16x4 vtr(lds_cptr p) { return __builtin_bit_cast(s16x4, __builtin_amdgcn_ds_read_tr16_b64_v4i16((LAS v4i16_t*)p)); }
__device__ __forceinline__ float rowmax(const f32x16& p0, const f32x16& p1) {
    float a = max3f(p0[0], p0[1], p1[0]), b = max3f(p0[2], p0[3], p1[1]); a = max3f(a, p1[2], p1[3]);
#pragma unroll
    for (int r = 4; r < 16; r += 4) { a = max3f(a, p0[r], p0[r + 1]); b = max3f(b, p0[r + 2], p0[r + 3]); a = max3f(a, p1[r], p1[r + 1]); b = max3f(b, p1[r + 2], p1[r + 3]); }
    const float m = __builtin_fmaxf(a, b);
    auto rr = __builtin_amdgcn_permlane32_swap(__float_as_uint(m), __float_as_uint(m), false, false);
    return __builtin_fmaxf(__uint_as_float(rr[0]), __uint_as_float(rr[1]));
}
__device__ __forceinline__ void pv(f32x16* o, int vb, bf16x8 pa0, bf16x8 pa1, bf16x8 pa2, bf16x8 pa3) {
#pragma unroll
    for (int d0 = 0; d0 < 2; ++d0) { s16x4 lo[4], hi[4];
#pragma unroll
        for (int ks = 0; ks < 4; ++ks) {
            asm volatile("ds_read_b64_tr_b16 %0,%1 offset:%c2" : "=&v"(lo[ks]) : "v"(vb), "i"(d0 * 4096 + ks * 1024) : "memory");
            asm volatile("ds_read_b64_tr_b16 %0,%1 offset:%c2" : "=&v"(hi[ks]) : "v"(vb), "i"(d0 * 4096 + ks * 1024 + 512) : "memory"); }
        asm volatile("s_waitcnt lgkmcnt(0)" ::: "memory"); __builtin_amdgcn_sched_barrier(0);
#define ATT_PK(k) (bf16x8){lo[k][0], lo[k][1], lo[k][2], lo[k][3], hi[k][0], hi[k][1], hi[k][2], hi[k][3]}
        o[d0] = __builtin_amdgcn_mfma_f32_32x32x16_bf16(pa0, ATT_PK(0), o[d0], 0, 0, 0);
        o[d0] = __builtin_amdgcn_mfma_f32_32x32x16_bf16(pa1, ATT_PK(1), o[d0], 0, 0, 0);
        o[d0] = __builtin_amdgcn_mfma_f32_32x32x16_bf16(pa2, ATT_PK(2), o[d0], 0, 0, 0);
        o[d0] = __builtin_amdgcn_mfma_f32_32x32x16_bf16(pa3, ATT_PK(3), o[d0], 0, 0, 0);
#undef ATT_PK
    }
}
template <int MODE>
__device__ __forceinline__ void attn_core(char* shm, const bf16_t* Qw, const bf16_t* Kh, const bf16_t* Vh, bf16_t* Ow, int q0, const int qw0, int t_lo, int t_hi, const int bias_off, float sinkl2, float slope2, const int tid, const float kn2 = 0.f) {
    const int lane = tid & 63, r32 = lane & 31, hi = lane >> 5; const int wid = __builtin_amdgcn_readfirstlane(tid >> 6);
    const unsigned lds0 = (unsigned)(uintptr_t)shm;
    float* wsf = (float*)(shm + LDS_WS) + wid * 64;
    const lds_cptr shm3 = (lds_cptr)shm;
    const bf16_t* ksrc = Kh + (long)lane * DM + wid * 8;
    const bf16_t* vsrc = Vh + (long)(16 * (wid & 3) + (lane >> 2)) * DM + (wid >> 2) * 32 + (lane & 3) * 8;
    const unsigned kdst = lds0 + LDS_K + wid * 1024, vdst = lds0 + LDS_V + wid * 1024;
#define ATT_DMA_K(t, slot) glds16(ksrc + (long)(t) * 64 * DM, (unsigned)__builtin_amdgcn_readfirstlane(kdst + (slot)))
#define ATT_DMA_V(t, slot) glds16(vsrc + (long)(t) * 64 * DM, (unsigned)__builtin_amdgcn_readfirstlane(vdst + (slot)))
    const int vb0 = (int)(lds0 + LDS_V) + ((lane >> 4) & 1) * 32 + (lane & 3) * 8 + (4 * hi + ((lane & 15) >> 2)) * 64;
    const int n = t_hi - t_lo + 1;
    const int w_hi = (qw0 + 31) >> 6;
    const int w_lo = (MODE == 1) ? ((qw0 - 127 > 0 ? qw0 - 127 : 0) >> 6) : t_lo;
    bf16x8 qr[4];
#pragma unroll
    for (int d0 = 0; d0 < 4; ++d0) qr[d0] = *reinterpret_cast<const bf16x8*>(&Qw[(long)r32 * DM + d0 * 16 + hi * 8]);
    ATT_DMA_K(t_hi, 0); ATT_DMA_V(t_hi, 0);
    if (n > 1) { ATT_DMA_K(t_hi - 1, SLOTB); ATT_DMA_V(t_hi - 1, SLOTB); }
    LAS float* mmp = (LAS float*)(shm3 + LDS_MM); LAS float* qmp = (LAS float*)(shm3 + LDS_QM);
    if (MODE == 0) {
        float qs = 0.f;
#pragma unroll
        for (int d0 = 0; d0 < 4; ++d0)
#pragma unroll
            for (int e = 0; e < 8; ++e) { const float v = bf2f((bf16_t)qr[d0][e]); qs += v * v; }
        { auto rr = __builtin_amdgcn_permlane32_swap(__float_as_uint(qs), __float_as_uint(qs), false, false); qs = __uint_as_float(rr[0]) + __uint_as_float(rr[1]); }
        qs = __builtin_fmaxf(qs, shx<1>(qs)); qs = __builtin_fmaxf(qs, shx<2>(qs)); qs = __builtin_fmaxf(qs, shx<4>(qs)); qs = __builtin_fmaxf(qs, shx<8>(qs)); qs = __builtin_fmaxf(qs, shx<16>(qs));
        if (lane == 0) { qmp[wid] = qs; mmp[wid] = -1e30f; mmp[8 + wid] = -1e30f; mmp[16 + wid] = -1e30f; }
    }
    float bqk = 0.f;
    float mhat = 0.f, l_reg = 0.f; f32x16 o[2]; o[0] = f32x16{}; o[1] = f32x16{}; bool first = true;
    float ex[32]; bool pend = false;
#pragma unroll
    for (int r = 0; r < 32; ++r) ex[r] = 0.f;
    const int q = qw0 + r32;
    const int grp = wid >> 2;
#define ATT_LBAR() asm volatile("s_waitcnt lgkmcnt(0)\n\ts_barrier" ::: "memory")
#define ATT_ISSUE(i2) do { if ((i2) < n) { const int sl_ = ((i2) % 3) * SLOTB; ATT_DMA_K(t_hi - (i2), sl_); ATT_DMA_V(t_hi - (i2), sl_); } } while (0)
    if (grp == 1) { if (n > 1) { ATT_WAIT_BAR(2); } else { ATT_WAIT_BAR(0); } }
#pragma unroll 1
    for (int ti = 0; ti < n; ++ti) {
        const int t = t_hi - ti, sl_cur = (ti % 3) * SLOTB;
        const bool need = (t >= w_lo && t <= w_hi);
        if (MODE == 0 && ti >= 2 && (ti & 3) == 2) {
            if (ti == 2) { const f32x4 qa = *(const LAS f32x4*)qmp, qb_ = *(const LAS f32x4*)(qmp + 4);
                const float qn2 = __builtin_fmaxf(__builtin_fmaxf(__builtin_fmaxf(qa[0], qa[1]), __builtin_fmaxf(qa[2], qa[3])), __builtin_fmaxf(__builtin_fmaxf(qb_[0], qb_[1]), __builtin_fmaxf(qb_[2], qb_[3])));
                bqk = __int_as_float(__builtin_amdgcn_readfirstlane(__float_as_int(sqrtf(qn2 * kn2) * 1.02f + 1.0f))); }
            const LAS float* mp = mmp + ((ti - 2) % 3) * 8; const f32x4 ma = *(const LAS f32x4*)mp, mb = *(const LAS f32x4*)(mp + 4);
            const float mm = __builtin_fminf(__builtin_fminf(__builtin_fminf(ma[0], ma[1]), __builtin_fminf(ma[2], ma[3])), __builtin_fminf(__builtin_fminf(mb[0], mb[1]), __builtin_fminf(mb[2], mb[3])));
            const float bmax = *((const LAS float*)(shm3 + LDS_BIAS) + (t - t_lo) * 64 + 63);
            if (__builtin_amdgcn_readfirstlane((int)(bqk + bmax < mm - 160.f))) break;
        }
        if (grp == 0) { if (ti + 1 < n) { ATT_WAIT_BAR(2); } else { ATT_WAIT_BAR(0); } }
        else { ATT_LBAR(); ATT_ISSUE(ti + 2); }
        f32x16 p0, p1;
        if (need) {
            { const LAS float* bp = (const LAS float*)(shm3 + LDS_BIAS) + bias_off + (t - t_lo) * 64 + 4 * hi;
#pragma unroll
              for (int jj = 0; jj < 4; ++jj) { const f32x4 a = *(const LAS f32x4*)(bp + 8 * jj), b = *(const LAS f32x4*)(bp + 32 + 8 * jj);
                  p0[4 * jj] = a[0] - mhat; p0[4 * jj + 1] = a[1] - mhat; p0[4 * jj + 2] = a[2] - mhat; p0[4 * jj + 3] = a[3] - mhat;
                  p1[4 * jj] = b[0] - mhat; p1[4 * jj + 1] = b[1] - mhat; p1[4 * jj + 2] = b[2] - mhat; p1[4 * jj + 3] = b[3] - mhat; } }
            { const lds_cptr kb = shm3 + LDS_K + sl_cur + hi * 1024 + r32 * 16;
              bf16x8 kf0[4], kf1[4];
#pragma unroll
              for (int d0 = 0; d0 < 4; ++d0) { kf0[d0] = *(const LAS bf16x8*)(kb + d0 * 2048); kf1[d0] = *(const LAS bf16x8*)(kb + d0 * 2048 + 512); }
              float sacc = 0.f;
#define ATT_QS4(B) do { sacc += ex[B]; sacc += ex[B + 1]; sacc += ex[B + 2]; sacc += ex[B + 3]; asm volatile("" : "+v"(sacc)); __builtin_amdgcn_sched_barrier(0); } while (0)
              p0 = __builtin_amdgcn_mfma_f32_32x32x16_bf16(kf0[0], qr[0], p0, 0, 0, 0); ATT_QS4(0);
              p1 = __builtin_amdgcn_mfma_f32_32x32x16_bf16(kf1[0], qr[0], p1, 0, 0, 0); ATT_QS4(4);
              p0 = __builtin_amdgcn_mfma_f32_32x32x16_bf16(kf0[1], qr[1], p0, 0, 0, 0); ATT_QS4(8);
              p1 = __builtin_amdgcn_mfma_f32_32x32x16_bf16(kf1[1], qr[1], p1, 0, 0, 0); ATT_QS4(12);
              p0 = __builtin_amdgcn_mfma_f32_32x32x16_bf16(kf0[2], qr[2], p0, 0, 0, 0); ATT_QS4(16);
              p1 = __builtin_amdgcn_mfma_f32_32x32x16_bf16(kf1[2], qr[2], p1, 0, 0, 0); ATT_QS4(20);
              p0 = __builtin_amdgcn_mfma_f32_32x32x16_bf16(kf0[3], qr[3], p0, 0, 0, 0); ATT_QS4(24);
              p1 = __builtin_amdgcn_mfma_f32_32x32x16_bf16(kf1[3], qr[3], p1, 0, 0, 0); ATT_QS4(28);
#undef ATT_QS4
              if (pend) { l_reg += sacc; pend = false; } }
            const float NEG = -__builtin_inff();
            if (MODE == 0) { if (t == w_hi) { const int kb_ = 64 * t + 4 * hi;
#pragma unroll
                for (int r = 0; r < 16; ++r) { const int kv = kb_ + (r & 3) + 8 * (r >> 2); if (kv > q) p0[r] = NEG; if (kv + 32 > q) p1[r] = NEG; } } }
            else { const int kb_ = 64 * t + 4 * hi;
#pragma unroll
                for (int r = 0; r < 16; ++r) { const int kv = kb_ + (r & 3) + 8 * (r >> 2); if ((unsigned)(q - kv) >= 128u) p0[r] = NEG; if ((unsigned)(q - kv - 32) >= 128u) p1[r] = NEG; } }
            const float rm = rowmax(p0, p1);
            if (first || __any(rm > 8.f)) {
                const float dl = first ? __builtin_fmaxf(rm, -1e30f) : __builtin_fmaxf(rm, 0.f); const float f = first ? 1.f : __builtin_amdgcn_exp2f(-dl);
                first = false; mhat += dl; l_reg *= f; if (hi == 0) wsf[r32] = f;
#pragma unroll
                for (int r = 0; r < 16; ++r) { p0[r] -= dl; p1[r] -= dl; }
                asm volatile("s_waitcnt lgkmcnt(0)" ::: "memory");
#pragma unroll
                for (int jj = 0; jj < 4; ++jj) { const f32x4 fv = *(const f32x4*)(wsf + 8 * jj + 4 * hi);
#pragma unroll
                    for (int i2 = 0; i2 < 4; ++i2) { o[0][4 * jj + i2] *= fv[i2]; o[1][4 * jj + i2] *= fv[i2]; } }
            }
            if (MODE == 0 && (ti & 3) == 0) {
                float mn = mhat; mn = __builtin_fminf(mn, shx<1>(mn)); mn = __builtin_fminf(mn, shx<2>(mn)); mn = __builtin_fminf(mn, shx<4>(mn)); mn = __builtin_fminf(mn, shx<8>(mn)); mn = __builtin_fminf(mn, shx<16>(mn));
                if (lane == 0) mmp[(ti % 3) * 8 + wid] = mn; }
        }
        if (grp == 0) { ATT_LBAR(); ATT_ISSUE(ti + 2); }
        else { if (ti + 1 < n) { if (ti + 2 < n) { ATT_WAIT_BAR(2); } else { ATT_WAIT_BAR(0); } } else { ATT_LBAR(); } }
        if (need) {
            const lds_cptr vp = shm3 + LDS_V + sl_cur + ((lane >> 4) & 1) * 32 + (lane & 3) * 8 + (4 * hi + ((lane & 15) >> 2)) * 64;
#define ATT_SB() __builtin_amdgcn_sched_barrier(0)
#define ATT_PIN(x) asm volatile("" : "+v"(x))
#define ATT_VRD(i) do { vlo[i] = vtr(vp + (((i) >> 2) * 4096 + ((i) & 3) * 1024)); vhi[i] = vtr(vp + (((i) >> 2) * 4096 + ((i) & 3) * 1024 + 512)); } while (0)
#define ATT_VF(i) (bf16x8){vlo[i][0], vlo[i][1], vlo[i][2], vlo[i][3], vhi[i][0], vhi[i][1], vhi[i][2], vhi[i][3]}
#define ATT_PIN4(B) asm volatile("" : "+v"(ex[B]), "+v"(ex[B + 1]), "+v"(ex[B + 2]), "+v"(ex[B + 3]))
#define ATT_EX4(P, PB, B) do { ex[B] = __builtin_amdgcn_exp2f(P[PB]); ex[B + 1] = __builtin_amdgcn_exp2f(P[PB + 1]); ex[B + 2] = __builtin_amdgcn_exp2f(P[PB + 2]); ex[B + 3] = __builtin_amdgcn_exp2f(P[PB + 3]); ATT_PIN4(B); } while (0)
#define ATT_PK4(B) (u32x4){cvtpk(ex[B], ex[B + 1]), cvtpk(ex[B + 2], ex[B + 3]), cvtpk(ex[B + 4], ex[B + 5]), cvtpk(ex[B + 6], ex[B + 7])}
#define ATT_SUM4(B) do { sacc += ex[B]; sacc += ex[B + 1]; sacc += ex[B + 2]; sacc += ex[B + 3]; ATT_PIN(sacc); } while (0)
            s16x4 vlo[8], vhi[8]; u32x4 pw0, pw1, pw2, pw3;
            ATT_VRD(0); ATT_VRD(4);
            ATT_EX4(p0, 0, 0); ATT_EX4(p0, 4, 4); pw0 = ATT_PK4(0); ATT_PIN(pw0); ATT_SB();
            o[0] = __builtin_amdgcn_mfma_f32_32x32x16_bf16(__builtin_bit_cast(bf16x8, pw0), ATT_VF(0), o[0], 0, 0, 0); ATT_VRD(1); ATT_EX4(p0, 8, 8); ATT_SB();
            o[1] = __builtin_amdgcn_mfma_f32_32x32x16_bf16(__builtin_bit_cast(bf16x8, pw0), ATT_VF(4), o[1], 0, 0, 0); ATT_VRD(5); ATT_EX4(p0, 12, 12); pw1 = ATT_PK4(8); ATT_PIN(pw1); ATT_SB();
            o[0] = __builtin_amdgcn_mfma_f32_32x32x16_bf16(__builtin_bit_cast(bf16x8, pw1), ATT_VF(1), o[0], 0, 0, 0); ATT_VRD(2); ATT_EX4(p1, 0, 16); ATT_SB();
            o[1] = __builtin_amdgcn_mfma_f32_32x32x16_bf16(__builtin_bit_cast(bf16x8, pw1), ATT_VF(5), o[1], 0, 0, 0); ATT_VRD(6); ATT_EX4(p1, 4, 20); pw2 = ATT_PK4(16); ATT_PIN(pw2); ATT_SB();
            o[0] = __builtin_amdgcn_mfma_f32_32x32x16_bf16(__builtin_bit_cast(bf16x8, pw2), ATT_VF(2), o[0], 0, 0, 0); ATT_VRD(3); ATT_EX4(p1, 8, 24); ATT_SB();
            o[1] = __builtin_amdgcn_mfma_f32_32x32x16_bf16(__builtin_bit_cast(bf16x8, pw2), ATT_VF(6), o[1], 0, 0, 0); ATT_VRD(7); ATT_EX4(p1, 12, 28); pw3 = ATT_PK4(24); ATT_PIN(pw3); ATT_SB();
            o[0] = __builtin_amdgcn_mfma_f32_32x32x16_bf16(__builtin_bit_cast(bf16x8, pw3), ATT_VF(3), o[0], 0, 0, 0); ATT_SB();
            o[1] = __builtin_amdgcn_mfma_f32_32x32x16_bf16(__builtin_bit_cast(bf16x8, pw3), ATT_VF(7), o[1], 0, 0, 0); ATT_SB();
            pend = true;
#undef ATT_SB
#undef ATT_PIN
#undef ATT_VRD
#undef ATT_VF
#undef ATT_EX4
#undef ATT_PK4
#undef ATT_SUM4
#undef ATT_PIN4
        }
    }
    if (pend) { float sacc = 0.f;
#pragma unroll
        for (int r = 0; r < 32; ++r) sacc += ex[r];
        l_reg += sacc; }
    if (grp == 0) { ATT_LBAR(); }
#undef ATT_LBAR
#undef ATT_ISSUE
    { auto rr = __builtin_amdgcn_permlane32_swap(__float_as_uint(l_reg), __float_as_uint(l_reg), false, false); l_reg = __uint_as_float(rr[0]) + __uint_as_float(rr[1]); }
    if (MODE == 1) l_reg += __builtin_amdgcn_exp2f(sinkl2 + slope2 * (float)(qw0 - q0 + r32) - mhat);
    if (hi == 0) wsf[32 + r32] = l_reg;
    asm volatile("s_waitcnt lgkmcnt(0)" ::: "memory");
    float rli[16];
#pragma unroll
    for (int r = 0; r < 16; ++r) rli[r] = __builtin_amdgcn_rcpf(wsf[32 + crow(r, hi)]);
    { bf16_t* stg = (bf16_t*)(shm + LDS_OST) + wid * 2048;
#pragma unroll
      for (int r = 0; r < 16; ++r) { const int orow = crow(r, hi);
#pragma unroll
          for (int d0 = 0; d0 < 2; ++d0) stg[orow * 64 + d0 * 32 + r32] = (bf16_t)(cvtpk(o[d0][r] * rli[r], 0.f) & 0xffffu); }
      asm volatile("s_waitcnt lgkmcnt(0)" ::: "memory");
#pragma unroll
      for (int i = 0; i < 4; ++i) { const int row = i * 8 + (lane >> 3), ch = lane & 7; const u32x4 v = *(const u32x4*)(stg + row * 64 + ch * 8); *(u32x4*)(Ow + (long)row * D + ch * 8) = v; } }
    asm volatile("s_waitcnt vmcnt(0) lgkmcnt(0)\n\ts_barrier" ::: "memory");
#undef ATT_DMA_K
#undef ATT_DMA_V
}

__device__ __forceinline__ void fox_core(char* shm, const bf16_t* Qw, const bf16_t* Kh, const bf16_t* Vh, bf16_t* Ow, const int n  , const int tid, const float kn2) {
    const int lane = tid & 63, r32 = lane & 31, hi = lane >> 5; const int wid = __builtin_amdgcn_readfirstlane(tid >> 6);
    const unsigned lds0 = (unsigned)(uintptr_t)shm;
    float* wsf = (float*)(shm + LDS_WS) + wid * 64;
    const lds_cptr shm3 = (lds_cptr)shm;
    const int t_hi = n - 1;
#define FX_TILE(j) ((j) < 4 ? (t_hi - 3 + (j)) : (t_hi - (j)))
    const bf16_t* ksrc = Kh + (long)lane * DM + wid * 8;
    const bf16_t* vsrc = Vh + (long)(16 * (wid & 3) + (lane >> 2)) * DM + (wid >> 2) * 32 + (lane & 3) * 8;
    const unsigned kdst = lds0 + LDS_K + wid * 1024, vdst = lds0 + LDS_V + wid * 1024;
#define FX_DMA_K(j, slot) do { const long t_ = FX_TILE(j); glds16(ksrc + t_ * 64 * DM, (unsigned)__builtin_amdgcn_readfirstlane(kdst + (slot))); } while (0)
#define FX_DMA_V(j, slot) do { const long t_ = FX_TILE(j); glds16(vsrc + t_ * 64 * DM, (unsigned)__builtin_amdgcn_readfirstlane(vdst + (slot))); } while (0)
#define FX_WAIT(N) asm volatile("s_waitcnt vmcnt(" #N ") lgkmcnt(0)\n\ts_barrier" ::: "memory")
#define FX_SB() __builtin_amdgcn_sched_barrier(0)
    const lds_cptr kp0 = shm3 + LDS_K + hi * 1024 + r32 * 16;
    const lds_cptr vp0 = shm3 + LDS_V + ((lane >> 4) & 1) * 32 + (lane & 3) * 8 + (4 * hi + ((lane & 15) >> 2)) * 64;
    const int vb0 = (int)(lds0 + LDS_V) + ((lane >> 4) & 1) * 32 + (lane & 3) * 8 + (4 * hi + ((lane & 15) >> 2)) * 64;
    const LAS float* biasl = (const LAS float*)(shm3 + LDS_BIAS) + 4 * hi;
    FX_DMA_K(0, 0); FX_DMA_V(0, 0); FX_DMA_K(1, SLOTB);
    bf16x8 qr[4];
#pragma unroll
    for (int d0 = 0; d0 < 4; ++d0) qr[d0] = *reinterpret_cast<const bf16x8*>(&Qw[(long)r32 * DM + d0 * 16 + hi * 8]);
    LAS float* mmp = (LAS float*)(shm3 + LDS_MM); LAS float* qmp = (LAS float*)(shm3 + LDS_QM);
    { float qs = 0.f;
#pragma unroll
      for (int d0 = 0; d0 < 4; ++d0)
#pragma unroll
          for (int e = 0; e < 8; ++e) { const float v = bf2f((bf16_t)qr[d0][e]); qs += v * v; }
      { auto rr = __builtin_amdgcn_permlane32_swap(__float_as_uint(qs), __float_as_uint(qs), false, false); qs = __uint_as_float(rr[0]) + __uint_as_float(rr[1]); }
      qs = __builtin_fmaxf(qs, shx<1>(qs)); qs = __builtin_fmaxf(qs, shx<2>(qs)); qs = __builtin_fmaxf(qs, shx<4>(qs)); qs = __builtin_fmaxf(qs, shx<8>(qs)); qs = __builtin_fmaxf(qs, shx<16>(qs));
      if (lane == 0) { qmp[wid] = qs; mmp[wid] = -1e30f; mmp[8 + wid] = -1e30f; mmp[16 + wid] = -1e30f; } }
    float mhat = 0.f, l_reg = 0.f; f32x16 o[2]; o[0] = f32x16{}; o[1] = f32x16{};
    const int qrel = wid * 32 + r32;
    bool resc = false; float bqk = 0.f;
    f32x16 pA0, pA1, pB0, pB1;
    bf16x8 kf[8];
    int sl_prev = 0, sl_cur = 0, sl_next = SLOTB;
#define FX_ROT() do { sl_prev = sl_cur; sl_cur = sl_next; sl_next = (sl_next == 2 * SLOTB) ? 0 : sl_next + SLOTB; } while (0)
#define FX_CMASK(P0, P1, j) do { const int kb_ = 64 * (j) + 4 * hi; const float NEG_ = -__builtin_inff(); \
        _Pragma("unroll") for (int r = 0; r < 16; ++r) { const int kv = kb_ + (r & 3) + 8 * (r >> 2); if (kv > qrel) P0[r] = NEG_; if (kv + 32 > qrel) P1[r] = NEG_; } } while (0)
#define FX_KLOAD2(jj, sl) do { kf[2 * (jj)] = *(const LAS bf16x8*)(kp0 + (sl) + (jj) * 2048); kf[2 * (jj) + 1] = *(const LAS bf16x8*)(kp0 + (sl) + (jj) * 2048 + 512); } while (0)
#define FX_MF(a, b, c) __builtin_amdgcn_mfma_f32_32x32x16_bf16(a, b, c, 0, 0, 0)
#define FX_BLD(g, tl) (*(const LAS f32x4*)(biasl + 64 * (tl) + ((g) & 3) * 8 + ((g) >> 2) * 32))
#define FX_BSET(P0, P1, g, v) do { if ((g) < 4) { P0[4 * (g)] = v[0] - mhat; P0[4 * (g) + 1] = v[1] - mhat; P0[4 * (g) + 2] = v[2] - mhat; P0[4 * (g) + 3] = v[3] - mhat; } \
        else { P1[4 * ((g) - 4)] = v[0] - mhat; P1[4 * ((g) - 4) + 1] = v[1] - mhat; P1[4 * ((g) - 4) + 2] = v[2] - mhat; P1[4 * ((g) - 4) + 3] = v[3] - mhat; } } while (0)
    FX_DMA_K(2, 2 * SLOTB);
    { const int t0 = FX_TILE(0);
#pragma unroll
      for (int g = 0; g < 8; ++g) { const f32x4 bv = FX_BLD(g, t0); FX_BSET(pA0, pA1, g, bv); } }
    FX_WAIT(3);
    FX_KLOAD2(0, 0); FX_KLOAD2(1, 0); FX_KLOAD2(2, 0); FX_KLOAD2(3, 0);
    pA0 = FX_MF(kf[0], qr[0], pA0); pA1 = FX_MF(kf[1], qr[0], pA1); pA0 = FX_MF(kf[2], qr[1], pA0); pA1 = FX_MF(kf[3], qr[1], pA1);
    pA0 = FX_MF(kf[4], qr[2], pA0); pA1 = FX_MF(kf[5], qr[2], pA1); pA0 = FX_MF(kf[6], qr[3], pA0); pA1 = FX_MF(kf[7], qr[3], pA1);
    FX_CMASK(pA0, pA1, 0);
    { const float rm = rowmax(pA0, pA1); const float dl = __builtin_fmaxf(rm, -1e30f); mhat += dl;
#pragma unroll
      for (int r = 0; r < 16; ++r) { pA0[r] = __builtin_amdgcn_exp2f(pA0[r] - dl); pA1[r] = __builtin_amdgcn_exp2f(pA1[r] - dl); } }
    { const int t1 = FX_TILE(1);
#pragma unroll
      for (int g = 0; g < 8; ++g) { const f32x4 bv = FX_BLD(g, t1); FX_BSET(pB0, pB1, g, bv); } }
    FX_WAIT(0);
    FX_DMA_K(3, 0); FX_DMA_V(1, SLOTB);
    FX_ROT();
    FX_KLOAD2(0, sl_cur); FX_KLOAD2(1, sl_cur); FX_KLOAD2(2, sl_cur); FX_KLOAD2(3, sl_cur);
    FX_WAIT(2);
    s16x4 vlo[8], vhi[8]; u32x4 pw0, pw1, pw2, pw3; f32x4 bt;
#define FX_PKW(P, B) cvtpk(P[B], P[B + 1])
#define FX_PAF(k) __builtin_bit_cast(bf16x8, pw##k)
#define FX_VFR(i) (bf16x8){vlo[i][0], vlo[i][1], vlo[i][2], vlo[i][3], vhi[i][0], vhi[i][1], vhi[i][2], vhi[i][3]}
#define FX_PIN(x) asm volatile("" : "+v"(x))
#define FX_VRD(i) do { vlo[i] = vtr(vp_ + (((i) >> 2) * 4096 + ((i) & 3) * 1024)); vhi[i] = vtr(vp_ + (((i) >> 2) * 4096 + ((i) & 3) * 1024 + 512)); } while (0)
#define FX_GAPA(MFS, A0, A1, A2, A3, W0, W1, PW) do { MFS; sacc += A0; sacc += A1; sacc += A2; sacc += A3; FX_PIN(sacc); W0; W1; FX_PIN(PW); FX_SB(); } while (0)
#define FX_GAPB(MFS, X, B, GL, N0, N1, g, tl) do { MFS; X[B] = __builtin_amdgcn_exp2f(X[B]); X[B + 1] = __builtin_amdgcn_exp2f(X[B + 1]); X[B + 2] = __builtin_amdgcn_exp2f(X[B + 2]); X[B + 3] = __builtin_amdgcn_exp2f(X[B + 3]); FX_PIN(X); \
        if (GL) { if ((g) > 0) { FX_BSET(N0, N1, (g) - 1, bt); } bt = FX_BLD(g, tl); } FX_SB(); } while (0)
#define FX_STEP(C0, C1, P0, P1, j, MASKED, GK, GV, GL) do { FX_SB(); \
    const lds_cptr vp_ = vp0 + sl_prev; const int tn_ = FX_TILE((j) + 1); \
    FX_VRD(0); FX_SB(); float sacc = (P0[0] + P0[1]); \
    FX_GAPA(C0 = FX_MF(kf[0], qr[0], C0), P0[2], P0[3], P0[4], P0[5],     pw0[0] = FX_PKW(P0, 0),  pw0[1] = FX_PKW(P0, 2),  pw0); \
    FX_VRD(4); FX_SB(); FX_GAPA(C1 = FX_MF(kf[1], qr[0], C1), P0[6], P0[7], P0[8], P0[9],     pw0[2] = FX_PKW(P0, 4),  pw0[3] = FX_PKW(P0, 6),  pw0); \
    FX_VRD(1); FX_SB(); FX_GAPA(C0 = FX_MF(kf[2], qr[1], C0),   P0[10], P0[11], P0[12], P0[13], pw1[0] = FX_PKW(P0, 8),  pw1[1] = FX_PKW(P0, 10), pw1); \
    FX_VRD(5); FX_SB(); FX_GAPA(C1 = FX_MF(kf[3], qr[1], C1),   P0[14], P0[15], P1[0], P1[1],   pw1[2] = FX_PKW(P0, 12), pw1[3] = FX_PKW(P0, 14), pw1); \
    FX_VRD(2); FX_SB(); FX_GAPA(C0 = FX_MF(kf[4], qr[2], C0),   P1[2], P1[3], P1[4], P1[5],     pw2[0] = FX_PKW(P1, 0),  pw2[1] = FX_PKW(P1, 2),  pw2); \
    FX_VRD(6); FX_SB(); FX_GAPA(C1 = FX_MF(kf[5], qr[2], C1),   P1[6], P1[7], P1[8], P1[9],     pw2[2] = FX_PKW(P1, 4),  pw2[3] = FX_PKW(P1, 6),  pw2); \
    FX_VRD(3); FX_SB(); FX_GAPA(C0 = FX_MF(kf[6], qr[3], C0),   P1[10], P1[11], P1[12], P1[13], pw3[0] = FX_PKW(P1, 8),  pw3[1] = FX_PKW(P1, 10), pw3); \
    FX_VRD(7); FX_SB(); FX_GAPA(C1 = FX_MF(kf[7], qr[3], C1),   P1[14], P1[15], 0.f, 0.f,       pw3[2] = FX_PKW(P1, 12), pw3[3] = FX_PKW(P1, 14), pw3); \
    l_reg += sacc; \
    if (GK) { FX_DMA_K((j) + 3, sl_cur); } if (GV) { FX_DMA_V((j) + 1, sl_next); } \
    if (MASKED) { FX_CMASK(C0, C1, j); } \
    { const float rm = rowmax(C0, C1); resc = false; \
      if (__builtin_expect(__any(rm > 8.f), 0)) { const float dl = __builtin_fmaxf(rm, 0.f); mhat += dl; \
        _Pragma("unroll") for (int r = 0; r < 16; ++r) { C0[r] -= dl; C1[r] -= dl; } \
        const float f = __builtin_amdgcn_exp2f(-dl); l_reg *= f; if (hi == 0) wsf[r32] = f; resc = true; } \
      if (((j) & 3) == 0) { float mn = mhat; mn = __builtin_fminf(mn, shx<1>(mn)); mn = __builtin_fminf(mn, shx<2>(mn)); mn = __builtin_fminf(mn, shx<4>(mn)); mn = __builtin_fminf(mn, shx<8>(mn)); mn = __builtin_fminf(mn, shx<16>(mn)); \
        if (lane == 0) mmp[((j) % 3) * 8 + wid] = mn; } } \
    FX_SB(); \
    FX_GAPB(o[0] = FX_MF(FX_PAF(0), FX_VFR(0), o[0]), C0, 0, GL, P0, P1, 0, tn_); \
    FX_GAPB(o[1] = FX_MF(FX_PAF(0), FX_VFR(4), o[1]), C0, 4, GL, P0, P1, 1, tn_); \
    if (GL) { FX_KLOAD2(0, sl_next); FX_SB(); } FX_GAPB(o[0] = FX_MF(FX_PAF(1), FX_VFR(1), o[0]), C0, 8, GL, P0, P1, 2, tn_); \
    if (GL) { FX_KLOAD2(1, sl_next); FX_SB(); } FX_GAPB(o[1] = FX_MF(FX_PAF(1), FX_VFR(5), o[1]), C0, 12, GL, P0, P1, 3, tn_); \
    if (GL) { FX_KLOAD2(2, sl_next); FX_SB(); } FX_GAPB(o[0] = FX_MF(FX_PAF(2), FX_VFR(2), o[0]), C1, 0, GL, P0, P1, 4, tn_); \
    if (GL) { FX_KLOAD2(3, sl_next); FX_SB(); } FX_GAPB(o[1] = FX_MF(FX_PAF(2), FX_VFR(6), o[1]), C1, 4, GL, P0, P1, 5, tn_); \
    FX_GAPB(o[0] = FX_MF(FX_PAF(3), FX_VFR(3), o[0]), C1, 8, GL, P0, P1, 6, tn_); \
    FX_GAPB(o[1] = FX_MF(FX_PAF(3), FX_VFR(7), o[1]), C1, 12, GL, P0, P1, 7, tn_); \
    if (GL) { FX_BSET(P0, P1, 7, bt); } \
    } while (0)
#define FX_CLOSEW(W) do { W; \
        if (resc) { asm volatile("s_waitcnt lgkmcnt(0)" ::: "memory"); \
            _Pragma("unroll") for (int d_ = 0; d_ < 2; ++d_) _Pragma("unroll") for (int r = 0; r < 16; ++r) o[d_][r] *= wsf[crow(r, hi)]; } \
        FX_ROT(); } while (0)
#define FX_CLOSE(j) do { if ((j) + 3 < n) { FX_CLOSEW(FX_WAIT(2)); } else if ((j) + 2 < n) { FX_CLOSEW(FX_WAIT(1)); } else { FX_CLOSEW(FX_WAIT(0)); } } while (0)
#define FX_EXIT_TEST(j) ({ bool stop_ = false; if ((((j) & 3) == 2) && (j) >= 6) { \
        if ((j) == 6) { const f32x4 qa_ = *(const LAS f32x4*)qmp, qb_ = *(const LAS f32x4*)(qmp + 4); \
            const float qn2 = __builtin_fmaxf(__builtin_fmaxf(__builtin_fmaxf(qa_[0], qa_[1]), __builtin_fmaxf(qa_[2], qa_[3])), __builtin_fmaxf(__builtin_fmaxf(qb_[0], qb_[1]), __builtin_fmaxf(qb_[2], qb_[3]))); \
            bqk = __int_as_float(__builtin_amdgcn_readfirstlane(__float_as_int(sqrtf(qn2 * kn2) * 1.02f + 1.0f))); } \
        const LAS float* mp_ = mmp + (((j) - 2) % 3) * 8; const f32x4 ma_ = *(const LAS f32x4*)mp_, mb_ = *(const LAS f32x4*)(mp_ + 4); \
        const float mm_ = __builtin_fminf(__builtin_fminf(__builtin_fminf(ma_[0], ma_[1]), __builtin_fminf(ma_[2], ma_[3])), __builtin_fminf(__builtin_fminf(mb_[0], mb_[1]), __builtin_fminf(mb_[2], mb_[3]))); \
        const float bmax_ = *((const LAS float*)(shm3 + LDS_BIAS) + FX_TILE(j) * 64 + 63); \
        stop_ = __builtin_amdgcn_readfirstlane((int)(bqk + bmax_ < mm_ - 160.f)) != 0; } stop_; })
    FX_STEP(pB0, pB1, pA0, pA1, 1, true, (4 < n), true, true); FX_CLOSE(1);
    FX_STEP(pA0, pA1, pB0, pB1, 2, true, (5 < n), true, true); FX_CLOSE(2);
    FX_STEP(pB0, pB1, pA0, pA1, 3, true, (6 < n), (4 < n), (4 < n)); FX_CLOSE(3);
    int j = 4, nrun = n;
#pragma unroll 1
    for (; j + 4 < nrun; j += 2) {
        FX_STEP(pA0, pA1, pB0, pB1, j, false, true, true, true); FX_CLOSEW(FX_WAIT(2));
        FX_STEP(pB0, pB1, pA0, pA1, j + 1, false, true, true, true); FX_CLOSEW(FX_WAIT(2));
        if (FX_EXIT_TEST(j + 2)) nrun = j + 2;
    }
#pragma unroll 1
    for (; j < nrun; j += 2) {
        FX_STEP(pA0, pA1, pB0, pB1, j, false, (j + 3 < n), (j + 1 < n), (j + 1 < n)); FX_CLOSE(j);
        FX_STEP(pB0, pB1, pA0, pA1, j + 1, false, (j + 4 < n), (j + 2 < n), (j + 2 < n)); FX_CLOSE(j + 1);
    }
    asm volatile("s_waitcnt vmcnt(0)" ::: "memory");
    { float sacc = 0.f;
#pragma unroll
      for (int r = 0; r < 16; ++r) sacc += pB0[r] + pB1[r];
      l_reg += sacc;
      pw0 = (u32x4){FX_PKW(pB0, 0), FX_PKW(pB0, 2), FX_PKW(pB0, 4), FX_PKW(pB0, 6)}; pw1 = (u32x4){FX_PKW(pB0, 8), FX_PKW(pB0, 10), FX_PKW(pB0, 12), FX_PKW(pB0, 14)};
      pw2 = (u32x4){FX_PKW(pB1, 0), FX_PKW(pB1, 2), FX_PKW(pB1, 4), FX_PKW(pB1, 6)}; pw3 = (u32x4){FX_PKW(pB1, 8), FX_PKW(pB1, 10), FX_PKW(pB1, 12), FX_PKW(pB1, 14)};
      FX_SB(); pv(o, vb0 + sl_prev, FX_PAF(0), FX_PAF(1), FX_PAF(2), FX_PAF(3)); }
    { auto rr = __builtin_amdgcn_permlane32_swap(__float_as_uint(l_reg), __float_as_uint(l_reg), false, false); l_reg = __uint_as_float(rr[0]) + __uint_as_float(rr[1]); }
    if (hi == 0) wsf[32 + r32] = l_reg;
    asm volatile("s_waitcnt lgkmcnt(0)" ::: "memory");
    float rli[16];
#pragma unroll
    for (int r = 0; r < 16; ++r) rli[r] = __builtin_amdgcn_rcpf(wsf[32 + crow(r, hi)]);
    { bf16_t* stg = (bf16_t*)(shm + LDS_OST) + wid * 2048;
#pragma unroll
      for (int r = 0; r < 16; ++r) { const int orow = crow(r, hi);
#pragma unroll
          for (int d0 = 0; d0 < 2; ++d0) stg[orow * 64 + d0 * 32 + r32] = (bf16_t)(cvtpk(o[d0][r] * rli[r], 0.f) & 0xffffu); }
      asm volatile("s_waitcnt lgkmcnt(0)" ::: "memory");
#pragma unroll
      for (int i = 0; i < 4; ++i) { const int row = i * 8 + (lane >> 3), ch = lane & 7; const u32x4 v = *(const u32x4*)(stg + row * 64 + ch * 8); *(u32x4*)(Ow + (long)row * D + ch * 8) = v; } }
    asm volatile("s_waitcnt lgkmcnt(0)\n\ts_barrier" ::: "memory");
#undef FX_TILE
#undef FX_DMA_K
#undef FX_DMA_V
#undef FX_WAIT
#undef FX_SB
#undef FX_ROT
#undef FX_CMASK
#undef FX_KLOAD2
#undef FX_MF
#undef FX_BLD
#undef FX_BSET
#undef FX_PKW
#undef FX_PAF
#undef FX_VFR
#undef FX_PIN
#undef FX_VRD
#undef FX_GAPA
#undef FX_GAPB
#undef FX_STEP
#undef FX_CLOSEW
#undef FX_CLOSE
#undef FX_EXIT_TEST
}

__device__ __forceinline__ void swa_core(char* shm, const bf16_t* Qw, const bf16_t* Kh, const bf16_t* Vh, bf16_t* Ow, const int q0, const int qw0, const int t_lo, const int t_hi, const int bias_off, const float sinkl2, const float slope2, const int tid) {
    const int lane = tid & 63, r32 = lane & 31, hi = lane >> 5; const int wid = __builtin_amdgcn_readfirstlane(tid >> 6);
    const unsigned lds0 = (unsigned)(uintptr_t)shm;
    float* wsf = (float*)(shm + LDS_WS) + wid * 64;
    const lds_cptr shm3 = (lds_cptr)shm;
    const bf16_t* ksrc = Kh + (long)lane * DM + wid * 8;
    const bf16_t* vsrc = Vh + (long)(16 * (wid & 3) + (lane >> 2)) * DM + (wid >> 2) * 32 + (lane & 3) * 8;
    const unsigned kdst = lds0 + LDS_K + wid * 1024, vdst = lds0 + LDS_V + wid * 1024;
#pragma unroll
    for (int i = 0; i < 3; ++i) { const long t_ = (t_hi - i) < 0 ? 0 : (t_hi - i);
        glds16(ksrc + t_ * 64 * DM, (unsigned)__builtin_amdgcn_readfirstlane(kdst + i * SLOTB)); glds16(vsrc + t_ * 64 * DM, (unsigned)__builtin_amdgcn_readfirstlane(vdst + i * SLOTB)); }
    const lds_cptr kp0 = shm3 + LDS_K + hi * 1024 + r32 * 16;
    const lds_cptr vp0 = shm3 + LDS_V + ((lane >> 4) & 1) * 32 + (lane & 3) * 8 + (4 * hi + ((lane & 15) >> 2)) * 64;
    const int vb0 = (int)(lds0 + LDS_V) + ((lane >> 4) & 1) * 32 + (lane & 3) * 8 + (4 * hi + ((lane & 15) >> 2)) * 64;
    const LAS float* biasl = (const LAS float*)(shm3 + LDS_BIAS) + bias_off + 4 * hi;
    bf16x8 qr[4];
#pragma unroll
    for (int d0 = 0; d0 < 4; ++d0) qr[d0] = *reinterpret_cast<const bf16x8*>(&Qw[(long)r32 * DM + d0 * 16 + hi * 8]);
    float mhat = 0.f, l_reg = 0.f; f32x16 o[2]; o[0] = f32x16{}; o[1] = f32x16{};
    const int q = qw0 + r32;
    bool resc = false;
    f32x16 pA0, pA1, pB0, pB1;
    bf16x8 kf[8];
#define SW_SB() __builtin_amdgcn_sched_barrier(0)
#define SW_MF(a, b, c) __builtin_amdgcn_mfma_f32_32x32x16_bf16(a, b, c, 0, 0, 0)
#define SW_KLOAD2(jj, sl) do { kf[2 * (jj)] = *(const LAS bf16x8*)(kp0 + (sl) + (jj) * 2048); kf[2 * (jj) + 1] = *(const LAS bf16x8*)(kp0 + (sl) + (jj) * 2048 + 512); } while (0)
#define SW_BLD(g, tl) (*(const LAS f32x4*)(biasl + 64 * (tl) + ((g) & 3) * 8 + ((g) >> 2) * 32))
#define SW_BSET(P0, P1, g, v) do { if ((g) < 4) { P0[4 * (g)] = v[0] - mhat; P0[4 * (g) + 1] = v[1] - mhat; P0[4 * (g) + 2] = v[2] - mhat; P0[4 * (g) + 3] = v[3] - mhat; } \
        else { P1[4 * ((g) - 4)] = v[0] - mhat; P1[4 * ((g) - 4) + 1] = v[1] - mhat; P1[4 * ((g) - 4) + 2] = v[2] - mhat; P1[4 * ((g) - 4) + 3] = v[3] - mhat; } } while (0)
#define SW_MASK(P0, P1, t) do { const int kb_ = 64 * (t) + 4 * hi; const float NEG_ = -__builtin_inff(); \
        _Pragma("unroll") for (int r = 0; r < 16; ++r) { const int kv = kb_ + (r & 3) + 8 * (r >> 2); if ((unsigned)(q - kv) >= 128u || (t) < 0) P0[r] = NEG_; if ((unsigned)(q - kv - 32) >= 128u || (t) < 0) P1[r] = NEG_; } } while (0)
    {
#pragma unroll
      for (int g = 0; g < 8; ++g) { const f32x4 bv = SW_BLD(g, t_hi - t_lo); SW_BSET(pA0, pA1, g, bv); } }
    asm volatile("s_waitcnt vmcnt(0) lgkmcnt(0)\n\ts_barrier" ::: "memory");
    SW_KLOAD2(0, 0); SW_KLOAD2(1, 0); SW_KLOAD2(2, 0); SW_KLOAD2(3, 0);
    pA0 = SW_MF(kf[0], qr[0], pA0); pA1 = SW_MF(kf[1], qr[0], pA1); pA0 = SW_MF(kf[2], qr[1], pA0); pA1 = SW_MF(kf[3], qr[1], pA1);
    pA0 = SW_MF(kf[4], qr[2], pA0); pA1 = SW_MF(kf[5], qr[2], pA1); pA0 = SW_MF(kf[6], qr[3], pA0); pA1 = SW_MF(kf[7], qr[3], pA1);
    SW_MASK(pA0, pA1, t_hi);
    { const float rm = rowmax(pA0, pA1); const float dl = __builtin_fmaxf(rm, -1e30f); mhat += dl;
#pragma unroll
      for (int r = 0; r < 16; ++r) { pA0[r] = __builtin_amdgcn_exp2f(pA0[r] - dl); pA1[r] = __builtin_amdgcn_exp2f(pA1[r] - dl); } }
    {
#pragma unroll
      for (int g = 0; g < 8; ++g) { const f32x4 bv = SW_BLD(g, t_hi - 1 - t_lo); SW_BSET(pB0, pB1, g, bv); }
      SW_KLOAD2(0, SLOTB); SW_KLOAD2(1, SLOTB); SW_KLOAD2(2, SLOTB); SW_KLOAD2(3, SLOTB); }
    s16x4 vlo[8], vhi[8]; u32x4 pw0, pw1, pw2, pw3; f32x4 bt;
#define SW_PKW(P, B) cvtpk(P[B], P[B + 1])
#define SW_PAF(k) __builtin_bit_cast(bf16x8, pw##k)
#define SW_VFR(i) (bf16x8){vlo[i][0], vlo[i][1], vlo[i][2], vlo[i][3], vhi[i][0], vhi[i][1], vhi[i][2], vhi[i][3]}
#define SW_PIN(x) asm volatile("" : "+v"(x))
#define SW_VRD(i) do { vlo[i] = vtr(vp_ + (((i) >> 2) * 4096 + ((i) & 3) * 1024)); vhi[i] = vtr(vp_ + (((i) >> 2) * 4096 + ((i) & 3) * 1024 + 512)); } while (0)
#define SW_GAPA(MFS, A0, A1, A2, A3, W0, W1, PW) do { MFS; sacc += A0; sacc += A1; sacc += A2; sacc += A3; SW_PIN(sacc); W0; W1; SW_PIN(PW); SW_SB(); } while (0)
#define SW_GAPB(MFS, X, B, GL, N0, N1, g, tl) do { MFS; X[B] = __builtin_amdgcn_exp2f(X[B]); X[B + 1] = __builtin_amdgcn_exp2f(X[B + 1]); X[B + 2] = __builtin_amdgcn_exp2f(X[B + 2]); X[B + 3] = __builtin_amdgcn_exp2f(X[B + 3]); SW_PIN(X); \
        if (GL) { if ((g) > 0) { SW_BSET(N0, N1, (g) - 1, bt); } bt = SW_BLD(g, tl); } SW_SB(); } while (0)
#define SW_STEP(C0, C1, P0, P1, j, GL) do { SW_SB(); \
    const lds_cptr vp_ = vp0 + ((j) - 1) * SLOTB; const int tn_ = t_hi - (j) - 1 - t_lo; const int sln_ = ((j) + 1) * SLOTB; \
    SW_VRD(0); SW_SB(); float sacc = (P0[0] + P0[1]); \
    SW_GAPA(C0 = SW_MF(kf[0], qr[0], C0), P0[2], P0[3], P0[4], P0[5],     pw0[0] = SW_PKW(P0, 0),  pw0[1] = SW_PKW(P0, 2),  pw0); \
    SW_VRD(4); SW_SB(); SW_GAPA(C1 = SW_MF(kf[1], qr[0], C1), P0[6], P0[7], P0[8], P0[9],     pw0[2] = SW_PKW(P0, 4),  pw0[3] = SW_PKW(P0, 6),  pw0); \
    SW_VRD(1); SW_SB(); SW_GAPA(C0 = SW_MF(kf[2], qr[1], C0),   P0[10], P0[11], P0[12], P0[13], pw1[0] = SW_PKW(P0, 8),  pw1[1] = SW_PKW(P0, 10), pw1); \
    SW_VRD(5); SW_SB(); SW_GAPA(C1 = SW_MF(kf[3], qr[1], C1),   P0[14], P0[15], P1[0], P1[1],   pw1[2] = SW_PKW(P0, 12), pw1[3] = SW_PKW(P0, 14), pw1); \
    SW_VRD(2); SW_SB(); SW_GAPA(C0 = SW_MF(kf[4], qr[2], C0),   P1[2], P1[3], P1[4], P1[5],     pw2[0] = SW_PKW(P1, 0),  pw2[1] = SW_PKW(P1, 2),  pw2); \
    SW_VRD(6); SW_SB(); SW_GAPA(C1 = SW_MF(kf[5], qr[2], C1),   P1[6], P1[7], P1[8], P1[9],     pw2[2] = SW_PKW(P1, 4),  pw2[3] = SW_PKW(P1, 6),  pw2); \
    SW_VRD(3); SW_SB(); SW_GAPA(C0 = SW_MF(kf[6], qr[3], C0),   P1[10], P1[11], P1[12], P1[13], pw3[0] = SW_PKW(P1, 8),  pw3[1] = SW_PKW(P1, 10), pw3); \
    SW_VRD(7); SW_SB(); SW_GAPA(C1 = SW_MF(kf[7], qr[3], C1),   P1[14], P1[15], 0.f, 0.f,       pw3[2] = SW_PKW(P1, 12), pw3[3] = SW_PKW(P1, 14), pw3); \
    l_reg += sacc; \
    SW_MASK(C0, C1, t_hi - (j)); \
    { const float rm = rowmax(C0, C1); resc = false; \
      if (__any(rm > 8.f)) { const float dl = __builtin_fmaxf(rm, 0.f); mhat += dl; \
        _Pragma("unroll") for (int r = 0; r < 16; ++r) { C0[r] -= dl; C1[r] -= dl; } \
        const float f = __builtin_amdgcn_exp2f(-dl); l_reg *= f; if (hi == 0) wsf[r32] = f; resc = true; } } \
    SW_SB(); \
    SW_GAPB(o[0] = SW_MF(SW_PAF(0), SW_VFR(0), o[0]), C0, 0, GL, P0, P1, 0, tn_); \
    SW_GAPB(o[1] = SW_MF(SW_PAF(0), SW_VFR(4), o[1]), C0, 4, GL, P0, P1, 1, tn_); \
    if (GL) { SW_KLOAD2(0, sln_); SW_SB(); } SW_GAPB(o[0] = SW_MF(SW_PAF(1), SW_VFR(1), o[0]), C0, 8, GL, P0, P1, 2, tn_); \
    if (GL) { SW_KLOAD2(1, sln_); SW_SB(); } SW_GAPB(o[1] = SW_MF(SW_PAF(1), SW_VFR(5), o[1]), C0, 12, GL, P0, P1, 3, tn_); \
    if (GL) { SW_KLOAD2(2, sln_); SW_SB(); } SW_GAPB(o[0] = SW_MF(SW_PAF(2), SW_VFR(2), o[0]), C1, 0, GL, P0, P1, 4, tn_); \
    if (GL) { SW_KLOAD2(3, sln_); SW_SB(); } SW_GAPB(o[1] = SW_MF(SW_PAF(2), SW_VFR(6), o[1]), C1, 4, GL, P0, P1, 5, tn_); \
    SW_GAPB(o[0] = SW_MF(SW_PAF(3), SW_VFR(3), o[0]), C1, 8, GL, P0, P1, 6, tn_); \
    SW_GAPB(o[1] = SW_MF(SW_PAF(3), SW_VFR(7), o[1]), C1, 12, GL, P0, P1, 7, tn_); \
    if (GL) { SW_BSET(P0, P1, 7, bt); } \
    if (resc) { asm volatile("s_waitcnt lgkmcnt(0)" ::: "memory"); \
        _Pragma("unroll") for (int d_ = 0; d_ < 2; ++d_) _Pragma("unroll") for (int r = 0; r < 16; ++r) o[d_][r] *= wsf[crow(r, hi)]; } \
    } while (0)
#define SW_DRAIN(D0, D1, sl) do { float sacc = 0.f; \
      _Pragma("unroll") for (int r = 0; r < 16; ++r) sacc += D0[r] + D1[r]; \
      l_reg += sacc; \
      pw0 = (u32x4){SW_PKW(D0, 0), SW_PKW(D0, 2), SW_PKW(D0, 4), SW_PKW(D0, 6)}; pw1 = (u32x4){SW_PKW(D0, 8), SW_PKW(D0, 10), SW_PKW(D0, 12), SW_PKW(D0, 14)}; \
      pw2 = (u32x4){SW_PKW(D1, 0), SW_PKW(D1, 2), SW_PKW(D1, 4), SW_PKW(D1, 6)}; pw3 = (u32x4){SW_PKW(D1, 8), SW_PKW(D1, 10), SW_PKW(D1, 12), SW_PKW(D1, 14)}; \
      SW_SB(); pv(o, vb0 + (sl), SW_PAF(0), SW_PAF(1), SW_PAF(2), SW_PAF(3)); } while (0)
    SW_STEP(pB0, pB1, pA0, pA1, 1, true);
    SW_STEP(pA0, pA1, pB0, pB1, 2, false);
    SW_DRAIN(pA0, pA1, 2 * SLOTB);
    { auto rr = __builtin_amdgcn_permlane32_swap(__float_as_uint(l_reg), __float_as_uint(l_reg), false, false); l_reg = __uint_as_float(rr[0]) + __uint_as_float(rr[1]); }
    l_reg += __builtin_amdgcn_exp2f(sinkl2 + slope2 * (float)(qw0 - q0 + r32) - mhat);
    if (hi == 0) wsf[32 + r32] = l_reg;
    asm volatile("s_waitcnt lgkmcnt(0)" ::: "memory");
    float rli[16];
#pragma unroll
    for (int r = 0; r < 16; ++r) rli[r] = __builtin_amdgcn_rcpf(wsf[32 + crow(r, hi)]);
    { bf16_t* stg = (bf16_t*)(shm + LDS_OST) + wid * 2048;
#pragma unroll
      for (int r = 0; r < 16; ++r) { const int orow = crow(r, hi);
#pragma unroll
          for (int d0 = 0; d0 < 2; ++d0) stg[orow * 64 + d0 * 32 + r32] = (bf16_t)(cvtpk(o[d0][r] * rli[r], 0.f) & 0xffffu); }
      asm volatile("s_waitcnt lgkmcnt(0)" ::: "memory");
#pragma unroll
      for (int i = 0; i < 4; ++i) { const int row = i * 8 + (lane >> 3), ch = lane & 7; const u32x4 v = *(const u32x4*)(stg + row * 64 + ch * 8); *(u32x4*)(Ow + (long)row * D + ch * 8) = v; } }
    asm volatile("s_waitcnt lgkmcnt(0)\n\ts_barrier" ::: "memory");
#undef SW_SB
#undef SW_MF
#undef SW_KLOAD2
#undef SW_BLD
#undef SW_BSET
#undef SW_MASK
#undef SW_PKW
#undef SW_PAF
#undef SW_VFR
#undef SW_PIN
#undef SW_VRD
#undef SW_GAPA
#undef SW_GAPB
#undef SW_STEP
#undef SW_DRAIN
}
}

__device__ __forceinline__ void p0_tr_item(const float* W, int ld_src, int k0, int n0, bf16_t* d0, bf16_t* d1, bf16_t* d2, int ld_dst, LAS float* scr, int lane) {
    float tv[32];
#pragma unroll
    for (int i = 0; i < 32; ++i) { const int kk = 2 * i + (lane >> 5); tv[i] = W[(size_t)(k0 + kk) * ld_src + n0 + (lane & 31)]; }
#pragma unroll
    for (int i = 0; i < 32; ++i) { const int kk = 2 * i + (lane >> 5); scr[kk * 33 + (lane & 31)] = tv[i]; }
    LDS_WAIT(); asm volatile("" ::: "memory");
    const int c = lane & 7;
#pragma unroll
    for (int j = 0; j < 4; ++j) { const int n = (lane >> 3) + 8 * j; const LAS float* s = scr + (8 * c) * 33 + n;
        u32x4 o; o.x = cvtpk(s[0 * 33], s[1 * 33]); o.y = cvtpk(s[2 * 33], s[3 * 33]); o.z = cvtpk(s[4 * 33], s[5 * 33]); o.w = cvtpk(s[6 * 33], s[7 * 33]);
        *(u32x4*)(d0 + (size_t)n * ld_dst + 8 * c) = o;
        if (d1) *(u32x4*)(d1 + (size_t)n * ld_dst + 8 * c) = o;
        if (d2) *(u32x4*)(d2 + (size_t)n * ld_dst + 8 * c) = o; }
    LDS_WAIT(); asm volatile("" ::: "memory");
}
__device__ __forceinline__ int pair_idx(int lo, int hi) { return lo == 0 ? hi - 1 : (lo == 1 ? hi + 1 : 5); }

__device__ __forceinline__ void phase_p0(Frame& F) {
    __syncthreads();
    {
        LAS float* sc = (LAS float*)F.lds;
        LAS float* red = (LAS float*)(F.lds + 16384);
        float* MOD = (float*)(F.ws + WS_MOD);
        bool have = false;
        for (int task = F.vcu; task < 48; task += F.G) {
            if (!have) { for (int i = F.tid; i < 4096; i += 512) { const float v = F.inp(F_C)[i]; sc[i] = v * sigmoidf_(v); } __syncthreads(); have = true; }
            const int l = task / 24, j0 = (task % 24) * 256;
            const float* wp = F.inp(F_WMOD) + (size_t)l * 1024 * 6144 + j0 + 4 * F.lane;
            f32x4 a0 = {0, 0, 0, 0}, a1 = a0, a2 = a0, a3 = a0;
            const int kbeg = F.wave * 128;
#pragma unroll 8
            for (int k = kbeg; k < kbeg + 128; ++k) { const f32x4 wv = *(const f32x4*)(wp + (size_t)k * 6144);
                a0 += wv * sc[k]; a1 += wv * sc[1024 + k]; a2 += wv * sc[2048 + k]; a3 += wv * sc[3072 + k]; }
            *(LAS f32x4*)(red + (F.wave * 4 + 0) * 256 + 4 * F.lane) = a0; *(LAS f32x4*)(red + (F.wave * 4 + 1) * 256 + 4 * F.lane) = a1;
            *(LAS f32x4*)(red + (F.wave * 4 + 2) * 256 + 4 * F.lane) = a2; *(LAS f32x4*)(red + (F.wave * 4 + 3) * 256 + 4 * F.lane) = a3;
            __syncthreads();
            for (int o = F.tid; o < 1024; o += 512) { const int b = o >> 8, cidx = o & 255; float s = F.inp(F_BMOD)[l * 6144 + j0 + cidx];
#pragma unroll
                for (int w = 0; w < 8; ++w) s += red[(w * 4 + b) * 256 + cidx];
                MOD[(size_t)(l * 4 + b) * 6144 + j0 + cidx] = s; }
            __syncthreads();
        }
        __syncthreads();
    }
    LAS float* scr = (LAS float*)(F.lds + F.wave * 16384);
    const int gw = F.vcu * 8 + F.wave, NGW = F.G * 8;
    bf16_t* WIN = (bf16_t*)(F.ws + WS_WIN); bf16_t* WOUT = (bf16_t*)(F.ws + WS_WOUT); bf16_t* WGU = (bf16_t*)(F.ws + WS_WGU); bf16_t* WDP = (bf16_t*)(F.ws + WS_WDP);
    constexpr int I_IN = 2 * 16 * 64, I_OUT = 2 * 16 * 32, I_GU = 2 * 16 * 2 * 16 * 8, I_DN = 2 * 16 * 4 * 32;
    for (int it = gw; it < I_IN + I_OUT + I_GU + I_DN; it += NGW) {
        int r = it;
        if (r < I_IN) { const int l = r / 1024, kb = (r % 1024) / 64, nb = r % 64;
            p0_tr_item(F.inp(F_WIN) + (size_t)l * 1024 * IN_COLS, IN_COLS, 64 * kb, 32 * nb, WIN + ((size_t)l * 2048 + 32 * nb) * 1024 + 64 * kb, nullptr, nullptr, 1024, scr, F.lane); continue; }
        r -= I_IN;
        if (r < I_OUT) { const int l = r / 512, kb = (r % 512) / 32, nb = r % 32;
            p0_tr_item(F.inp(F_WOUT) + (size_t)l * 1024 * 1024, 1024, 64 * kb, 32 * nb, WOUT + ((size_t)l * 1024 + 32 * nb) * 1024 + 64 * kb, nullptr, nullptr, 1024, scr, F.lane); continue; }
        r -= I_OUT;
        if (r < I_GU) { const int le = r / 256, which = (r % 256) / 128, kb = (r % 128) / 8, nb = r % 8;
            const int j0 = 32 * nb, row = 256 * (j0 >> 7) + (j0 & 127) + which * 128;
            p0_tr_item((which ? F.inp(F_WUP) : F.inp(F_WGATE)) + (size_t)le * 1024 * 256, 256, 64 * kb, j0, WGU + ((size_t)le * 512 + row) * 1024 + 64 * kb, nullptr, nullptr, 1024, scr, F.lane); continue; }
        r -= I_GU;
        { const int le = r / 128, kb = (r % 128) / 32, nb = r % 32; const int l = le >> 4, e = le & 15, g = e >> 2, i = e & 3;
          bf16_t* dst[3]; int nd = 0;
#pragma unroll
          for (int j = 0; j < 4; ++j) { if (j == i) continue; const int lo = i < j ? i : j, hi = i < j ? j : i; const int cls = g * 6 + pair_idx(lo, hi); const int kofs = (i == lo) ? 0 : 256;
              dst[nd++] = WDP + ((size_t)(l * 24 + cls) * 1024 + 32 * nb) * 512 + kofs + 64 * kb; }
          p0_tr_item(F.inp(F_WDOWN) + (size_t)le * 256 * 1024, 1024, 64 * kb, 32 * nb, dst[0], dst[1], dst[2], 512, scr, F.lane); }
    }
}

template <bool PM>
__device__ __forceinline__ void phase_norm1(Frame& F, int l, const float* xin) {
    const bf16_t* Pb = (const bf16_t*)(F.ws + WS_P); const bf16_t* Mb = (const bf16_t*)(F.ws + WS_M); float* XA = (float*)(F.ws + WS_XA);
    LAS float* gpm = (LAS float*)(F.lds + 256);
    const float* MOD = (const float*)(F.ws + WS_MOD) + (size_t)l * 4 * 6144;
    bf16_t* H = (bf16_t*)(F.ws + WS_H); float* CUM = (float*)(F.ws + WS_CUM); float* CTOT = (float*)(F.ws + WS_CTOT);
    LAS float* wtot = (LAS float*)F.lds;
    for (int tile = F.vcu; tile < T / 128; tile += F.G) {
        const int b = tile >> 6, row0 = tile * 128;
        f32x4 g1[4], s1[4], wfc[16];
#pragma unroll
        for (int j = 0; j < 4; ++j) { const int col = 4 * F.lane + 256 * j;
            const f32x4 nm = *(const f32x4*)(F.inp(F_NMIX) + l * 1024 + col), scv = *(const f32x4*)(MOD + b * 6144 + 1024 + col);
            g1[j] = nm * (scv + 1.0f); s1[j] = *(const f32x4*)(MOD + b * 6144 + col);
#pragma unroll
            for (int i = 0; i < 4; ++i) wfc[j * 4 + i] = *(const f32x4*)(F.inp(F_WIN) + ((size_t)l * 1024 + col + i) * IN_COLS + 2048); }
        const f32x4 fb = *(const f32x4*)(F.inp(F_FOXB) + l * 4);
        if (PM) { const float* MODp = (const float*)(F.ws + WS_MOD) + (size_t)(l - 1) * 4 * 6144 + b * 6144;
            for (int i = F.tid; i < 1024; i += 512) { gpm[i] = MODp[2048 + i]; gpm[1024 + i] = MODp[5120 + i]; }
            __syncthreads(); }
        f32x4 run = {0.f, 0.f, 0.f, 0.f}, keep = {0.f, 0.f, 0.f, 0.f};
#pragma unroll 1
        for (int i = 0; i < 16; i += 2) {
            const int row = row0 + F.wave * 16 + i;
            const f32x4* xr0 = (const f32x4*)(xin + (size_t)row * D) + F.lane; const f32x4* xr1 = xr0 + D / 4;
            f32x4 v0[4], v1[4]; float ss0 = 0.f, ss1 = 0.f;
#pragma unroll
            for (int j = 0; j < 4; ++j) { v0[j] = xr0[64 * j]; v1[j] = xr1[64 * j]; }
            if (PM) {
                u32x2 p0[4], p1[4], m0[4], m1[4];
                const u32x2* pr0 = (const u32x2*)(Pb + (size_t)row * D) + F.lane; const u32x2* mr0 = (const u32x2*)(Mb + (size_t)row * D) + F.lane;
#pragma unroll
                for (int j = 0; j < 4; ++j) { p0[j] = pr0[64 * j]; p1[j] = pr0[64 * j + D / 4]; m0[j] = mr0[64 * j]; m1[j] = mr0[64 * j + D / 4]; }
                f32x4* xo0 = (f32x4*)(XA + (size_t)row * D) + F.lane; f32x4* xo1 = xo0 + D / 4;
#pragma unroll
                for (int j = 0; j < 4; ++j) { const f32x4 gm = *(const LAS f32x4*)(gpm + 4 * F.lane + 256 * j), gf = *(const LAS f32x4*)(gpm + 1024 + 4 * F.lane + 256 * j);
                    v0[j] = v0[j] + gm * bf4_to_f32(p0[j]) + gf * bf4_to_f32(m0[j]); v1[j] = v1[j] + gm * bf4_to_f32(p1[j]) + gf * bf4_to_f32(m1[j]);
                    xo0[64 * j] = v0[j]; xo1[64 * j] = v1[j]; }
            }
#pragma unroll
            for (int j = 0; j < 4; ++j) { ss0 += (v0[j].x * v0[j].x + v0[j].y * v0[j].y) + (v0[j].z * v0[j].z + v0[j].w * v0[j].w); ss1 += (v1[j].x * v1[j].x + v1[j].y * v1[j].y) + (v1[j].z * v1[j].z + v1[j].w * v1[j].w); }
            const float rstd0 = 1.0f / sqrtf(wave_sum(ss0) * (1.f / D) + EPS), rstd1 = 1.0f / sqrtf(wave_sum(ss1) * (1.f / D) + EPS);
            f32x4 fa0 = {0.f, 0.f, 0.f, 0.f}, fa1 = {0.f, 0.f, 0.f, 0.f};
            u32x2* o0 = (u32x2*)(H + (size_t)row * D) + F.lane; u32x2* o1 = o0 + D / 4;
#pragma unroll
            for (int j = 0; j < 4; ++j) { const f32x4 h0 = v0[j] * rstd0 * g1[j] + s1[j], h1 = v1[j] * rstd1 * g1[j] + s1[j];
                fa0 += wfc[j * 4 + 0] * h0.x + wfc[j * 4 + 1] * h0.y + wfc[j * 4 + 2] * h0.z + wfc[j * 4 + 3] * h0.w;
                fa1 += wfc[j * 4 + 0] * h1.x + wfc[j * 4 + 1] * h1.y + wfc[j * 4 + 2] * h1.z + wfc[j * 4 + 3] * h1.w;
                u32x2 w; w.x = cvtpk(h0.x, h0.y); w.y = cvtpk(h0.z, h0.w); o0[64 * j] = w; w.x = cvtpk(h1.x, h1.y); w.y = cvtpk(h1.z, h1.w); o1[64 * j] = w; }
            f32x4 lf0, lf1;
#pragma unroll
            for (int e = 0; e < 4; ++e) { const float z0 = wave_sum(fa0[e]) + fb[e], z1 = wave_sum(fa1[e]) + fb[e];
                lf0[e] = fminf(z0, 0.f) - __builtin_amdgcn_logf(1.f + fast_exp(-fabsf(z0))) * 0.6931471805599453f;
                lf1[e] = fminf(z1, 0.f) - __builtin_amdgcn_logf(1.f + fast_exp(-fabsf(z1))) * 0.6931471805599453f; }
            run += lf0; if (F.lane == i) keep = run;
            run += lf1; if (F.lane == i + 1) keep = run;
        }
        if (F.lane == 0) *(LAS f32x4*)(wtot + F.wave * 4) = run;
        __syncthreads();
        f32x4 pre = {0.f, 0.f, 0.f, 0.f}, tot = {0.f, 0.f, 0.f, 0.f};
#pragma unroll
        for (int w = 0; w < 8; ++w) { const f32x4 tv = *(const LAS f32x4*)(wtot + w * 4); if (w < F.wave) pre += tv; tot += tv; }
        if (F.lane < 16) { const int s = (row0 & (SEQ - 1)) + F.wave * 16 + F.lane; const f32x4 cv = keep + pre;
#pragma unroll
            for (int e = 0; e < 4; ++e) CUM[(size_t)(b * 4 + e) * SEQ + s] = cv[e]; }
        if (F.tid == 0) *(f32x4*)(CTOT + (size_t)(b * 64 + (tile & 63)) * 4) = tot;
        __syncthreads();
    }
}

__device__ __forceinline__ void lru_unit(Frame& F, int l, int b, int tt) {
    const bf16_t* PROJ = (const bf16_t*)(F.ws + WS_PROJ);
    float* HLOC = (float*)(F.ws + WS_H); float* PP = HLOC + (size_t)T * 256;
    float* LRUA = (float*)(F.ws + WS_LRUA); float* LRUH = (float*)(F.ws + WS_LRUH);
    LAS bf16_t* xcb = (LAS bf16_t*)F.lds;
    LAS float* gb_ = (LAS float*)(F.lds + 16384);
    const int c = F.tid & 255, sl = F.tid >> 8;
    const int blk = F.wave, kq = F.lane >> 4, nn = F.lane & 15;
    bf16x8 bfr[2][2];
    f32x4 cinit[2][2];
#pragma unroll
    for (int g = 0; g < 2; ++g)
#pragma unroll
        for (int hf = 0; hf < 2; ++hf) { const float* wp = (g ? F.inp(F_LWX) : F.inp(F_LWA)) + ((size_t)(l * 8 + blk) * 32 + 8 * kq) * 32 + 16 * hf + nn;
            u32x4 pk; pk.x = cvtpk(wp[0], wp[32]); pk.y = cvtpk(wp[64], wp[96]); pk.z = cvtpk(wp[128], wp[160]); pk.w = cvtpk(wp[192], wp[224]); bfr[g][hf] = __builtin_bit_cast(bf16x8, pk);
            const float bv = (g ? F.inp(F_LBX) : F.inp(F_LBA))[l * 256 + blk * 32 + 16 * hf + nn]; cinit[g][hf] = (f32x4){bv, bv, bv, bv}; }
    const float cw0 = F.inp(F_CONVW)[(l * 4 + 0) * 256 + c], cw1 = F.inp(F_CONVW)[(l * 4 + 1) * 256 + c], cw2 = F.inp(F_CONVW)[(l * 4 + 2) * 256 + c], cw3 = F.inp(F_CONVW)[(l * 4 + 3) * 256 + c];
    const float cb = F.inp(F_CONVB)[l * 256 + c];
    const float lam = F.inp(F_LAM)[l * 256 + c];
    const float sp = -8.0f * (fmaxf(-lam, 0.f) + log1pf(expf(-fabsf(lam))));
    const int s0 = tt * 128 + sl * 64;
    const bf16_t* xp = PROJ + ((size_t)b * SEQ + s0) * NPROJ + C_XB + c;
    float xm3 = s0 >= 3 ? bf2f(xp[-3 * (long)NPROJ]) : 0.f, xm2 = s0 >= 2 ? bf2f(xp[-2 * (long)NPROJ]) : 0.f, xm1 = s0 >= 1 ? bf2f(xp[-1 * (long)NPROJ]) : 0.f;
    float h = 0.f, P = 1.f;
    bf16_t xr[16];
#pragma unroll
    for (int i = 0; i < 16; ++i) xr[i] = xp[(long)i * NPROJ];
#pragma unroll 1
    for (int sub = 0; sub < 4; ++sub) {
        float xv[16];
#pragma unroll
        for (int i = 0; i < 16; ++i) { const float xc = bf2f(xr[i]); xv[i] = cb + cw0 * xm3 + cw1 * xm2 + cw2 * xm1 + cw3 * xc; xm3 = xm2; xm2 = xm1; xm1 = xc;
            xcb[(sl * 16 + i) * 256 + c] = (bf16_t)(cvtpk(xv[i], 0.f) & 0xffffu); }
        if (sub < 3) {
#pragma unroll
            for (int i = 0; i < 16; ++i) xr[i] = xp[(long)((sub + 1) * 16 + i) * NPROJ]; }
        __syncthreads();
#pragma unroll
        for (int s2 = 0; s2 < 2; ++s2) {
            const bf16x8 af = *(const LAS bf16x8*)(xcb + (s2 * 16 + nn) * 256 + blk * 32 + 8 * kq);
#pragma unroll
            for (int g = 0; g < 2; ++g)
#pragma unroll
                for (int hf = 0; hf < 2; ++hf) { const f32x4 r4 = __builtin_amdgcn_mfma_f32_16x16x32_bf16(af, bfr[g][hf], cinit[g][hf], 0, 0, 0);
                    LAS float* gp = gb_ + ((g * 2 + s2) * 16 + 4 * kq) * 256 + blk * 32 + 16 * hf + nn;
                    gp[0] = r4[0]; gp[256] = r4[1]; gp[512] = r4[2]; gp[768] = r4[3]; }
        }
        __syncthreads();
#pragma unroll
        for (int i = 0; i < 16; ++i) {
            const float ga = gb_[((0 * 2 + sl) * 16 + i) * 256 + c], gx = gb_[((1 * 2 + sl) * 16 + i) * 256 + c];
            const float r = sigmoidf_(ga), ig = sigmoidf_(gx);
            const float la = sp * r; const float a = fast_exp(la);
            const float mult = __builtin_amdgcn_sqrtf(__builtin_fmaxf(1.f - a * a, 0.f));
            const float u = mult * ig * xv[i];
            h = a * h + u; P *= a;
            const size_t off = ((size_t)b * SEQ + s0 + sub * 16 + i) * 256 + c;
            HLOC[off] = h; PP[off] = P;
        }
    }
    const size_t so = ((size_t)(b * 128 + tt * 2 + sl)) * 256 + c;
    LRUA[so] = P; LRUH[so] = h;
    __syncthreads();
}

__device__ __forceinline__ void fox_unit(Frame& F, int l, int b, int h, int qb) {
    const bf16_t* PROJ = (const bf16_t*)(F.ws + WS_PROJ); bf16_t* Y = (bf16_t*)(F.ws + WS_Y);
    const float* CUM = (const float*)(F.ws + WS_CUM) + (size_t)(b * 4 + h) * SEQ; const float* CTOT = (const float*)(F.ws + WS_CTOT);
    LAS float* bias = (LAS float*)(F.lds + att::LDS_BIAS); LAS float* blk = (LAS float*)(F.lds + att::LDS_BLK);
    const int q0 = qb * 256;
    const float vtot = CTOT[(size_t)(b * 64 + F.lane) * 4 + h];
    float cv[16];
#pragma unroll
    for (int k = 0; k < 16; ++k) { const int s = F.tid + 512 * k; cv[k] = (s < q0 + 256) ? CUM[s] : 0.f; }
    const float cq = CUM[q0 + 255];
    float kn2 = 0.f; { const unsigned* km = (const unsigned*)(F.ws + WS_CTL) + CW_KM + l * 128 + (b * 4 + h) * 8;
#pragma unroll
        for (int c = 0; c < 8; ++c) kn2 += __uint_as_float(__hip_atomic_load(km + c, __ATOMIC_RELAXED, __HIP_MEMORY_SCOPE_AGENT)); }
    if (F.wave == 0) { float s = vtot;
#pragma unroll
        for (int o = 1; o < 64; o <<= 1) { const float t = __int_as_float(__builtin_amdgcn_ds_bpermute(((F.lane - o) & 63) << 2, __float_as_int(s))); if (F.lane >= o) s += t; }
        blk[F.lane] = s - vtot; }
    __syncthreads();
    const float cref = cq + blk[(q0 + 255) >> 7];
#pragma unroll
    for (int k = 0; k < 16; ++k) { const int s = F.tid + 512 * k; if (s < q0 + 256) bias[s] = (cref - (cv[k] + blk[s >> 7])) * LOG2E; }
    __syncthreads();
    const size_t rowbase = (size_t)b * SEQ;
    att::fox_core(F.shm, PROJ + (rowbase + q0 + F.wave * 32) * NPROJ + C_QC + h * 64, PROJ + rowbase * NPROJ + C_KC + h * 64, PROJ + rowbase * NPROJ + C_VC + h * 64,
                  Y + (rowbase + q0 + F.wave * 32) * D + 768 + h * 64, 4 * (qb + 1), F.tid, kn2);
}
__device__ __forceinline__ void swa_unit(Frame& F, int l, int b, int kvh, int qb64) {
    const bf16_t* PROJ = (const bf16_t*)(F.ws + WS_PROJ); bf16_t* Y = (bf16_t*)(F.ws + WS_Y);
    LAS float* bias = (LAS float*)(F.lds + att::LDS_BIAS);
    const int q0 = qb64 * 64;
    const int t_hi = q0 >> 6, t_lo = t_hi - 2;
    for (int i = F.tid; i < 4 * 192; i += 512) { const int hh = i / 192, j = i - hh * 192; const float sl = exp2f(-(float)(kvh * 4 + hh + 1)) * LOG2E;
        bias[i] = sl * (float)(64 * t_lo + j - q0); }
    __syncthreads();
    const int h = kvh * 4 + (F.wave >> 1), qw0 = q0 + 32 * (F.wave & 1);
    const float slope2 = exp2f(-(float)(h + 1)) * LOG2E;
    const size_t rowbase = (size_t)b * SEQ;
    att::swa_core(F.shm, PROJ + (rowbase + qw0) * NPROJ + C_QA + h * 64, PROJ + rowbase * NPROJ + C_KA + kvh * 64, PROJ + rowbase * NPROJ + C_VA + kvh * 64,
                  Y + (rowbase + qw0) * D + h * 64, q0, qw0, t_lo, t_hi, (F.wave >> 1) * 192, F.inp(F_SINKS)[l * 8 + h] * LOG2E, slope2, F.tid);
}
__device__ __forceinline__ void phase_mixer(Frame& F, int l, int qsel) {
    unsigned* qhead = (unsigned*)(F.ws + WS_CTL) + CW_Q + qsel * 64;
    LAS unsigned* qslot = (LAS unsigned*)(F.lds + LDSCTL_OFF + 16);
#pragma unroll 1
    for (;;) {
        frame_refresh(F);
        if (F.tid == 0) qslot[0] = __hip_atomic_fetch_add(qhead, 1u, __ATOMIC_RELAXED, __HIP_MEMORY_SCOPE_AGENT);
        __syncthreads();
        const int u = __builtin_amdgcn_readfirstlane((int)qslot[0]);
        __syncthreads();
        if (u >= 512 + 256 + 1024) break;
        if (u < 512) { if (PH(11)) fox_unit(F, l, (u & 15) >> 2, u & 3, 31 - (u >> 4)); }
        else if (u < 768) { if (PH(10)) lru_unit(F, l, (u - 512) >> 6, (u - 512) & 63); }
        else { if (PH(12)) { const int v = u - 768; swa_unit(F, l, v >> 8, (v >> 7) & 1, v & 127); } }
    }
}

__device__ __forceinline__ void phase_ynorm(Frame& F, int l, bf16_t* YO) {
    const bf16_t* Y = (const bf16_t*)(F.ws + WS_Y); const bf16_t* PROJ = (const bf16_t*)(F.ws + WS_PROJ);
    const float* HLOC = (const float*)(F.ws + WS_H); const float* PP = HLOC + (size_t)T * 256;
    const float* LRUA = (const float*)(F.ws + WS_LRUA); const float* LRUH = (const float*)(F.ws + WS_LRUH);
    LAS float* cs = (LAS float*)F.lds;
    LAS float* carry = (LAS float*)(F.lds + 4096);
    const float* og = F.inp(F_OGAIN) + l * 1024;
    for (int tile = F.vcu; tile < T / 128; tile += F.G) {
        const int b = tile >> 6, tt = tile & 63, j0 = 2 * tt;
        { const int c = F.tid & 255, seg = F.tid >> 8; const int jb = seg ? j0 / 2 : 0, je = seg ? j0 : j0 / 2;
          float A = 1.f, Hh = 0.f;
          int j = jb;
          for (; j + 8 <= je; j += 8) {
              float aj[8], hj[8];
#pragma unroll
              for (int k = 0; k < 8; ++k) { const size_t so = (size_t)(b * 128 + j + k) * 256 + c; aj[k] = LRUA[so]; hj[k] = LRUH[so]; }
#pragma unroll
              for (int k = 0; k < 8; ++k) { Hh = aj[k] * Hh + hj[k]; A *= aj[k]; } }
          for (; j < je; ++j) { const size_t so = (size_t)(b * 128 + j) * 256 + c; const float aj = LRUA[so], hj = LRUH[so]; Hh = aj * Hh + hj; A *= aj; }
          cs[(seg * 2 + 0) * 256 + c] = A; cs[(seg * 2 + 1) * 256 + c] = Hh; }
        __syncthreads();
        if (F.tid < 256) { const int c = F.tid; const float c0 = cs[(2 + 0) * 256 + c] * cs[(0 + 1) * 256 + c] + cs[(2 + 1) * 256 + c];
            const size_t so = (size_t)(b * 128 + j0) * 256 + c; carry[c] = c0; carry[256 + c] = LRUA[so] * c0 + LRUH[so]; }
        __syncthreads();
#pragma unroll 1
        for (int i = 0; i < 16; i += 2) {
            u32x4 ya[2]; u32x2 yc[2], gb[2]; f32x4 hl[2], pp[2], cr[2];
#pragma unroll
            for (int k = 0; k < 2; ++k) { const int rl = F.wave * 16 + i + k; const size_t row = (size_t)tile * 128 + rl; const bf16_t* yr = Y + row * D;
                ya[k] = *(const u32x4*)(yr + 8 * F.lane); yc[k] = *(const u32x2*)(yr + 768 + 4 * F.lane);
                hl[k] = *(const f32x4*)(HLOC + row * 256 + 4 * F.lane); pp[k] = *(const f32x4*)(PP + row * 256 + 4 * F.lane);
                gb[k] = *(const u32x2*)(PROJ + row * NPROJ + C_GB + 4 * F.lane); cr[k] = *(const LAS f32x4*)(carry + (rl >> 6) * 256 + 4 * F.lane); }
#pragma unroll
            for (int k = 0; k < 2; ++k) { const int rl = F.wave * 16 + i + k; const size_t row = (size_t)tile * 128 + rl; bf16_t* yr = YO + row * D;
                float fa[8]; fa[0] = __uint_as_float(ya[k].x << 16); fa[1] = __uint_as_float(ya[k].x & 0xffff0000u); fa[2] = __uint_as_float(ya[k].y << 16); fa[3] = __uint_as_float(ya[k].y & 0xffff0000u);
                fa[4] = __uint_as_float(ya[k].z << 16); fa[5] = __uint_as_float(ya[k].z & 0xffff0000u); fa[6] = __uint_as_float(ya[k].w << 16); fa[7] = __uint_as_float(ya[k].w & 0xffff0000u);
                float sa = 0.f;
#pragma unroll
                for (int e = 0; e < 8; ++e) sa += fa[e] * fa[e];
                float fc[4]; fc[0] = __uint_as_float(yc[k].x << 16); fc[1] = __uint_as_float(yc[k].x & 0xffff0000u); fc[2] = __uint_as_float(yc[k].y << 16); fc[3] = __uint_as_float(yc[k].y & 0xffff0000u);
                const float sc_ = fc[0] * fc[0] + fc[1] * fc[1] + fc[2] * fc[2] + fc[3] * fc[3];
                float fb[4]; { const f32x4 hh = hl[k] + pp[k] * cr[k];
                    fb[0] = hh.x * gelu_tanh(__uint_as_float(gb[k].x << 16)); fb[1] = hh.y * gelu_tanh(__uint_as_float(gb[k].x & 0xffff0000u));
                    fb[2] = hh.z * gelu_tanh(__uint_as_float(gb[k].y << 16)); fb[3] = hh.w * gelu_tanh(__uint_as_float(gb[k].y & 0xffff0000u)); }
                const float sb = fb[0] * fb[0] + fb[1] * fb[1] + fb[2] * fb[2] + fb[3] * fb[3];
                const float ra = 1.0f / sqrtf(wave_sum(sa) * (1.f / 512.f) + EPS), rb = 1.0f / sqrtf(wave_sum(sb) * (1.f / 256.f) + EPS), rc = 1.0f / sqrtf(wave_sum(sc_) * (1.f / 256.f) + EPS);
                { const f32x4 g0 = *(const f32x4*)(og + 8 * F.lane), g1 = *(const f32x4*)(og + 8 * F.lane + 4);
                  u32x4 w; w.x = cvtpk(fa[0] * ra * g0.x, fa[1] * ra * g0.y); w.y = cvtpk(fa[2] * ra * g0.z, fa[3] * ra * g0.w); w.z = cvtpk(fa[4] * ra * g1.x, fa[5] * ra * g1.y); w.w = cvtpk(fa[6] * ra * g1.z, fa[7] * ra * g1.w);
                  *(u32x4*)(yr + 8 * F.lane) = w; }
                { const f32x4 g = *(const f32x4*)(og + 512 + 4 * F.lane); u32x2 w; w.x = cvtpk(fb[0] * rb * g.x, fb[1] * rb * g.y); w.y = cvtpk(fb[2] * rb * g.z, fb[3] * rb * g.w); *(u32x2*)(yr + 512 + 4 * F.lane) = w; }
                { const f32x4 g = *(const f32x4*)(og + 768 + 4 * F.lane); u32x2 w; w.x = cvtpk(fc[0] * rc * g.x, fc[1] * rc * g.y); w.y = cvtpk(fc[2] * rc * g.z, fc[3] * rc * g.w); *(u32x2*)(yr + 768 + 4 * F.lane) = w; }
            }
        }
        __syncthreads();
    }
}

template <int N, int MASK, int SZ> __device__ __forceinline__ void tr_step(float (&v)[SZ], bool upper) {
#pragma unroll
    for (int i = 0; i < N / 2; ++i) { const float a = v[i], b = v[i + N / 2]; const float send = upper ? a : b, kp = upper ? b : a; float rcv;
        if constexpr (MASK == 32) { auto rr = __builtin_amdgcn_permlane32_swap(__float_as_uint(send), __float_as_uint(send), false, false); rcv = upper ? __uint_as_float(rr[0]) : __uint_as_float(rr[1]); }
        else rcv = shx<MASK>(send);
        v[i] = kp + rcv; }
}
__device__ __forceinline__ void phase_norm2_router(Frame& F, int l, const float* xa, unsigned* cnt) {
    const float* MOD = (const float*)(F.ws + WS_MOD) + (size_t)l * 4 * 6144;
    bf16_t* H = (bf16_t*)(F.ws + WS_H);
    LEntry* list = (LEntry*)(F.ws + WS_LIST);
    LAS float* wr = (LAS float*)F.lds;
    LAS float* gs = (LAS float*)(F.lds + 81920);
    LAS float* lg = (LAS float*)(F.lds + 90112);
    LAS int* tcls = (LAS int*)(F.lds + 92672);
    LAS float* tw = (LAS float*)(F.lds + 93184);
    LAS int* trank = (LAS int*)(F.lds + 94208);
    LAS unsigned* lcnt = (LAS unsigned*)(F.lds + 94720);
    LAS unsigned* lbase = (LAS unsigned*)(F.lds + 94848);
    const bf16_t* Pb = (const bf16_t*)(F.ws + WS_P); LAS float* gmv = (LAS float*)(F.lds + 98304);
    for (int i = F.tid; i < 1024 * 4; i += 512) { const int k = i >> 2, e = i & 3; wr[e * 1024 + k] = F.inp(F_WRG)[(size_t)l * 4096 + i]; }
    for (int i = F.tid; i < 1024 * 16; i += 512) { const int k = i >> 4, e = i & 15; wr[(4 + e) * 1024 + k] = F.inp(F_WRE)[(size_t)l * 16384 + i]; }
    int cur_b = -1;
    for (int tile = F.vcu; tile < T / 128; tile += F.G) {
        const int b = tile >> 6;
        __syncthreads();
        if (b != cur_b) { for (int i = F.tid; i < 1024; i += 512) { gs[i] = F.inp(F_NFFN)[l * 1024 + i] * (1.f + MOD[b * 6144 + 4096 + i]); gs[1024 + i] = MOD[b * 6144 + 3072 + i]; gmv[i] = MOD[b * 6144 + 2048 + i]; } cur_b = b; }
        if (F.tid < NCLS) lcnt[F.tid] = 0u;
        __syncthreads();
        f32x4 xn[2][4]; u32x2 pn_[2][4];
#define N2_LOAD(g_) do { const size_t r0_ = (size_t)tile * 128 + F.wave * 16 + (g_) * 2; \
            _Pragma("unroll") for (int r = 0; r < 2; ++r) { \
                const f32x4* xr = (const f32x4*)(xa + (r0_ + r) * D) + F.lane; const u32x2* pr = (const u32x2*)(Pb + (r0_ + r) * D) + F.lane; \
                _Pragma("unroll") for (int j = 0; j < 4; ++j) { xn[r][j] = xr[64 * j]; pn_[r][j] = pr[64 * j]; } } } while (0)
        N2_LOAD(0);
#pragma unroll 1
        for (int grp = 0; grp < 8; ++grp) {
            const size_t row0 = (size_t)tile * 128 + F.wave * 16 + grp * 2;
            f32x4 hv[2][4];
#pragma unroll
            for (int j = 0; j < 4; ++j) { const f32x4 gm = *(const LAS f32x4*)(gmv + 4 * F.lane + 256 * j);
                hv[0][j] = xn[0][j] + gm * bf4_to_f32(pn_[0][j]); hv[1][j] = xn[1][j] + gm * bf4_to_f32(pn_[1][j]); }
            if (grp < 7) N2_LOAD(grp + 1);
#pragma unroll
            for (int r = 0; r < 2; ++r) { float ss = 0.f;
#pragma unroll
                for (int j = 0; j < 4; ++j) ss += (hv[r][j].x * hv[r][j].x + hv[r][j].y * hv[r][j].y) + (hv[r][j].z * hv[r][j].z + hv[r][j].w * hv[r][j].w);
                const float rstd = 1.0f / sqrtf(wave_sum(ss) * (1.f / D) + EPS);
                u32x2* o8 = (u32x2*)(H + (row0 + r) * D) + F.lane;
#pragma unroll
                for (int j = 0; j < 4; ++j) { const f32x4 g = *(const LAS f32x4*)(gs + 4 * F.lane + 256 * j), s = *(const LAS f32x4*)(gs + 1024 + 4 * F.lane + 256 * j);
                    hv[r][j] = hv[r][j] * rstd * g + s; u32x2 w; w.x = cvtpk(hv[r][j].x, hv[r][j].y); w.y = cvtpk(hv[r][j].z, hv[r][j].w); o8[64 * j] = w; } }
            float ga[8];
#pragma unroll
            for (int e = 0; e < 4; ++e) { float a0 = 0.f, a1 = 0.f;
#pragma unroll
                for (int j = 0; j < 4; ++j) { const f32x4 w = *(const LAS f32x4*)(wr + e * 1024 + 4 * F.lane + 256 * j);
                    a0 += hv[0][j].x * w.x + hv[0][j].y * w.y + hv[0][j].z * w.z + hv[0][j].w * w.w;
                    a1 += hv[1][j].x * w.x + hv[1][j].y * w.y + hv[1][j].z * w.z + hv[1][j].w * w.w; }
                ga[e] = a0; ga[4 + e] = a1; }
            tr_step<8, 32, 8>(ga, (F.lane & 32) != 0); tr_step<4, 16, 8>(ga, (F.lane & 16) != 0); tr_step<2, 8, 8>(ga, (F.lane & 8) != 0);
            ga[0] += shx<4>(ga[0]); ga[0] += shx<2>(ga[0]); ga[0] += shx<1>(ga[0]);
            int gsel[2]; float gp[2];
#pragma unroll
            for (int r = 0; r < 2; ++r) { float gl[4];
#pragma unroll
                for (int g = 0; g < 4; ++g) gl[g] = __int_as_float(__builtin_amdgcn_readlane(__float_as_int(ga[0]), 32 * r + 8 * g)) + F.inp(F_BRG)[l * 4 + g];
                int gs_ = 0; float gm = gl[0];
#pragma unroll
                for (int g = 1; g < 4; ++g) if (gl[g] > gm) { gm = gl[g]; gs_ = g; }
                float den = 0.f;
#pragma unroll
                for (int g = 0; g < 4; ++g) den += fast_exp(gl[g] - gm);
                gsel[r] = __builtin_amdgcn_readfirstlane(gs_); gp[r] = __builtin_amdgcn_rcpf(den); }
            float ea[8];
#pragma unroll
            for (int r = 0; r < 2; ++r) { const LAS float* we = wr + (4 + 4 * gsel[r]) * 1024 + 4 * F.lane;
#pragma unroll
                for (int e = 0; e < 4; ++e) { float a0 = 0.f;
#pragma unroll
                    for (int j = 0; j < 4; ++j) { const f32x4 w = *(const LAS f32x4*)(we + e * 1024 + 256 * j); a0 += hv[r][j].x * w.x + hv[r][j].y * w.y + hv[r][j].z * w.z + hv[r][j].w * w.w; }
                    ea[4 * r + e] = a0; } }
            tr_step<8, 32, 8>(ea, (F.lane & 32) != 0); tr_step<4, 16, 8>(ea, (F.lane & 16) != 0); tr_step<2, 8, 8>(ea, (F.lane & 8) != 0);
            ea[0] += shx<4>(ea[0]); ea[0] += shx<2>(ea[0]); ea[0] += shx<1>(ea[0]);
#pragma unroll
            for (int r = 0; r < 2; ++r) { float el[4];
#pragma unroll
                for (int e = 0; e < 4; ++e) el[e] = __int_as_float(__builtin_amdgcn_readlane(__float_as_int(ea[0]), 32 * r + 8 * e)) + F.inp(F_BRE)[l * 16 + gsel[r] * 4 + e];
                int i1 = 0; float m1 = el[0];
#pragma unroll
                for (int e = 1; e < 4; ++e) if (el[e] > m1) { m1 = el[e]; i1 = e; }
                int i2 = -1; float m2 = -__builtin_inff();
#pragma unroll
                for (int e = 0; e < 4; ++e) if (e != i1 && el[e] > m2) { m2 = el[e]; i2 = e; }
                const float e2 = fast_exp(m2 - m1); const float w1 = gp[r] * __builtin_amdgcn_rcpf(1.f + e2), w2 = w1 * e2;
                const int lo = i1 < i2 ? i1 : i2, hi = i1 < i2 ? i2 : i1;
                if (F.lane == 0) { const int rl = F.wave * 16 + grp * 2 + r;
                    tcls[rl] = gsel[r] * 6 + pair_idx(lo, hi); tw[rl * 2] = (i1 < i2) ? w1 : w2; tw[rl * 2 + 1] = (i1 < i2) ? w2 : w1; } }
        }
#undef N2_LOAD
        __syncthreads();
        if (F.tid < 128) trank[F.tid] = (int)atomicAdd((unsigned*)&lcnt[tcls[F.tid]], 1u);
        __syncthreads();
        if (F.tid < NCLS) lbase[F.tid] = lcnt[F.tid] ? __hip_atomic_fetch_add(cnt + 64 * F.tid, lcnt[F.tid], __ATOMIC_RELAXED, __HIP_MEMORY_SCOPE_AGENT) : 0u;
        __syncthreads();
        if (F.tid < 128) { const int cls = tcls[F.tid]; const unsigned pos = lbase[cls] + (unsigned)trank[F.tid];
            LEntry e; e.tok = tile * 128 + F.tid; e.w0 = tw[F.tid * 2]; e.w1 = tw[F.tid * 2 + 1]; e.pad = 0; list[(size_t)cls * LCAP + pos] = e; }
    }
    __syncthreads();
}

__device__ __forceinline__ int build_tile_table(Frame& F, int l) {
    unsigned* cnt = (unsigned*)(F.ws + WS_CTL) + CW_CNT + l * NCLS * 64;
    LAS int* tt = (LAS int*)(F.lds + TT_OFF); LAS int* ntl = (LAS int*)(F.lds + TT_OFF + 1024);
    __syncthreads();
    if (F.tid == 0) { int nt = 0;
        for (int c = 0; c < NCLS; ++c) { const unsigned n = __hip_atomic_load(cnt + 64 * c, __ATOMIC_RELAXED, __HIP_MEMORY_SCOPE_AGENT); const int k = (int)((n + 255u) >> 8);
            for (int j = 0; j < k; ++j) tt[nt++] = c | ((j * 256) << 8); }
        ntl[0] = nt; }
    __syncthreads();
    return ntl[0];
}

__device__ __forceinline__ void phase_final(Frame& F, const float* xa, int lp) {
    const bf16_t* Pb = (const bf16_t*)(F.ws + WS_P); const bf16_t* Mb = (const bf16_t*)(F.ws + WS_M); const float* MODp = (const float*)(F.ws + WS_MOD) + (size_t)lp * 4 * 6144;
    const int gw = F.vcu * 8 + F.wave;
    const int rbase = gw * 16; const float* gp = MODp + (rbase >> 13) * 6144;
    f32x4 g[4], gm[4], gf[4];
#pragma unroll
    for (int j = 0; j < 4; ++j) { const int col = 4 * F.lane + 256 * j; g[j] = *(const f32x4*)(F.inp(F_NFIN) + col); gm[j] = *(const f32x4*)(gp + 2048 + col); gf[j] = *(const f32x4*)(gp + 5120 + col); }
#pragma unroll 1
    for (int i = 0; i < 16; i += 2) {
        const int row = rbase + i;
        const f32x4* xr0 = (const f32x4*)(xa + (size_t)row * D) + F.lane; const f32x4* xr1 = xr0 + D / 4;
        const u32x2* pa = (const u32x2*)(Pb + (size_t)row * D) + F.lane; const u32x2* ma = (const u32x2*)(Mb + (size_t)row * D) + F.lane;
        f32x4 v0[4], v1[4]; u32x2 p0[4], p1[4], m0[4], m1[4]; float ss0 = 0.f, ss1 = 0.f;
#pragma unroll
        for (int j = 0; j < 4; ++j) { v0[j] = xr0[64 * j]; v1[j] = xr1[64 * j]; p0[j] = pa[64 * j]; p1[j] = pa[64 * j + D / 4]; m0[j] = ma[64 * j]; m1[j] = ma[64 * j + D / 4]; }
#pragma unroll
        for (int j = 0; j < 4; ++j) { v0[j] = v0[j] + gm[j] * bf4_to_f32(p0[j]) + gf[j] * bf4_to_f32(m0[j]); v1[j] = v1[j] + gm[j] * bf4_to_f32(p1[j]) + gf[j] * bf4_to_f32(m1[j]);
            ss0 += (v0[j].x * v0[j].x + v0[j].y * v0[j].y) + (v0[j].z * v0[j].z + v0[j].w * v0[j].w); ss1 += (v1[j].x * v1[j].x + v1[j].y * v1[j].y) + (v1[j].z * v1[j].z + v1[j].w * v1[j].w); }
        const float rstd0 = 1.0f / sqrtf(wave_sum(ss0) * (1.f / D) + EPS), rstd1 = 1.0f / sqrtf(wave_sum(ss1) * (1.f / D) + EPS);
        f32x4* o0 = (f32x4*)(F.out + (size_t)row * D) + F.lane; f32x4* o1 = o0 + D / 4;
#pragma unroll
        for (int j = 0; j < 4; ++j) { o0[64 * j] = v0[j] * rstd0 * g[j]; o1[64 * j] = v1[j] * rstd1 * g[j]; }
    }
}

__global__ void __launch_bounds__(512, 2) mk_fwd(const Args args) {
    extern __shared__ __attribute__((aligned(16))) unsigned char lds[];
    Frame F;
    F.lds = (LAS unsigned char*)lds; F.shm = (char*)lds;
    F.tid = threadIdx.x; F.lane = F.tid & 63; F.wave = __builtin_amdgcn_readfirstlane(F.tid >> 6);
    F.G = 256; { const int bx = blockIdx.x; __builtin_assume(bx >= 0 && bx < 256); F.vcu = (bx % 8) * 32 + bx / 8; }
    for (int u = F.tid; u < (LDS_BYTES - LDSCTL_OFF) / 4; u += 512) ((LAS unsigned*)(F.lds + LDSCTL_OFF))[u] = 0u;
    __syncthreads();
    F.wave_s = __builtin_amdgcn_readfirstlane((int)threadIdx.x >> 6);
#define REFRESH() frame_refresh(F)
    REFRESH();
    unsigned* ctl = (unsigned*)(F.ws + WS_CTL);
    XcdBarrier bar = xcd_barrier_post(ctl + CW_BAR, (volatile LAS unsigned*)(F.lds + MISC_OFF) + 8);

    for (int rep = 0; rep < DUP(0); ++rep) if (PH(0)) phase_p0(F);
    xcd_barrier(bar, F.tid);
    float* XA = (float*)(F.ws + WS_XA);
    for (int l = 0; l < DEPTH; ++l) {
        const float* xin = (l <= 1) ? F.inp(F_X) : XA;
        const float* xbase = (l == 0) ? F.inp(F_X) : XA;
        const float* MODl = (const float*)(F.ws + WS_MOD) + (size_t)l * 4 * 6144;
        REFRESH();
        for (int rep = 0; rep < DUP(1); ++rep) if (PH(1)) { if (l == 0) phase_norm1<false>(F, l, xin); else phase_norm1<true>(F, l, xin); }
        xcd_barrier(bar, F.tid);
        REFRESH();
        for (int rep = 0; rep < DUP(2); ++rep) if (PH(2)) { pg8::DenseOrder S; S.init(T, NPROJ, F.G, (int)blockIdx.x, F.ws + WS_WIN + (size_t)l * 2048 * 1024 * 2, 2048u, G1REP);
          EpiProj E{(bf16_t*)(F.ws + WS_PROJ), (unsigned*)(F.ws + WS_CTL) + CW_KM + l * 128};
          pg8::gemm_phase<EpiProj, pg8::DenseOrder, true>(F.tid, F.lds, (const char*)(F.ws + WS_H), 2048u, 2048u, 1024, S, E); }
        xcd_barrier(bar, F.tid);
        REFRESH();
        for (int rep = 0; rep < DUP(3); ++rep) if (PH(3)) { phase_mixer(F, l, l + 2 * rep); if (rep + 1 < DUP(3)) xcd_barrier(bar, F.tid); }
        xcd_barrier(bar, F.tid);
        REFRESH();
        for (int rep = 0; rep < DUP(4); ++rep) if (PH(4)) phase_ynorm(F, l, (rep + 1 < DUP(4)) ? (bf16_t*)F.out : (bf16_t*)(F.ws + WS_Y));
        xcd_barrier(bar, F.tid);
        REFRESH();
        for (int rep = 0; rep < DUP(5); ++rep) if (PH(5)) { pg8::DenseOrder S; S.init(T, D, F.G, (int)blockIdx.x, F.ws + WS_WOUT + (size_t)l * 1024 * 1024 * 2, 2048u, (l == 0) ? G2REP : 1);
          EpiP E{(bf16_t*)(F.ws + WS_P)};
          pg8::gemm_phase<EpiP, pg8::DenseOrder, true>(F.tid, F.lds, (const char*)(F.ws + WS_Y), 2048u, 2048u, 1024, S, E); }
        xcd_barrier(bar, F.tid);
        REFRESH();
        for (int rep = 0; rep < DUP(6); ++rep) if (PH(6)) phase_norm2_router(F, l, xbase, (unsigned*)(F.ws + WS_CTL) + ((rep + 1 < DUP(6)) ? 32768 + l * NCLS * 64 : CW_CNT + l * NCLS * 64));
        xcd_barrier(bar, F.tid);
        REFRESH();
        const int ntiles = build_tile_table(F, l);
        const LEntry* list = (const LEntry*)(F.ws + WS_LIST); const unsigned* cnt = (const unsigned*)(F.ws + WS_CTL) + CW_CNT + l * NCLS * 64;
        for (int rep = 0; rep < DUP(7); ++rep) if (PH(7)) { MoeUpOrder S{ntiles * 4, F.G, (int)blockIdx.x, (const LAS int*)(F.lds + TT_OFF), (const char*)(F.ws + WS_WGU + (size_t)l * 16 * 512 * 1024 * 2), list, cnt};
          EpiUp E{(bf16_t*)(F.ws + WS_PROJ), list, cnt};
          pg8::gemm_phase<EpiUp, MoeUpOrder, true>(F.tid, F.lds, (const char*)(F.ws + WS_H), 2048u, 2048u, 1024, S, E); }
        xcd_barrier(bar, F.tid);
        REFRESH();
        for (int rep = 0; rep < DUP(8); ++rep) if (PH(8)) { MoeDownOrder S{ntiles * 4, F.G, (int)blockIdx.x, (const LAS int*)(F.lds + TT_OFF), (const char*)(F.ws + WS_WDP + (size_t)l * 24 * 1024 * 512 * 2)};
          EpiDown E{(bf16_t*)(F.ws + WS_M), list, cnt};
          pg8::gemm_phase<EpiDown, MoeDownOrder, true>(F.tid, F.lds, (const char*)(F.ws + WS_PROJ), 1024u, 1024u, 512, S, E); }
        xcd_barrier(bar, F.tid);
    }
        REFRESH();
    for (int rep = 0; rep < DUP(9); ++rep) if (PH(9)) phase_final(F, (DEPTH == 1) ? F.inp(F_X) : XA, DEPTH - 1);
}

extern "C" void kernel_launch(void* const* d_in, const int* in_sizes, int n_in, void* d_out, int out_size, void* d_ws, size_t ws_size, hipStream_t stream) {
    static int grid = 0;
    if (grid == 0) {
        if (n_in != 26 || in_sizes[0] != T * D || out_size != T * D || ws_size < WS_END) { fprintf(stderr, "kernel_launch: unexpected shapes (n_in %d, in0 %d, out %d, ws %zu)\n", n_in, n_in > 0 ? in_sizes[0] : -1, out_size, ws_size); grid = -1; return; }
        int dev = 0, cus = 0, per_cu = 0;
        if (hipGetDevice(&dev) != hipSuccess || hipDeviceGetAttribute(&cus, hipDeviceAttributeMultiprocessorCount, dev) != hipSuccess) { grid = -1; return; }
        if (hipFuncSetAttribute((const void*)mk_fwd, hipFuncAttributeMaxDynamicSharedMemorySize, LDS_BYTES) != hipSuccess) { fprintf(stderr, "kernel_launch: hipFuncSetAttribute failed\n"); grid = -1; return; }
        if (hipOccupancyMaxActiveBlocksPerMultiprocessor(&per_cu, (const void*)mk_fwd, 512, LDS_BYTES) != hipSuccess || per_cu < 1) fprintf(stderr, "kernel_launch: occupancy query reports %d\n", per_cu);
        (void)hipGetLastError();
        if (cus != 256) fprintf(stderr, "kernel_launch: built for 256 CUs, device reports %d\n", cus);
        grid = 256;
    }
    if (grid < 0) return;
    (void)hipMemsetAsync((char*)d_ws + WS_CTL, 0, CTL_ZERO_BYTES, stream);
    Args a{};
    for (int i = 0; i < 26; ++i) a.in[i] = (const float*)d_in[i];
    a.out = (float*)d_out; a.ws = (unsigned char*)d_ws;
    hipLaunchKernelGGL(mk_fwd, dim3(grid), dim3(512), LDS_BYTES, stream, a);
}
```
